# Optimizing an MI355X kernel written in HIP

```python
import math
import jax, jax.numpy as jnp
from jax import lax
import numpy as np

D_MODEL = 2048
BATCH = 4
SEQ = 4096
DEPTH = 4

MIX_WIDTH = D_MODEL
HEAD_DIM = 128
MLA_HEADS = 8
SB_HEADS = 8
MLA_WIDTH = MLA_HEADS * HEAD_DIM
SB_WIDTH = SB_HEADS * HEAD_DIM
Q_LORA_RANK = 768
KV_LORA_RANK = 512
QK_NOPE_DIM = 128
QK_ROPE_DIM = 64
V_HEAD_DIM = HEAD_DIM
MLA_QK_DIM = QK_NOPE_DIM + QK_ROPE_DIM
ROPE_THETA = 10000.0
D_FF = 5632
BLOCK_Q = 128
N_ADA = 9
DEEPNORM_ALPHA = (2.0 * DEPTH) ** 0.25
DEEPNORM_BETA = (8.0 * DEPTH) ** -0.25
FFN_RESIDUAL_WEIGHT = 0.5
LN_EPS = 1e-5
RMS_EPS = 1e-6
MASK_VALUE = -1e30
IN_COLS = Q_LORA_RANK + KV_LORA_RANK + QK_ROPE_DIM + 3 * SB_WIDTH

kernel_name = "hybrid_mla_stickbreaking_macaron_deepnorm_adaln"


def layer_norm(x, g, b):
    xf = x.astype(jnp.float32)
    mu = jnp.mean(xf, axis=-1, keepdims=True)
    var = jnp.mean(jnp.square(xf - mu), axis=-1, keepdims=True)
    y = (xf - mu) * lax.rsqrt(var + LN_EPS)
    return (y * g.astype(jnp.float32) + b.astype(jnp.float32)).astype(x.dtype)


def rms_norm(x, g):
    xf = x.astype(jnp.float32)
    y = xf * lax.rsqrt(jnp.mean(xf * xf, axis=-1, keepdims=True) + RMS_EPS)
    return (y * g.astype(jnp.float32)).astype(x.dtype)


def modulate(x, shift, scale):
    return x * (1.0 + scale[:, None, :]) + shift[:, None, :]


def swiglu_ffn(h, wi, wo):
    g, u = jnp.split(h @ wi, 2, axis=-1)
    return (jax.nn.silu(g) * u) @ wo


def rope(x, positions):
    half = QK_ROPE_DIM // 2
    inv_freq = ROPE_THETA ** (-jnp.arange(half, dtype=jnp.float32) / half)
    ang = positions.astype(jnp.float32)[..., None] * inv_freq
    cos = jnp.cos(ang)[:, :, None, :]
    sin = jnp.sin(ang)[:, :, None, :]
    xf = x.astype(jnp.float32)
    x1, x2 = xf[..., :half], xf[..., half:]
    return jnp.concatenate([x1 * cos - x2 * sin, x1 * sin + x2 * cos], axis=-1).astype(x.dtype)


def sweep_query_blocks(block_fn, q):
    B, S, H, D = q.shape
    nb = S // BLOCK_Q
    qb = q.reshape(B, nb, BLOCK_Q, H, D).transpose(1, 0, 2, 3, 4)
    out = lax.map(lambda args: block_fn(args[0], args[1]), (qb, jnp.arange(nb)))
    Dv = out.shape[-1]
    return out.transpose(1, 0, 2, 3, 4).reshape(B, S, H * Dv)


def causal_softmax_attention(q, k, v):
    S = k.shape[1]
    scale = q.shape[-1] ** -0.5
    k_idx = jnp.arange(S)

    def block(q_blk, blk):
        q_idx = blk * BLOCK_Q + jnp.arange(BLOCK_Q)
        s = jnp.einsum('bthd,bshd->bhts', q_blk, k).astype(jnp.float32) * scale
        mask = k_idx[None, :] <= q_idx[:, None]
        p = jax.nn.softmax(jnp.where(mask, s, MASK_VALUE), axis=-1).astype(v.dtype)
        return jnp.einsum('bhts,bshd->bthd', p, v)

    return sweep_query_blocks(block, q)


def stick_breaking_attention(q, k, v):
    S = k.shape[1]
    scale = q.shape[-1] ** -0.5
    k_idx = jnp.arange(S)

    def block(q_blk, blk):
        q_idx = blk * BLOCK_Q + jnp.arange(BLOCK_Q)
        z = jnp.einsum('bthd,bshd->bhts', q_blk, k).astype(jnp.float32) * scale
        mask = k_idx[None, :] < q_idx[:, None]
        log_beta = jax.nn.log_sigmoid(z)
        log_one_minus = jnp.where(mask, jax.nn.log_sigmoid(-z), 0.0)
        key_axis = log_one_minus.ndim - 1
        tail = lax.cumsum(log_one_minus, axis=key_axis, reverse=True) - log_one_minus
        a = jnp.where(mask, jnp.exp(log_beta + tail), 0.0).astype(v.dtype)
        return jnp.einsum('bhts,bshd->bthd', a, v)

    return sweep_query_blocks(block, q)


def hybrid_token_mixer(h, positions, w_in, q_norm_g, kv_norm_g, w_uq, w_ukv,
                       mla_out_g, sb_out_g, w_o):
    B, S, _ = h.shape
    proj = h @ w_in
    o1 = Q_LORA_RANK
    o2 = o1 + KV_LORA_RANK
    o3 = o2 + QK_ROPE_DIM
    c_q, c_kv, k_rope, sb_qkv = jnp.split(proj, [o1, o2, o3], axis=-1)

    q = (rms_norm(c_q, q_norm_g) @ w_uq).reshape(B, S, MLA_HEADS, MLA_QK_DIM)
    q_mla = jnp.concatenate([q[..., :QK_NOPE_DIM], rope(q[..., QK_NOPE_DIM:], positions)], axis=-1)
    kv = (rms_norm(c_kv, kv_norm_g) @ w_ukv).reshape(B, S, MLA_HEADS, QK_NOPE_DIM + V_HEAD_DIM)
    k_nope, v_mla = kv[..., :QK_NOPE_DIM], kv[..., QK_NOPE_DIM:]
    k_pe = rope(k_rope[:, :, None, :], positions)
    k_mla = jnp.concatenate(
        [k_nope, jnp.broadcast_to(k_pe, (B, S, MLA_HEADS, QK_ROPE_DIM))], axis=-1)
    o_mla = causal_softmax_attention(q_mla, k_mla, v_mla)

    sb_qkv = sb_qkv.reshape(B, S, 3, SB_HEADS, HEAD_DIM)
    o_sb = stick_breaking_attention(sb_qkv[:, :, 0], sb_qkv[:, :, 1], sb_qkv[:, :, 2])

    o = jnp.concatenate([rms_norm(o_mla, mla_out_g), rms_norm(o_sb, sb_out_g)], axis=-1)
    return o @ w_o


def setup_inputs(seed: int = 0) -> dict:
    key = jax.random.key(seed)
    ks = jax.random.split(key, 24)
    L, D, F = DEPTH, D_MODEL, D_FF

    def normal(k, shape, std):
        return jax.random.normal(k, shape, dtype=jnp.float32) * std

    x = normal(ks[0], (BATCH, SEQ, D), 1.0)
    c = normal(ks[1], (BATCH, D), 1.0)
    start = jax.random.randint(ks[2], (BATCH, 1), 0, 1024, dtype=jnp.int32)
    positions = (start + jnp.arange(SEQ, dtype=jnp.int32)[None, :]).astype(jnp.int32)

    ada_w = normal(ks[3], (L, D, N_ADA * D), 0.1 * D ** -0.5)
    ada_b = normal(ks[4], (L, N_ADA * D), 0.01)
    ln_g = 1.0 + normal(ks[5], (L, 3, D), 0.02)
    ln_b = normal(ks[6], (L, 3, D), 0.02)
    ffn1_wi = normal(ks[7], (L, D, 2 * F), D ** -0.5)
    ffn1_wo = normal(ks[8], (L, F, D), DEEPNORM_BETA * F ** -0.5)
    w_in = normal(ks[9], (L, D, IN_COLS), D ** -0.5)
    q_norm_g = 1.0 + normal(ks[10], (L, Q_LORA_RANK), 0.02)
    kv_norm_g = 1.0 + normal(ks[11], (L, KV_LORA_RANK), 0.02)
    w_uq = normal(ks[12], (L, Q_LORA_RANK, MLA_HEADS * MLA_QK_DIM), Q_LORA_RANK ** -0.5)
    w_ukv = normal(ks[13], (L, KV_LORA_RANK, MLA_HEADS * (QK_NOPE_DIM + V_HEAD_DIM)), KV_LORA_RANK ** -0.5)
    mla_out_g = 1.0 + normal(ks[14], (L, MLA_WIDTH), 0.02)
    sb_out_g = 1.0 + normal(ks[15], (L, SB_WIDTH), 0.02)
    w_o = normal(ks[16], (L, MIX_WIDTH, D), DEEPNORM_BETA * MIX_WIDTH ** -0.5)
    ffn2_wi = normal(ks[17], (L, D, 2 * F), D ** -0.5)
    ffn2_wo = normal(ks[18], (L, F, D), DEEPNORM_BETA * F ** -0.5)
    return {"x": x, "c": c, "positions": positions,
            "ada_w": ada_w, "ada_b": ada_b, "ln_g": ln_g, "ln_b": ln_b,
            "ffn1_wi": ffn1_wi, "ffn1_wo": ffn1_wo,
            "w_in": w_in, "q_norm_g": q_norm_g, "kv_norm_g": kv_norm_g,
            "w_uq": w_uq, "w_ukv": w_ukv, "mla_out_g": mla_out_g, "sb_out_g": sb_out_g,
            "w_o": w_o, "ffn2_wi": ffn2_wi, "ffn2_wo": ffn2_wo}


def reference(x, c, positions, ada_w, ada_b, ln_g, ln_b, ffn1_wi, ffn1_wo,
              w_in, q_norm_g, kv_norm_g, w_uq, w_ukv, mla_out_g, sb_out_g,
              w_o, ffn2_wi, ffn2_wo):
    c_act = jax.nn.silu(c)
    for l in range(DEPTH):
        ada = c_act @ ada_w[l] + ada_b[l]
        sh1, sc1, g1, shm, scm, gm, sh2, sc2, g2 = jnp.split(ada, N_ADA, axis=-1)

        f = swiglu_ffn(modulate(x, sh1, sc1), ffn1_wi[l], ffn1_wo[l])
        x = layer_norm(DEEPNORM_ALPHA * x + FFN_RESIDUAL_WEIGHT * (1.0 + g1)[:, None, :] * f,
                       ln_g[l, 0], ln_b[l, 0])

        m = hybrid_token_mixer(modulate(x, shm, scm), positions, w_in[l], q_norm_g[l], kv_norm_g[l],
                               w_uq[l], w_ukv[l], mla_out_g[l], sb_out_g[l], w_o[l])
        x = layer_norm(DEEPNORM_ALPHA * x + (1.0 + gm)[:, None, :] * m, ln_g[l, 1], ln_b[l, 1])

        f = swiglu_ffn(modulate(x, sh2, sc2), ffn2_wi[l], ffn2_wo[l])
        x = layer_norm(DEEPNORM_ALPHA * x + FFN_RESIDUAL_WEIGHT * (1.0 + g2)[:, None, :] * f,
                       ln_g[l, 2], ln_b[l, 2])
    return x
```

```cpp
#include <hip/hip_runtime.h>
#include <cstdio>
#include <cstdint>
#include <cmath>
namespace pg8 {
#define PG8_LAS __attribute__((address_space(3)))
typedef unsigned short bf16_t;
typedef short bf16x8 __attribute__((ext_vector_type(8)));
typedef float f32x4 __attribute__((ext_vector_type(4)));
typedef unsigned u32x4 __attribute__((ext_vector_type(4)));
constexpr int BM = 256, BK = 64, HALF = 128, HTB = HALF * BK * 2  , STAGE_BYTES = 8 * HTB, NXCD = 8, WGM = 8;

__host__ __device__ __forceinline__ int lds_byte(int r, int c) { const int st = (r >> 4) * 2 + (c >> 5), rr = r & 15, cc = c & 31, ob = rr * 64 + cc * 2; return st * 1024 + (ob ^ (((ob >> 9) & 1) << 5)); }
__host__ __device__ __forceinline__ void stage_rc(int b, int& R, int& C) { const int st = b / 1024, sb = b % 1024, swz = sb ^ (((sb >> 9) & 1) << 5); R = (st >> 1) * 16 + swz / 64; C = (st & 1) * 32 + (swz % 64) / 2; }
__host__ __device__ __forceinline__ int perm32(int rho) { const int n = rho >> 4, i = rho & 15; return 8 * (i >> 2) + 4 * n + (i & 3); }

struct Unit { int pm, pn; };
struct Gemm { const bf16_t* A; const bf16_t* Bt; int M, N, K; };

struct StaticOrder {
    int nM, nN, nwg, G, c;
    __host__ __device__ void init(int M, int N, int G_, int c_) { nM = M / BM; nN = N / BM; nwg = nM * nN; G = G_; c = c_; }
    __host__ __device__ bool next(int i, Unit& u) const {
        const long L = (long)i * G + c; if (L >= nwg) return false;
        int wgid = (int)L; { const int q = nwg / NXCD, r = nwg % NXCD, xcd = wgid % NXCD, off = wgid / NXCD; wgid = (xcd < r ? xcd * (q + 1) : r * (q + 1) + (xcd - r) * q) + off; }
        const int nig = WGM * nN, gid = wgid / nig, fm = gid * WGM, gsz = (nM - fm) < WGM ? (nM - fm) : WGM;
        u.pm = fm + ((wgid % nig) % gsz); u.pn = (wgid % nig) / gsz; return true;
    }
    __device__ __forceinline__ void a_ready(const Unit&) const {}
    __device__ __forceinline__ void done(const Unit&) const {}
};


__device__ __forceinline__ unsigned cvt_pk_bf16(float lo, float hi) { unsigned r; asm volatile("v_cvt_pk_bf16_f32 %0, %1, %2" : "=v"(r) : "v"(lo), "v"(hi)); return r; }
typedef float f32x2 __attribute__((ext_vector_type(2)));
__device__ __forceinline__ u32x4 pack8bf(const f32x4 v0, const f32x4 v1) { u32x4 w; w.x = cvt_pk_bf16(v0[0], v0[1]); w.y = cvt_pk_bf16(v0[2], v0[3]); w.z = cvt_pk_bf16(v1[0], v1[1]); w.w = cvt_pk_bf16(v1[2], v1[3]); return w; }

struct EpiPlain {
    static constexpr bool PERM = true, AFTER_DRAIN = false;
    bf16_t* O; int ldc;
    __device__ __forceinline__ void operator()(const f32x4 (&acc)[2][2][4][2], const Unit& u, int wr, int wc, int fr, int fq) const {
        const int row0 = u.pm * BM + wr * 64 + fr; const int col0 = u.pn * BM + wc * 32 + 8 * fq;
#pragma unroll
        for (int ai = 0; ai < 2; ++ai)
#pragma unroll
            for (int m = 0; m < 4; ++m) { bf16_t* rowp = O + (size_t)(row0 + ai * HALF + m * 16) * ldc + col0;
#pragma unroll
                for (int bj = 0; bj < 2; ++bj) *(u32x4*)(rowp + bj * HALF) = pack8bf(acc[ai][bj][m][0], acc[ai][bj][m][1]); }
    }
};

struct EpiSwiGLU {
    static constexpr bool PERM = true, AFTER_DRAIN = false;
    bf16_t* O; int ldc;
    __device__ __forceinline__ static f32x4 sg(const f32x4 g, const f32x4 up) {
        f32x4 r;
#pragma unroll
        for (int i = 0; i < 4; ++i) { const float e = __builtin_amdgcn_exp2f(g[i] * -1.4426950408889634f); r[i] = g[i] * __builtin_amdgcn_rcpf(1.0f + e) * up[i]; }
        return r;
    }
    __device__ __forceinline__ void operator()(const f32x4 (&acc)[2][2][4][2], const Unit& u, int wr, int wc, int fr, int fq) const {
        const int row0 = u.pm * BM + wr * 64 + fr; const int col0 = u.pn * HALF + wc * 32 + 8 * fq;
#pragma unroll
        for (int ai = 0; ai < 2; ++ai)
#pragma unroll
            for (int m = 0; m < 4; ++m) { bf16_t* rowp = O + (size_t)(row0 + ai * HALF + m * 16) * ldc + col0;
                const f32x4 h0 = sg(acc[ai][0][m][0], acc[ai][1][m][0]), h1 = sg(acc[ai][0][m][1], acc[ai][1][m][1]);
                *(u32x4*)rowp = pack8bf(h0, h1); }
    }
};

__device__ __forceinline__ void rope8(f32x4& v0, f32x4& v1, const f32x4 cs0, const f32x4 cs1) {
    const float a0 = v0[0], b0 = v0[1], a1 = v0[2], b1 = v0[3], a2 = v1[0], b2 = v1[1], a3 = v1[2], b3 = v1[3];
    v0[0] = a0 * cs0[0] - b0 * cs0[1]; v0[1] = a0 * cs0[1] + b0 * cs0[0];
    v0[2] = a1 * cs0[2] - b1 * cs0[3]; v0[3] = a1 * cs0[3] + b1 * cs0[2];
    v1[0] = a2 * cs1[0] - b2 * cs1[1]; v1[1] = a2 * cs1[1] + b2 * cs1[0];
    v1[2] = a3 * cs1[2] - b3 * cs1[3]; v1[3] = a3 * cs1[3] + b3 * cs1[2];
}

struct EpiWin {
    static constexpr bool PERM = true, AFTER_DRAIN = false;
    bf16_t *CQ, *CKV, *SBQ, *SBK, *SBV, *KPE; float* SSQ; const float* ROPE; float sbq_scale;
    __device__ __forceinline__ void operator()(const f32x4 (&acc)[2][2][4][2], const Unit& u, int wr, int wc, int fr, int fq) const {
        const int pn = u.pn; const int row0 = u.pm * BM + wr * 64 + fr;
        if (pn < 17) {
            bf16_t* base; int ldc, colt; float sc = 1.0f; const bool ssq = pn < 5;
            if (pn < 3) { base = CQ; ldc = 768; colt = pn * BM; }
            else if (pn < 5) { base = CKV; ldc = 512; colt = (pn - 3) * BM; }
            else if (pn < 9) { base = SBQ; ldc = 1024; colt = (pn - 5) * BM; sc = sbq_scale; }
            else if (pn < 13) { base = SBK; ldc = 1024; colt = (pn - 9) * BM; }
            else { base = SBV; ldc = 1024; colt = (pn - 13) * BM; }
            const int col0 = colt + wc * 32 + 8 * fq;
#pragma unroll
            for (int ai = 0; ai < 2; ++ai)
#pragma unroll
                for (int m = 0; m < 4; ++m) { const int row = row0 + ai * HALF + m * 16; bf16_t* rowp = base + (size_t)row * ldc + col0; float s = 0.f;
#pragma unroll
                    for (int bj = 0; bj < 2; ++bj) { const f32x4 v0 = acc[ai][bj][m][0] * sc, v1 = acc[ai][bj][m][1] * sc;
                        s += (v0[0] * v0[0] + v0[1] * v0[1]) + (v0[2] * v0[2] + v0[3] * v0[3]) + (v1[0] * v1[0] + v1[1] * v1[1]) + (v1[2] * v1[2] + v1[3] * v1[3]);
                        *(u32x4*)(rowp + bj * HALF) = pack8bf(v0, v1); }
                    if (ssq) { s += __shfl_xor(s, 16); s += __shfl_xor(s, 32); if (fq == 0) SSQ[((size_t)row * 5 + pn) * 4 + wc] = s; } }
        } else if (wc < 2) {
            const int c0 = wc * 32 + 8 * fq;
#pragma unroll
            for (int ai = 0; ai < 2; ++ai)
#pragma unroll
                for (int m = 0; m < 4; ++m) { const int row = row0 + ai * HALF + m * 16;
                    const f32x4 cs0 = *(const f32x4*)(ROPE + (size_t)row * 64 + c0), cs1 = *(const f32x4*)(ROPE + (size_t)row * 64 + c0 + 4);
                    f32x4 v0 = acc[ai][0][m][0], v1 = acc[ai][0][m][1]; rope8(v0, v1, cs0, cs1);
                    *(u32x4*)(KPE + (size_t)row * 64 + c0) = pack8bf(v0, v1); }
        }
    }
};

template <bool ROPE_Q> struct EpiRS {
    static constexpr bool PERM = true, AFTER_DRAIN = false;
    bf16_t* O; int ldc; const float* SSQ; int t0, nt; float invn, eps, oscale; const float* ROPE;
    __device__ __forceinline__ void operator()(const f32x4 (&acc)[2][2][4][2], const Unit& u, int wr, int wc, int fr, int fq) const {
        const int row0 = u.pm * BM + wr * 64 + fr; const int col0 = u.pn * BM + wc * 32 + 8 * fq;
        float rsv[2][4];
#pragma unroll
        for (int ai = 0; ai < 2; ++ai)
#pragma unroll
            for (int m = 0; m < 4; ++m) { const int row = row0 + ai * HALF + m * 16; f32x4 q = {0.f, 0.f, 0.f, 0.f};
                if (fq < nt) q = *(const f32x4*)(SSQ + ((size_t)row * 5 + t0 + fq) * 4);
                rsv[ai][m] = (q[0] + q[1]) + (q[2] + q[3]); }
#pragma unroll
        for (int ai = 0; ai < 2; ++ai)
#pragma unroll
            for (int m = 0; m < 4; ++m) { float ss = rsv[ai][m]; ss += __shfl_xor(ss, 16); ss += __shfl_xor(ss, 32); rsv[ai][m] = oscale / sqrtf(ss * invn + eps); }
#pragma unroll
        for (int ai = 0; ai < 2; ++ai)
#pragma unroll
            for (int m = 0; m < 4; ++m) { const int row = row0 + ai * HALF + m * 16;
                const float rs = rsv[ai][m];
#pragma unroll
                for (int bj = 0; bj < 2; ++bj) { const int c = col0 + bj * HALF; f32x4 v0 = acc[ai][bj][m][0] * rs, v1 = acc[ai][bj][m][1] * rs;
                    if (ROPE_Q) { const int w = c % 192; if (w >= 128) { const float* cs = ROPE + (size_t)row * 64 + (w - 128); rope8(v0, v1, *(const f32x4*)cs, *(const f32x4*)(cs + 4)); } }
                    *(u32x4*)(O + (size_t)row * ldc + c) = pack8bf(v0, v1); } }
    }
};

template <class Epi, class Sched, bool ALIGN_EPI = false, bool SP2 = false>
__device__ __forceinline__ void gemm_phase(PG8_LAS unsigned char* lds, const Gemm g, const Sched& S, const Epi& E) {
    int tid_ = threadIdx.x; asm volatile("" : "+v"(tid_));
    const int tid = tid_, wid = __builtin_amdgcn_readfirstlane(tid >> 6), lane = tid & 63, wr = wid >> 2, wc = wid & 3, fr = lane & 15, fq = lane >> 4;
    const int K = g.K, nt = K / BK;
    unsigned voffA[2], voffB[2];
#pragma unroll
    for (int i = 0; i < 2; ++i) { int R, C; stage_rc(tid * 16 + i * 8192, R, C); const int Rb = Epi::PERM ? ((R & ~31) + perm32(R & 31)) : R;
        voffA[i] = (unsigned)(R * K + C) * 2u; voffB[i] = (unsigned)(Rb * K + C) * 2u; }
    const size_t kstep = (size_t)(BK * 2);
    const size_t hstep = (size_t)HALF * K * 2;
    const size_t tstep = 2 * hstep;
    const unsigned ldsw = (unsigned)wid * 1024u;
    const int aoff = lds_byte(wr * 64 + fr, fq * 8), boff = lds_byte(wc * 32 + fr, fq * 8);
#define PG8_SA(b, h) (((b) * 2 + (h)) * HTB)
#define PG8_SB(b, h) ((4 + (b) * 2 + (h)) * HTB)
#define PG8_STAGE(bufoff, gbase, voff) do { _Pragma("unroll") for (int _i = 0; _i < 2; ++_i) \
        __builtin_amdgcn_global_load_lds((const unsigned*)((const char*)(gbase) + (voff)[_i]), (PG8_LAS unsigned*)(lds + (bufoff) + ldsw + _i * 8192), 16, 0, 0); } while (0)
#define PG8_LDA(dst, b, h) do { _Pragma("unroll") for (int m = 0; m < 4; ++m) _Pragma("unroll") for (int k = 0; k < 2; ++k) dst[m][k] = *(const PG8_LAS bf16x8*)(lds + PG8_SA(b, h) + aoff + m * 2048 + k * 1024); } while (0)
#define PG8_LDB(dst, b, h) do { _Pragma("unroll") for (int n = 0; n < 2; ++n) _Pragma("unroll") for (int k = 0; k < 2; ++k) dst[n][k] = *(const PG8_LAS bf16x8*)(lds + PG8_SB(b, h) + boff + n * 2048 + k * 1024); } while (0)
#define PG8_MMA(ai, bj, At, Bt) do { __builtin_amdgcn_s_setprio(1); _Pragma("unroll") for (int m = 0; m < 4; ++m) _Pragma("unroll") for (int n = 0; n < 2; ++n) _Pragma("unroll") for (int k = 0; k < 2; ++k) \
        acc[ai][bj][m][n] = __builtin_amdgcn_mfma_f32_16x16x32_bf16(Bt[n][k], At[m][k], acc[ai][bj][m][n], 0, 0, 0); __builtin_amdgcn_s_setprio(0); } while (0)
#define PG8_WAIT_V(n) asm volatile("s_waitcnt vmcnt(" #n ")" ::: "memory")
#define PG8_WAIT_L(n) asm volatile("s_waitcnt lgkmcnt(" #n ")" ::: "memory")
#define PG8_BAR __builtin_amdgcn_s_barrier()
#define PG8_SCHED __builtin_amdgcn_sched_barrier(0)
    Unit cur, nxt; int ui = 0;
    if (!S.next(0, cur)) return;
    f32x4 acc[2][2][4][2];
#pragma unroll
    for (int a = 0; a < 2; ++a)
#pragma unroll
        for (int b = 0; b < 2; ++b)
#pragma unroll
            for (int m = 0; m < 4; ++m)
#pragma unroll
                for (int n = 0; n < 2; ++n) acc[a][b][m][n] = (f32x4){0.f, 0.f, 0.f, 0.f};
    bf16x8 At[4][2], B0[2][2], B1[2][2];
    const char* cA = (const char*)g.A + (size_t)cur.pm * tstep; const char* cB = (const char*)g.Bt + (size_t)cur.pn * tstep;
    S.a_ready(cur);
    if constexpr (SP2) {
        PG8_STAGE(PG8_SB(0, 0), cB, voffB); PG8_STAGE(PG8_SB(0, 1), cB + hstep, voffB); PG8_STAGE(PG8_SA(0, 0), cA, voffA); PG8_STAGE(PG8_SA(0, 1), cA + hstep, voffA);
        if (wr == 1) PG8_BAR;
        PG8_WAIT_V(2); PG8_BAR;
        PG8_STAGE(PG8_SB(1, 0), cB + kstep, voffB); PG8_STAGE(PG8_SA(1, 0), cA + kstep, voffA); PG8_STAGE(PG8_SB(1, 1), cB + hstep + kstep, voffB);
        PG8_WAIT_V(6); PG8_BAR;
    } else {
        PG8_STAGE(PG8_SB(0, 0), cB, voffB); PG8_STAGE(PG8_SA(0, 0), cA, voffA); PG8_STAGE(PG8_SB(0, 1), cB + hstep, voffB); PG8_STAGE(PG8_SA(0, 1), cA + hstep, voffA);
        if (wr == 1) PG8_BAR;
        PG8_WAIT_V(4); PG8_BAR;
        PG8_STAGE(PG8_SB(1, 0), cB + kstep, voffB); PG8_STAGE(PG8_SA(1, 0), cA + kstep, voffA); PG8_STAGE(PG8_SB(1, 1), cB + hstep + kstep, voffB);
        PG8_WAIT_V(6); PG8_BAR;
    }
    for (;;) {
        const bool has_next = S.next(ui + 1, nxt);
        const char* nA = has_next ? (const char*)g.A + (size_t)nxt.pm * tstep : cA; const char* nB = has_next ? (const char*)g.Bt + (size_t)nxt.pn * tstep : cB;
        for (int t = 0; t < nt; t += 2) {
            const bool last = (t == nt - 2);
            const char* a1 = cA + (size_t)(t + 1) * kstep;
            const char* a2 = last ? nA : cA + (size_t)(t + 2) * kstep; const char* b2 = last ? nB : cB + (size_t)(t + 2) * kstep;
            const char* a3 = a2 + kstep; const char* b3 = b2 + kstep;
            if (last && has_next) S.a_ready(nxt);
            if constexpr (SP2) {
            PG8_LDB(B0, 0, 0); PG8_LDB(B1, 0, 1); PG8_SCHED; PG8_LDA(At, 0, 0); PG8_STAGE(PG8_SA(1, 1), a1 + hstep, voffA);
            PG8_WAIT_V(8); PG8_WAIT_L(0); PG8_BAR; PG8_MMA(0, 0, At, B0); PG8_MMA(0, 1, At, B1); PG8_BAR; PG8_SCHED;
            PG8_LDA(At, 0, 1); PG8_STAGE(PG8_SB(0, 0), b2, voffB); PG8_STAGE(PG8_SB(0, 1), b2 + hstep, voffB); PG8_STAGE(PG8_SA(0, 0), a2, voffA);
            PG8_WAIT_V(8); PG8_WAIT_L(0); PG8_BAR; PG8_MMA(1, 0, At, B0); PG8_MMA(1, 1, At, B1); PG8_BAR; PG8_SCHED;
            PG8_LDB(B0, 1, 0); PG8_LDB(B1, 1, 1); PG8_SCHED; PG8_LDA(At, 1, 0); PG8_STAGE(PG8_SA(0, 1), a2 + hstep, voffA);
            PG8_WAIT_V(8); PG8_WAIT_L(0); PG8_BAR; PG8_MMA(0, 0, At, B0); PG8_MMA(0, 1, At, B1); PG8_BAR; PG8_SCHED;
            PG8_LDA(At, 1, 1); PG8_STAGE(PG8_SB(1, 0), b3, voffB); PG8_STAGE(PG8_SB(1, 1), b3 + hstep, voffB); PG8_STAGE(PG8_SA(1, 0), a3, voffA);
            PG8_WAIT_V(8); PG8_WAIT_L(0); PG8_BAR; PG8_MMA(1, 0, At, B0); PG8_MMA(1, 1, At, B1); PG8_BAR; PG8_SCHED;
            } else {
            PG8_LDB(B0, 0, 0); PG8_SCHED; PG8_LDA(At, 0, 0); PG8_STAGE(PG8_SA(1, 1), a1 + hstep, voffA);
            PG8_WAIT_L(8); PG8_BAR; PG8_WAIT_L(0); PG8_MMA(0, 0, At, B0); PG8_BAR; PG8_SCHED;
            PG8_LDB(B1, 0, 1); PG8_STAGE(PG8_SB(0, 0), b2, voffB);
            PG8_BAR; PG8_WAIT_L(0); PG8_MMA(0, 1, At, B1); PG8_BAR;
            PG8_LDA(At, 0, 1); PG8_STAGE(PG8_SA(0, 0), a2, voffA);
            PG8_BAR; PG8_WAIT_L(0); PG8_MMA(1, 0, At, B0); PG8_BAR; PG8_SCHED;
            PG8_STAGE(PG8_SB(0, 1), b2 + hstep, voffB);
            PG8_WAIT_V(6); PG8_BAR; PG8_MMA(1, 1, At, B1); PG8_BAR;
            PG8_LDB(B0, 1, 0); PG8_SCHED; PG8_LDA(At, 1, 0); PG8_STAGE(PG8_SA(0, 1), a2 + hstep, voffA);
            PG8_WAIT_L(8); PG8_BAR; PG8_WAIT_L(0); PG8_MMA(0, 0, At, B0); PG8_BAR; PG8_SCHED;
            PG8_LDB(B1, 1, 1); PG8_STAGE(PG8_SB(1, 0), b3, voffB);
            PG8_BAR; PG8_WAIT_L(0); PG8_MMA(0, 1, At, B1); PG8_BAR;
            PG8_LDA(At, 1, 1); PG8_STAGE(PG8_SA(1, 0), a3, voffA);
            PG8_BAR; PG8_WAIT_L(0); PG8_MMA(1, 0, At, B0); PG8_BAR; PG8_SCHED;
            PG8_STAGE(PG8_SB(1, 1), b3 + hstep, voffB);
            PG8_WAIT_V(6); PG8_BAR; PG8_MMA(1, 1, At, B1); PG8_BAR;
            }
        }
        if constexpr (ALIGN_EPI) { if (wr == 0) PG8_BAR; }
        if constexpr (!Epi::AFTER_DRAIN) { E(acc, cur, wr, wc, fr, fq); S.done(cur); }
        if (!has_next) break;
#pragma unroll
        for (int a = 0; a < 2; ++a)
#pragma unroll
            for (int b = 0; b < 2; ++b)
#pragma unroll
                for (int m = 0; m < 4; ++m)
#pragma unroll
                    for (int n = 0; n < 2; ++n) acc[a][b][m][n] = (f32x4){0.f, 0.f, 0.f, 0.f};
        cur = nxt; cA = nA; cB = nB; ++ui;
        if constexpr (ALIGN_EPI) { if (wr == 1) PG8_BAR; }
    }
    PG8_WAIT_V(0);
    if constexpr (!ALIGN_EPI) { if (wr == 0) PG8_BAR; }
    PG8_BAR;
    if constexpr (Epi::AFTER_DRAIN) { E.fused(acc, cur, wr, wc, fr, fq, lds, wid, lane); S.done(cur); }
#undef PG8_SA
#undef PG8_SB
#undef PG8_STAGE
#undef PG8_LDA
#undef PG8_LDB
#undef PG8_MMA
#undef PG8_WAIT_V
#undef PG8_WAIT_L
#undef PG8_BAR
#undef PG8_SCHED
}
}


namespace att {
typedef unsigned short bf16_t;
typedef short bf16x8 __attribute__((ext_vector_type(8)));
typedef short s16x4 __attribute__((ext_vector_type(4)));
typedef float f32x16 __attribute__((ext_vector_type(16)));
typedef float f32x4 __attribute__((ext_vector_type(4)));
typedef unsigned u32x4 __attribute__((ext_vector_type(4)));
#define ATT_LAS __attribute__((address_space(3)))
#ifndef SB_EARLY_EXIT
#define SB_EARLY_EXIT 1
#endif
constexpr int KVBLK = 64, QB = 256;
constexpr int SHM_V = 16384, SHM_K = 16384, SHM_R = 8192;
constexpr int OFF_V = 0, OFF_K = 2 * SHM_V, OFF_R = OFF_K + 2 * SHM_K, OFF_WS = OFF_R + 2 * SHM_R, OFF_FLAG = OFF_WS + 8 * 256, OFF_QR = OFF_FLAG + 64, ATT_LDS_BYTES = OFF_QR + 8 * 4096;
#define KSWZ(row, colB) ((row) * 256 + ((colB) ^ (((row) & 7) << 4)))
#define RSWZ(row, colB) ((row) * 128 + ((colB) ^ (((row) & 7) << 4)))
#define SBAR() __builtin_amdgcn_sched_barrier(0)
__device__ __forceinline__ int v_st(int k, int c) { const int kk = (k & ~0xC) | ((k & 4) << 1) | ((k & 8) >> 1); return ((kk >> 3) * 4 + (c >> 5)) * 512 + ((kk & 7) * 32 + (c & 31)) * 2; }
__device__ __forceinline__ int v_rd_base(int lane) { return ((lane & 3) << 3) | (((lane >> 2) & 3) << 6) | (((lane >> 4) & 1) << 5) | (((lane >> 5) & 1) << 8); }
__device__ __forceinline__ int crow(int r, int hi) { return (r & 3) + 8 * (r >> 2) + 4 * hi; }
__device__ __forceinline__ unsigned cvtpk(float lo, float hi) { unsigned r; asm volatile("v_cvt_pk_bf16_f32 %0, %1, %2" : "=v"(r) : "v"(lo), "v"(hi)); return r; }
__device__ __forceinline__ float other_half(float x, int hi) { auto rr = __builtin_amdgcn_permlane32_swap(__float_as_uint(x), __float_as_uint(x), false, false); return __uint_as_float(hi ? rr[0] : rr[1]); }

__device__ __forceinline__ void pack_p(const f32x16& p0, const f32x16& p1, bf16x8& pa0, bf16x8& pa1, bf16x8& pa2, bf16x8& pa3) {
#define PK4(P, B_, OUT) do { unsigned a0 = cvtpk(P[B_+0], P[B_+1]), a1 = cvtpk(P[B_+2], P[B_+3]);                          \
        unsigned b0 = cvtpk(P[B_+4], P[B_+5]), b1 = cvtpk(P[B_+6], P[B_+7]);                                             \
        auto r0 = __builtin_amdgcn_permlane32_swap(a0, b0, false, false); auto r1 = __builtin_amdgcn_permlane32_swap(a1, b1, false, false); \
        u32x4 w = {r0[0], r1[0], r0[1], r1[1]}; OUT = __builtin_bit_cast(bf16x8, w); } while (0)
    PK4(p0, 0, pa0); PK4(p0, 8, pa1); PK4(p1, 0, pa2); PK4(p1, 8, pa3);
#undef PK4
}
__device__ __forceinline__ void pv_tile(f32x16* o, int vb, bf16x8 pa0, bf16x8 pa1, bf16x8 pa2, bf16x8 pa3) {
#define TRRD(dst, off) asm volatile("ds_read_b64_tr_b16 %0, %1 offset:%2" : "=&v"(dst) : "v"(vb), "i"(off) : "memory")
#define PV_D0(d0) do { s16x4 l0, l1, l2, l3, h0, h1, h2, h3; constexpr int b_ = (d0) * 512;   \
        TRRD(l0, b_); TRRD(h0, b_ + 2048); TRRD(l1, b_ + 4096); TRRD(h1, b_ + 6144); TRRD(l2, b_ + 8192); TRRD(h2, b_ + 10240); TRRD(l3, b_ + 12288); TRRD(h3, b_ + 14336); \
        asm volatile("s_waitcnt lgkmcnt(0)" ::: "memory"); SBAR();   \
        o[d0] = __builtin_amdgcn_mfma_f32_32x32x16_bf16(pa0, (bf16x8){l0[0], l0[1], l0[2], l0[3], h0[0], h0[1], h0[2], h0[3]}, o[d0], 0, 0, 0);   \
        o[d0] = __builtin_amdgcn_mfma_f32_32x32x16_bf16(pa1, (bf16x8){l1[0], l1[1], l1[2], l1[3], h1[0], h1[1], h1[2], h1[3]}, o[d0], 0, 0, 0);   \
        o[d0] = __builtin_amdgcn_mfma_f32_32x32x16_bf16(pa2, (bf16x8){l2[0], l2[1], l2[2], l2[3], h2[0], h2[1], h2[2], h2[3]}, o[d0], 0, 0, 0);   \
        o[d0] = __builtin_amdgcn_mfma_f32_32x32x16_bf16(pa3, (bf16x8){l3[0], l3[1], l3[2], l3[3], h3[0], h3[1], h3[2], h3[3]}, o[d0], 0, 0, 0); } while (0)
    PV_D0(0); PV_D0(1); PV_D0(2); PV_D0(3);
#undef PV_D0
#undef TRRD
}

template <bool SB>
__device__ __forceinline__ void attn_block(ATT_LAS unsigned char* lds, const bf16_t* Qg, int ldq, const bf16_t* Kg, int ldk, const bf16_t* Vg, int ldv, const bf16_t* Rg, bf16_t* Og, int ldo, int P0) {
    constexpr int NQ = 8;
    int tid_ = threadIdx.x; asm volatile("" : "+v"(tid_));
    const int tid = tid_, wid = __builtin_amdgcn_readfirstlane(tid >> 6), lane = tid & 63, r32 = lane & 31, hi = lane >> 5;
    const int qlo = P0 + wid * 32;
    const int NT = (P0 + QB) / KVBLK;
    ATT_LAS unsigned char* V_lds = lds + OFF_V; ATT_LAS unsigned char* K_lds = lds + OFF_K; ATT_LAS unsigned char* R_lds = lds + OFF_R;
    ATT_LAS float* ws = (ATT_LAS float*)(lds + OFF_WS) + wid * 64;
    ATT_LAS unsigned* flags = (ATT_LAS unsigned*)(lds + OFF_FLAG);
    const int sr = tid >> 4, sc = (tid & 15) * 8, rr = tid >> 3, rc = (tid & 7) * 8;
    const int vst0 = v_st(sr, sc), vst1 = v_st(32 + sr, sc), kws = KSWZ(sr, sc * 2), rws = RSWZ(rr, rc * 2);
    const int vb0 = (int)(unsigned)(uintptr_t)V_lds + v_rd_base(lane);
    bf16x8 qr[NQ];
#pragma unroll
    for (int d0 = 0; d0 < NQ; ++d0) qr[d0] = *(const bf16x8*)(Qg + (size_t)(wid * 32 + r32) * ldq + d0 * 16 + hi * 8);
    ATT_LAS unsigned char* qsl = lds + OFF_QR + wid * 4096 + lane * 16;
    if (!SB) {
#pragma unroll
        for (int d0 = 0; d0 < 4; ++d0) *(ATT_LAS bf16x8*)(qsl + d0 * 1024) = *(const bf16x8*)(Qg + (size_t)(wid * 32 + r32) * ldq + 128 + d0 * 16 + hi * 8);
    }
    bf16x8 st_k0, st_k1, st_v0, st_v1, st_r;
#define STAGE_LOAD(t_) do { const size_t k0_ = (size_t)(t_) * KVBLK;                                                                   \
        st_k0 = *(const bf16x8*)(Kg + (k0_ + sr) * ldk + sc); st_k1 = *(const bf16x8*)(Kg + (k0_ + 32 + sr) * ldk + sc);               \
        st_v0 = *(const bf16x8*)(Vg + (k0_ + sr) * ldv + sc); st_v1 = *(const bf16x8*)(Vg + (k0_ + 32 + sr) * ldv + sc);               \
        if (!SB) st_r = *(const bf16x8*)(Rg + (k0_ + rr) * 64 + rc); } while (0)
#define STAGE_WRITE(bf_) do { *(ATT_LAS bf16x8*)(K_lds + (bf_) * SHM_K + kws) = st_k0; *(ATT_LAS bf16x8*)(K_lds + (bf_) * SHM_K + kws + 32 * 256) = st_k1;   \
        *(ATT_LAS bf16x8*)(V_lds + (bf_) * SHM_V + vst0) = st_v0; *(ATT_LAS bf16x8*)(V_lds + (bf_) * SHM_V + vst1) = st_v1;                                  \
        if (!SB) *(ATT_LAS bf16x8*)(R_lds + (bf_) * SHM_R + rws) = st_r; } while (0)
    f32x16 o[4];
#pragma unroll
    for (int d = 0; d < 4; ++d)
#pragma unroll
        for (int r = 0; r < 16; ++r) o[d][r] = 0.f;
    float m_reg = -1e30f, l_reg = 0.f, R = 0.f;
    int kro[4];
#pragma unroll
    for (int dd = 0; dd < 4; ++dd) kro[dd] = KSWZ(r32, (dd * 16 + hi * 8) * 2);
    STAGE_LOAD(SB ? NT - 1 : 0);
    asm volatile("s_waitcnt vmcnt(0)" ::: "memory");
    STAGE_WRITE(0);
    __syncthreads();
    for (int it = 0; it < NT; ++it) {
        const int t = SB ? NT - 1 - it : it; const int buf = it & 1; const bool more = it + 1 < NT;
        if (more) STAGE_LOAD(SB ? t - 1 : t + 1);
        const int kb = t * KVBLK;
        if (kb <= qlo + 31) {
            f32x16 p0, p1;
#pragma unroll
            for (int r = 0; r < 16; ++r) { p0[r] = 0.f; p1[r] = 0.f; }
            ATT_LAS const unsigned char* kt = K_lds + buf * SHM_K;
#pragma unroll
            for (int d0 = 0; d0 < 8; ++d0) { ATT_LAS const unsigned char* a = kt + kro[d0 & 3] + (d0 >> 2) * 128;
                const bf16x8 b0 = *(ATT_LAS const bf16x8*)a; const bf16x8 b1 = *(ATT_LAS const bf16x8*)(a + 32 * 256);
                p0 = __builtin_amdgcn_mfma_f32_32x32x16_bf16(b0, qr[d0], p0, 0, 0, 0);
                p1 = __builtin_amdgcn_mfma_f32_32x32x16_bf16(b1, qr[d0], p1, 0, 0, 0); }
            if (!SB) { ATT_LAS const unsigned char* rt = R_lds + buf * SHM_R;
#pragma unroll
                for (int d0 = 0; d0 < 4; ++d0) { ATT_LAS const unsigned char* a = rt + (kro[d0] - 128 * r32);
                    const bf16x8 b0 = *(ATT_LAS const bf16x8*)a; const bf16x8 b1 = *(ATT_LAS const bf16x8*)(a + 32 * 128);
                    const bf16x8 qf = *(ATT_LAS const bf16x8*)(qsl + d0 * 1024);
                    p0 = __builtin_amdgcn_mfma_f32_32x32x16_bf16(b0, qf, p0, 0, 0, 0);
                    p1 = __builtin_amdgcn_mfma_f32_32x32x16_bf16(b1, qf, p1, 0, 0, 0); } }
            const int dql = qlo + r32 - kb - 4 * hi - (SB ? 1 : 0);
            const bool need_mask = SB ? (kb + KVBLK - 1 >= qlo) : (kb + KVBLK - 1 > qlo);
            bf16x8 pa0, pa1, pa2, pa3;
            if (!SB) {
                if (need_mask) { const float NEG = -__builtin_inff();
#pragma unroll
                    for (int r = 0; r < 16; ++r) { const int c = (r & 3) + 8 * (r >> 2); if (c > dql) p0[r] = NEG; if (c + 32 > dql) p1[r] = NEG; } }
                float pmax = p0[0];
#pragma unroll
                for (int r = 1; r < 16; ++r) pmax = fmaxf(pmax, p0[r]);
#pragma unroll
                for (int r = 0; r < 16; ++r) pmax = fmaxf(pmax, p1[r]);
                pmax = fmaxf(pmax, other_half(pmax, hi));
                const float mn = fmaxf(m_reg, pmax); const float alpha = __builtin_amdgcn_exp2f(m_reg - mn); m_reg = mn;
                float ps = 0.f;
#pragma unroll
                for (int r = 0; r < 16; ++r) { p0[r] = __builtin_amdgcn_exp2f(p0[r] - mn); ps += p0[r]; }
#pragma unroll
                for (int r = 0; r < 16; ++r) { p1[r] = __builtin_amdgcn_exp2f(p1[r] - mn); ps += p1[r]; }
                ps += other_half(ps, hi);
                l_reg = l_reg * alpha + ps;
                if (__any(alpha < 1.f)) { if (hi == 0) ws[r32] = alpha; asm volatile("s_waitcnt lgkmcnt(0)" ::: "memory");
#pragma unroll
                    for (int r = 0; r < 16; ++r) { const float a = ws[crow(r, hi)];
#pragma unroll
                        for (int d = 0; d < 4; ++d) o[d][r] *= a; }
                    asm volatile("s_waitcnt lgkmcnt(0)" ::: "memory"); }
                pack_p(p0, p1, pa0, pa1, pa2, pa3);
            } else {
                f32x16 l0, l1;
#pragma unroll
                for (int r = 0; r < 16; ++r) { const float z = p0[r]; const float sp = fmaxf(z, 0.f) + __builtin_amdgcn_logf(1.0f + __builtin_amdgcn_exp2f(-fabsf(z))); l0[r] = -sp; p0[r] = z - sp; }
#pragma unroll
                for (int r = 0; r < 16; ++r) { const float z = p1[r]; const float sp = fmaxf(z, 0.f) + __builtin_amdgcn_logf(1.0f + __builtin_amdgcn_exp2f(-fabsf(z))); l1[r] = -sp; p1[r] = z - sp; }
                if (need_mask) { const float NEG = -__builtin_inff();
#pragma unroll
                    for (int r = 0; r < 16; ++r) { const int c = (r & 3) + 8 * (r >> 2); if (c > dql) { p0[r] = NEG; l0[r] = 0.f; } if (c + 32 > dql) { p1[r] = NEG; l1[r] = 0.f; } } }
                float T[8];
#pragma unroll
                for (int g = 0; g < 4; ++g) {
                    { const float a0 = l0[4 * g], a1 = l0[4 * g + 1], a2 = l0[4 * g + 2], a3 = l0[4 * g + 3]; const float x2 = a3, x1 = a3 + a2, x0 = x1 + a1; T[g] = x0 + a0;
                      l0[4 * g] = x0; l0[4 * g + 1] = x1; l0[4 * g + 2] = x2; l0[4 * g + 3] = 0.f; }
                    { const float a0 = l1[4 * g], a1 = l1[4 * g + 1], a2 = l1[4 * g + 2], a3 = l1[4 * g + 3]; const float x2 = a3, x1 = a3 + a2, x0 = x1 + a1; T[4 + g] = x0 + a0;
                      l1[4 * g] = x0; l1[4 * g + 1] = x1; l1[4 * g + 2] = x2; l1[4 * g + 3] = 0.f; }
                }
                float gs[8]; float run = R;
#pragma unroll
                for (int g = 7; g >= 0; --g) { const float To = other_half(T[g], hi); gs[g] = run + (hi == 0 ? To : 0.f); run += T[g] + To; }
                R = run;
#pragma unroll
                for (int g = 0; g < 4; ++g)
#pragma unroll
                    for (int i = 0; i < 4; ++i) { p0[4 * g + i] = __builtin_amdgcn_exp2f(p0[4 * g + i] + l0[4 * g + i] + gs[g]); p1[4 * g + i] = __builtin_amdgcn_exp2f(p1[4 * g + i] + l1[4 * g + i] + gs[4 + g]); }
                pack_p(p0, p1, pa0, pa1, pa2, pa3);
            }
            pv_tile(o, vb0 + buf * SHM_V, pa0, pa1, pa2, pa3);
        }
        if (more) { asm volatile("s_waitcnt vmcnt(0)" ::: "memory"); STAGE_WRITE(buf ^ 1); }
        if (SB && SB_EARLY_EXIT) { const bool dead = __all(R < -160.f); if (lane == 0) flags[buf * 8 + wid] = dead ? 1u : 0u; }
        __syncthreads();
        if (SB && SB_EARLY_EXIT) { const u32x4 f0 = *(ATT_LAS const u32x4*)(flags + buf * 8), f1 = *(ATT_LAS const u32x4*)(flags + buf * 8 + 4);
            if ((f0[0] & f0[1] & f0[2] & f0[3] & f1[0] & f1[1] & f1[2] & f1[3]) != 0u) break; }
    }
    if (!SB) { if (hi == 0) ws[32 + r32] = l_reg; asm volatile("s_waitcnt lgkmcnt(0)" ::: "memory"); }
    bf16_t* Ow = Og + (size_t)(wid * 32) * ldo;
#pragma unroll
    for (int r = 0; r < 16; ++r) { const int orow = crow(r, hi); const float rl = SB ? 1.0f : 1.0f / ws[32 + orow];
#pragma unroll
        for (int d0 = 0; d0 < 4; ++d0) { const float v = o[d0][r] * rl; const float vn = __shfl_xor(v, 1);
            if ((r32 & 1) == 0) *(unsigned*)(Ow + (size_t)orow * ldo + d0 * 32 + r32) = cvtpk(v, vn); } }
    asm volatile("s_waitcnt lgkmcnt(0)" ::: "memory");
    __syncthreads();
#undef STAGE_LOAD
#undef STAGE_WRITE
}
#undef KSWZ
#undef RSWZ
}


constexpr int NWAVES = 8;
constexpr int D = 2048, BATCH = 4, SEQ = 4096, DEPTH = 4, M = BATCH * SEQ, FF = 5632, NADA = 9;
constexpr int QLR = 768, KVLR = 512, ROPE_D = 64, NH = 8, HD = 128, QKD = 192;
constexpr int IN_COLS = QLR + KVLR + ROPE_D + 3 * NH * HD;
constexpr int WIN_ROWS = 4608;
constexpr float LN_EPS = 1e-5f, RMS_EPS = 1e-6f;
constexpr float DN_ALPHA = 1.6817928305074290f;
constexpr float LOG2E = 1.4426950408889634f;
constexpr float MLA_QSCALE = 0.07216878364870322f * LOG2E;
constexpr float SB_QSCALE = 0.08838834764831845f * LOG2E;
#ifndef MK_ONE_LAUNCH
#define MK_ONE_LAUNCH 1
#endif
constexpr int N_PHASES = 3 + 8 * 3 + 4 * 6;

constexpr size_t MiB = 1u << 20;
constexpr size_t WS_CTL = 0, CTL_ZERO_BYTES = 1 * MiB;
constexpr size_t WS_ADA = 1 * MiB;
constexpr size_t WS_ADAP = 3 * MiB;
constexpr size_t WS_ROPE = 24 * MiB;
constexpr size_t WS_SSQ = 28 * MiB;
constexpr size_t WS_KPE = 30 * MiB;
constexpr size_t WS_X = 32 * MiB;
constexpr size_t WS_H = 160 * MiB;
constexpr size_t WS_F = 224 * MiB;
constexpr size_t WS_ACT = 288 * MiB;
constexpr size_t WS_CQ = 464 * MiB;
constexpr size_t WS_CKV = 488 * MiB;
constexpr size_t WS_SBQ = 504 * MiB, WS_SBK = 536 * MiB, WS_SBV = 568 * MiB;
constexpr size_t WS_QM = 600 * MiB;
constexpr size_t WS_KV = 648 * MiB;
constexpr size_t WS_O = 712 * MiB;
constexpr size_t WS_W = 776 * MiB;
constexpr size_t W_WI = (size_t)2 * FF * D * 2, W_WO = (size_t)D * FF * 2, W_WIN = (size_t)WIN_ROWS * D * 2, W_WUQ = (size_t)NH * QKD * QLR * 2, W_WUKV = (size_t)NH * 256 * KVLR * 2, W_WOUT = (size_t)D * D * 2;
constexpr size_t WO_WI1 = 0, WO_WO1 = WO_WI1 + W_WI, WO_WI2 = WO_WO1 + W_WO, WO_WO2 = WO_WI2 + W_WI, WO_WIN = WO_WO2 + W_WO, WO_WUQ = WO_WIN + W_WIN, WO_WUKV = WO_WUQ + W_WUQ, WO_WOUT = WO_WUKV + W_WUKV;
constexpr size_t W_LAYER = WO_WOUT + W_WOUT;
constexpr size_t WS_END = WS_W + DEPTH * W_LAYER;
static_assert(W_LAYER % 256 == 0 && WS_END < (size_t)1600 * MiB, "ws map");
constexpr int ADA_KS = 16;
constexpr int CW_BAR = 4096;

constexpr int RING_OFF = 0, SCR_BYTES = 135168;
constexpr int MISC_OFF = SCR_BYTES;
constexpr int LDS_BYTES = 147456;

#define GAS __attribute__((address_space(1)))
#define LAS __attribute__((address_space(3)))
typedef unsigned short bf16;
typedef unsigned v4u __attribute__((ext_vector_type(4)));
typedef unsigned v2u __attribute__((ext_vector_type(2)));
typedef float f32x4 __attribute__((ext_vector_type(4)));
#define LDS_WAIT() asm volatile("s_waitcnt lgkmcnt(0)" ::: "memory")
#define VM_WAIT() asm volatile("s_waitcnt vmcnt(0)" ::: "memory")
__device__ __forceinline__ unsigned pk2(float lo, float hi) { unsigned r; asm volatile("v_cvt_pk_bf16_f32 %0, %1, %2" : "=v"(r) : "v"(lo), "v"(hi)); return r; }
__device__ __forceinline__ float bf_lo(unsigned w) { return __uint_as_float(w << 16); }
__device__ __forceinline__ float bf_hi(unsigned w) { return __uint_as_float(w & 0xffff0000u); }
__device__ __forceinline__ float wave_sum(float v) {
#pragma unroll
    for (int o = 1; o < 64; o <<= 1) v += __shfl_xor(v, o);
    return v;
}

#define XB_TMO      128
#define XB_XCNT(j)  (256  + 64 * (j))
#define XB_XSUB(j)  (1280 + 64 * (j))
#define XB_XGEN(j)  (2304 + 64 * (j))
#define XB_TOP      3328
#define XB_TOPGEN   3392
#define XCD_BAR_WORDS 3456
#define XB_SPIN_CAP (1u << 18)

__device__ __forceinline__ unsigned xb_ld(unsigned* p)              { return __hip_atomic_load(p, __ATOMIC_RELAXED, __HIP_MEMORY_SCOPE_AGENT); }
__device__ __forceinline__ unsigned xb_add(unsigned* p, unsigned v) { return __hip_atomic_fetch_add(p, v, __ATOMIC_RELAXED, __HIP_MEMORY_SCOPE_AGENT); }
__device__ __forceinline__ unsigned xb_xcc_id() { return (unsigned)__builtin_amdgcn_s_getreg((3 << 11) | 20) & 0xFu; }
#define XB_SPIN(cond, bar) do { unsigned _sp = 0; while (cond) { __builtin_amdgcn_s_sleep(1); \
    if ((++_sp & 255u) == 0u) { if (xb_ld(&(bar)[XB_TMO])) break; if (_sp > XB_SPIN_CAP) { atomicAdd(&(bar)[XB_TMO], 1u); break; } } } } while (0)

struct XcdBarrier {
    unsigned* bar; unsigned x;
    volatile LAS unsigned* st;
};

__device__ __forceinline__ XcdBarrier xcd_barrier_post(unsigned* bar, volatile LAS unsigned* st) {
    XcdBarrier b; b.bar = bar; b.x = xb_xcc_id(); b.st = st;
    if (threadIdx.x == 0) (void)xb_add(&bar[XB_XCNT(b.x)], 1u);
    return b;
}
__device__ __forceinline__ void xcd_barrier_complete(unsigned* bar, unsigned x, unsigned& nloc, unsigned& nx) {
    const unsigned G = gridDim.x * gridDim.y * gridDim.z;
    unsigned sum, cnt, mine, sp = 0u;
    for (;;) {
        sum = 0u; cnt = 0u; mine = 0u;
#pragma unroll 1
        for (unsigned j = 0; j < 16; ++j) { const unsigned c = xb_ld(&bar[XB_XCNT(j)]); sum += c; cnt += (c > 0u) ? 1u : 0u; mine = (j == x) ? c : mine; }
        if (sum == G) break;
        __builtin_amdgcn_s_sleep(1);
        if ((++sp & 255u) == 0u) { if (xb_ld(&bar[XB_TMO])) break; if (sp > XB_SPIN_CAP) { atomicAdd(&bar[XB_TMO], 1u); break; } }
    }
    nloc = mine > 0u ? mine : 1u; nx = cnt > 0u ? cnt : 1u;
}

__device__ __forceinline__ void xcd_barrier(const XcdBarrier& b) {
    asm volatile("s_waitcnt vmcnt(0)" ::: "memory");
    __syncthreads();
    if (threadIdx.x == 0) {
        unsigned* bar = b.bar;
        __builtin_amdgcn_s_waitcnt(0);
        unsigned nloc = b.st[0], nx = b.st[1];
        if (nloc == 0u) { xcd_barrier_complete(bar, b.x, nloc, nx); b.st[0] = nloc; b.st[1] = nx; }
        const unsigned old = xb_add(&bar[XB_XSUB(b.x)], 1u);
        const unsigned gen = old / nloc;
        if (old + 1u == (gen + 1u) * nloc) {
            __builtin_amdgcn_fence(__ATOMIC_RELEASE, "agent");
            asm volatile("s_waitcnt vmcnt(0)" ::: "memory");
            const unsigned og = xb_add(&bar[XB_TOP], 1u);
            const unsigned tg = og / nx;
            if (og + 1u == (tg + 1u) * nx) xb_add(&bar[XB_TOPGEN], 1u);
            else XB_SPIN(xb_ld(&bar[XB_TOPGEN]) == tg, bar);
            __builtin_amdgcn_fence(__ATOMIC_ACQUIRE, "agent");
            xb_add(&bar[XB_XGEN(b.x)], 1u);
            asm volatile("s_waitcnt vmcnt(0)" ::: "memory");
        } else {
            XB_SPIN(xb_ld(&bar[XB_XGEN(b.x)]) == gen, bar);
            __builtin_amdgcn_fence(__ATOMIC_ACQUIRE, "agent");
            asm volatile("s_waitcnt vmcnt(0)" ::: "memory");
        }
    }
    __syncthreads();
}

#ifndef P0_PARTS
#define P0_PARTS 7
#endif
#ifndef SITE_P0
#define SITE_P0 1
#endif
#ifndef SITE_P1
#define SITE_P1 1
#endif
#ifndef SITE_P2
#define SITE_P2 1
#endif
#ifndef SITE_ATT
#define SITE_ATT 3
#endif
#ifndef SITE_ONORM
#define SITE_ONORM 1
#endif
#ifndef SITE_G1
#define SITE_G1 1
#endif
#ifndef SITE_WIN
#define SITE_WIN 1
#endif
#ifndef SITE_UQKV
#define SITE_UQKV 1
#endif
#ifndef SITE_GF
#define SITE_GF 1
#endif
#ifndef SITE_LN
#define SITE_LN 1
#endif
#ifndef DBG_LAST_S
#define DBG_LAST_S (3 * DEPTH - 1)
#endif
#ifndef P0_PARTS
#define P0_PARTS 7
#endif

struct Frame {
    LAS unsigned char* lds;
    int tid, lane, wave;
    int vcu, G;
};

__device__ __forceinline__ int dst_row(int kind, int n) {
    if (kind == 1) { const int u = n >= FF ? 1 : 0, j = n - u * FF; return (j >> 7) * 256 + u * 128 + (j & 127); }
    if (kind == 2) { if (n < QLR + KVLR) return n; if (n < QLR + KVLR + ROPE_D) { const int j = n - (QLR + KVLR); return 4352 + (j < 32 ? 2 * j : 2 * (j - 32) + 1); } return n - ROPE_D; }
    if (kind == 3) { const int h = n / QKD, w = n - h * QKD; if (w < 128) return n; const int j = w - 128; return h * QKD + 128 + (j < 32 ? 2 * j : 2 * (j - 32) + 1); }
    return n;
}
__device__ __forceinline__ void tr_item(const float* __restrict__ W, int K, int N, bf16* __restrict__ WT, int kind, const float* __restrict__ gk, LAS float* scr, int item, int lane) {
    const int nblk = N >> 6, kb = item / nblk, nb = item - kb * nblk, k0 = kb << 6, n0 = nb << 6;
    const float* src = W + (size_t)k0 * N + n0 + lane;
#pragma unroll 16
    for (int kk = 0; kk < 64; ++kk) { float w = src[(size_t)kk * N]; if (gk) w *= gk[k0 + kk]; scr[kk * 65 + lane] = w; }
    LDS_WAIT(); asm volatile("" ::: "memory");
    const int c = lane & 7;
#pragma unroll
    for (int j = 0; j < 8; ++j) { const int n = (lane >> 3) + 8 * j; const LAS float* s = scr + (8 * c) * 65 + n;
        v4u o; o.x = pk2(s[0 * 65], s[1 * 65]); o.y = pk2(s[2 * 65], s[3 * 65]); o.z = pk2(s[4 * 65], s[5 * 65]); o.w = pk2(s[6 * 65], s[7 * 65]);
        *(v4u*)(WT + (size_t)dst_row(kind, n0 + n) * K + k0 + 8 * c) = o; }
    LDS_WAIT(); asm volatile("" ::: "memory");
}

struct Args { const float* in[19]; float* out; unsigned char* ws; int ph_lo, ph_hi; };
typedef const __attribute__((address_space(4))) Args CArgs;
__device__ __forceinline__ CArgs* fresh_args(CArgs* p) { asm volatile("" : "+s"(p)); return p; }
__device__ __forceinline__ Frame fresh_frame(Frame F) { asm volatile("" : "+v"(F.tid)); F.lane = F.tid & 63; return F; }
__constant__ float INVF[32] = {1.000000000e+00f, 7.498942614e-01f, 5.623413324e-01f, 4.216965139e-01f, 3.162277639e-01f, 2.371373773e-01f, 1.778279394e-01f, 1.333521307e-01f, 1.000000015e-01f, 7.498941571e-02f, 5.623413250e-02f, 4.216965288e-02f, 3.162277490e-02f, 2.371373773e-02f, 1.778279431e-02f, 1.333521493e-02f, 9.999999776e-03f, 7.498941850e-03f, 5.623413250e-03f, 4.216964822e-03f, 3.162277630e-03f, 2.371373586e-03f, 1.778279431e-03f, 1.333521446e-03f, 1.000000047e-03f, 7.498942432e-04f, 5.623413017e-04f, 4.216965172e-04f, 3.162277571e-04f, 2.371373703e-04f, 1.778279402e-04f, 1.333521504e-04f};

__device__ __forceinline__ void p0_prologue(const Frame& F, const CArgs& a) {
    unsigned char* ws = a.ws;
    const int gw = F.vcu * NWAVES + F.wave, NGW = F.G * NWAVES;
    const int gt = F.vcu * (NWAVES * 64) + F.tid, NGT = F.G * NWAVES * 64;
#if P0_PARTS & 1
    {
        LAS float* scr = (LAS float*)(F.lds + F.wave * 16640);
        constexpr int I_WI = (D / 64) * (2 * FF / 64), I_WO = (FF / 64) * (D / 64), I_WIN = (D / 64) * (IN_COLS / 64), I_WUQ = (QLR / 64) * (NH * QKD / 64), I_WUKV = (KVLR / 64) * (NH * 256 / 64), I_WOUT = (D / 64) * (D / 64);
        constexpr int I_LAYER = 2 * I_WI + 2 * I_WO + I_WIN + I_WUQ + I_WUKV + I_WOUT;
        for (int it = gw; it < DEPTH * I_LAYER; it += NGW) {
            const int l = it / I_LAYER; int r = it - l * I_LAYER;
            unsigned char* wl = ws + WS_W + (size_t)l * W_LAYER;
            const float* src; const float* gk = nullptr; int K_, N_, kind = 0; size_t dsto;
            if (r < I_WI) { src = a.in[7] + (size_t)l * D * 2 * FF; K_ = D; N_ = 2 * FF; dsto = WO_WI1; kind = 1; }
            else if ((r -= I_WI) < I_WO) { src = a.in[8] + (size_t)l * FF * D; K_ = FF; N_ = D; dsto = WO_WO1; }
            else if ((r -= I_WO) < I_WI) { src = a.in[17] + (size_t)l * D * 2 * FF; K_ = D; N_ = 2 * FF; dsto = WO_WI2; kind = 1; }
            else if ((r -= I_WI) < I_WO) { src = a.in[18] + (size_t)l * FF * D; K_ = FF; N_ = D; dsto = WO_WO2; }
            else if ((r -= I_WO) < I_WIN) { src = a.in[9] + (size_t)l * D * IN_COLS; K_ = D; N_ = IN_COLS; dsto = WO_WIN; kind = 2; }
            else if ((r -= I_WIN) < I_WUQ) { src = a.in[12] + (size_t)l * QLR * NH * QKD; K_ = QLR; N_ = NH * QKD; dsto = WO_WUQ; kind = 3; gk = a.in[10] + l * QLR; }
            else if ((r -= I_WUQ) < I_WUKV) { src = a.in[13] + (size_t)l * KVLR * NH * 256; K_ = KVLR; N_ = NH * 256; dsto = WO_WUKV; gk = a.in[11] + l * KVLR; }
            else { r -= I_WUKV; src = a.in[16] + (size_t)l * D * D; K_ = D; N_ = D; dsto = WO_WOUT;
                   gk = (r / (D / 64)) < 16 ? a.in[14] + l * 1024 : a.in[15] + l * 1024 - 1024; }
            tr_item(src, K_, N_, (bf16*)(wl + dsto), kind, gk, scr, r, F.lane);
        }
        constexpr int PADV = (WIN_ROWS - IN_COLS) * D * 2 / 16;
        for (int i = gt; i < DEPTH * PADV; i += NGT) { const int l = i / PADV, r = i - l * PADV;
            *(v4u*)(ws + WS_W + (size_t)l * W_LAYER + WO_WIN + (size_t)IN_COLS * D * 2 + (size_t)r * 16) = (v4u){0u, 0u, 0u, 0u}; }
    }
#endif
#if P0_PARTS & 2
    {
        const int* pos = (const int*)a.in[2]; float* rope = (float*)(ws + WS_ROPE);
        for (int i = gt; i < M * 32; i += NGT) { const int row = i >> 5, j = i & 31;
            const float ang = (float)pos[row] * INVF[j];
            double rev = (double)ang * 0.15915494309189535; rev -= __builtin_floor(rev);
            const float fr = (float)rev;
            *(float2*)(rope + (size_t)i * 2) = make_float2(__builtin_amdgcn_cosf(fr), __builtin_amdgcn_sinf(fr)); }
    }
#endif
    __syncthreads();
#if P0_PARTS & 4
    {
        LAS f32x4* cact = (LAS f32x4*)F.lds;
        for (int k = F.tid; k < D; k += NWAVES * 64) { f32x4 v;
#pragma unroll
            for (int b = 0; b < 4; ++b) { const float cv = a.in[1][b * D + k]; v[b] = cv / (1.0f + __expf(-cv)); }
            cact[k] = v; }
        __syncthreads();
        constexpr int NCH = NADA * D / 256, KSL = D / ADA_KS;
        float* adap = (float*)(ws + WS_ADAP);
        for (int it = gw; it < DEPTH * NCH * ADA_KS; it += NGW) {
            const int ks = it % ADA_KS, r = it / ADA_KS, ch = r % NCH, l = r / NCH;
            const int n = ch * 256 + 4 * F.lane;
            const float* w = a.in[3] + ((size_t)l * D + (size_t)ks * KSL) * (NADA * D) + n;
            f32x4 acc[4];
#pragma unroll
            for (int b = 0; b < 4; ++b) acc[b] = (f32x4){0.f, 0.f, 0.f, 0.f};
            if (ks == 0) { const f32x4 bv = *(const f32x4*)(a.in[4] + (size_t)l * NADA * D + n);
#pragma unroll
                for (int b = 0; b < 4; ++b) acc[b] = bv; }
#pragma unroll 8
            for (int kk = 0; kk < KSL; ++kk) { const f32x4 wv = *(const f32x4*)(w + (size_t)kk * (NADA * D)); const f32x4 cv = cact[ks * KSL + kk];
#pragma unroll
                for (int b = 0; b < 4; ++b) acc[b] += wv * cv[b]; }
#pragma unroll
            for (int b = 0; b < 4; ++b) *(f32x4*)(adap + (((size_t)ks * DEPTH + l) * BATCH + b) * (NADA * D) + n) = acc[b];
        }
    }
#endif
}
__device__ __forceinline__ void p1_ada_reduce(const Frame& F, const CArgs& a) {
    const int gt = F.vcu * (NWAVES * 64) + F.tid, NGT = F.G * NWAVES * 64;
    const f32x4* adap = (const f32x4*)(a.ws + WS_ADAP); f32x4* ada = (f32x4*)(a.ws + WS_ADA);
    constexpr int NV = DEPTH * BATCH * NADA * D / 4;
    for (int i = gt; i < NV; i += NGT) { f32x4 s = adap[i];
#pragma unroll
        for (int ks = 1; ks < ADA_KS; ++ks) s += adap[(size_t)ks * NV + i];
        ada[i] = s; }
}
__device__ __forceinline__ void p2_modulate0(const Frame& F, const CArgs& a) {
    const int gw = F.vcu * NWAVES + F.wave, NGW = F.G * NWAVES;
    const float* ada = (const float*)(a.ws + WS_ADA); bf16* H = (bf16*)(a.ws + WS_H);
    for (int row = gw; row < M; row += NGW) { const int b = row >> 12;
        const float* sh = ada + (size_t)b * NADA * D, * sc = sh + D;
#pragma unroll
        for (int j = 0; j < 8; ++j) { const int idx = 4 * (F.lane + 64 * j);
            const f32x4 xv = *(const f32x4*)(a.in[0] + (size_t)row * D + idx), s1 = *(const f32x4*)(sc + idx), s0 = *(const f32x4*)(sh + idx);
            const f32x4 h = xv * (s1 + 1.0f) + s0;
            *(v2u*)(H + (size_t)row * D + idx) = (v2u){pk2(h[0], h[1]), pk2(h[2], h[3])}; } }
}
__device__ __forceinline__ void ln_phase(const Frame& F, const float* xin, float* xout, const bf16* f, float cres, const float* gate, const float* lng, const float* lnb, const float* nsh, const float* nsc, bf16* H) {
    const int gw = F.vcu * NWAVES + F.wave, NGW = F.G * NWAVES;
    for (int row = gw; row < M; row += NGW) { const int b = row >> 12; const size_t bo = (size_t)b * NADA * D;
        f32x4 v[8]; float s = 0.f;
#pragma unroll
        for (int j = 0; j < 8; ++j) { const int idx = 4 * (F.lane + 64 * j);
            const f32x4 xv = *(const f32x4*)(xin + (size_t)row * D + idx); const v2u fw = *(const v2u*)(f + (size_t)row * D + idx); const f32x4 g = *(const f32x4*)(gate + bo + idx);
            const f32x4 fv = {bf_lo(fw.x), bf_hi(fw.x), bf_lo(fw.y), bf_hi(fw.y)};
            v[j] = xv * DN_ALPHA + (g + 1.0f) * cres * fv; s += (v[j][0] + v[j][1]) + (v[j][2] + v[j][3]); }
        const float mean = wave_sum(s) * (1.0f / D); float s2 = 0.f;
#pragma unroll
        for (int j = 0; j < 8; ++j) { v[j] = v[j] - mean; s2 += (v[j][0] * v[j][0] + v[j][1] * v[j][1]) + (v[j][2] * v[j][2] + v[j][3] * v[j][3]); }
        const float rstd = 1.0f / sqrtf(wave_sum(s2) * (1.0f / D) + LN_EPS);
#pragma unroll
        for (int j = 0; j < 8; ++j) { const int idx = 4 * (F.lane + 64 * j);
            const f32x4 y = v[j] * rstd * *(const f32x4*)(lng + idx) + *(const f32x4*)(lnb + idx);
            *(f32x4*)(xout + (size_t)row * D + idx) = y;
            if (nsh) { const f32x4 h = y * (*(const f32x4*)(nsc + bo + idx) + 1.0f) + *(const f32x4*)(nsh + bo + idx);
                *(v2u*)(H + (size_t)row * D + idx) = (v2u){pk2(h[0], h[1]), pk2(h[2], h[3])}; } } }
}
__device__ __forceinline__ void onorm_phase(const Frame& F, const bf16* O, bf16* ON) {
    const int gw = F.vcu * NWAVES + F.wave, NGW = F.G * NWAVES;
    for (int row = gw; row < M; row += NGW) {
#pragma unroll
        for (int g = 0; g < 2; ++g) { const bf16* p = O + (size_t)row * D + g * 1024 + 16 * F.lane; bf16* po = ON + (size_t)row * D + g * 1024 + 16 * F.lane;
            const v4u w0 = *(const v4u*)p, w1 = *(const v4u*)(p + 8);
            float x[16];
#pragma unroll
            for (int i = 0; i < 4; ++i) { x[2 * i] = bf_lo(w0[i]); x[2 * i + 1] = bf_hi(w0[i]); x[8 + 2 * i] = bf_lo(w1[i]); x[8 + 2 * i + 1] = bf_hi(w1[i]); }
            float s = 0.f;
#pragma unroll
            for (int i = 0; i < 16; ++i) s += x[i] * x[i];
            const float rs = 1.0f / sqrtf(wave_sum(s) * (1.0f / 1024.0f) + RMS_EPS);
            v4u o0, o1;
#pragma unroll
            for (int i = 0; i < 4; ++i) { o0[i] = pk2(x[2 * i] * rs, x[2 * i + 1] * rs); o1[i] = pk2(x[8 + 2 * i] * rs, x[8 + 2 * i + 1] * rs); }
            *(v4u*)po = o0; *(v4u*)(po + 8) = o1; } }
}
__device__ __forceinline__ void attn_phase(const Frame& F, const CArgs& a) {
    unsigned char* ws = a.ws;
    const bf16* QM = (const bf16*)(ws + WS_QM); const bf16* KV = (const bf16*)(ws + WS_KV); const bf16* KPE = (const bf16*)(ws + WS_KPE);
    const bf16* SBQ = (const bf16*)(ws + WS_SBQ); const bf16* SBK = (const bf16*)(ws + WS_SBK); const bf16* SBV = (const bf16*)(ws + WS_SBV);
    bf16* O = (bf16*)(ws + WS_O);
    constexpr int NQB = SEQ / 256, NPAIR = NQB / 2, NITEM = BATCH * NH * NPAIR;
    for (int it = F.vcu; it < NITEM; it += F.G) {
        const int bh = it / NPAIR, x = it - bh * NPAIR, b = bh / NH, h = bh - b * NH;
        const size_t r0 = (size_t)b * SEQ;
#if SITE_ATT & 1
#pragma unroll 1
        for (int pass = 0; pass < 2; ++pass) { const int qb = pass ? NQB - 1 - x : x; const size_t rq = r0 + (size_t)qb * 256;
            att::attn_block<false>(F.lds, QM + rq * (NH * QKD) + h * QKD, NH * QKD, KV + r0 * D + h * 256, D, KV + r0 * D + h * 256 + 128, D, KPE + r0 * 64, O + rq * D + h * HD, D, qb * 256); }
#endif
#if SITE_ATT & 2
#pragma unroll 1
        for (int pass = 0; pass < 2; ++pass) { const int qb = pass ? NQB - 1 - x : x; const size_t rq = r0 + (size_t)qb * 256;
            att::attn_block<true>(F.lds, SBQ + rq * 1024 + h * HD, 1024, SBK + r0 * 1024 + h * HD, 1024, SBV + r0 * 1024 + h * HD, 1024, nullptr, O + rq * D + 1024 + h * HD, D, qb * 256); }
#endif
    }
}

__global__ void __launch_bounds__(NWAVES * 64, 2) mk_fwd(Args args_unused) {
    extern __shared__ __attribute__((aligned(16))) unsigned char lds[];
    (void)args_unused;
    CArgs* ap = (CArgs*)__builtin_amdgcn_kernarg_segment_ptr();
    Frame F;
    F.lds = (LAS unsigned char*)lds;
    F.tid = threadIdx.x; F.lane = F.tid & 63; F.wave = __builtin_amdgcn_readfirstlane(F.tid >> 6);
    F.G = gridDim.x; { const int bx = blockIdx.x; F.vcu = (F.G % 8 == 0) ? (bx % 8) * (F.G / 8) + bx / 8 : bx; }
    volatile LAS unsigned* MISC = (volatile LAS unsigned*)(F.lds + MISC_OFF);
    for (int u = F.tid; u < (LDS_BYTES - MISC_OFF) / 4; u += NWAVES * 64) ((LAS unsigned*)(F.lds + MISC_OFF))[u] = 0u;
    __syncthreads();
    XcdBarrier bar; bar.bar = (unsigned*)(ap->ws + WS_CTL) + CW_BAR; bar.x = 0; bar.st = nullptr;
    if (MK_ONE_LAUNCH) bar = xcd_barrier_post((unsigned*)(ap->ws + WS_CTL) + CW_BAR, MISC + 8);
    const int lo = ap->ph_lo, hi = ap->ph_hi; int ph = 0;
#define RUN_PH (ph >= lo && ph < hi)
#define END_PH do { if (MK_ONE_LAUNCH && RUN_PH && ph + 1 < hi) xcd_barrier(bar); ++ph; } while (0)
#define WSP(T, off) ((T*)(A->ws + (off)))

#if SITE_P0
    if (RUN_PH) p0_prologue(fresh_frame(F), *fresh_args(ap));
#endif
    END_PH;
#if SITE_P1
    if (RUN_PH) p1_ada_reduce(fresh_frame(F), *fresh_args(ap));
#endif
    END_PH;
#if SITE_P2
    if (RUN_PH) p2_modulate0(fresh_frame(F), *fresh_args(ap));
#endif
    END_PH;

#pragma unroll 1
    for (int s = 0; s <= DBG_LAST_S; ++s) {
        const int l = s / 3, j = s - 3 * l;
        if (j != 1) {
#if SITE_G1
            if (RUN_PH) { CArgs* A = fresh_args(ap); const unsigned char* wl = A->ws + WS_W + (size_t)l * W_LAYER;
                pg8::Gemm g{WSP(const bf16, WS_H), (const bf16*)(wl + (j == 0 ? WO_WI1 : WO_WI2)), M, 2 * FF, D}; pg8::StaticOrder S; S.init(M, 2 * FF, F.G, (int)blockIdx.x);
                pg8::EpiSwiGLU E{WSP(bf16, WS_ACT), FF};
                pg8::gemm_phase<pg8::EpiSwiGLU, pg8::StaticOrder, true, true>(F.lds + RING_OFF, g, S, E);
            }
#endif
            END_PH;
        } else {
#if SITE_WIN
            if (RUN_PH) { CArgs* A = fresh_args(ap); const unsigned char* wl = A->ws + WS_W + (size_t)l * W_LAYER;
                pg8::Gemm g{WSP(const bf16, WS_H), (const bf16*)(wl + WO_WIN), M, WIN_ROWS, D}; pg8::StaticOrder S; S.init(M, WIN_ROWS, F.G, (int)blockIdx.x);
                pg8::EpiWin E{WSP(bf16, WS_CQ), WSP(bf16, WS_CKV), WSP(bf16, WS_SBQ), WSP(bf16, WS_SBK), WSP(bf16, WS_SBV), WSP(bf16, WS_KPE), WSP(float, WS_SSQ), WSP(const float, WS_ROPE), SB_QSCALE};
                pg8::gemm_phase<pg8::EpiWin, pg8::StaticOrder, true, true>(F.lds + RING_OFF, g, S, E);
            }
#endif
            END_PH;
#if SITE_UQKV
            if (RUN_PH) {
                { CArgs* A = fresh_args(ap); const unsigned char* wl = A->ws + WS_W + (size_t)l * W_LAYER;
                  pg8::Gemm g{WSP(const bf16, WS_CQ), (const bf16*)(wl + WO_WUQ), M, NH * QKD, QLR}; pg8::StaticOrder S; S.init(M, NH * QKD, F.G, (int)blockIdx.x);
                  pg8::EpiRS<true> E{WSP(bf16, WS_QM), NH * QKD, WSP(const float, WS_SSQ), 0, 3, 1.0f / QLR, RMS_EPS, MLA_QSCALE, WSP(const float, WS_ROPE)};
                  pg8::gemm_phase<pg8::EpiRS<true>, pg8::StaticOrder, true, true>(F.lds + RING_OFF, g, S, E); }
                { CArgs* A = fresh_args(ap); const unsigned char* wl = A->ws + WS_W + (size_t)l * W_LAYER;
                  pg8::Gemm g{WSP(const bf16, WS_CKV), (const bf16*)(wl + WO_WUKV), M, NH * 256, KVLR}; pg8::StaticOrder S; S.init(M, NH * 256, F.G, (int)blockIdx.x);
                  pg8::EpiRS<false> E{WSP(bf16, WS_KV), NH * 256, WSP(const float, WS_SSQ), 3, 2, 1.0f / KVLR, RMS_EPS, 1.0f, nullptr};
                  pg8::gemm_phase<pg8::EpiRS<false>, pg8::StaticOrder, true, true>(F.lds + RING_OFF, g, S, E); }
            }
#endif
            END_PH;
#if SITE_ATT
            if (RUN_PH) attn_phase(fresh_frame(F), *fresh_args(ap));
#endif
            END_PH;
#if SITE_ONORM
            if (RUN_PH) { CArgs* A = fresh_args(ap); onorm_phase(fresh_frame(F), WSP(const bf16, WS_O), WSP(bf16, WS_H)); }
#endif
            END_PH;
        }
#if SITE_GF
        if (RUN_PH) { CArgs* A = fresh_args(ap); const unsigned char* wl = A->ws + WS_W + (size_t)l * W_LAYER;
            pg8::Gemm g{j != 1 ? WSP(const bf16, WS_ACT) : WSP(const bf16, WS_H), (const bf16*)(wl + (j == 0 ? WO_WO1 : j == 2 ? WO_WO2 : WO_WOUT)), M, D, j != 1 ? FF : D}; pg8::StaticOrder S; S.init(M, D, F.G, (int)blockIdx.x);
            pg8::EpiPlain E{WSP(bf16, WS_F), D};
            pg8::gemm_phase<pg8::EpiPlain, pg8::StaticOrder, true, true>(F.lds + RING_OFF, g, S, E);
        }
#endif
        END_PH;
#if SITE_LN
        if (RUN_PH) { CArgs* A = fresh_args(ap);
            const bool last = s == DBG_LAST_S; const int s1 = s + 1, l1 = s1 / 3, j1 = s1 - 3 * l1;
            const float* ADA = WSP(const float, WS_ADA); float* X = WSP(float, WS_X);
            const float* gate = ADA + (size_t)l * BATCH * NADA * D + (3 * j + 2) * D;
            const float* nsh = last ? nullptr : ADA + (size_t)l1 * BATCH * NADA * D + (3 * j1) * D;
            ln_phase(fresh_frame(F), s == 0 ? A->in[0] : X, last ? A->out : X, WSP(const bf16, WS_F), j == 1 ? 1.0f : 0.5f, gate, A->in[5] + (size_t)(l * 3 + j) * D, A->in[6] + (size_t)(l * 3 + j) * D, nsh, nsh ? nsh + D : nullptr, WSP(bf16, WS_H));
        }
#endif
        END_PH;
    }
#undef RUN_PH
#undef END_PH
#undef WSP
}

extern "C" void kernel_launch(void* const* d_in, const int* in_sizes, int n_in, void* d_out, int out_size, void* d_ws, size_t ws_size, hipStream_t stream) {
    static int grid = 0;
    if (grid == 0) {
        if (n_in != 19 || in_sizes[0] != M * D || out_size != M * D || ws_size < WS_END) { fprintf(stderr, "kernel_launch: unexpected shapes (n_in %d, in0 %d, out %d, ws %zu < %zu); nothing launched\n", n_in, n_in > 0 ? in_sizes[0] : -1, out_size, ws_size, (size_t)WS_END); grid = -1; return; }
        int dev = 0, cus = 0, per_cu = 0;
        if (hipGetDevice(&dev) != hipSuccess || hipDeviceGetAttribute(&cus, hipDeviceAttributeMultiprocessorCount, dev) != hipSuccess) { grid = -1; return; }
        if (hipFuncSetAttribute((const void*)mk_fwd, hipFuncAttributeMaxDynamicSharedMemorySize, LDS_BYTES) != hipSuccess) { fprintf(stderr, "kernel_launch: hipFuncSetAttribute failed\n"); grid = -1; return; }
        if (hipOccupancyMaxActiveBlocksPerMultiprocessor(&per_cu, (const void*)mk_fwd, NWAVES * 64, LDS_BYTES) != hipSuccess || per_cu < 1)
            fprintf(stderr, "kernel_launch: note: occupancy query reports %d workgroups per CU\n", per_cu);
        (void)hipGetLastError();
        grid = cus;
    }
    if (grid < 0) return;
    if (hipMemsetAsync((char*)d_ws + WS_CTL, 0, CTL_ZERO_BYTES, stream) != hipSuccess) { fprintf(stderr, "kernel_launch: hipMemsetAsync failed\n"); return; }
    Args a{};
    for (int i = 0; i < 19; ++i) a.in[i] = (const float*)d_in[i];
    a.out = (float*)d_out; a.ws = (unsigned char*)d_ws;
#if MK_ONE_LAUNCH
    a.ph_lo = 0; a.ph_hi = N_PHASES;
    hipLaunchKernelGGL(mk_fwd, dim3(grid), dim3(NWAVES * 64), LDS_BYTES, stream, a);
#else
    for (int p = 0; p < N_PHASES; ++p) { a.ph_lo = p; a.ph_hi = p + 1; hipLaunchKernelGGL(mk_fwd, dim3(grid), dim3(NWAVES * 64), LDS_BYTES, stream, a); }
#endif
}
```

```cpp
#include <hip/hip_runtime.h>
#include <cstdio>
#include <cstdint>
#include <cmath>
namespace pg8 {
#define PG8_LAS __attribute__((address_space(3)))
typedef unsigned short bf16_t;
typedef short bf16x8 __attribute__((ext_vector_type(8)));
typedef float f32x4 __attribute__((ext_vector_type(4)));
typedef unsigned u32x4 __attribute__((ext_vector_type(4)));
constexpr int BM = 256, BK = 64, HALF = 128, HTB = HALF * BK * 2  , STAGE_BYTES = 8 * HTB, NXCD = 8, WGM = 8;

__host__ __device__ __forceinline__ int lds_byte(int r, int c) { const int st = (r >> 4) * 2 + (c >> 5), rr = r & 15, cc = c & 31, ob = rr * 64 + cc * 2; return st * 1024 + (ob ^ (((ob >> 9) & 1) << 5)); }
__host__ __device__ __forceinline__ void stage_rc(int b, int& R, int& C) { const int st = b / 1024, sb = b % 1024, swz = sb ^ (((sb >> 9) & 1) << 5); R = (st >> 1) * 16 + swz / 64; C = (st & 1) * 32 + (swz % 64) / 2; }
__host__ __device__ __forceinline__ int perm32(int rho) { const int n = rho >> 4, i = rho & 15; return 8 * (i >> 2) + 4 * n + (i & 3); }

struct Unit { int pm, pn; };
struct Gemm { const bf16_t* A; const bf16_t* Bt; int M, N, K; };

struct StaticOrder {
    int nM, nN, nwg, G, c;
    __host__ __device__ void init(int M, int N, int G_, int c_) { nM = M / BM; nN = N / BM; nwg = nM * nN; G = G_; c = c_; }
    __host__ __device__ bool next(int i, Unit& u) const {
        const long L = (long)i * G + c; if (L >= nwg) return false;
        int wgid = (int)L; { const int q = nwg / NXCD, r = nwg % NXCD, xcd = wgid % NXCD, off = wgid / NXCD; wgid = (xcd < r ? xcd * (q + 1) : r * (q + 1) + (xcd - r) * q) + off; }
        const int nig = WGM * nN, gid = wgid / nig, fm = gid * WGM, gsz = (nM - fm) < WGM ? (nM - fm) : WGM;
        u.pm = fm + ((wgid % nig) % gsz); u.pn = (wgid % nig) / gsz; return true;
    }
    __device__ __forceinline__ void a_ready(const Unit&) const {}
    __device__ __forceinline__ void done(const Unit&) const {}
};


__device__ __forceinline__ unsigned cvt_pk_bf16(float lo, float hi) { unsigned r; asm volatile("v_cvt_pk_bf16_f32 %0, %1, %2" : "=v"(r) : "v"(lo), "v"(hi)); return r; }
typedef float f32x2 __attribute__((ext_vector_type(2)));
__device__ __forceinline__ u32x4 pack8bf(const f32x4 v0, const f32x4 v1) { u32x4 w; w.x = cvt_pk_bf16(v0[0], v0[1]); w.y = cvt_pk_bf16(v0[2], v0[3]); w.z = cvt_pk_bf16(v1[0], v1[1]); w.w = cvt_pk_bf16(v1[2], v1[3]); return w; }

struct EpiPlain {
    static constexpr bool PERM = true, AFTER_DRAIN = false;
    bf16_t* O; int ldc;
    __device__ __forceinline__ void operator()(const f32x4 (&acc)[2][2][4][2], const Unit& u, int wr, int wc, int fr, int fq) const {
        const int row0 = u.pm * BM + wr * 64 + fr; const int col0 = u.pn * BM + wc * 32 + 8 * fq;
#pragma unroll
        for (int ai = 0; ai < 2; ++ai)
#pragma unroll
            for (int m = 0; m < 4; ++m) { bf16_t* rowp = O + (size_t)(row0 + ai * HALF + m * 16) * ldc + col0;
#pragma unroll
                for (int bj = 0; bj < 2; ++bj) *(u32x4*)(rowp + bj * HALF) = pack8bf(acc[ai][bj][m][0], acc[ai][bj][m][1]); }
    }
};

struct EpiSwiGLU {
    static constexpr bool PERM = true, AFTER_DRAIN = false;
    bf16_t* O; int ldc;
    __device__ __forceinline__ static f32x4 sg(const f32x4 g, const f32x4 up) {
        f32x4 r;
#pragma unroll
        for (int i = 0; i < 4; ++i) { const float e = __builtin_amdgcn_exp2f(g[i] * -1.4426950408889634f); r[i] = g[i] * __builtin_amdgcn_rcpf(1.0f + e) * up[i]; }
        return r;
    }
    __device__ __forceinline__ void operator()(const f32x4 (&acc)[2][2][4][2], const Unit& u, int wr, int wc, int fr, int fq) const {
        const int row0 = u.pm * BM + wr * 64 + fr; const int col0 = u.pn * HALF + wc * 32 + 8 * fq;
#pragma unroll
        for (int ai = 0; ai < 2; ++ai)
#pragma unroll
            for (int m = 0; m < 4; ++m) { bf16_t* rowp = O + (size_t)(row0 + ai * HALF + m * 16) * ldc + col0;
                const f32x4 h0 = sg(acc[ai][0][m][0], acc[ai][1][m][0]), h1 = sg(acc[ai][0][m][1], acc[ai][1][m][1]);
                *(u32x4*)rowp = pack8bf(h0, h1); }
    }
};

__device__ __forceinline__ void rope8(f32x4& v0, f32x4& v1, const f32x4 cs0, const f32x4 cs1) {
    const float a0 = v0[0], b0 = v0[1], a1 = v0[2], b1 = v0[3], a2 = v1[0], b2 = v1[1], a3 = v1[2], b3 = v1[3];
    v0[0] = a0 * cs0[0] - b0 * cs0[1]; v0[1] = a0 * cs0[1] + b0 * cs0[0];
    v0[2] = a1 * cs0[2] - b1 * cs0[3]; v0[3] = a1 * cs0[3] + b1 * cs0[2];
    v1[0] = a2 * cs1[0] - b2 * cs1[1]; v1[1] = a2 * cs1[1] + b2 * cs1[0];
    v1[2] = a3 * cs1[2] - b3 * cs1[3]; v1[3] = a3 * cs1[3] + b3 * cs1[2];
}

struct EpiWin {
    static constexpr bool PERM = true, AFTER_DRAIN = false;
    bf16_t *CQ, *CKV, *SBQ, *SBK, *SBV, *KPE; float* SSQ; const float* ROPE; float sbq_scale;
    __device__ __forceinline__ void operator()(const f32x4 (&acc)[2][2][4][2], const Unit& u, int wr, int wc, int fr, int fq) const {
        const int pn = u.pn; const int row0 = u.pm * BM + wr * 64 + fr;
        if (pn < 17) {
            bf16_t* base; int ldc, colt; float sc = 1.0f; const bool ssq = pn < 5;
            if (pn < 3) { base = CQ; ldc = 768; colt = pn * BM; }
            else if (pn < 5) { base = CKV; ldc = 512; colt = (pn - 3) * BM; }
            else if (pn < 9) { base = SBQ; ldc = 1024; colt = (pn - 5) * BM; sc = sbq_scale; }
            else if (pn < 13) { base = SBK; ldc = 1024; colt = (pn - 9) * BM; }
            else { base = SBV; ldc = 1024; colt = (pn - 13) * BM; }
            const int col0 = colt + wc * 32 + 8 * fq;
#pragma unroll
            for (int ai = 0; ai < 2; ++ai)
#pragma unroll
                for (int m = 0; m < 4; ++m) { const int row = row0 + ai * HALF + m * 16; bf16_t* rowp = base + (size_t)row * ldc + col0; float s = 0.f;
#pragma unroll
                    for (int bj = 0; bj < 2; ++bj) { const f32x4 v0 = acc[ai][bj][m][0] * sc, v1 = acc[ai][bj][m][1] * sc;
                        s += (v0[0] * v0[0] + v0[1] * v0[1]) + (v0[2] * v0[2] + v0[3] * v0[3]) + (v1[0] * v1[0] + v1[1] * v1[1]) + (v1[2] * v1[2] + v1[3] * v1[3]);
                        *(u32x4*)(rowp + bj * HALF) = pack8bf(v0, v1); }
                    if (ssq) { s += __shfl_xor(s, 16); s += __shfl_xor(s, 32); if (fq == 0) SSQ[((size_t)row * 5 + pn) * 4 + wc] = s; } }
        } else if (wc < 2) {
            const int c0 = wc * 32 + 8 * fq;
#pragma unroll
            for (int ai = 0; ai < 2; ++ai)
#pragma unroll
                for (int m = 0; m < 4; ++m) { const int row = row0 + ai * HALF + m * 16;
                    const f32x4 cs0 = *(const f32x4*)(ROPE + (size_t)row * 64 + c0), cs1 = *(const f32x4*)(ROPE + (size_t)row * 64 + c0 + 4);
                    f32x4 v0 = acc[ai][0][m][0], v1 = acc[ai][0][m][1]; rope8(v0, v1, cs0, cs1);
                    *(u32x4*)(KPE + (size_t)row * 64 + c0) = pack8bf(v0, v1); }
        }
    }
};

template <bool ROPE_Q> struct EpiRS {
    static constexpr bool PERM = true, AFTER_DRAIN = false;
    bf16_t* O; int ldc; const float* SSQ; int t0, nt; float invn, eps, oscale; const float* ROPE;
    __device__ __forceinline__ void operator()(const f32x4 (&acc)[2][2][4][2], const Unit& u, int wr, int wc, int fr, int fq) const {
        const int row0 = u.pm * BM + wr * 64 + fr; const int col0 = u.pn * BM + wc * 32 + 8 * fq;
        float rsv[2][4];
#pragma unroll
        for (int ai = 0; ai < 2; ++ai)
#pragma unroll
            for (int m = 0; m < 4; ++m) { const int row = row0 + ai * HALF + m * 16; f32x4 q = {0.f, 0.f, 0.f, 0.f};
                if (fq < nt) q = *(const f32x4*)(SSQ + ((size_t)row * 5 + t0 + fq) * 4);
                rsv[ai][m] = (q[0] + q[1]) + (q[2] + q[3]); }
#pragma unroll
        for (int ai = 0; ai < 2; ++ai)
#pragma unroll
            for (int m = 0; m < 4; ++m) { float ss = rsv[ai][m]; ss += __shfl_xor(ss, 16); ss += __shfl_xor(ss, 32); rsv[ai][m] = oscale / sqrtf(ss * invn + eps); }
#pragma unroll
        for (int ai = 0; ai < 2; ++ai)
#pragma unroll
            for (int m = 0; m < 4; ++m) { const int row = row0 + ai * HALF + m * 16;
                const float rs = rsv[ai][m];
#pragma unroll
                for (int bj = 0; bj < 2; ++bj) { const int c = col0 + bj * HALF; f32x4 v0 = acc[ai][bj][m][0] * rs, v1 = acc[ai][bj][m][1] * rs;
                    if (ROPE_Q) { const int w = c % 192; if (w >= 128) { const float* cs = ROPE + (size_t)row * 64 + (w - 128); rope8(v0, v1, *(const f32x4*)cs, *(const f32x4*)(cs + 4)); } }
                    *(u32x4*)(O + (size_t)row * ldc + c) = pack8bf(v0, v1); } }
    }
};

template <class Epi, class Sched, bool ALIGN_EPI = false, bool SP2 = false>
__device__ __forceinline__ void gemm_phase(PG8_LAS unsigned char* lds, const Gemm g, const Sched& S, const Epi& E) {
    int tid_ = threadIdx.x; asm volatile("" : "+v"(tid_));
    const int tid = tid_, wid = __builtin_amdgcn_readfirstlane(tid >> 6), lane = tid & 63, wr = wid >> 2, wc = wid & 3, fr = lane & 15, fq = lane >> 4;
    const int K = g.K, nt = K / BK;
    unsigned voffA[2], voffB[2];
#pragma unroll
    for (int i = 0; i < 2; ++i) { int R, C; stage_rc(tid * 16 + i * 8192, R, C); const int Rb = Epi::PERM ? ((R & ~31) + perm32(R & 31)) : R;
        voffA[i] = (unsigned)(R * K + C) * 2u; voffB[i] = (unsigned)(Rb * K + C) * 2u; }
    const size_t kstep = (size_t)(BK * 2);
    const size_t hstep = (size_t)HALF * K * 2;
    const size_t tstep = 2 * hstep;
    const unsigned ldsw = (unsigned)wid * 1024u;
    const int aoff = lds_byte(wr * 64 + fr, fq * 8), boff = lds_byte(wc * 32 + fr, fq * 8);
#define PG8_SA(b, h) (((b) * 2 + (h)) * HTB)
#define PG8_SB(b, h) ((4 + (b) * 2 + (h)) * HTB)
#define PG8_STAGE(bufoff, gbase, voff) do { _Pragma("unroll") for (int _i = 0; _i < 2; ++_i) \
        __builtin_amdgcn_global_load_lds((const unsigned*)((const char*)(gbase) + (voff)[_i]), (PG8_LAS unsigned*)(lds + (bufoff) + ldsw + _i * 8192), 16, 0, 0); } while (0)
#define PG8_LDA(dst, b, h) do { _Pragma("unroll") for (int m = 0; m < 4; ++m) _Pragma("unroll") for (int k = 0; k < 2; ++k) dst[m][k] = *(const PG8_LAS bf16x8*)(lds + PG8_SA(b, h) + aoff + m * 2048 + k * 1024); } while (0)
#define PG8_LDB(dst, b, h) do { _Pragma("unroll") for (int n = 0; n < 2; ++n) _Pragma("unroll") for (int k = 0; k < 2; ++k) dst[n][k] = *(const PG8_LAS bf16x8*)(lds + PG8_SB(b, h) + boff + n * 2048 + k * 1024); } while (0)
#define PG8_MMA(ai, bj, At, Bt) do { __builtin_amdgcn_s_setprio(1); _Pragma("unroll") for (int m = 0; m < 4; ++m) _Pragma("unroll") for (int n = 0; n < 2; ++n) _Pragma("unroll") for (int k = 0; k < 2; ++k) \
        acc[ai][bj][m][n] = __builtin_amdgcn_mfma_f32_16x16x32_bf16(Bt[n][k], At[m][k], acc[ai][bj][m][n], 0, 0, 0); __builtin_amdgcn_s_setprio(0); } while (0)
#define PG8_WAIT_V(n) asm volatile("s_waitcnt vmcnt(" #n ")" ::: "memory")
#define PG8_WAIT_L(n) asm volatile("s_waitcnt lgkmcnt(" #n ")" ::: "memory")
#define PG8_BAR __builtin_amdgcn_s_barrier()
#define PG8_SCHED __builtin_amdgcn_sched_barrier(0)
    Unit cur, nxt; int ui = 0;
    if (!S.next(0, cur)) return;
    f32x4 acc[2][2][4][2];
#pragma unroll
    for (int a = 0; a < 2; ++a)
#pragma unroll
        for (int b = 0; b < 2; ++b)
#pragma unroll
            for (int m = 0; m < 4; ++m)
#pragma unroll
                for (int n = 0; n < 2; ++n) acc[a][b][m][n] = (f32x4){0.f, 0.f, 0.f, 0.f};
    bf16x8 At[4][2], B0[2][2], B1[2][2];
    const char* cA = (const char*)g.A + (size_t)cur.pm * tstep; const char* cB = (const char*)g.Bt + (size_t)cur.pn * tstep;
    S.a_ready(cur);
    if constexpr (SP2) {
        PG8_STAGE(PG8_SB(0, 0), cB, voffB); PG8_STAGE(PG8_SB(0, 1), cB + hstep, voffB); PG8_STAGE(PG8_SA(0, 0), cA, voffA); PG8_STAGE(PG8_SA(0, 1), cA + hstep, voffA);
        if (wr == 1) PG8_BAR;
        PG8_WAIT_V(2); PG8_BAR;
        PG8_STAGE(PG8_SB(1, 0), cB + kstep, voffB); PG8_STAGE(PG8_SA(1, 0), cA + kstep, voffA); PG8_STAGE(PG8_SB(1, 1), cB + hstep + kstep, voffB);
        PG8_WAIT_V(6); PG8_BAR;
    } else {
        PG8_STAGE(PG8_SB(0, 0), cB, voffB); PG8_STAGE(PG8_SA(0, 0), cA, voffA); PG8_STAGE(PG8_SB(0, 1), cB + hstep, voffB); PG8_STAGE(PG8_SA(0, 1), cA + hstep, voffA);
        if (wr == 1) PG8_BAR;
        PG8_WAIT_V(4); PG8_BAR;
        PG8_STAGE(PG8_SB(1, 0), cB + kstep, voffB); PG8_STAGE(PG8_SA(1, 0), cA + kstep, voffA); PG8_STAGE(PG8_SB(1, 1), cB + hstep + kstep, voffB);
        PG8_WAIT_V(6); PG8_BAR;
    }
    for (;;) {
        const bool has_next = S.next(ui + 1, nxt);
        const char* nA = has_next ? (const char*)g.A + (size_t)nxt.pm * tstep : cA; const char* nB = has_next ? (const char*)g.Bt + (size_t)nxt.pn * tstep : cB;
        for (int t = 0; t < nt; t += 2) {
            const bool last = (t == nt - 2);
            const char* a1 = cA + (size_t)(t + 1) * kstep;
            const char* a2 = last ? nA : cA + (size_t)(t + 2) * kstep; const char* b2 = last ? nB : cB + (size_t)(t + 2) * kstep;
            const char* a3 = a2 + kstep; const char* b3 = b2 + kstep;
            if (last && has_next) S.a_ready(nxt);
            if constexpr (SP2) {
            PG8_LDB(B0, 0, 0); PG8_LDB(B1, 0, 1); PG8_SCHED; PG8_LDA(At, 0, 0); PG8_STAGE(PG8_SA(1, 1), a1 + hstep, voffA);
            PG8_WAIT_V(8); PG8_WAIT_L(0); PG8_BAR; PG8_MMA(0, 0, At, B0); PG8_MMA(0, 1, At, B1); PG8_BAR; PG8_SCHED;
            PG8_LDA(At, 0, 1); PG8_STAGE(PG8_SB(0, 0), b2, voffB); PG8_STAGE(PG8_SB(0, 1), b2 + hstep, voffB); PG8_STAGE(PG8_SA(0, 0), a2, voffA);
            PG8_WAIT_V(8); PG8_WAIT_L(0); PG8_BAR; PG8_MMA(1, 0, At, B0); PG8_MMA(1, 1, At, B1); PG8_BAR; PG8_SCHED;
            PG8_LDB(B0, 1, 0); PG8_LDB(B1, 1, 1); PG8_SCHED; PG8_LDA(At, 1, 0); PG8_STAGE(PG8_SA(0, 1), a2 + hstep, voffA);
            PG8_WAIT_V(8); PG8_WAIT_L(0); PG8_BAR; PG8_MMA(0, 0, At, B0); PG8_MMA(0, 1, At, B1); PG8_BAR; PG8_SCHED;
            PG8_LDA(At, 1, 1); PG8_STAGE(PG8_SB(1, 0), b3, voffB); PG8_STAGE(PG8_SB(1, 1), b3 + hstep, voffB); PG8_STAGE(PG8_SA(1, 0), a3, voffA);
            PG8_WAIT_V(8); PG8_WAIT_L(0); PG8_BAR; PG8_MMA(1, 0, At, B0); PG8_MMA(1, 1, At, B1); PG8_BAR; PG8_SCHED;
            } else {
            PG8_LDB(B0, 0, 0); PG8_SCHED; PG8_LDA(At, 0, 0); PG8_STAGE(PG8_SA(1, 1), a1 + hstep, voffA);
            PG8_WAIT_L(8); PG8_BAR; PG8_WAIT_L(0); PG8_MMA(0, 0, At, B0); PG8_BAR; PG8_SCHED;
            PG8_LDB(B1, 0, 1); PG8_STAGE(PG8_SB(0, 0), b2, voffB);
            PG8_BAR; PG8_WAIT_L(0); PG8_MMA(0, 1, At, B1); PG8_BAR;
            PG8_LDA(At, 0, 1); PG8_STAGE(PG8_SA(0, 0), a2, voffA);
            PG8_BAR; PG8_WAIT_L(0); PG8_MMA(1, 0, At, B0); PG8_BAR; PG8_SCHED;
            PG8_STAGE(PG8_SB(0, 1), b2 + hstep, voffB);
            PG8_WAIT_V(6); PG8_BAR; PG8_MMA(1, 1, At, B1); PG8_BAR;
            PG8_LDB(B0, 1, 0); PG8_SCHED; PG8_LDA(At, 1, 0); PG8_STAGE(PG8_SA(0, 1), a2 + hstep, voffA);
            PG8_WAIT_L(8); PG8_BAR; PG8_WAIT_L(0); PG8_MMA(0, 0, At, B0); PG8_BAR; PG8_SCHED;
            PG8_LDB(B1, 1, 1); PG8_STAGE(PG8_SB(1, 0), b3, voffB);
            PG8_BAR; PG8_WAIT_L(0); PG8_MMA(0, 1, At, B1); PG8_BAR;
            PG8_LDA(At, 1, 1); PG8_STAGE(PG8_SA(1, 0), a3, voffA);
            PG8_BAR; PG8_WAIT_L(0); PG8_MMA(1, 0, At, B0); PG8_BAR; PG8_SCHED;
            PG8_STAGE(PG8_SB(1, 1), b3 + hstep, voffB);
            PG8_WAIT_V(6); PG8_BAR; PG8_MMA(1, 1, At, B1); PG8_BAR;
            }
        }
        if constexpr (ALIGN_EPI) { if (wr == 0) PG8_BAR; }
        if constexpr (!Epi::AFTER_DRAIN) { E(acc, cur, wr, wc, fr, fq); S.done(cur); }
        if (!has_next) break;
#pragma unroll
        for (int a = 0; a < 2; ++a)
#pragma unroll
            for (int b = 0; b < 2; ++b)
#pragma unroll
                for (int m = 0; m < 4; ++m)
#pragma unroll
                    for (int n = 0; n < 2; ++n) acc[a][b][m][n] = (f32x4){0.f, 0.f, 0.f, 0.f};
        cur = nxt; cA = nA; cB = nB; ++ui;
        if constexpr (ALIGN_EPI) { if (wr == 1) PG8_BAR; }
    }
    PG8_WAIT_V(0);
    if constexpr (!ALIGN_EPI) { if (wr == 0) PG8_BAR; }
    PG8_BAR;
    if constexpr (Epi::AFTER_DRAIN) { E.fused(acc, cur, wr, wc, fr, fq, lds, wid, lane); S.done(cur); }
#undef PG8_SA
#undef PG8_SB
#undef PG8_STAGE
#undef PG8_LDA
#undef PG8_LDB
#undef PG8_MMA
#undef PG8_WAIT_V
#undef PG8_WAIT_L
#undef PG8_BAR
#undef PG8_SCHED
}
}


namespace att {
typedef unsigned short bf16_t;
typedef short bf16x8 __attribute__((ext_vector_type(8)));
typedef short s16x4 __attribute__((ext_vector_type(4)));
typedef float f32x16 __attribute__((ext_vector_type(16)));
typedef float f32x4 __attribute__((ext_vector_type(4)));
typedef unsigned u32x4 __attribute__((ext_vector_type(4)));
#define ATT_LAS __attribute__((address_space(3)))
#ifndef SB_EARLY_EXIT
#define SB_EARLY_EXIT 1
#endif
constexpr int KVBLK = 64, QB = 256;
constexpr int SHM_V = 16384, SHM_K = 16384, SHM_R = 8192;
constexpr int OFF_V = 0, OFF_K = 2 * SHM_V, OFF_R = OFF_K + 2 * SHM_K, OFF_WS = OFF_R + 2 * SHM_R, OFF_FLAG = OFF_WS + 8 * 256, OFF_QR = OFF_FLAG + 64, ATT_LDS_BYTES = OFF_QR + 8 * 4096;
#define KSWZ(row, colB) ((row) * 256 + ((colB) ^ (((row) & 7) << 4)))
#define RSWZ(row, colB) ((row) * 128 + ((colB) ^ (((row) & 7) << 4)))
#define SBAR() __builtin_amdgcn_sched_barrier(0)
__device__ __forceinline__ int v_st(int k, int c) { const int kk = (k & ~0xC) | ((k & 4) << 1) | ((k & 8) >> 1); return ((kk >> 3) * 4 + (c >> 5)) * 512 + ((kk & 7) * 32 + (c & 31)) * 2; }
__device__ __forceinline__ int v_rd_base(int lane) { return ((lane & 3) << 3) | (((lane >> 2) & 3) << 6) | (((lane >> 4) & 1) << 5) | (((lane >> 5) & 1) << 8); }
__device__ __forceinline__ int crow(int r, int hi) { return (r & 3) + 8 * (r >> 2) + 4 * hi; }
__device__ __forceinline__ unsigned cvtpk(float lo, float hi) { unsigned r; asm volatile("v_cvt_pk_bf16_f32 %0, %1, %2" : "=v"(r) : "v"(lo), "v"(hi)); return r; }
__device__ __forceinline__ float other_half(float x, int hi) { auto rr = __builtin_amdgcn_permlane32_swap(__float_as_uint(x), __float_as_uint(x), false, false); return __uint_as_float(hi ? rr[0] : rr[1]); }

__device__ __forceinline__ void pack_p(const f32x16& p0, const f32x16& p1, bf16x8& pa0, bf16x8& pa1, bf16x8& pa2, bf16x8& pa3) {
#define PK4(P, B_, OUT) do { unsigned a0 = cvtpk(P[B_+0], P[B_+1]), a1 = cvtpk(P[B_+2], P[B_+3]);                          \
        unsigned b0 = cvtpk(P[B_+4], P[B_+5]), b1 = cvtpk(P[B_+6], P[B_+7]);                                             \
        auto r0 = __builtin_amdgcn_permlane32_swap(a0, b0, false, false); auto r1 = __builtin_amdgcn_permlane32_swap(a1, b1, false, false); \
        u32x4 w = {r0[0], r1[0], r0[1], r1[1]}; OUT = __builtin_bit_cast(bf16x8, w); } while (0)
    PK4(p0, 0, pa0); PK4(p0, 8, pa1); PK4(p1, 0, pa2); PK4(p1, 8, pa3);
#undef PK4
}
__device__ __forceinline__ void pv_tile(f32x16* o, int vb, bf16x8 pa0, bf16x8 pa1, bf16x8 pa2, bf16x8 pa3) {
#define TRRD(dst, off) asm volatile("ds_read_b64_tr_b16 %0, %1 offset:%2" : "=&v"(dst) : "v"(vb), "i"(off) : "memory")
#define PV_D0(d0) do { s16x4 l0, l1, l2, l3, h0, h1, h2, h3; constexpr int b_ = (d0) * 512;   \
        TRRD(l0, b_); TRRD(h0, b_ + 2048); TRRD(l1, b_ + 4096); TRRD(h1, b_ + 6144); TRRD(l2, b_ + 8192); TRRD(h2, b_ + 10240); TRRD(l3, b_ + 12288); TRRD(h3, b_ + 14336); \
        asm volatile("s_waitcnt lgkmcnt(0)" ::: "memory"); SBAR();   \
        o[d0] = __builtin_amdgcn_mfma_f32_32x32x16_bf16(pa0, (bf16x8){l0[0], l0[1], l0[2], l0[3], h0[0], h0[1], h0[2], h0[3]}, o[d0], 0, 0, 0);   \
        o[d0] = __builtin_amdgcn_mfma_f32_32x32x16_bf16(pa1, (bf16x8){l1[0], l1[1], l1[2], l1[3], h1[0], h1[1], h1[2], h1[3]}, o[d0], 0, 0, 0);   \
        o[d0] = __builtin_amdgcn_mfma_f32_32x32x16_bf16(pa2, (bf16x8){l2[0], l2[1], l2[2], l2[3], h2[0], h2[1], h2[2], h2[3]}, o[d0], 0, 0, 0);   \
        o[d0] = __builtin_amdgcn_mfma_f32_32x32x16_bf16(pa3, (bf16x8){l3[0], l3[1], l3[2], l3[3], h3[0], h3[1], h3[2], h3[3]}, o[d0], 0, 0, 0); } while (0)
    PV_D0(0); PV_D0(1); PV_D0(2); PV_D0(3);
#undef PV_D0
#undef TRRD
}

template <bool SB>
__device__ __forceinline__ void attn_block(ATT_LAS unsigned char* lds, const bf16_t* Qg, int ldq, const bf16_t* Kg, int ldk, const bf16_t* Vg, int ldv, const bf16_t* Rg, bf16_t* Og, int ldo, int P0) {
    constexpr int NQ = 8;
    int tid_ = threadIdx.x; asm volatile("" : "+v"(tid_));
    const int tid = tid_, wid = __builtin_amdgcn_readfirstlane(tid >> 6), lane = tid & 63, r32 = lane & 31, hi = lane >> 5;
    const int qlo = P0 + wid * 32;
    const int NT = (P0 + QB) / KVBLK;
    ATT_LAS unsigned char* V_lds = lds + OFF_V; ATT_LAS unsigned char* K_lds = lds + OFF_K; ATT_LAS unsigned char* R_lds = lds + OFF_R;
    ATT_LAS float* ws = (ATT_LAS float*)(lds + OFF_WS) + wid * 64;
    ATT_LAS unsigned* flags = (ATT_LAS unsigned*)(lds + OFF_FLAG);
    const int sr = tid >> 4, sc = (tid & 15) * 8, rr = tid >> 3, rc = (tid & 7) * 8;
    const int vst0 = v_st(sr, sc), vst1 = v_st(32 + sr, sc), kws = KSWZ(sr, sc * 2), rws = RSWZ(rr, rc * 2);
    const int vb0 = (int)(unsigned)(uintptr_t)V_lds + v_rd_base(lane);
    bf16x8 qr[NQ];
#pragma unroll
    for (int d0 = 0; d0 < NQ; ++d0) qr[d0] = *(const bf16x8*)(Qg + (size_t)(wid * 32 + r32) * ldq + d0 * 16 + hi * 8);
    ATT_LAS unsigned char* qsl = lds + OFF_QR + wid * 4096 + lane * 16;
    if (!SB) {
#pragma unroll
        for (int d0 = 0; d0 < 4; ++d0) *(ATT_LAS bf16x8*)(qsl + d0 * 1024) = *(const bf16x8*)(Qg + (size_t)(wid * 32 + r32) * ldq + 128 + d0 * 16 + hi * 8);
    }
    bf16x8 st_k0, st_k1, st_v0, st_v1, st_r;
#define STAGE_LOAD(t_) do { const size_t k0_ = (size_t)(t_) * KVBLK;                                                                   \
        st_k0 = *(const bf16x8*)(Kg + (k0_ + sr) * ldk + sc); st_k1 = *(const bf16x8*)(Kg + (k0_ + 32 + sr) * ldk + sc);               \
        st_v0 = *(const bf16x8*)(Vg + (k0_ + sr) * ldv + sc); st_v1 = *(const bf16x8*)(Vg + (k0_ + 32 + sr) * ldv + sc);               \
        if (!SB) st_r = *(const bf16x8*)(Rg + (k0_ + rr) * 64 + rc); } while (0)
#define STAGE_WRITE(bf_) do { *(ATT_LAS bf16x8*)(K_lds + (bf_) * SHM_K + kws) = st_k0; *(ATT_LAS bf16x8*)(K_lds + (bf_) * SHM_K + kws + 32 * 256) = st_k1;   \
        *(ATT_LAS bf16x8*)(V_lds + (bf_) * SHM_V + vst0) = st_v0; *(ATT_LAS bf16x8*)(V_lds + (bf_) * SHM_V + vst1) = st_v1;                                  \
        if (!SB) *(ATT_LAS bf16x8*)(R_lds + (bf_) * SHM_R + rws) = st_r; } while (0)
    f32x16 o[4];
#pragma unroll
    for (int d = 0; d < 4; ++d)
#pragma unroll
        for (int r = 0; r < 16; ++r) o[d][r] = 0.f;
    float m_reg = -1e30f, l_reg = 0.f, R = 0.f;
    int kro[4];
#pragma unroll
    for (int dd = 0; dd < 4; ++dd) kro[dd] = KSWZ(r32, (dd * 16 + hi * 8) * 2);
    STAGE_LOAD(SB ? NT - 1 : 0);
    asm volatile("s_waitcnt vmcnt(0)" ::: "memory");
    STAGE_WRITE(0);
    __syncthreads();
    for (int it = 0; it < NT; ++it) {
        const int t = SB ? NT - 1 - it : it; const int buf = it & 1; const bool more = it + 1 < NT;
        if (more) STAGE_LOAD(SB ? t - 1 : t + 1);
        const int kb = t * KVBLK;
        if (kb <= qlo + 31) {
            f32x16 p0, p1;
#pragma unroll
            for (int r = 0; r < 16; ++r) { p0[r] = 0.f; p1[r] = 0.f; }
            ATT_LAS const unsigned char* kt = K_lds + buf * SHM_K;
#pragma unroll
            for (int d0 = 0; d0 < 8; ++d0) { ATT_LAS const unsigned char* a = kt + kro[d0 & 3] + (d0 >> 2) * 128;
                const bf16x8 b0 = *(ATT_LAS const bf16x8*)a; const bf16x8 b1 = *(ATT_LAS const bf16x8*)(a + 32 * 256);
                p0 = __builtin_amdgcn_mfma_f32_32x32x16_bf16(b0, qr[d0], p0, 0, 0, 0);
                p1 = __builtin_amdgcn_mfma_f32_32x32x16_bf16(b1, qr[d0], p1, 0, 0, 0); }
            if (!SB) { ATT_LAS const unsigned char* rt = R_lds + buf * SHM_R;
#pragma unroll
                for (int d0 = 0; d0 < 4; ++d0) { ATT_LAS const unsigned char* a = rt + (kro[d0] - 128 * r32);
                    const bf16x8 b0 = *(ATT_LAS const bf16x8*)a; const bf16x8 b1 = *(ATT_LAS const bf16x8*)(a + 32 * 128);
                    const bf16x8 qf = *(ATT_LAS const bf16x8*)(qsl + d0 * 1024);
                    p0 = __builtin_amdgcn_mfma_f32_32x32x16_bf16(b0, qf, p0, 0, 0, 0);
                    p1 = __builtin_amdgcn_mfma_f32_32x32x16_bf16(b1, qf, p1, 0, 0, 0); } }
            const int dql = qlo + r32 - kb - 4 * hi - (SB ? 1 : 0);
            const bool need_mask = SB ? (kb + KVBLK - 1 >= qlo) : (kb + KVBLK - 1 > qlo);
            bf16x8 pa0, pa1, pa2, pa3;
            if (!SB) {
                if (need_mask) { const float NEG = -__builtin_inff();
#pragma unroll
                    for (int r = 0; r < 16; ++r) { const int c = (r & 3) + 8 * (r >> 2); if (c > dql) p0[r] = NEG; if (c + 32 > dql) p1[r] = NEG; } }
                float pmax = p0[0];
#pragma unroll
                for (int r = 1; r < 16; ++r) pmax = fmaxf(pmax, p0[r]);
#pragma unroll
                for (int r = 0; r < 16; ++r) pmax = fmaxf(pmax, p1[r]);
                pmax = fmaxf(pmax, other_half(pmax, hi));
                const float mn = fmaxf(m_reg, pmax); const float alpha = __builtin_amdgcn_exp2f(m_reg - mn); m_reg = mn;
                float ps = 0.f;
#pragma unroll
                for (int r = 0; r < 16; ++r) { p0[r] = __builtin_amdgcn_exp2f(p0[r] - mn); ps += p0[r]; }
#pragma unroll
                for (int r = 0; r < 16; ++r) { p1[r] = __builtin_amdgcn_exp2f(p1[r] - mn); ps += p1[r]; }
                ps += other_half(ps, hi);
                l_reg = l_reg * alpha + ps;
                if (__any(alpha < 1.f)) { if (hi == 0) ws[r32] = alpha; asm volatile("s_waitcnt lgkmcnt(0)" ::: "memory");
#pragma unroll
                    for (int r = 0; r < 16; ++r) { const float a = ws[crow(r, hi)];
#pragma unroll
                        for (int d = 0; d < 4; ++d) o[d][r] *= a; }
                    asm volatile("s_waitcnt lgkmcnt(0)" ::: "memory"); }
                pack_p(p0, p1, pa0, pa1, pa2, pa3);
            } else {
                f32x16 l0, l1;
#pragma unroll
                for (int r = 0; r < 16; ++r) { const float z = p0[r]; const float sp = fmaxf(z, 0.f) + __builtin_amdgcn_logf(1.0f + __builtin_amdgcn_exp2f(-fabsf(z))); l0[r] = -sp; p0[r] = z - sp; }
#pragma unroll
                for (int r = 0; r < 16; ++r) { const float z = p1[r]; const float sp = fmaxf(z, 0.f) + __builtin_amdgcn_logf(1.0f + __builtin_amdgcn_exp2f(-fabsf(z))); l1[r] = -sp; p1[r] = z - sp; }
                if (need_mask) { const float NEG = -__builtin_inff();
#pragma unroll
                    for (int r = 0; r < 16; ++r) { const int c = (r & 3) + 8 * (r >> 2); if (c > dql) { p0[r] = NEG; l0[r] = 0.f; } if (c + 32 > dql) { p1[r] = NEG; l1[r] = 0.f; } } }
                float T[8];
#pragma unroll
                for (int g = 0; g < 4; ++g) {
                    { const float a0 = l0[4 * g], a1 = l0[4 * g + 1], a2 = l0[4 * g + 2], a3 = l0[4 * g + 3]; const float x2 = a3, x1 = a3 + a2, x0 = x1 + a1; T[g] = x0 + a0;
                      l0[4 * g] = x0; l0[4 * g + 1] = x1; l0[4 * g + 2] = x2; l0[4 * g + 3] = 0.f; }
                    { const float a0 = l1[4 * g], a1 = l1[4 * g + 1], a2 = l1[4 * g + 2], a3 = l1[4 * g + 3]; const float x2 = a3, x1 = a3 + a2, x0 = x1 + a1; T[4 + g] = x0 + a0;
                      l1[4 * g] = x0; l1[4 * g + 1] = x1; l1[4 * g + 2] = x2; l1[4 * g + 3] = 0.f; }
                }
                float gs[8]; float run = R;
#pragma unroll
                for (int g = 7; g >= 0; --g) { const float To = other_half(T[g], hi); gs[g] = run + (hi == 0 ? To : 0.f); run += T[g] + To; }
                R = run;
#pragma unroll
                for (int g = 0; g < 4; ++g)
#pragma unroll
                    for (int i = 0; i < 4; ++i) { p0[4 * g + i] = __builtin_amdgcn_exp2f(p0[4 * g + i] + l0[4 * g + i] + gs[g]); p1[4 * g + i] = __builtin_amdgcn_exp2f(p1[4 * g + i] + l1[4 * g + i] + gs[4 + g]); }
                pack_p(p0, p1, pa0, pa1, pa2, pa3);
            }
            pv_tile(o, vb0 + buf * SHM_V, pa0, pa1, pa2, pa3);
        }
        if (more) { asm volatile("s_waitcnt vmcnt(0)" ::: "memory"); STAGE_WRITE(buf ^ 1); }
        if (SB && SB_EARLY_EXIT) { const bool dead = __all(R < -160.f); if (lane == 0) flags[buf * 8 + wid] = dead ? 1u : 0u; }
        __syncthreads();
        if (SB && SB_EARLY_EXIT) { const u32x4 f0 = *(ATT_LAS const u32x4*)(flags + buf * 8), f1 = *(ATT_LAS const u32x4*)(flags + buf * 8 + 4);
            if ((f0[0] & f0[1] & f0[2] & f0[3] & f1[0] & f1[1] & f1[2] & f1[3]) != 0u) break; }
    }
    if (!SB) { if (hi == 0) ws[32 + r32] = l_reg; asm volatile("s_waitcnt lgkmcnt(0)" ::: "memory"); }
    bf16_t* Ow = Og + (size_t)(wid * 32) * ldo;
#pragma unroll
    for (int r = 0; r < 16; ++r) { const int orow = crow(r, hi); const float rl = SB ? 1.0f : 1.0f / ws[32 + orow];
#pragma unroll
        for (int d0 = 0; d0 < 4; ++d0) { const float v = o[d0][r] * rl; const float vn = __shfl_xor(v, 1);
            if ((r32 & 1) == 0) *(unsigned*)(Ow + (size_t)orow * ldo + d0 * 32 + r32) = cvtpk(v, vn); } }
    asm volatile("s_waitcnt lgkmcnt(0)" ::: "memory");
    __syncthreads();
#undef STAGE_LOAD
#undef STAGE_WRITE
}
#undef KSWZ
#undef RSWZ
}

#ifdef DUP_LN
#define DUP_LN_ANY DUP_LN
#else
#define DUP_LN_ANY 0
#endif

constexpr int NWAVES = 8;
constexpr int D = 2048, BATCH = 4, SEQ = 4096, DEPTH = 4, M = BATCH * SEQ, FF = 5632, NADA = 9;
constexpr int QLR = 768, KVLR = 512, ROPE_D = 64, NH = 8, HD = 128, QKD = 192;
constexpr int IN_COLS = QLR + KVLR + ROPE_D + 3 * NH * HD;
constexpr int WIN_ROWS = 4608;
constexpr float LN_EPS = 1e-5f, RMS_EPS = 1e-6f;
constexpr float DN_ALPHA = 1.6817928305074290f;
constexpr float LOG2E = 1.4426950408889634f;
constexpr float MLA_QSCALE = 0.07216878364870322f * LOG2E;
constexpr float SB_QSCALE = 0.08838834764831845f * LOG2E;
#ifndef MK_ONE_LAUNCH
#define MK_ONE_LAUNCH 1
#endif
constexpr int N_PHASES = 3 + 8 * 3 + 4 * 6;

constexpr size_t MiB = 1u << 20;
constexpr size_t WS_CTL = 0, CTL_ZERO_BYTES = 1 * MiB;
constexpr size_t WS_ADA = 1 * MiB;
constexpr size_t WS_ADAP = 3 * MiB;
constexpr size_t WS_VEC = 22 * MiB;
constexpr size_t WS_ROPE = 24 * MiB;
constexpr size_t WS_SSQ = 28 * MiB;
constexpr size_t WS_KPE = 30 * MiB;
constexpr size_t WS_HL = 32 * MiB;
constexpr size_t WS_H = 160 * MiB;
constexpr size_t WS_F = 224 * MiB;
constexpr size_t WS_ACT = 288 * MiB;
constexpr size_t WS_CQ = 464 * MiB;
constexpr size_t WS_CKV = 488 * MiB;
constexpr size_t WS_SBQ = 504 * MiB, WS_SBK = 536 * MiB, WS_SBV = 568 * MiB;
constexpr size_t WS_QM = 600 * MiB;
constexpr size_t WS_KV = 648 * MiB;
constexpr size_t WS_O = 712 * MiB;
constexpr size_t WS_W = 776 * MiB;
constexpr size_t W_WI = (size_t)2 * FF * D * 2, W_WO = (size_t)D * FF * 2, W_WIN = (size_t)WIN_ROWS * D * 2, W_WUQ = (size_t)NH * QKD * QLR * 2, W_WUKV = (size_t)NH * 256 * KVLR * 2, W_WOUT = (size_t)D * D * 2;
constexpr size_t WO_WI1 = 0, WO_WO1 = WO_WI1 + W_WI, WO_WI2 = WO_WO1 + W_WO, WO_WO2 = WO_WI2 + W_WI, WO_WIN = WO_WO2 + W_WO, WO_WUQ = WO_WIN + W_WIN, WO_WUKV = WO_WUQ + W_WUQ, WO_WOUT = WO_WUKV + W_WUKV;
constexpr size_t W_LAYER = WO_WOUT + W_WOUT;
constexpr size_t WS_DUMMY = WS_W + DEPTH * W_LAYER;
constexpr size_t WS_END = WS_DUMMY + (size_t)(DUP_LN_ANY ? 128 : 0) * MiB;
static_assert(W_LAYER % 256 == 0 && WS_END < (size_t)1700 * MiB, "ws map");
constexpr int ADA_KS = 16;
constexpr int CW_BAR = 4096;

constexpr int RING_OFF = 0, SCR_BYTES = 135168;
constexpr int MISC_OFF = SCR_BYTES;
constexpr int LDS_BYTES = 147456;

#define GAS __attribute__((address_space(1)))
#define LAS __attribute__((address_space(3)))
typedef unsigned short bf16;
typedef unsigned v4u __attribute__((ext_vector_type(4)));
typedef unsigned v2u __attribute__((ext_vector_type(2)));
typedef float f32x4 __attribute__((ext_vector_type(4)));
#define LDS_WAIT() asm volatile("s_waitcnt lgkmcnt(0)" ::: "memory")
#define VM_WAIT() asm volatile("s_waitcnt vmcnt(0)" ::: "memory")
__device__ __forceinline__ unsigned pk2(float lo, float hi) { unsigned r; asm volatile("v_cvt_pk_bf16_f32 %0, %1, %2" : "=v"(r) : "v"(lo), "v"(hi)); return r; }
__device__ __forceinline__ float bf_lo(unsigned w) { return __uint_as_float(w << 16); }
__device__ __forceinline__ float bf_hi(unsigned w) { return __uint_as_float(w & 0xffff0000u); }
__device__ __forceinline__ float wave_sum(float v) {
#pragma unroll
    for (int o = 1; o < 64; o <<= 1) v += __shfl_xor(v, o);
    return v;
}

#define XB_TMO      128
#define XB_XCNT(j)  (256  + 64 * (j))
#define XB_XSUB(j)  (1280 + 64 * (j))
#define XB_XGEN(j)  (2304 + 64 * (j))
#define XB_TOP      3328
#define XB_TOPGEN   3392
#define XCD_BAR_WORDS 3456
#define XB_SPIN_CAP (1u << 18)

__device__ __forceinline__ unsigned xb_ld(unsigned* p)              { return __hip_atomic_load(p, __ATOMIC_RELAXED, __HIP_MEMORY_SCOPE_AGENT); }
__device__ __forceinline__ unsigned xb_add(unsigned* p, unsigned v) { return __hip_atomic_fetch_add(p, v, __ATOMIC_RELAXED, __HIP_MEMORY_SCOPE_AGENT); }
__device__ __forceinline__ unsigned xb_xcc_id() { return (unsigned)__builtin_amdgcn_s_getreg((3 << 11) | 20) & 0xFu; }
#define XB_SPIN(cond, bar) do { unsigned _sp = 0; while (cond) { __builtin_amdgcn_s_sleep(1); \
    if ((++_sp & 255u) == 0u) { if (xb_ld(&(bar)[XB_TMO])) break; if (_sp > XB_SPIN_CAP) { atomicAdd(&(bar)[XB_TMO], 1u); break; } } } } while (0)

struct XcdBarrier {
    unsigned* bar; unsigned x;
    volatile LAS unsigned* st;
};

__device__ __forceinline__ XcdBarrier xcd_barrier_post(unsigned* bar, volatile LAS unsigned* st) {
    XcdBarrier b; b.bar = bar; b.x = xb_xcc_id(); b.st = st;
    if (threadIdx.x == 0) (void)xb_add(&bar[XB_XCNT(b.x)], 1u);
    return b;
}
__device__ __forceinline__ void xcd_barrier_complete(unsigned* bar, unsigned x, unsigned& nloc, unsigned& nx) {
    const unsigned G = gridDim.x * gridDim.y * gridDim.z;
    unsigned sum, cnt, mine, sp = 0u;
    for (;;) {
        sum = 0u; cnt = 0u; mine = 0u;
#pragma unroll 1
        for (unsigned j = 0; j < 16; ++j) { const unsigned c = xb_ld(&bar[XB_XCNT(j)]); sum += c; cnt += (c > 0u) ? 1u : 0u; mine = (j == x) ? c : mine; }
        if (sum == G) break;
        __builtin_amdgcn_s_sleep(1);
        if ((++sp & 255u) == 0u) { if (xb_ld(&bar[XB_TMO])) break; if (sp > XB_SPIN_CAP) { atomicAdd(&bar[XB_TMO], 1u); break; } }
    }
    nloc = mine > 0u ? mine : 1u; nx = cnt > 0u ? cnt : 1u;
}

__device__ __forceinline__ void xcd_barrier(const XcdBarrier& b) {
    asm volatile("s_waitcnt vmcnt(0)" ::: "memory");
    __syncthreads();
    if (threadIdx.x == 0) {
        unsigned* bar = b.bar;
        __builtin_amdgcn_s_waitcnt(0);
        unsigned nloc = b.st[0], nx = b.st[1];
        if (nloc == 0u) { xcd_barrier_complete(bar, b.x, nloc, nx); b.st[0] = nloc; b.st[1] = nx; }
        const unsigned old = xb_add(&bar[XB_XSUB(b.x)], 1u);
        const unsigned gen = old / nloc;
        if (old + 1u == (gen + 1u) * nloc) {
            __builtin_amdgcn_fence(__ATOMIC_RELEASE, "agent");
            asm volatile("s_waitcnt vmcnt(0)" ::: "memory");
            const unsigned og = xb_add(&bar[XB_TOP], 1u);
            const unsigned tg = og / nx;
            if (og + 1u == (tg + 1u) * nx) xb_add(&bar[XB_TOPGEN], 1u);
            else XB_SPIN(xb_ld(&bar[XB_TOPGEN]) == tg, bar);
            __builtin_amdgcn_fence(__ATOMIC_ACQUIRE, "agent");
            xb_add(&bar[XB_XGEN(b.x)], 1u);
            asm volatile("s_waitcnt vmcnt(0)" ::: "memory");
        } else {
            XB_SPIN(xb_ld(&bar[XB_XGEN(b.x)]) == gen, bar);
            __builtin_amdgcn_fence(__ATOMIC_ACQUIRE, "agent");
            asm volatile("s_waitcnt vmcnt(0)" ::: "memory");
        }
    }
    __syncthreads();
}

#ifndef DUP_P0
#define DUP_P0 0
#endif
#ifndef DUP_P1
#define DUP_P1 0
#endif
#ifndef DUP_P2
#define DUP_P2 0
#endif
#ifndef DUP_G1
#define DUP_G1 0
#endif
#ifndef DUP_WIN
#define DUP_WIN 0
#endif
#ifndef DUP_UQKV
#define DUP_UQKV 0
#endif
#ifndef DUP_ATT
#define DUP_ATT 0
#endif
#ifndef DUP_ONORM
#define DUP_ONORM 0
#endif
#ifndef DUP_GF
#define DUP_GF 0
#endif
#ifndef DUP_LN
#define DUP_LN 0
#endif
#define REP(n) for (int rep_ = 0; rep_ < 1 + (n); ++rep_)
#ifndef P0_PARTS
#define P0_PARTS 7
#endif
#ifndef SITE_P0
#define SITE_P0 1
#endif
#ifndef SITE_P1
#define SITE_P1 1
#endif
#ifndef SITE_P2
#define SITE_P2 1
#endif
#ifndef SITE_ATT
#define SITE_ATT 3
#endif
#ifndef SITE_ONORM
#define SITE_ONORM 1
#endif
#ifndef SITE_G1
#define SITE_G1 1
#endif
#ifndef SITE_WIN
#define SITE_WIN 1
#endif
#ifndef SITE_UQKV
#define SITE_UQKV 1
#endif
#ifndef SITE_GF
#define SITE_GF 1
#endif
#ifndef SITE_LN
#define SITE_LN 1
#endif
#ifndef DBG_LAST_S
#define DBG_LAST_S (3 * DEPTH - 1)
#endif
#ifndef P0_PARTS
#define P0_PARTS 7
#endif

struct Frame {
    LAS unsigned char* lds;
    int tid, lane, wave;
    int vcu, G;
};

__device__ __forceinline__ int dst_row(int kind, int n) {
    if (kind == 1) { const int u = n >= FF ? 1 : 0, j = n - u * FF; return (j >> 7) * 256 + u * 128 + (j & 127); }
    if (kind == 2) { if (n < QLR + KVLR) return n; if (n < QLR + KVLR + ROPE_D) { const int j = n - (QLR + KVLR); return 4352 + (j < 32 ? 2 * j : 2 * (j - 32) + 1); } return n - ROPE_D; }
    if (kind == 3) { const int h = n / QKD, w = n - h * QKD; if (w < 128) return n; const int j = w - 128; return h * QKD + 128 + (j < 32 ? 2 * j : 2 * (j - 32) + 1); }
    return n;
}
__device__ __forceinline__ void tr_item(const float* __restrict__ W, int K, int N, bf16* __restrict__ WT, int kind, const float* __restrict__ gk, LAS float* scr, int item, int lane) {
    const int nblk = N >> 6, kb = item / nblk, nb = item - kb * nblk, k0 = kb << 6, n0 = nb << 6;
    const int kk4 = lane >> 4, n4 = (lane & 15) * 4;
    const float* src = W + (size_t)(k0 + kk4) * N + n0 + n4;
    f32x4 wv[16];
#pragma unroll
    for (int i = 0; i < 16; ++i) wv[i] = *(const f32x4*)(src + (size_t)(4 * i) * N);
#pragma unroll
    for (int i = 0; i < 16; ++i) { const int kk = 4 * i + kk4; f32x4 w = wv[i]; if (gk) w = w * gk[k0 + kk];
        LAS float* d = scr + kk * 65 + n4; d[0] = w[0]; d[1] = w[1]; d[2] = w[2]; d[3] = w[3]; }
    LDS_WAIT(); asm volatile("" ::: "memory");
    const int c = lane & 7;
#pragma unroll
    for (int j = 0; j < 8; ++j) { const int n = (lane >> 3) + 8 * j; const LAS float* s = scr + (8 * c) * 65 + n;
        v4u o; o.x = pk2(s[0 * 65], s[1 * 65]); o.y = pk2(s[2 * 65], s[3 * 65]); o.z = pk2(s[4 * 65], s[5 * 65]); o.w = pk2(s[6 * 65], s[7 * 65]);
        *(v4u*)(WT + (size_t)dst_row(kind, n0 + n) * K + k0 + 8 * c) = o; }
    LDS_WAIT(); asm volatile("" ::: "memory");
}

struct Args { const float* in[19]; float* out; unsigned char* ws; int ph_lo, ph_hi; };
typedef const __attribute__((address_space(4))) Args CArgs;
__device__ __forceinline__ CArgs* fresh_args(CArgs* p) { asm volatile("" : "+s"(p)); return p; }
__device__ __forceinline__ Frame fresh_frame(Frame F) { asm volatile("" : "+v"(F.tid)); F.lane = F.tid & 63; return F; }
__constant__ float INVF[32] = {1.000000000e+00f, 7.498942614e-01f, 5.623413324e-01f, 4.216965139e-01f, 3.162277639e-01f, 2.371373773e-01f, 1.778279394e-01f, 1.333521307e-01f, 1.000000015e-01f, 7.498941571e-02f, 5.623413250e-02f, 4.216965288e-02f, 3.162277490e-02f, 2.371373773e-02f, 1.778279431e-02f, 1.333521493e-02f, 9.999999776e-03f, 7.498941850e-03f, 5.623413250e-03f, 4.216964822e-03f, 3.162277630e-03f, 2.371373586e-03f, 1.778279431e-03f, 1.333521446e-03f, 1.000000047e-03f, 7.498942432e-04f, 5.623413017e-04f, 4.216965172e-04f, 3.162277571e-04f, 2.371373703e-04f, 1.778279402e-04f, 1.333521504e-04f};

__device__ __forceinline__ void p0_prologue(const Frame& F, const CArgs& a) {
    unsigned char* ws = a.ws;
    const int gw = F.vcu * NWAVES + F.wave, NGW = F.G * NWAVES;
    const int gt = F.vcu * (NWAVES * 64) + F.tid, NGT = F.G * NWAVES * 64;
#if P0_PARTS & 1
    {
        LAS float* scr = (LAS float*)(F.lds + F.wave * 16640);
        constexpr int I_WI = (D / 64) * (2 * FF / 64), I_WO = (FF / 64) * (D / 64), I_WIN = (D / 64) * (IN_COLS / 64), I_WUQ = (QLR / 64) * (NH * QKD / 64), I_WUKV = (KVLR / 64) * (NH * 256 / 64), I_WOUT = (D / 64) * (D / 64);
        constexpr int I_LAYER = 2 * I_WI + 2 * I_WO + I_WIN + I_WUQ + I_WUKV + I_WOUT;
        for (int it = gw; it < DEPTH * I_LAYER; it += NGW) {
            const int l = it / I_LAYER; int r = it - l * I_LAYER;
            unsigned char* wl = ws + WS_W + (size_t)l * W_LAYER;
            const float* src; const float* gk = nullptr; int K_, N_, kind = 0; size_t dsto;
            if (r < I_WI) { src = a.in[7] + (size_t)l * D * 2 * FF; K_ = D; N_ = 2 * FF; dsto = WO_WI1; kind = 1; }
            else if ((r -= I_WI) < I_WO) { src = a.in[8] + (size_t)l * FF * D; K_ = FF; N_ = D; dsto = WO_WO1; }
            else if ((r -= I_WO) < I_WI) { src = a.in[17] + (size_t)l * D * 2 * FF; K_ = D; N_ = 2 * FF; dsto = WO_WI2; kind = 1; }
            else if ((r -= I_WI) < I_WO) { src = a.in[18] + (size_t)l * FF * D; K_ = FF; N_ = D; dsto = WO_WO2; }
            else if ((r -= I_WO) < I_WIN) { src = a.in[9] + (size_t)l * D * IN_COLS; K_ = D; N_ = IN_COLS; dsto = WO_WIN; kind = 2; }
            else if ((r -= I_WIN) < I_WUQ) { src = a.in[12] + (size_t)l * QLR * NH * QKD; K_ = QLR; N_ = NH * QKD; dsto = WO_WUQ; kind = 3; gk = a.in[10] + l * QLR; }
            else if ((r -= I_WUQ) < I_WUKV) { src = a.in[13] + (size_t)l * KVLR * NH * 256; K_ = KVLR; N_ = NH * 256; dsto = WO_WUKV; gk = a.in[11] + l * KVLR; }
            else { r -= I_WUKV; src = a.in[16] + (size_t)l * D * D; K_ = D; N_ = D; dsto = WO_WOUT;
                   gk = (r / (D / 64)) < 16 ? a.in[14] + l * 1024 : a.in[15] + l * 1024 - 1024; }
            tr_item(src, K_, N_, (bf16*)(wl + dsto), kind, gk, scr, r, F.lane);
        }
        constexpr int PADV = (WIN_ROWS - IN_COLS) * D * 2 / 16;
        for (int i = gt; i < DEPTH * PADV; i += NGT) { const int l = i / PADV, r = i - l * PADV;
            *(v4u*)(ws + WS_W + (size_t)l * W_LAYER + WO_WIN + (size_t)IN_COLS * D * 2 + (size_t)r * 16) = (v4u){0u, 0u, 0u, 0u}; }
    }
#endif
#if P0_PARTS & 2
    {
        const int* pos = (const int*)a.in[2]; float* rope = (float*)(ws + WS_ROPE);
        for (int i = gt; i < M * 32; i += NGT) { const int row = i >> 5, j = i & 31;
            const float ang = (float)pos[row] * INVF[j];
            double rev = (double)ang * 0.15915494309189535; rev -= __builtin_floor(rev);
            const float fr = (float)rev;
            *(float2*)(rope + (size_t)i * 2) = make_float2(__builtin_amdgcn_cosf(fr), __builtin_amdgcn_sinf(fr)); }
    }
#endif
    __syncthreads();
#if P0_PARTS & 4
    {
        LAS f32x4* cact = (LAS f32x4*)F.lds;
        for (int k = F.tid; k < D; k += NWAVES * 64) { f32x4 v;
#pragma unroll
            for (int b = 0; b < 4; ++b) { const float cv = a.in[1][b * D + k]; v[b] = cv / (1.0f + __expf(-cv)); }
            cact[k] = v; }
        __syncthreads();
        constexpr int NCH = NADA * D / 256, KSL = D / ADA_KS;
        float* adap = (float*)(ws + WS_ADAP);
        for (int it = gw; it < DEPTH * NCH * ADA_KS; it += NGW) {
            const int ks = it % ADA_KS, r = it / ADA_KS, ch = r % NCH, l = r / NCH;
            const int n = ch * 256 + 4 * F.lane;
            const float* w = a.in[3] + ((size_t)l * D + (size_t)ks * KSL) * (NADA * D) + n;
            f32x4 acc[4];
#pragma unroll
            for (int b = 0; b < 4; ++b) acc[b] = (f32x4){0.f, 0.f, 0.f, 0.f};
            if (ks == 0) { const f32x4 bv = *(const f32x4*)(a.in[4] + (size_t)l * NADA * D + n);
#pragma unroll
                for (int b = 0; b < 4; ++b) acc[b] = bv; }
#pragma unroll 16
            for (int kk = 0; kk < KSL; ++kk) { const f32x4 wv = *(const f32x4*)(w + (size_t)kk * (NADA * D)); const f32x4 cv = cact[ks * KSL + kk];
#pragma unroll
                for (int b = 0; b < 4; ++b) acc[b] += wv * cv[b]; }
#pragma unroll
            for (int b = 0; b < 4; ++b) *(f32x4*)(adap + (((size_t)ks * DEPTH + l) * BATCH + b) * (NADA * D) + n) = acc[b];
        }
    }
#endif
}
__device__ __forceinline__ void p1_ada_reduce(const Frame& F, const CArgs& a) {
    const int gt = F.vcu * (NWAVES * 64) + F.tid, NGT = F.G * NWAVES * 64;
    const f32x4* adap = (const f32x4*)(a.ws + WS_ADAP); f32x4* ada = (f32x4*)(a.ws + WS_ADA);
    constexpr int NV = DEPTH * BATCH * NADA * D / 4;
    for (int i = gt; i < NV; i += NGT) { f32x4 s = adap[i];
#pragma unroll
        for (int ks = 1; ks < ADA_KS; ++ks) s += adap[(size_t)ks * NV + i];
        ada[i] = s; }
}
__device__ __forceinline__ void p2_modulate0(const Frame& F, const CArgs& a) {
    const int gw = F.vcu * NWAVES + F.wave, NGW = F.G * NWAVES;
    const float* ada = (const float*)(a.ws + WS_ADA); bf16* H = (bf16*)(a.ws + WS_H);
    for (int row = gw; row < M; row += NGW) { const int b = row >> 12;
        const float* sh = ada + (size_t)b * NADA * D, * sc = sh + D;
#pragma unroll
        for (int j = 0; j < 8; ++j) { const int idx = 4 * (F.lane + 64 * j);
            const f32x4 xv = *(const f32x4*)(a.in[0] + (size_t)row * D + idx), s1 = *(const f32x4*)(sc + idx), s0 = *(const f32x4*)(sh + idx);
            const f32x4 h = xv * (s1 + 1.0f) + s0;
            *(v2u*)(H + (size_t)row * D + idx) = (v2u){pk2(h[0], h[1]), pk2(h[2], h[3])}; } }
}
__device__ __forceinline__ void vec_prep(const Frame& F, const CArgs& a) {
    const int gt = F.vcu * (NWAVES * 64) + F.tid, NGT = F.G * NWAVES * 64;
    const float* ada = (const float*)(a.ws + WS_ADA); float* vec = (float*)(a.ws + WS_VEC);
    for (int i = gt; i < 3 * DEPTH * BATCH * D; i += NGT) { const int d = i % D, sb = i / D, b = sb % BATCH, s = sb / BATCH, l = s / 3, j = s - 3 * l;
        const float* ad = ada + ((size_t)l * BATCH + b) * NADA * D + d;
        const float sh = ad[(3 * j) * D], sc = ad[(3 * j + 1) * D], gt_ = ad[(3 * j + 2) * D];
        const float lg = a.in[5][(size_t)(l * 3 + j) * D + d], lb = a.in[6][(size_t)(l * 3 + j) * D + d];
        float P = DN_ALPHA, Q = 0.f; if (s != 0) { P = DN_ALPHA / (1.0f + sc); Q = -P * sh; }
        float U = lg, W = lb;
        if (s != 3 * DEPTH - 1) { const int s1 = s + 1, l1 = s1 / 3, j1 = s1 - 3 * l1; const float* an = ada + ((size_t)l1 * BATCH + b) * NADA * D + d;
            const float nsh = an[(3 * j1) * D], nsc = an[(3 * j1 + 1) * D]; U = lg * (1.0f + nsc); W = lb * (1.0f + nsc) + nsh; }
        float* o = vec + (size_t)sb * 5 * D + d;
        o[0] = P; o[D] = Q; o[2 * D] = (j == 1 ? 1.0f : 0.5f) * (1.0f + gt_); o[3 * D] = U; o[4 * D] = W; }
}
template <bool FIRST>
__device__ __forceinline__ void ln_phase(const Frame& F, bf16* H, bf16* L, const bf16* f, const float* vecs  , const float* X32, float* OUT32) {
    const int gw = F.vcu * NWAVES + F.wave, NGW = F.G * NWAVES;
    constexpr int RPW = 8;
    LAS f32x4* lv = (LAS f32x4*)F.lds;
    int staged_b = -1;
    for (int r0 = gw * RPW; r0 < M; r0 += NGW * RPW) { const int b = r0 >> 12;
        if (b != staged_b) {
            if (staged_b >= 0) __syncthreads();
            const f32x4* src = (const f32x4*)(vecs + (size_t)b * 5 * D);
#pragma unroll
            for (int i = 0; i < 5; ++i) { const int q = F.tid + 512 * i, vec = q >> 9, e = (q & 511) * 4, j = e >> 9, ln = (e & 511) >> 3, half = (e >> 2) & 1;
                lv[((vec * 4 + j) * 2 + half) * 64 + ln] = src[q]; }
            __syncthreads(); staged_b = b; }
        v4u hq[4], lq[4], fq[4]; f32x4 xq[8];
#define LN_LOAD(row_) do { _Pragma("unroll") for (int j = 0; j < 4; ++j) { const int idx = 8 * (F.lane + 64 * j);                                     \
            fq[j] = *(const v4u*)(f + (size_t)(row_) * D + idx);                                                                                          \
            if (FIRST) { xq[2 * j] = *(const f32x4*)(X32 + (size_t)(row_) * D + idx); xq[2 * j + 1] = *(const f32x4*)(X32 + (size_t)(row_) * D + idx + 4); } \
            else { hq[j] = *(const v4u*)(H + (size_t)(row_) * D + idx); lq[j] = *(const v4u*)(L + (size_t)(row_) * D + idx); } } } while (0)
        LN_LOAD(r0);
#pragma unroll 1
        for (int i = 0; i < RPW; ++i) { const int row = r0 + i;
            int ln_ = F.lane; asm volatile("" : "+v"(ln_));
            float v[32]; float s = 0.f;
#pragma unroll
            for (int j = 0; j < 4; ++j) {
                const f32x4 p0 = lv[((0 * 4 + j) * 2 + 0) * 64 + ln_], p1 = lv[((0 * 4 + j) * 2 + 1) * 64 + ln_], q0 = lv[((1 * 4 + j) * 2 + 0) * 64 + ln_], q1 = lv[((1 * 4 + j) * 2 + 1) * 64 + ln_], c0 = lv[((2 * 4 + j) * 2 + 0) * 64 + ln_], c1 = lv[((2 * 4 + j) * 2 + 1) * 64 + ln_];
#pragma unroll
                for (int e = 0; e < 4; ++e) { const float fl = bf_lo(fq[j][e]), fh = bf_hi(fq[j][e]);
                    const float xl = FIRST ? xq[2 * j + (e >> 1)][(e & 1) * 2] : bf_lo(hq[j][e]) + bf_lo(lq[j][e]), xh = FIRST ? xq[2 * j + (e >> 1)][(e & 1) * 2 + 1] : bf_hi(hq[j][e]) + bf_hi(lq[j][e]);
                    const float pl = e < 2 ? p0[2 * e] : p1[2 * e - 4], ph_ = e < 2 ? p0[2 * e + 1] : p1[2 * e - 3], ql = e < 2 ? q0[2 * e] : q1[2 * e - 4], qh = e < 2 ? q0[2 * e + 1] : q1[2 * e - 3], cl = e < 2 ? c0[2 * e] : c1[2 * e - 4], ch = e < 2 ? c0[2 * e + 1] : c1[2 * e - 3];
                    const float vl = pl * xl + ql + cl * fl, vh = ph_ * xh + qh + ch * fh; v[8 * j + 2 * e] = vl; v[8 * j + 2 * e + 1] = vh; s += vl + vh; } }
            if (i + 1 < RPW) LN_LOAD(row + 1);
            const float mean = wave_sum(s) * (1.0f / D); float s2 = 0.f;
#pragma unroll
            for (int k = 0; k < 32; ++k) { v[k] -= mean; s2 += v[k] * v[k]; }
            const float rstd = 1.0f / sqrtf(wave_sum(s2) * (1.0f / D) + LN_EPS);
#pragma unroll
            for (int j = 0; j < 4; ++j) { const int idx = 8 * (ln_ + 64 * j);
                const f32x4 u0 = lv[((3 * 4 + j) * 2 + 0) * 64 + ln_], u1 = lv[((3 * 4 + j) * 2 + 1) * 64 + ln_], w0 = lv[((4 * 4 + j) * 2 + 0) * 64 + ln_], w1 = lv[((4 * 4 + j) * 2 + 1) * 64 + ln_];
                float o[8];
#pragma unroll
                for (int e = 0; e < 8; ++e) o[e] = v[8 * j + e] * rstd * (e < 4 ? u0[e] : u1[e - 4]) + (e < 4 ? w0[e] : w1[e - 4]);
                if (OUT32) { *(f32x4*)(OUT32 + (size_t)row * D + idx) = (f32x4){o[0], o[1], o[2], o[3]}; *(f32x4*)(OUT32 + (size_t)row * D + idx + 4) = (f32x4){o[4], o[5], o[6], o[7]}; }
                else { v4u hw, lw;
#pragma unroll
                    for (int e = 0; e < 4; ++e) { hw[e] = pk2(o[2 * e], o[2 * e + 1]); lw[e] = pk2(o[2 * e] - bf_lo(hw[e]), o[2 * e + 1] - bf_hi(hw[e])); }
                    *(v4u*)(H + (size_t)row * D + idx) = hw; *(v4u*)(L + (size_t)row * D + idx) = lw; } } }
#undef LN_LOAD
    }
    __syncthreads();
}
__device__ __forceinline__ void onorm_phase(const Frame& F, const bf16* O, bf16* ON) {
    const int gw = F.vcu * NWAVES + F.wave, NGW = F.G * NWAVES;
    for (int row = gw; row < M; row += NGW) {
#pragma unroll
        for (int g = 0; g < 2; ++g) { const bf16* p = O + (size_t)row * D + g * 1024 + 16 * F.lane; bf16* po = ON + (size_t)row * D + g * 1024 + 16 * F.lane;
            const v4u w0 = *(const v4u*)p, w1 = *(const v4u*)(p + 8);
            float x[16];
#pragma unroll
            for (int i = 0; i < 4; ++i) { x[2 * i] = bf_lo(w0[i]); x[2 * i + 1] = bf_hi(w0[i]); x[8 + 2 * i] = bf_lo(w1[i]); x[8 + 2 * i + 1] = bf_hi(w1[i]); }
            float s = 0.f;
#pragma unroll
            for (int i = 0; i < 16; ++i) s += x[i] * x[i];
            const float rs = 1.0f / sqrtf(wave_sum(s) * (1.0f / 1024.0f) + RMS_EPS);
            v4u o0, o1;
#pragma unroll
            for (int i = 0; i < 4; ++i) { o0[i] = pk2(x[2 * i] * rs, x[2 * i + 1] * rs); o1[i] = pk2(x[8 + 2 * i] * rs, x[8 + 2 * i + 1] * rs); }
            *(v4u*)po = o0; *(v4u*)(po + 8) = o1; } }
}
__device__ __forceinline__ void attn_phase(const Frame& F, const CArgs& a) {
    unsigned char* ws = a.ws;
    const bf16* QM = (const bf16*)(ws + WS_QM); const bf16* KV = (const bf16*)(ws + WS_KV); const bf16* KPE = (const bf16*)(ws + WS_KPE);
    const bf16* SBQ = (const bf16*)(ws + WS_SBQ); const bf16* SBK = (const bf16*)(ws + WS_SBK); const bf16* SBV = (const bf16*)(ws + WS_SBV);
    bf16* O = (bf16*)(ws + WS_O);
    constexpr int NQB = SEQ / 256, NPAIR = NQB / 2, NITEM = BATCH * NH * NPAIR;
    for (int it = F.vcu; it < NITEM; it += F.G) {
        const int bh = it / NPAIR, x = it - bh * NPAIR, b = bh / NH, h = bh - b * NH;
        const size_t r0 = (size_t)b * SEQ;
#if SITE_ATT & 1
#pragma unroll 1
        for (int pass = 0; pass < 2; ++pass) { const int qb = pass ? NQB - 1 - x : x; const size_t rq = r0 + (size_t)qb * 256;
            att::attn_block<false>(F.lds, QM + rq * (NH * QKD) + h * QKD, NH * QKD, KV + r0 * D + h * 256, D, KV + r0 * D + h * 256 + 128, D, KPE + r0 * 64, O + rq * D + h * HD, D, qb * 256); }
#endif
#if SITE_ATT & 2
#pragma unroll 1
        for (int pass = 0; pass < 2; ++pass) { const int qb = pass ? NQB - 1 - x : x; const size_t rq = r0 + (size_t)qb * 256;
            att::attn_block<true>(F.lds, SBQ + rq * 1024 + h * HD, 1024, SBK + r0 * 1024 + h * HD, 1024, SBV + r0 * 1024 + h * HD, 1024, nullptr, O + rq * D + 1024 + h * HD, D, qb * 256); }
#endif
    }
}

__global__ void __launch_bounds__(NWAVES * 64, 2) mk_fwd(Args args_unused) {
    extern __shared__ __attribute__((aligned(16))) unsigned char lds[];
    (void)args_unused;
    CArgs* ap = (CArgs*)__builtin_amdgcn_kernarg_segment_ptr();
    Frame F;
    F.lds = (LAS unsigned char*)lds;
    F.tid = threadIdx.x; F.lane = F.tid & 63; F.wave = __builtin_amdgcn_readfirstlane(F.tid >> 6);
    F.G = gridDim.x; { const int bx = blockIdx.x; F.vcu = (F.G % 8 == 0) ? (bx % 8) * (F.G / 8) + bx / 8 : bx; }
    volatile LAS unsigned* MISC = (volatile LAS unsigned*)(F.lds + MISC_OFF);
    for (int u = F.tid; u < (LDS_BYTES - MISC_OFF) / 4; u += NWAVES * 64) ((LAS unsigned*)(F.lds + MISC_OFF))[u] = 0u;
    __syncthreads();
    XcdBarrier bar; bar.bar = (unsigned*)(ap->ws + WS_CTL) + CW_BAR; bar.x = 0; bar.st = nullptr;
    if (MK_ONE_LAUNCH) bar = xcd_barrier_post((unsigned*)(ap->ws + WS_CTL) + CW_BAR, MISC + 8);
    const int lo = ap->ph_lo, hi = ap->ph_hi; int ph = 0; bool fin_ = false;
#define RUN_PH (ph >= lo && ph < hi)
#define END_PH do { if (MK_ONE_LAUNCH && RUN_PH && ph + 1 < hi && !fin_) xcd_barrier(bar); ++ph; } while (0)
#define WSP(T, off) ((T*)(A->ws + (off)))

REP(DUP_P0) {
#if SITE_P0
    if (RUN_PH) p0_prologue(fresh_frame(F), *fresh_args(ap));
#endif
    END_PH; }
REP(DUP_P1) {
#if SITE_P1
    if (RUN_PH) p1_ada_reduce(fresh_frame(F), *fresh_args(ap));
#endif
    END_PH; }
REP(DUP_P2) {
#if SITE_P2
    if (RUN_PH) { p2_modulate0(fresh_frame(F), *fresh_args(ap)); vec_prep(fresh_frame(F), *fresh_args(ap)); }
#endif
    END_PH; }

#pragma unroll 1
    for (int s = 0; s <= DBG_LAST_S; ++s) {
        const int l = s / 3, j = s - 3 * l;
        if (j != 1) {
REP(DUP_G1) {
#if SITE_G1
            if (RUN_PH) { CArgs* A = fresh_args(ap); const unsigned char* wl = A->ws + WS_W + (size_t)l * W_LAYER;
                pg8::Gemm g{WSP(const bf16, WS_H), (const bf16*)(wl + (j == 0 ? WO_WI1 : WO_WI2)), M, 2 * FF, D}; pg8::StaticOrder S; S.init(M, 2 * FF, F.G, (int)blockIdx.x);
                pg8::EpiSwiGLU E{WSP(bf16, WS_ACT), FF};
                pg8::gemm_phase<pg8::EpiSwiGLU, pg8::StaticOrder, true, true>(F.lds + RING_OFF, g, S, E);
            }
#endif
            END_PH; }
        } else {
REP(DUP_WIN) {
#if SITE_WIN
            if (RUN_PH) { CArgs* A = fresh_args(ap); const unsigned char* wl = A->ws + WS_W + (size_t)l * W_LAYER;
                pg8::Gemm g{WSP(const bf16, WS_H), (const bf16*)(wl + WO_WIN), M, WIN_ROWS, D}; pg8::StaticOrder S; S.init(M, WIN_ROWS, F.G, (int)blockIdx.x);
                pg8::EpiWin E{WSP(bf16, WS_CQ), WSP(bf16, WS_CKV), WSP(bf16, WS_SBQ), WSP(bf16, WS_SBK), WSP(bf16, WS_SBV), WSP(bf16, WS_KPE), WSP(float, WS_SSQ), WSP(const float, WS_ROPE), SB_QSCALE};
                pg8::gemm_phase<pg8::EpiWin, pg8::StaticOrder, true, true>(F.lds + RING_OFF, g, S, E);
            }
#endif
            END_PH; }
REP(DUP_UQKV) {
#if SITE_UQKV
            if (RUN_PH) {
                { CArgs* A = fresh_args(ap); const unsigned char* wl = A->ws + WS_W + (size_t)l * W_LAYER;
                  pg8::Gemm g{WSP(const bf16, WS_CQ), (const bf16*)(wl + WO_WUQ), M, NH * QKD, QLR}; pg8::StaticOrder S; S.init(M, NH * QKD, F.G, (int)blockIdx.x);
                  pg8::EpiRS<true> E{WSP(bf16, WS_QM), NH * QKD, WSP(const float, WS_SSQ), 0, 3, 1.0f / QLR, RMS_EPS, MLA_QSCALE, WSP(const float, WS_ROPE)};
                  pg8::gemm_phase<pg8::EpiRS<true>, pg8::StaticOrder, true, true>(F.lds + RING_OFF, g, S, E); }
                { CArgs* A = fresh_args(ap); const unsigned char* wl = A->ws + WS_W + (size_t)l * W_LAYER;
                  pg8::Gemm g{WSP(const bf16, WS_CKV), (const bf16*)(wl + WO_WUKV), M, NH * 256, KVLR}; pg8::StaticOrder S; S.init(M, NH * 256, F.G, (int)blockIdx.x);
                  pg8::EpiRS<false> E{WSP(bf16, WS_KV), NH * 256, WSP(const float, WS_SSQ), 3, 2, 1.0f / KVLR, RMS_EPS, 1.0f, nullptr};
                  pg8::gemm_phase<pg8::EpiRS<false>, pg8::StaticOrder, true, true>(F.lds + RING_OFF, g, S, E); }
            }
#endif
            END_PH; }
REP(DUP_ATT) {
#if SITE_ATT
            if (RUN_PH) attn_phase(fresh_frame(F), *fresh_args(ap));
#endif
            END_PH; }
REP(DUP_ONORM) {
#if SITE_ONORM
            if (RUN_PH) { CArgs* A = fresh_args(ap); onorm_phase(fresh_frame(F), WSP(const bf16, WS_O), WSP(bf16, WS_ACT)); }
#endif
            END_PH; }
        }
REP(DUP_GF) {
#if SITE_GF
        if (RUN_PH) { CArgs* A = fresh_args(ap); const unsigned char* wl = A->ws + WS_W + (size_t)l * W_LAYER;
            pg8::Gemm g{WSP(const bf16, WS_ACT), (const bf16*)(wl + (j == 0 ? WO_WO1 : j == 2 ? WO_WO2 : WO_WOUT)), M, D, j != 1 ? FF : D}; pg8::StaticOrder S; S.init(M, D, F.G, (int)blockIdx.x);
            pg8::EpiPlain E{WSP(bf16, WS_F), D};
            pg8::gemm_phase<pg8::EpiPlain, pg8::StaticOrder, true, true>(F.lds + RING_OFF, g, S, E);
        }
#endif
        END_PH; }
REP(DUP_LN) {
#if SITE_LN
        fin_ = (s == DBG_LAST_S);
        if (RUN_PH) { CArgs* A = fresh_args(ap); const bool last = s == DBG_LAST_S;
            if (s == 0) ln_phase<true>(fresh_frame(F), WSP(bf16, WS_H), WSP(bf16, WS_HL), WSP(const bf16, WS_F), WSP(const float, WS_VEC), A->in[0], last ? A->out : nullptr);
            else ln_phase<false>(fresh_frame(F), WSP(bf16, WS_H), WSP(bf16, WS_HL), WSP(const bf16, WS_F), WSP(const float, WS_VEC) + (size_t)s * BATCH * 5 * D, nullptr, last ? A->out : nullptr);
        }
#endif
        END_PH; }
    }
#undef RUN_PH
#undef END_PH
#undef WSP
}

extern "C" void kernel_launch(void* const* d_in, const int* in_sizes, int n_in, void* d_out, int out_size, void* d_ws, size_t ws_size, hipStream_t stream) {
    static int grid = 0;
    if (grid == 0) {
        if (n_in != 19 || in_sizes[0] != M * D || out_size != M * D || ws_size < WS_END) { fprintf(stderr, "kernel_launch: unexpected shapes (n_in %d, in0 %d, out %d, ws %zu < %zu); nothing launched\n", n_in, n_in > 0 ? in_sizes[0] : -1, out_size, ws_size, (size_t)WS_END); grid = -1; return; }
        int dev = 0, cus = 0, per_cu = 0;
        if (hipGetDevice(&dev) != hipSuccess || hipDeviceGetAttribute(&cus, hipDeviceAttributeMultiprocessorCount, dev) != hipSuccess) { grid = -1; return; }
        if (hipFuncSetAttribute((const void*)mk_fwd, hipFuncAttributeMaxDynamicSharedMemorySize, LDS_BYTES) != hipSuccess) { fprintf(stderr, "kernel_launch: hipFuncSetAttribute failed\n"); grid = -1; return; }
        if (hipOccupancyMaxActiveBlocksPerMultiprocessor(&per_cu, (const void*)mk_fwd, NWAVES * 64, LDS_BYTES) != hipSuccess || per_cu < 1)
            fprintf(stderr, "kernel_launch: note: occupancy query reports %d workgroups per CU\n", per_cu);
        (void)hipGetLastError();
        grid = cus;
    }
    if (grid < 0) return;
    if (hipMemsetAsync((char*)d_ws + WS_CTL, 0, CTL_ZERO_BYTES, stream) != hipSuccess) { fprintf(stderr, "kernel_launch: hipMemsetAsync failed\n"); return; }
    Args a{};
    for (int i = 0; i < 19; ++i) a.in[i] = (const float*)d_in[i];
    a.out = (float*)d_out; a.ws = (unsigned char*)d_ws;
#if MK_ONE_LAUNCH
    a.ph_lo = 0; a.ph_hi = 1 << 20;
    hipLaunchKernelGGL(mk_fwd, dim3(grid), dim3(NWAVES * 64), LDS_BYTES, stream, a);
#else
    for (int p = 0; p < N_PHASES; ++p) { a.ph_lo = p; a.ph_hi = p + 1; hipLaunchKernelGGL(mk_fwd, dim3(grid), dim3(NWAVES * 64), LDS_BYTES, stream, a); }
#endif
}
```

```cpp
#include <hip/hip_runtime.h>
#include <cstdio>
#include <cstdint>
#include <cmath>
namespace pg8 {
#define PG8_LAS __attribute__((address_space(3)))
typedef unsigned short bf16_t;
typedef short bf16x8 __attribute__((ext_vector_type(8)));
typedef float f32x4 __attribute__((ext_vector_type(4)));
typedef unsigned u32x4 __attribute__((ext_vector_type(4)));
constexpr int BM = 256, BK = 64, HALF = 128, HTB = HALF * BK * 2  , STAGE_BYTES = 8 * HTB, NXCD = 8, WGM = 8;

__host__ __device__ __forceinline__ int lds_byte(int r, int c) { const int st = (r >> 4) * 2 + (c >> 5), rr = r & 15, cc = c & 31, ob = rr * 64 + cc * 2; return st * 1024 + (ob ^ (((ob >> 9) & 1) << 5)); }
__host__ __device__ __forceinline__ void stage_rc(int b, int& R, int& C) { const int st = b / 1024, sb = b % 1024, swz = sb ^ (((sb >> 9) & 1) << 5); R = (st >> 1) * 16 + swz / 64; C = (st & 1) * 32 + (swz % 64) / 2; }
__host__ __device__ __forceinline__ int perm32(int rho) { const int n = rho >> 4, i = rho & 15; return 8 * (i >> 2) + 4 * n + (i & 3); }

struct Unit { int pm, pn; };
struct Gemm { const bf16_t* A; const bf16_t* Bt; int M, N, K; };

struct StaticOrder {
    int nM, nN, nwg, G, c;
    __host__ __device__ void init(int M, int N, int G_, int c_) { nM = M / BM; nN = N / BM; nwg = nM * nN; G = G_; c = c_; }
    __host__ __device__ bool next(int i, Unit& u) const {
        const long L = (long)i * G + c; if (L >= nwg) return false;
        int wgid = (int)L; { const int q = nwg / NXCD, r = nwg % NXCD, xcd = wgid % NXCD, off = wgid / NXCD; wgid = (xcd < r ? xcd * (q + 1) : r * (q + 1) + (xcd - r) * q) + off; }
        const int nig = WGM * nN, gid = wgid / nig, fm = gid * WGM, gsz = (nM - fm) < WGM ? (nM - fm) : WGM;
        u.pm = fm + ((wgid % nig) % gsz); u.pn = (wgid % nig) / gsz; return true;
    }
    __device__ __forceinline__ void a_ready(const Unit&) const {}
    __device__ __forceinline__ void done(const Unit&) const {}
};


#ifndef EPI_NT
#define EPI_NT 0
#endif

__device__ __forceinline__ unsigned cvt_pk_bf16(float lo, float hi) { unsigned r; asm volatile("v_cvt_pk_bf16_f32 %0, %1, %2" : "=v"(r) : "v"(lo), "v"(hi)); return r; }
typedef float f32x2 __attribute__((ext_vector_type(2)));
__device__ __forceinline__ u32x4 pack8bf(const f32x4 v0, const f32x4 v1) { u32x4 w; w.x = cvt_pk_bf16(v0[0], v0[1]); w.y = cvt_pk_bf16(v0[2], v0[3]); w.z = cvt_pk_bf16(v1[0], v1[1]); w.w = cvt_pk_bf16(v1[2], v1[3]); return w; }

struct EpiPlain {
    static constexpr bool PERM = true, AFTER_DRAIN = false;
    bf16_t* O; int ldc;
    __device__ __forceinline__ void operator()(const f32x4 (&acc)[2][2][4][2], const Unit& u, int wr, int wc, int fr, int fq) const {
        const int row0 = u.pm * BM + wr * 64 + fr; const int col0 = u.pn * BM + wc * 32 + 8 * fq;
#pragma unroll
        for (int ai = 0; ai < 2; ++ai)
#pragma unroll
            for (int m = 0; m < 4; ++m) { bf16_t* rowp = O + (size_t)(row0 + ai * HALF + m * 16) * ldc + col0;
#pragma unroll
                for (int bj = 0; bj < 2; ++bj) { const u32x4 w = pack8bf(acc[ai][bj][m][0], acc[ai][bj][m][1]); if (EPI_NT) __builtin_nontemporal_store(w, (u32x4*)(rowp + bj * HALF)); else *(u32x4*)(rowp + bj * HALF) = w; } }
    }
};

struct EpiSwiGLU {
    static constexpr bool PERM = true, AFTER_DRAIN = false;
    bf16_t* O; int ldc;
    __device__ __forceinline__ static f32x4 sg(const f32x4 g, const f32x4 up) {
        f32x4 r;
#pragma unroll
        for (int i = 0; i < 4; ++i) { const float e = __builtin_amdgcn_exp2f(g[i] * -1.4426950408889634f); r[i] = g[i] * __builtin_amdgcn_rcpf(1.0f + e) * up[i]; }
        return r;
    }
    __device__ __forceinline__ void operator()(const f32x4 (&acc)[2][2][4][2], const Unit& u, int wr, int wc, int fr, int fq) const {
        const int row0 = u.pm * BM + wr * 64 + fr; const int col0 = u.pn * HALF + wc * 32 + 8 * fq;
#pragma unroll
        for (int ai = 0; ai < 2; ++ai)
#pragma unroll
            for (int m = 0; m < 4; ++m) { bf16_t* rowp = O + (size_t)(row0 + ai * HALF + m * 16) * ldc + col0;
                const f32x4 h0 = sg(acc[ai][0][m][0], acc[ai][1][m][0]), h1 = sg(acc[ai][0][m][1], acc[ai][1][m][1]);
                { const u32x4 w = pack8bf(h0, h1); if (EPI_NT) __builtin_nontemporal_store(w, (u32x4*)rowp); else *(u32x4*)rowp = w; } }
    }
};

__device__ __forceinline__ void rope8(f32x4& v0, f32x4& v1, const f32x4 cs0, const f32x4 cs1) {
    const float a0 = v0[0], b0 = v0[1], a1 = v0[2], b1 = v0[3], a2 = v1[0], b2 = v1[1], a3 = v1[2], b3 = v1[3];
    v0[0] = a0 * cs0[0] - b0 * cs0[1]; v0[1] = a0 * cs0[1] + b0 * cs0[0];
    v0[2] = a1 * cs0[2] - b1 * cs0[3]; v0[3] = a1 * cs0[3] + b1 * cs0[2];
    v1[0] = a2 * cs1[0] - b2 * cs1[1]; v1[1] = a2 * cs1[1] + b2 * cs1[0];
    v1[2] = a3 * cs1[2] - b3 * cs1[3]; v1[3] = a3 * cs1[3] + b3 * cs1[2];
}

struct EpiWin {
    static constexpr bool PERM = true, AFTER_DRAIN = false;
    bf16_t *CQ, *CKV, *SBQ, *SBK, *SBV, *KPE; float* SSQ; const float* ROPE; float sbq_scale;
    __device__ __forceinline__ void operator()(const f32x4 (&acc)[2][2][4][2], const Unit& u, int wr, int wc, int fr, int fq) const {
        const int pn = u.pn; const int row0 = u.pm * BM + wr * 64 + fr;
        if (pn < 17) {
            bf16_t* base; int ldc, colt; float sc = 1.0f; const bool ssq = pn < 5;
            if (pn < 3) { base = CQ; ldc = 768; colt = pn * BM; }
            else if (pn < 5) { base = CKV; ldc = 512; colt = (pn - 3) * BM; }
            else if (pn < 9) { base = SBQ; ldc = 1024; colt = (pn - 5) * BM; sc = sbq_scale; }
            else if (pn < 13) { base = SBK; ldc = 1024; colt = (pn - 9) * BM; }
            else { base = SBV; ldc = 1024; colt = (pn - 13) * BM; }
            const int col0 = colt + wc * 32 + 8 * fq;
#pragma unroll
            for (int ai = 0; ai < 2; ++ai)
#pragma unroll
                for (int m = 0; m < 4; ++m) { const int row = row0 + ai * HALF + m * 16; bf16_t* rowp = base + (size_t)row * ldc + col0; float s = 0.f;
#pragma unroll
                    for (int bj = 0; bj < 2; ++bj) { const f32x4 v0 = acc[ai][bj][m][0] * sc, v1 = acc[ai][bj][m][1] * sc;
                        s += (v0[0] * v0[0] + v0[1] * v0[1]) + (v0[2] * v0[2] + v0[3] * v0[3]) + (v1[0] * v1[0] + v1[1] * v1[1]) + (v1[2] * v1[2] + v1[3] * v1[3]);
                        *(u32x4*)(rowp + bj * HALF) = pack8bf(v0, v1); }
                    if (ssq) { s += __shfl_xor(s, 16); s += __shfl_xor(s, 32); if (fq == 0) SSQ[((size_t)row * 5 + pn) * 4 + wc] = s; } }
        } else if (wc < 2) {
            const int c0 = wc * 32 + 8 * fq;
#pragma unroll
            for (int ai = 0; ai < 2; ++ai)
#pragma unroll
                for (int m = 0; m < 4; ++m) { const int row = row0 + ai * HALF + m * 16;
                    const f32x4 cs0 = *(const f32x4*)(ROPE + (size_t)row * 64 + c0), cs1 = *(const f32x4*)(ROPE + (size_t)row * 64 + c0 + 4);
                    f32x4 v0 = acc[ai][0][m][0], v1 = acc[ai][0][m][1]; rope8(v0, v1, cs0, cs1);
                    *(u32x4*)(KPE + (size_t)row * 64 + c0) = pack8bf(v0, v1); }
        }
    }
};

template <bool ROPE_Q> struct EpiRS {
    static constexpr bool PERM = true, AFTER_DRAIN = false;
    bf16_t* O; int ldc; const float* SSQ; int t0, nt; float invn, eps, oscale; const float* ROPE;
    __device__ __forceinline__ void operator()(const f32x4 (&acc)[2][2][4][2], const Unit& u, int wr, int wc, int fr, int fq) const {
        const int row0 = u.pm * BM + wr * 64 + fr; const int col0 = u.pn * BM + wc * 32 + 8 * fq;
        float rsv[2][4];
#pragma unroll
        for (int ai = 0; ai < 2; ++ai)
#pragma unroll
            for (int m = 0; m < 4; ++m) { const int row = row0 + ai * HALF + m * 16; f32x4 q = {0.f, 0.f, 0.f, 0.f};
                if (fq < nt) q = *(const f32x4*)(SSQ + ((size_t)row * 5 + t0 + fq) * 4);
                rsv[ai][m] = (q[0] + q[1]) + (q[2] + q[3]); }
#pragma unroll
        for (int ai = 0; ai < 2; ++ai)
#pragma unroll
            for (int m = 0; m < 4; ++m) { float ss = rsv[ai][m]; ss += __shfl_xor(ss, 16); ss += __shfl_xor(ss, 32); rsv[ai][m] = oscale / sqrtf(ss * invn + eps); }
#pragma unroll
        for (int ai = 0; ai < 2; ++ai)
#pragma unroll
            for (int m = 0; m < 4; ++m) { const int row = row0 + ai * HALF + m * 16;
                const float rs = rsv[ai][m];
#pragma unroll
                for (int bj = 0; bj < 2; ++bj) { const int c = col0 + bj * HALF; f32x4 v0 = acc[ai][bj][m][0] * rs, v1 = acc[ai][bj][m][1] * rs;
                    if (ROPE_Q) { const int w = c % 192; if (w >= 128) { const float* cs = ROPE + (size_t)row * 64 + (w - 128); rope8(v0, v1, *(const f32x4*)cs, *(const f32x4*)(cs + 4)); } }
                    *(u32x4*)(O + (size_t)row * ldc + c) = pack8bf(v0, v1); } }
    }
};

#ifndef PG8_EPI_DUP
#define PG8_EPI_DUP 0
#endif
template <class Epi, class Sched, bool ALIGN_EPI = false, bool SP2 = false>
__device__ __forceinline__ void gemm_phase(PG8_LAS unsigned char* lds, const Gemm g, const Sched& S, const Epi& E) {
    int tid_ = threadIdx.x; asm volatile("" : "+v"(tid_));
    const int tid = tid_, wid = __builtin_amdgcn_readfirstlane(tid >> 6), lane = tid & 63, wr = wid >> 2, wc = wid & 3, fr = lane & 15, fq = lane >> 4;
    const int K = g.K, nt = K / BK;
    unsigned voffA[2], voffB[2];
#pragma unroll
    for (int i = 0; i < 2; ++i) { int R, C; stage_rc(tid * 16 + i * 8192, R, C); const int Rb = Epi::PERM ? ((R & ~31) + perm32(R & 31)) : R;
        voffA[i] = (unsigned)(R * K + C) * 2u; voffB[i] = (unsigned)(Rb * K + C) * 2u; }
    const size_t kstep = (size_t)(BK * 2);
    const size_t hstep = (size_t)HALF * K * 2;
    const size_t tstep = 2 * hstep;
    const unsigned ldsw = (unsigned)wid * 1024u;
    const int aoff = lds_byte(wr * 64 + fr, fq * 8), boff = lds_byte(wc * 32 + fr, fq * 8);
#define PG8_SA(b, h) (((b) * 2 + (h)) * HTB)
#define PG8_SB(b, h) ((4 + (b) * 2 + (h)) * HTB)
#define PG8_STAGE(bufoff, gbase, voff) do { _Pragma("unroll") for (int _i = 0; _i < 2; ++_i) \
        __builtin_amdgcn_global_load_lds((const unsigned*)((const char*)(gbase) + (voff)[_i]), (PG8_LAS unsigned*)(lds + (bufoff) + ldsw + _i * 8192), 16, 0, 0); } while (0)
#define PG8_LDA(dst, b, h) do { _Pragma("unroll") for (int m = 0; m < 4; ++m) _Pragma("unroll") for (int k = 0; k < 2; ++k) dst[m][k] = *(const PG8_LAS bf16x8*)(lds + PG8_SA(b, h) + aoff + m * 2048 + k * 1024); } while (0)
#define PG8_LDB(dst, b, h) do { _Pragma("unroll") for (int n = 0; n < 2; ++n) _Pragma("unroll") for (int k = 0; k < 2; ++k) dst[n][k] = *(const PG8_LAS bf16x8*)(lds + PG8_SB(b, h) + boff + n * 2048 + k * 1024); } while (0)
#define PG8_MMA(ai, bj, At, Bt) do { __builtin_amdgcn_s_setprio(1); _Pragma("unroll") for (int m = 0; m < 4; ++m) _Pragma("unroll") for (int n = 0; n < 2; ++n) _Pragma("unroll") for (int k = 0; k < 2; ++k) \
        acc[ai][bj][m][n] = __builtin_amdgcn_mfma_f32_16x16x32_bf16(Bt[n][k], At[m][k], acc[ai][bj][m][n], 0, 0, 0); __builtin_amdgcn_s_setprio(0); } while (0)
#define PG8_WAIT_V(n) asm volatile("s_waitcnt vmcnt(" #n ")" ::: "memory")
#define PG8_WAIT_L(n) asm volatile("s_waitcnt lgkmcnt(" #n ")" ::: "memory")
#define PG8_BAR __builtin_amdgcn_s_barrier()
#define PG8_SCHED __builtin_amdgcn_sched_barrier(0)
    Unit cur, nxt; int ui = 0;
    if (!S.next(0, cur)) return;
    f32x4 acc[2][2][4][2];
#pragma unroll
    for (int a = 0; a < 2; ++a)
#pragma unroll
        for (int b = 0; b < 2; ++b)
#pragma unroll
            for (int m = 0; m < 4; ++m)
#pragma unroll
                for (int n = 0; n < 2; ++n) acc[a][b][m][n] = (f32x4){0.f, 0.f, 0.f, 0.f};
    bf16x8 At[4][2], B0[2][2], B1[2][2];
    const char* cA = (const char*)g.A + (size_t)cur.pm * tstep; const char* cB = (const char*)g.Bt + (size_t)cur.pn * tstep;
    S.a_ready(cur);
    if constexpr (SP2) {
        PG8_STAGE(PG8_SB(0, 0), cB, voffB); PG8_STAGE(PG8_SB(0, 1), cB + hstep, voffB); PG8_STAGE(PG8_SA(0, 0), cA, voffA); PG8_STAGE(PG8_SA(0, 1), cA + hstep, voffA);
        if (wr == 1) PG8_BAR;
        PG8_WAIT_V(2); PG8_BAR;
        PG8_STAGE(PG8_SB(1, 0), cB + kstep, voffB); PG8_STAGE(PG8_SA(1, 0), cA + kstep, voffA); PG8_STAGE(PG8_SB(1, 1), cB + hstep + kstep, voffB);
        PG8_WAIT_V(6); PG8_BAR;
    } else {
        PG8_STAGE(PG8_SB(0, 0), cB, voffB); PG8_STAGE(PG8_SA(0, 0), cA, voffA); PG8_STAGE(PG8_SB(0, 1), cB + hstep, voffB); PG8_STAGE(PG8_SA(0, 1), cA + hstep, voffA);
        if (wr == 1) PG8_BAR;
        PG8_WAIT_V(4); PG8_BAR;
        PG8_STAGE(PG8_SB(1, 0), cB + kstep, voffB); PG8_STAGE(PG8_SA(1, 0), cA + kstep, voffA); PG8_STAGE(PG8_SB(1, 1), cB + hstep + kstep, voffB);
        PG8_WAIT_V(6); PG8_BAR;
    }
    for (;;) {
        const bool has_next = S.next(ui + 1, nxt);
        const char* nA = has_next ? (const char*)g.A + (size_t)nxt.pm * tstep : cA; const char* nB = has_next ? (const char*)g.Bt + (size_t)nxt.pn * tstep : cB;
        for (int t = 0; t < nt; t += 2) {
            const bool last = (t == nt - 2);
            const char* a1 = cA + (size_t)(t + 1) * kstep;
            const char* a2 = last ? nA : cA + (size_t)(t + 2) * kstep; const char* b2 = last ? nB : cB + (size_t)(t + 2) * kstep;
            const char* a3 = a2 + kstep; const char* b3 = b2 + kstep;
            if (last && has_next) S.a_ready(nxt);
            if constexpr (SP2) {
            PG8_LDB(B0, 0, 0); PG8_LDB(B1, 0, 1); PG8_SCHED; PG8_LDA(At, 0, 0); PG8_STAGE(PG8_SA(1, 1), a1 + hstep, voffA);
            PG8_WAIT_V(8); PG8_WAIT_L(0); PG8_BAR; PG8_MMA(0, 0, At, B0); PG8_MMA(0, 1, At, B1); PG8_BAR; PG8_SCHED;
            PG8_LDA(At, 0, 1); PG8_STAGE(PG8_SB(0, 0), b2, voffB); PG8_STAGE(PG8_SB(0, 1), b2 + hstep, voffB); PG8_STAGE(PG8_SA(0, 0), a2, voffA);
            PG8_WAIT_V(8); PG8_WAIT_L(0); PG8_BAR; PG8_MMA(1, 0, At, B0); PG8_MMA(1, 1, At, B1); PG8_BAR; PG8_SCHED;
            PG8_LDB(B0, 1, 0); PG8_LDB(B1, 1, 1); PG8_SCHED; PG8_LDA(At, 1, 0); PG8_STAGE(PG8_SA(0, 1), a2 + hstep, voffA);
            PG8_WAIT_V(8); PG8_WAIT_L(0); PG8_BAR; PG8_MMA(0, 0, At, B0); PG8_MMA(0, 1, At, B1); PG8_BAR; PG8_SCHED;
            PG8_LDA(At, 1, 1); PG8_STAGE(PG8_SB(1, 0), b3, voffB); PG8_STAGE(PG8_SB(1, 1), b3 + hstep, voffB); PG8_STAGE(PG8_SA(1, 0), a3, voffA);
            PG8_WAIT_V(8); PG8_WAIT_L(0); PG8_BAR; PG8_MMA(1, 0, At, B0); PG8_MMA(1, 1, At, B1); PG8_BAR; PG8_SCHED;
            } else {
            PG8_LDB(B0, 0, 0); PG8_SCHED; PG8_LDA(At, 0, 0); PG8_STAGE(PG8_SA(1, 1), a1 + hstep, voffA);
            PG8_WAIT_L(8); PG8_BAR; PG8_WAIT_L(0); PG8_MMA(0, 0, At, B0); PG8_BAR; PG8_SCHED;
            PG8_LDB(B1, 0, 1); PG8_STAGE(PG8_SB(0, 0), b2, voffB);
            PG8_BAR; PG8_WAIT_L(0); PG8_MMA(0, 1, At, B1); PG8_BAR;
            PG8_LDA(At, 0, 1); PG8_STAGE(PG8_SA(0, 0), a2, voffA);
            PG8_BAR; PG8_WAIT_L(0); PG8_MMA(1, 0, At, B0); PG8_BAR; PG8_SCHED;
            PG8_STAGE(PG8_SB(0, 1), b2 + hstep, voffB);
            PG8_WAIT_V(6); PG8_BAR; PG8_MMA(1, 1, At, B1); PG8_BAR;
            PG8_LDB(B0, 1, 0); PG8_SCHED; PG8_LDA(At, 1, 0); PG8_STAGE(PG8_SA(0, 1), a2 + hstep, voffA);
            PG8_WAIT_L(8); PG8_BAR; PG8_WAIT_L(0); PG8_MMA(0, 0, At, B0); PG8_BAR; PG8_SCHED;
            PG8_LDB(B1, 1, 1); PG8_STAGE(PG8_SB(1, 0), b3, voffB);
            PG8_BAR; PG8_WAIT_L(0); PG8_MMA(0, 1, At, B1); PG8_BAR;
            PG8_LDA(At, 1, 1); PG8_STAGE(PG8_SA(1, 0), a3, voffA);
            PG8_BAR; PG8_WAIT_L(0); PG8_MMA(1, 0, At, B0); PG8_BAR; PG8_SCHED;
            PG8_STAGE(PG8_SB(1, 1), b3 + hstep, voffB);
            PG8_WAIT_V(6); PG8_BAR; PG8_MMA(1, 1, At, B1); PG8_BAR;
            }
        }
        if constexpr (ALIGN_EPI) { if (wr == 0) PG8_BAR; }
        if constexpr (!Epi::AFTER_DRAIN) { E(acc, cur, wr, wc, fr, fq); if (PG8_EPI_DUP) { asm volatile("" ::: "memory"); E(acc, cur, wr, wc, fr, fq); } S.done(cur); }
        if (!has_next) break;
#pragma unroll
        for (int a = 0; a < 2; ++a)
#pragma unroll
            for (int b = 0; b < 2; ++b)
#pragma unroll
                for (int m = 0; m < 4; ++m)
#pragma unroll
                    for (int n = 0; n < 2; ++n) acc[a][b][m][n] = (f32x4){0.f, 0.f, 0.f, 0.f};
        cur = nxt; cA = nA; cB = nB; ++ui;
        if constexpr (ALIGN_EPI) { if (wr == 1) PG8_BAR; }
    }
    PG8_WAIT_V(0);
    if constexpr (!ALIGN_EPI) { if (wr == 0) PG8_BAR; }
    PG8_BAR;
    if constexpr (Epi::AFTER_DRAIN) { E.fused(acc, cur, wr, wc, fr, fq, lds, wid, lane); S.done(cur); }
#undef PG8_SA
#undef PG8_SB
#undef PG8_STAGE
#undef PG8_LDA
#undef PG8_LDB
#undef PG8_MMA
#undef PG8_WAIT_V
#undef PG8_WAIT_L
#undef PG8_BAR
#undef PG8_SCHED
}
}


namespace att {
typedef unsigned short bf16_t;
typedef short bf16x8 __attribute__((ext_vector_type(8)));
typedef short s16x4 __attribute__((ext_vector_type(4)));
typedef float f32x16 __attribute__((ext_vector_type(16)));
typedef float f32x4 __attribute__((ext_vector_type(4)));
typedef unsigned u32x4 __attribute__((ext_vector_type(4)));
#define ATT_LAS __attribute__((address_space(3)))
#ifndef ATT_PRIO
#define ATT_PRIO 1
#endif
#ifndef SB_EARLY_EXIT
#define SB_EARLY_EXIT 1
#endif
constexpr int KVBLK = 64, QB = 256;
constexpr int SHM_V = 16384, SHM_K = 16384, SHM_R = 8192;
constexpr int OFF_V = 0, OFF_K = 2 * SHM_V, OFF_R = OFF_K + 2 * SHM_K, OFF_WS = OFF_R + 2 * SHM_R, OFF_FLAG = OFF_WS + 8 * 256, OFF_QR = OFF_FLAG + 64, ATT_LDS_BYTES = OFF_QR + 8 * 4096;
#define KSWZ(row, colB) ((row) * 256 + ((colB) ^ (((row) & 7) << 4)))
#define RSWZ(row, colB) ((row) * 128 + ((colB) ^ (((row) & 7) << 4)))
#define SBAR() __builtin_amdgcn_sched_barrier(0)
__device__ __forceinline__ int v_st(int k, int c) { const int kk = (k & ~0xC) | ((k & 4) << 1) | ((k & 8) >> 1); return ((kk >> 3) * 4 + (c >> 5)) * 512 + ((kk & 7) * 32 + (c & 31)) * 2; }
__device__ __forceinline__ int v_rd_base(int lane) { return ((lane & 3) << 3) | (((lane >> 2) & 3) << 6) | (((lane >> 4) & 1) << 5) | (((lane >> 5) & 1) << 8); }
__device__ __forceinline__ int crow(int r, int hi) { return (r & 3) + 8 * (r >> 2) + 4 * hi; }
__device__ __forceinline__ unsigned cvtpk(float lo, float hi) { unsigned r; asm volatile("v_cvt_pk_bf16_f32 %0, %1, %2" : "=v"(r) : "v"(lo), "v"(hi)); return r; }
__device__ __forceinline__ float other_half(float x, int hi) { auto rr = __builtin_amdgcn_permlane32_swap(__float_as_uint(x), __float_as_uint(x), false, false); return __uint_as_float(hi ? rr[0] : rr[1]); }

__device__ __forceinline__ void pack_p(const f32x16& p0, const f32x16& p1, bf16x8& pa0, bf16x8& pa1, bf16x8& pa2, bf16x8& pa3) {
#define PK4(P, B_, OUT) do { unsigned a0 = cvtpk(P[B_+0], P[B_+1]), a1 = cvtpk(P[B_+2], P[B_+3]);                          \
        unsigned b0 = cvtpk(P[B_+4], P[B_+5]), b1 = cvtpk(P[B_+6], P[B_+7]);                                             \
        auto r0 = __builtin_amdgcn_permlane32_swap(a0, b0, false, false); auto r1 = __builtin_amdgcn_permlane32_swap(a1, b1, false, false); \
        u32x4 w = {r0[0], r1[0], r0[1], r1[1]}; OUT = __builtin_bit_cast(bf16x8, w); } while (0)
    PK4(p0, 0, pa0); PK4(p0, 8, pa1); PK4(p1, 0, pa2); PK4(p1, 8, pa3);
#undef PK4
}
__device__ __forceinline__ void pv_tile(f32x16* o, int vb, bf16x8 pa0, bf16x8 pa1, bf16x8 pa2, bf16x8 pa3) {
#define TRRD(dst, off) asm volatile("ds_read_b64_tr_b16 %0, %1 offset:%2" : "=&v"(dst) : "v"(vb), "i"(off) : "memory")
#define PV_D0(d0) do { s16x4 l0, l1, l2, l3, h0, h1, h2, h3; constexpr int b_ = (d0) * 512;   \
        TRRD(l0, b_); TRRD(h0, b_ + 2048); TRRD(l1, b_ + 4096); TRRD(h1, b_ + 6144); TRRD(l2, b_ + 8192); TRRD(h2, b_ + 10240); TRRD(l3, b_ + 12288); TRRD(h3, b_ + 14336); \
        asm volatile("s_waitcnt lgkmcnt(0)" ::: "memory"); SBAR();   \
        o[d0] = __builtin_amdgcn_mfma_f32_32x32x16_bf16(pa0, (bf16x8){l0[0], l0[1], l0[2], l0[3], h0[0], h0[1], h0[2], h0[3]}, o[d0], 0, 0, 0);   \
        o[d0] = __builtin_amdgcn_mfma_f32_32x32x16_bf16(pa1, (bf16x8){l1[0], l1[1], l1[2], l1[3], h1[0], h1[1], h1[2], h1[3]}, o[d0], 0, 0, 0);   \
        o[d0] = __builtin_amdgcn_mfma_f32_32x32x16_bf16(pa2, (bf16x8){l2[0], l2[1], l2[2], l2[3], h2[0], h2[1], h2[2], h2[3]}, o[d0], 0, 0, 0);   \
        o[d0] = __builtin_amdgcn_mfma_f32_32x32x16_bf16(pa3, (bf16x8){l3[0], l3[1], l3[2], l3[3], h3[0], h3[1], h3[2], h3[3]}, o[d0], 0, 0, 0); } while (0)
    PV_D0(0); PV_D0(1); PV_D0(2); PV_D0(3);
#undef PV_D0
#undef TRRD
}

template <bool SB>
__device__ __forceinline__ void attn_block(ATT_LAS unsigned char* lds, const bf16_t* Qg, int ldq, const bf16_t* Kg, int ldk, const bf16_t* Vg, int ldv, const bf16_t* Rg, bf16_t* Og, int ldo, int P0) {
    constexpr int NQ = 8;
    int tid_ = threadIdx.x; asm volatile("" : "+v"(tid_));
    const int tid = tid_, wid = __builtin_amdgcn_readfirstlane(tid >> 6), lane = tid & 63, r32 = lane & 31, hi = lane >> 5;
    const int qlo = P0 + wid * 32;
    const int NT = (P0 + QB) / KVBLK;
    ATT_LAS unsigned char* V_lds = lds + OFF_V; ATT_LAS unsigned char* K_lds = lds + OFF_K; ATT_LAS unsigned char* R_lds = lds + OFF_R;
    ATT_LAS float* ws = (ATT_LAS float*)(lds + OFF_WS) + wid * 64;
    ATT_LAS unsigned* flags = (ATT_LAS unsigned*)(lds + OFF_FLAG);
    const int sr = tid >> 4, sc = (tid & 15) * 8, rr = tid >> 3, rc = (tid & 7) * 8;
    const int vst0 = v_st(sr, sc), vst1 = v_st(32 + sr, sc), kws = KSWZ(sr, sc * 2), rws = RSWZ(rr, rc * 2);
    const int vb0 = (int)(unsigned)(uintptr_t)V_lds + v_rd_base(lane);
    bf16x8 qr[NQ];
#pragma unroll
    for (int d0 = 0; d0 < NQ; ++d0) qr[d0] = *(const bf16x8*)(Qg + (size_t)(wid * 32 + r32) * ldq + d0 * 16 + hi * 8);
    ATT_LAS unsigned char* qsl = lds + OFF_QR + wid * 4096 + lane * 16;
    if (!SB) {
#pragma unroll
        for (int d0 = 0; d0 < 4; ++d0) *(ATT_LAS bf16x8*)(qsl + d0 * 1024) = *(const bf16x8*)(Qg + (size_t)(wid * 32 + r32) * ldq + 128 + d0 * 16 + hi * 8);
    }
    bf16x8 st_k0, st_k1, st_v0, st_v1, st_r;
#define STAGE_LOAD(t_) do { const size_t k0_ = (size_t)(t_) * KVBLK;                                                                   \
        st_k0 = *(const bf16x8*)(Kg + (k0_ + sr) * ldk + sc); st_k1 = *(const bf16x8*)(Kg + (k0_ + 32 + sr) * ldk + sc);               \
        st_v0 = *(const bf16x8*)(Vg + (k0_ + sr) * ldv + sc); st_v1 = *(const bf16x8*)(Vg + (k0_ + 32 + sr) * ldv + sc);               \
        if (!SB) st_r = *(const bf16x8*)(Rg + (k0_ + rr) * 64 + rc); } while (0)
#define STAGE_WRITE(bf_) do { *(ATT_LAS bf16x8*)(K_lds + (bf_) * SHM_K + kws) = st_k0; *(ATT_LAS bf16x8*)(K_lds + (bf_) * SHM_K + kws + 32 * 256) = st_k1;   \
        *(ATT_LAS bf16x8*)(V_lds + (bf_) * SHM_V + vst0) = st_v0; *(ATT_LAS bf16x8*)(V_lds + (bf_) * SHM_V + vst1) = st_v1;                                  \
        if (!SB) *(ATT_LAS bf16x8*)(R_lds + (bf_) * SHM_R + rws) = st_r; } while (0)
    f32x16 o[4];
#pragma unroll
    for (int d = 0; d < 4; ++d)
#pragma unroll
        for (int r = 0; r < 16; ++r) o[d][r] = 0.f;
    float m_reg = -1e30f, l_reg = 0.f, R = 0.f;
    int kro[4];
#pragma unroll
    for (int dd = 0; dd < 4; ++dd) kro[dd] = KSWZ(r32, (dd * 16 + hi * 8) * 2);
    STAGE_LOAD(SB ? NT - 1 : 0);
    asm volatile("s_waitcnt vmcnt(0)" ::: "memory");
    STAGE_WRITE(0);
    __syncthreads();
    for (int it = 0; it < NT; ++it) {
        const int t = SB ? NT - 1 - it : it; const int buf = it & 1; const bool more = it + 1 < NT;
        if (more) STAGE_LOAD(SB ? t - 1 : t + 1);
        const int kb = t * KVBLK;
        if (kb <= qlo + 31) {
            f32x16 p0, p1;
#pragma unroll
            for (int r = 0; r < 16; ++r) { p0[r] = 0.f; p1[r] = 0.f; }
            ATT_LAS const unsigned char* kt = K_lds + buf * SHM_K;
            __builtin_amdgcn_s_setprio(ATT_PRIO);
#pragma unroll
            for (int d0 = 0; d0 < 8; ++d0) { ATT_LAS const unsigned char* a = kt + kro[d0 & 3] + (d0 >> 2) * 128;
                const bf16x8 b0 = *(ATT_LAS const bf16x8*)a; const bf16x8 b1 = *(ATT_LAS const bf16x8*)(a + 32 * 256);
                p0 = __builtin_amdgcn_mfma_f32_32x32x16_bf16(b0, qr[d0], p0, 0, 0, 0);
                p1 = __builtin_amdgcn_mfma_f32_32x32x16_bf16(b1, qr[d0], p1, 0, 0, 0); }
            if (!SB) { ATT_LAS const unsigned char* rt = R_lds + buf * SHM_R;
#pragma unroll
                for (int d0 = 0; d0 < 4; ++d0) { ATT_LAS const unsigned char* a = rt + (kro[d0] - 128 * r32);
                    const bf16x8 b0 = *(ATT_LAS const bf16x8*)a; const bf16x8 b1 = *(ATT_LAS const bf16x8*)(a + 32 * 128);
                    const bf16x8 qf = *(ATT_LAS const bf16x8*)(qsl + d0 * 1024);
                    p0 = __builtin_amdgcn_mfma_f32_32x32x16_bf16(b0, qf, p0, 0, 0, 0);
                    p1 = __builtin_amdgcn_mfma_f32_32x32x16_bf16(b1, qf, p1, 0, 0, 0); } }
            __builtin_amdgcn_s_setprio(0);
            const int dql = qlo + r32 - kb - 4 * hi - (SB ? 1 : 0);
            const bool need_mask = SB ? (kb + KVBLK - 1 >= qlo) : (kb + KVBLK - 1 > qlo);
            bf16x8 pa0, pa1, pa2, pa3;
            if (!SB) {
                if (need_mask) { const float NEG = -__builtin_inff();
#pragma unroll
                    for (int r = 0; r < 16; ++r) { const int c = (r & 3) + 8 * (r >> 2); if (c > dql) p0[r] = NEG; if (c + 32 > dql) p1[r] = NEG; } }
                float pmax = p0[0];
#pragma unroll
                for (int r = 1; r < 16; ++r) pmax = fmaxf(pmax, p0[r]);
#pragma unroll
                for (int r = 0; r < 16; ++r) pmax = fmaxf(pmax, p1[r]);
                pmax = fmaxf(pmax, other_half(pmax, hi));
                const float mn = fmaxf(m_reg, pmax); const float alpha = __builtin_amdgcn_exp2f(m_reg - mn); m_reg = mn;
                float ps = 0.f;
#pragma unroll
                for (int r = 0; r < 16; ++r) { p0[r] = __builtin_amdgcn_exp2f(p0[r] - mn); ps += p0[r]; }
#pragma unroll
                for (int r = 0; r < 16; ++r) { p1[r] = __builtin_amdgcn_exp2f(p1[r] - mn); ps += p1[r]; }
                ps += other_half(ps, hi);
                l_reg = l_reg * alpha + ps;
                if (__any(alpha < 1.f)) { if (hi == 0) ws[r32] = alpha; asm volatile("s_waitcnt lgkmcnt(0)" ::: "memory");
#pragma unroll
                    for (int r = 0; r < 16; ++r) { const float a = ws[crow(r, hi)];
#pragma unroll
                        for (int d = 0; d < 4; ++d) o[d][r] *= a; }
                    asm volatile("s_waitcnt lgkmcnt(0)" ::: "memory"); }
                pack_p(p0, p1, pa0, pa1, pa2, pa3);
            } else {
                f32x16 l0, l1;
#pragma unroll
                for (int r = 0; r < 16; ++r) { const float z = p0[r]; const float sp = fmaxf(z, 0.f) + __builtin_amdgcn_logf(1.0f + __builtin_amdgcn_exp2f(-fabsf(z))); l0[r] = -sp; p0[r] = z - sp; }
#pragma unroll
                for (int r = 0; r < 16; ++r) { const float z = p1[r]; const float sp = fmaxf(z, 0.f) + __builtin_amdgcn_logf(1.0f + __builtin_amdgcn_exp2f(-fabsf(z))); l1[r] = -sp; p1[r] = z - sp; }
                if (need_mask) { const float NEG = -__builtin_inff();
#pragma unroll
                    for (int r = 0; r < 16; ++r) { const int c = (r & 3) + 8 * (r >> 2); if (c > dql) { p0[r] = NEG; l0[r] = 0.f; } if (c + 32 > dql) { p1[r] = NEG; l1[r] = 0.f; } } }
                float T[8];
#pragma unroll
                for (int g = 0; g < 4; ++g) {
                    { const float a0 = l0[4 * g], a1 = l0[4 * g + 1], a2 = l0[4 * g + 2], a3 = l0[4 * g + 3]; const float x2 = a3, x1 = a3 + a2, x0 = x1 + a1; T[g] = x0 + a0;
                      l0[4 * g] = x0; l0[4 * g + 1] = x1; l0[4 * g + 2] = x2; l0[4 * g + 3] = 0.f; }
                    { const float a0 = l1[4 * g], a1 = l1[4 * g + 1], a2 = l1[4 * g + 2], a3 = l1[4 * g + 3]; const float x2 = a3, x1 = a3 + a2, x0 = x1 + a1; T[4 + g] = x0 + a0;
                      l1[4 * g] = x0; l1[4 * g + 1] = x1; l1[4 * g + 2] = x2; l1[4 * g + 3] = 0.f; }
                }
                float gs[8]; float run = R;
#pragma unroll
                for (int g = 7; g >= 0; --g) { const float To = other_half(T[g], hi); gs[g] = run + (hi == 0 ? To : 0.f); run += T[g] + To; }
                R = run;
#pragma unroll
                for (int g = 0; g < 4; ++g)
#pragma unroll
                    for (int i = 0; i < 4; ++i) { p0[4 * g + i] = __builtin_amdgcn_exp2f(p0[4 * g + i] + l0[4 * g + i] + gs[g]); p1[4 * g + i] = __builtin_amdgcn_exp2f(p1[4 * g + i] + l1[4 * g + i] + gs[4 + g]); }
                pack_p(p0, p1, pa0, pa1, pa2, pa3);
            }
            __builtin_amdgcn_s_setprio(ATT_PRIO); pv_tile(o, vb0 + buf * SHM_V, pa0, pa1, pa2, pa3); __builtin_amdgcn_s_setprio(0);
        }
        if (more) { asm volatile("s_waitcnt vmcnt(0)" ::: "memory"); STAGE_WRITE(buf ^ 1); }
        if (SB && SB_EARLY_EXIT) { const bool dead = __all(R < -160.f); if (lane == 0) flags[buf * 8 + wid] = dead ? 1u : 0u; }
        __syncthreads();
        if (SB && SB_EARLY_EXIT) { const u32x4 f0 = *(ATT_LAS const u32x4*)(flags + buf * 8), f1 = *(ATT_LAS const u32x4*)(flags + buf * 8 + 4);
            if ((f0[0] & f0[1] & f0[2] & f0[3] & f1[0] & f1[1] & f1[2] & f1[3]) != 0u) break; }
    }
    if (!SB) { if (hi == 0) ws[32 + r32] = l_reg; asm volatile("s_waitcnt lgkmcnt(0)" ::: "memory"); }
    bf16_t* Ow = Og + (size_t)(wid * 32) * ldo;
#pragma unroll
    for (int r = 0; r < 16; ++r) { const int orow = crow(r, hi); const float rl = SB ? 1.0f : 1.0f / ws[32 + orow];
#pragma unroll
        for (int d0 = 0; d0 < 4; ++d0) { const float v = o[d0][r] * rl; const float vn = __shfl_xor(v, 1);
            if ((r32 & 1) == 0) *(unsigned*)(Ow + (size_t)orow * ldo + d0 * 32 + r32) = cvtpk(v, vn); } }
    asm volatile("s_waitcnt lgkmcnt(0)" ::: "memory");
    __syncthreads();
#undef STAGE_LOAD
#undef STAGE_WRITE
}
#undef KSWZ
#undef RSWZ
}

#ifdef DUP_LN
#define DUP_LN_ANY DUP_LN
#else
#define DUP_LN_ANY 0
#endif

constexpr int NWAVES = 8;
constexpr int D = 2048, BATCH = 4, SEQ = 4096, DEPTH = 4, M = BATCH * SEQ, FF = 5632, NADA = 9;
constexpr int QLR = 768, KVLR = 512, ROPE_D = 64, NH = 8, HD = 128, QKD = 192;
constexpr int IN_COLS = QLR + KVLR + ROPE_D + 3 * NH * HD;
constexpr int WIN_ROWS = 4608;
constexpr float LN_EPS = 1e-5f, RMS_EPS = 1e-6f;
constexpr float DN_ALPHA = 1.6817928305074290f;
constexpr float LOG2E = 1.4426950408889634f;
constexpr float MLA_QSCALE = 0.07216878364870322f * LOG2E;
constexpr float SB_QSCALE = 0.08838834764831845f * LOG2E;
#ifndef MK_ONE_LAUNCH
#define MK_ONE_LAUNCH 1
#endif
constexpr int N_PHASES = 3 + 8 * 3 + 4 * 6;

constexpr size_t MiB = 1u << 20;
constexpr size_t WS_CTL = 0, CTL_ZERO_BYTES = 1 * MiB;
constexpr size_t WS_ADA = 1 * MiB;
constexpr size_t WS_ADAP = 3 * MiB;
constexpr size_t WS_VEC = 22 * MiB;
constexpr size_t WS_ROPE = 24 * MiB;
constexpr size_t WS_SSQ = 28 * MiB;
constexpr size_t WS_KPE = 30 * MiB;
constexpr size_t WS_HL = 32 * MiB;
constexpr size_t WS_H = 160 * MiB;
constexpr size_t WS_F = 224 * MiB;
constexpr size_t WS_ACT = 288 * MiB;
constexpr size_t WS_CQ = 464 * MiB;
constexpr size_t WS_CKV = 488 * MiB;
constexpr size_t WS_SBQ = 504 * MiB, WS_SBK = 536 * MiB, WS_SBV = 568 * MiB;
constexpr size_t WS_QM = 600 * MiB;
constexpr size_t WS_KV = 648 * MiB;
constexpr size_t WS_O = 712 * MiB;
constexpr size_t WS_W = 776 * MiB;
constexpr size_t W_WI = (size_t)2 * FF * D * 2, W_WO = (size_t)D * FF * 2, W_WIN = (size_t)WIN_ROWS * D * 2, W_WUQ = (size_t)NH * QKD * QLR * 2, W_WUKV = (size_t)NH * 256 * KVLR * 2, W_WOUT = (size_t)D * D * 2;
constexpr size_t WO_WI1 = 0, WO_WO1 = WO_WI1 + W_WI, WO_WI2 = WO_WO1 + W_WO, WO_WO2 = WO_WI2 + W_WI, WO_WIN = WO_WO2 + W_WO, WO_WUQ = WO_WIN + W_WIN, WO_WUKV = WO_WUQ + W_WUQ, WO_WOUT = WO_WUKV + W_WUKV;
constexpr size_t W_LAYER = WO_WOUT + W_WOUT;
constexpr size_t WS_DUMMY = WS_W + DEPTH * W_LAYER;
constexpr size_t WS_END = WS_DUMMY + (size_t)(DUP_LN_ANY ? 128 : 0) * MiB;
static_assert(W_LAYER % 256 == 0 && WS_END < (size_t)1700 * MiB, "ws map");
constexpr int ADA_KS = 16;
constexpr int CW_BAR = 4096;

constexpr int RING_OFF = 0, SCR_BYTES = 135168;
constexpr int MISC_OFF = SCR_BYTES;
constexpr int LDS_BYTES = 147456;

#define GAS __attribute__((address_space(1)))
#define LAS __attribute__((address_space(3)))
typedef unsigned short bf16;
typedef unsigned v4u __attribute__((ext_vector_type(4)));
typedef unsigned v2u __attribute__((ext_vector_type(2)));
typedef float f32x4 __attribute__((ext_vector_type(4)));
#define LDS_WAIT() asm volatile("s_waitcnt lgkmcnt(0)" ::: "memory")
#define VM_WAIT() asm volatile("s_waitcnt vmcnt(0)" ::: "memory")
__device__ __forceinline__ unsigned pk2(float lo, float hi) { unsigned r; asm volatile("v_cvt_pk_bf16_f32 %0, %1, %2" : "=v"(r) : "v"(lo), "v"(hi)); return r; }
__device__ __forceinline__ float bf_lo(unsigned w) { return __uint_as_float(w << 16); }
__device__ __forceinline__ float bf_hi(unsigned w) { return __uint_as_float(w & 0xffff0000u); }
__device__ __forceinline__ float wave_sum(float v) {
#pragma unroll
    for (int o = 1; o < 64; o <<= 1) v += __shfl_xor(v, o);
    return v;
}

#define XB_TMO      128
#define XB_XCNT(j)  (256  + 64 * (j))
#define XB_XSUB(j)  (1280 + 64 * (j))
#define XB_XGEN(j)  (2304 + 64 * (j))
#define XB_TOP      3328
#define XB_TOPGEN   3392
#define XCD_BAR_WORDS 3456
#define XB_SPIN_CAP (1u << 18)

__device__ __forceinline__ unsigned xb_ld(unsigned* p)              { return __hip_atomic_load(p, __ATOMIC_RELAXED, __HIP_MEMORY_SCOPE_AGENT); }
__device__ __forceinline__ unsigned xb_add(unsigned* p, unsigned v) { return __hip_atomic_fetch_add(p, v, __ATOMIC_RELAXED, __HIP_MEMORY_SCOPE_AGENT); }
__device__ __forceinline__ unsigned xb_xcc_id() { return (unsigned)__builtin_amdgcn_s_getreg((3 << 11) | 20) & 0xFu; }
#define XB_SPIN(cond, bar) do { unsigned _sp = 0; while (cond) { __builtin_amdgcn_s_sleep(1); \
    if ((++_sp & 255u) == 0u) { if (xb_ld(&(bar)[XB_TMO])) break; if (_sp > XB_SPIN_CAP) { atomicAdd(&(bar)[XB_TMO], 1u); break; } } } } while (0)

struct XcdBarrier {
    unsigned* bar; unsigned x;
    volatile LAS unsigned* st;
};

__device__ __forceinline__ XcdBarrier xcd_barrier_post(unsigned* bar, volatile LAS unsigned* st) {
    XcdBarrier b; b.bar = bar; b.x = xb_xcc_id(); b.st = st;
    if (threadIdx.x == 0) (void)xb_add(&bar[XB_XCNT(b.x)], 1u);
    return b;
}
__device__ __forceinline__ void xcd_barrier_complete(unsigned* bar, unsigned x, unsigned& nloc, unsigned& nx) {
    const unsigned G = gridDim.x * gridDim.y * gridDim.z;
    unsigned sum, cnt, mine, sp = 0u;
    for (;;) {
        sum = 0u; cnt = 0u; mine = 0u;
#pragma unroll 1
        for (unsigned j = 0; j < 16; ++j) { const unsigned c = xb_ld(&bar[XB_XCNT(j)]); sum += c; cnt += (c > 0u) ? 1u : 0u; mine = (j == x) ? c : mine; }
        if (sum == G) break;
        __builtin_amdgcn_s_sleep(1);
        if ((++sp & 255u) == 0u) { if (xb_ld(&bar[XB_TMO])) break; if (sp > XB_SPIN_CAP) { atomicAdd(&bar[XB_TMO], 1u); break; } }
    }
    nloc = mine > 0u ? mine : 1u; nx = cnt > 0u ? cnt : 1u;
}

__device__ __forceinline__ void xcd_barrier(const XcdBarrier& b) {
    asm volatile("s_waitcnt vmcnt(0)" ::: "memory");
    __syncthreads();
    if (threadIdx.x == 0) {
        unsigned* bar = b.bar;
        __builtin_amdgcn_s_waitcnt(0);
        unsigned nloc = b.st[0], nx = b.st[1];
        if (nloc == 0u) { xcd_barrier_complete(bar, b.x, nloc, nx); b.st[0] = nloc; b.st[1] = nx; }
        const unsigned old = xb_add(&bar[XB_XSUB(b.x)], 1u);
        const unsigned gen = old / nloc;
        if (old + 1u == (gen + 1u) * nloc) {
            __builtin_amdgcn_fence(__ATOMIC_RELEASE, "agent");
            asm volatile("s_waitcnt vmcnt(0)" ::: "memory");
            const unsigned og = xb_add(&bar[XB_TOP], 1u);
            const unsigned tg = og / nx;
            if (og + 1u == (tg + 1u) * nx) xb_add(&bar[XB_TOPGEN], 1u);
            else XB_SPIN(xb_ld(&bar[XB_TOPGEN]) == tg, bar);
            __builtin_amdgcn_fence(__ATOMIC_ACQUIRE, "agent");
            xb_add(&bar[XB_XGEN(b.x)], 1u);
            asm volatile("s_waitcnt vmcnt(0)" ::: "memory");
        } else {
            XB_SPIN(xb_ld(&bar[XB_XGEN(b.x)]) == gen, bar);
            __builtin_amdgcn_fence(__ATOMIC_ACQUIRE, "agent");
            asm volatile("s_waitcnt vmcnt(0)" ::: "memory");
        }
    }
    __syncthreads();
}

#ifndef G1_ALIGN
#define G1_ALIGN true
#endif
#ifndef GF_ALIGN
#define GF_ALIGN true
#endif
#ifndef DUP_ATT_WHICH
#define DUP_ATT_WHICH 3
#endif
#ifndef DUP_P0
#define DUP_P0 0
#endif
#ifndef DUP_P1
#define DUP_P1 0
#endif
#ifndef DUP_P2
#define DUP_P2 0
#endif
#ifndef DUP_G1
#define DUP_G1 0
#endif
#ifndef DUP_WIN
#define DUP_WIN 0
#endif
#ifndef DUP_UQKV
#define DUP_UQKV 0
#endif
#ifndef DUP_ATT
#define DUP_ATT 0
#endif
#ifndef DUP_ONORM
#define DUP_ONORM 0
#endif
#ifndef DUP_GF
#define DUP_GF 0
#endif
#ifndef DUP_LN
#define DUP_LN 0
#endif
#define REP(n) for (int rep_ = 0; rep_ < 1 + (n); ++rep_)
#ifndef P0_PARTS
#define P0_PARTS 7
#endif
#ifndef SITE_P0
#define SITE_P0 1
#endif
#ifndef SITE_P1
#define SITE_P1 1
#endif
#ifndef SITE_P2
#define SITE_P2 1
#endif
#ifndef SITE_ATT
#define SITE_ATT 3
#endif
#ifndef SITE_ONORM
#define SITE_ONORM 1
#endif
#ifndef SITE_G1
#define SITE_G1 1
#endif
#ifndef SITE_WIN
#define SITE_WIN 1
#endif
#ifndef SITE_UQKV
#define SITE_UQKV 1
#endif
#ifndef SITE_GF
#define SITE_GF 1
#endif
#ifndef SITE_LN
#define SITE_LN 1
#endif
#ifndef DBG_LAST_S
#define DBG_LAST_S (3 * DEPTH - 1)
#endif
#ifndef P0_PARTS
#define P0_PARTS 7
#endif

struct Frame {
    LAS unsigned char* lds;
    int tid, lane, wave;
    int vcu, G;
};

__device__ __forceinline__ int dst_row(int kind, int n) {
    if (kind == 1) { const int u = n >= FF ? 1 : 0, j = n - u * FF; return (j >> 7) * 256 + u * 128 + (j & 127); }
    if (kind == 2) { if (n < QLR + KVLR) return n; if (n < QLR + KVLR + ROPE_D) { const int j = n - (QLR + KVLR); return 4352 + (j < 32 ? 2 * j : 2 * (j - 32) + 1); } return n - ROPE_D; }
    if (kind == 3) { const int h = n / QKD, w = n - h * QKD; if (w < 128) return n; const int j = w - 128; return h * QKD + 128 + (j < 32 ? 2 * j : 2 * (j - 32) + 1); }
    return n;
}
__device__ __forceinline__ void tr_item(const float* __restrict__ W, int K, int N, bf16* __restrict__ WT, int kind, const float* __restrict__ gk, LAS float* scr, int item, int lane) {
    const int nblk = N >> 6, kb = item / nblk, nb = item - kb * nblk, k0 = kb << 6, n0 = nb << 6;
    const int kk4 = lane >> 4, n4 = (lane & 15) * 4;
    const float* src = W + (size_t)(k0 + kk4) * N + n0 + n4;
    f32x4 wv[16];
#pragma unroll
    for (int i = 0; i < 16; ++i) wv[i] = *(const f32x4*)(src + (size_t)(4 * i) * N);
#pragma unroll
    for (int i = 0; i < 16; ++i) { const int kk = 4 * i + kk4; f32x4 w = wv[i]; if (gk) w = w * gk[k0 + kk];
        LAS float* d = scr + kk * 65 + n4; d[0] = w[0]; d[1] = w[1]; d[2] = w[2]; d[3] = w[3]; }
    LDS_WAIT(); asm volatile("" ::: "memory");
    const int c = lane & 7;
#pragma unroll
    for (int j = 0; j < 8; ++j) { const int n = (lane >> 3) + 8 * j; const LAS float* s = scr + (8 * c) * 65 + n;
        v4u o; o.x = pk2(s[0 * 65], s[1 * 65]); o.y = pk2(s[2 * 65], s[3 * 65]); o.z = pk2(s[4 * 65], s[5 * 65]); o.w = pk2(s[6 * 65], s[7 * 65]);
        *(v4u*)(WT + (size_t)dst_row(kind, n0 + n) * K + k0 + 8 * c) = o; }
    LDS_WAIT(); asm volatile("" ::: "memory");
}

struct Args { const float* in[19]; float* out; unsigned char* ws; int ph_lo, ph_hi; };
typedef const __attribute__((address_space(4))) Args CArgs;
__device__ __forceinline__ CArgs* fresh_args(CArgs* p) { asm volatile("" : "+s"(p)); return p; }
__device__ __forceinline__ Frame fresh_frame(Frame F) { asm volatile("" : "+v"(F.tid)); F.lane = F.tid & 63; return F; }
__constant__ float INVF[32] = {1.000000000e+00f, 7.498942614e-01f, 5.623413324e-01f, 4.216965139e-01f, 3.162277639e-01f, 2.371373773e-01f, 1.778279394e-01f, 1.333521307e-01f, 1.000000015e-01f, 7.498941571e-02f, 5.623413250e-02f, 4.216965288e-02f, 3.162277490e-02f, 2.371373773e-02f, 1.778279431e-02f, 1.333521493e-02f, 9.999999776e-03f, 7.498941850e-03f, 5.623413250e-03f, 4.216964822e-03f, 3.162277630e-03f, 2.371373586e-03f, 1.778279431e-03f, 1.333521446e-03f, 1.000000047e-03f, 7.498942432e-04f, 5.623413017e-04f, 4.216965172e-04f, 3.162277571e-04f, 2.371373703e-04f, 1.778279402e-04f, 1.333521504e-04f};

__device__ __forceinline__ void p0_prologue(const Frame& F, const CArgs& a) {
    unsigned char* ws = a.ws;
    const int gw = F.vcu * NWAVES + F.wave, NGW = F.G * NWAVES;
    const int gt = F.vcu * (NWAVES * 64) + F.tid, NGT = F.G * NWAVES * 64;
#if P0_PARTS & 1
    {
        LAS float* scr = (LAS float*)(F.lds + F.wave * 16640);
        constexpr int I_WI = (D / 64) * (2 * FF / 64), I_WO = (FF / 64) * (D / 64), I_WIN = (D / 64) * (IN_COLS / 64), I_WUQ = (QLR / 64) * (NH * QKD / 64), I_WUKV = (KVLR / 64) * (NH * 256 / 64), I_WOUT = (D / 64) * (D / 64);
        constexpr int I_LAYER = 2 * I_WI + 2 * I_WO + I_WIN + I_WUQ + I_WUKV + I_WOUT;
        for (int it = gw; it < DEPTH * I_LAYER; it += NGW) {
            const int l = it / I_LAYER; int r = it - l * I_LAYER;
            unsigned char* wl = ws + WS_W + (size_t)l * W_LAYER;
            const float* src; const float* gk = nullptr; int K_, N_, kind = 0; size_t dsto;
            if (r < I_WI) { src = a.in[7] + (size_t)l * D * 2 * FF; K_ = D; N_ = 2 * FF; dsto = WO_WI1; kind = 1; }
            else if ((r -= I_WI) < I_WO) { src = a.in[8] + (size_t)l * FF * D; K_ = FF; N_ = D; dsto = WO_WO1; }
            else if ((r -= I_WO) < I_WI) { src = a.in[17] + (size_t)l * D * 2 * FF; K_ = D; N_ = 2 * FF; dsto = WO_WI2; kind = 1; }
            else if ((r -= I_WI) < I_WO) { src = a.in[18] + (size_t)l * FF * D; K_ = FF; N_ = D; dsto = WO_WO2; }
            else if ((r -= I_WO) < I_WIN) { src = a.in[9] + (size_t)l * D * IN_COLS; K_ = D; N_ = IN_COLS; dsto = WO_WIN; kind = 2; }
            else if ((r -= I_WIN) < I_WUQ) { src = a.in[12] + (size_t)l * QLR * NH * QKD; K_ = QLR; N_ = NH * QKD; dsto = WO_WUQ; kind = 3; gk = a.in[10] + l * QLR; }
            else if ((r -= I_WUQ) < I_WUKV) { src = a.in[13] + (size_t)l * KVLR * NH * 256; K_ = KVLR; N_ = NH * 256; dsto = WO_WUKV; gk = a.in[11] + l * KVLR; }
            else { r -= I_WUKV; src = a.in[16] + (size_t)l * D * D; K_ = D; N_ = D; dsto = WO_WOUT;
                   gk = (r / (D / 64)) < 16 ? a.in[14] + l * 1024 : a.in[15] + l * 1024 - 1024; }
            tr_item(src, K_, N_, (bf16*)(wl + dsto), kind, gk, scr, r, F.lane);
        }
        constexpr int PADV = (WIN_ROWS - IN_COLS) * D * 2 / 16;
        for (int i = gt; i < DEPTH * PADV; i += NGT) { const int l = i / PADV, r = i - l * PADV;
            *(v4u*)(ws + WS_W + (size_t)l * W_LAYER + WO_WIN + (size_t)IN_COLS * D * 2 + (size_t)r * 16) = (v4u){0u, 0u, 0u, 0u}; }
    }
#endif
#if P0_PARTS & 2
    {
        const int* pos = (const int*)a.in[2]; float* rope = (float*)(ws + WS_ROPE);
        for (int i = gt; i < M * 32; i += NGT) { const int row = i >> 5, j = i & 31;
            const float ang = (float)pos[row] * INVF[j];
            double rev = (double)ang * 0.15915494309189535; rev -= __builtin_floor(rev);
            const float fr = (float)rev;
            *(float2*)(rope + (size_t)i * 2) = make_float2(__builtin_amdgcn_cosf(fr), __builtin_amdgcn_sinf(fr)); }
    }
#endif
    __syncthreads();
#if P0_PARTS & 4
    {
        LAS f32x4* cact = (LAS f32x4*)F.lds;
        for (int k = F.tid; k < D; k += NWAVES * 64) { f32x4 v;
#pragma unroll
            for (int b = 0; b < 4; ++b) { const float cv = a.in[1][b * D + k]; v[b] = cv / (1.0f + __expf(-cv)); }
            cact[k] = v; }
        __syncthreads();
        constexpr int NCH = NADA * D / 256, KSL = D / ADA_KS;
        float* adap = (float*)(ws + WS_ADAP);
        for (int it = gw; it < DEPTH * NCH * ADA_KS; it += NGW) {
            const int ks = it % ADA_KS, r = it / ADA_KS, ch = r % NCH, l = r / NCH;
            const int n = ch * 256 + 4 * F.lane;
            const float* w = a.in[3] + ((size_t)l * D + (size_t)ks * KSL) * (NADA * D) + n;
            f32x4 acc[4];
#pragma unroll
            for (int b = 0; b < 4; ++b) acc[b] = (f32x4){0.f, 0.f, 0.f, 0.f};
            if (ks == 0) { const f32x4 bv = *(const f32x4*)(a.in[4] + (size_t)l * NADA * D + n);
#pragma unroll
                for (int b = 0; b < 4; ++b) acc[b] = bv; }
#pragma unroll 16
            for (int kk = 0; kk < KSL; ++kk) { const f32x4 wv = *(const f32x4*)(w + (size_t)kk * (NADA * D)); const f32x4 cv = cact[ks * KSL + kk];
#pragma unroll
                for (int b = 0; b < 4; ++b) acc[b] += wv * cv[b]; }
#pragma unroll
            for (int b = 0; b < 4; ++b) *(f32x4*)(adap + (((size_t)ks * DEPTH + l) * BATCH + b) * (NADA * D) + n) = acc[b];
        }
    }
#endif
}
__device__ __forceinline__ void p1_ada_reduce(const Frame& F, const CArgs& a) {
    const int gt = F.vcu * (NWAVES * 64) + F.tid, NGT = F.G * NWAVES * 64;
    const f32x4* adap = (const f32x4*)(a.ws + WS_ADAP); f32x4* ada = (f32x4*)(a.ws + WS_ADA);
    constexpr int NV = DEPTH * BATCH * NADA * D / 4;
    for (int i = gt; i < NV; i += NGT) { f32x4 s = adap[i];
#pragma unroll
        for (int ks = 1; ks < ADA_KS; ++ks) s += adap[(size_t)ks * NV + i];
        ada[i] = s; }
}
__device__ __forceinline__ void p2_modulate0(const Frame& F, const CArgs& a) {
    const int gw = F.vcu * NWAVES + F.wave, NGW = F.G * NWAVES;
    const float* ada = (const float*)(a.ws + WS_ADA); bf16* H = (bf16*)(a.ws + WS_H);
    for (int row = gw; row < M; row += NGW) { const int b = row >> 12;
        const float* sh = ada + (size_t)b * NADA * D, * sc = sh + D;
#pragma unroll
        for (int j = 0; j < 8; ++j) { const int idx = 4 * (F.lane + 64 * j);
            const f32x4 xv = *(const f32x4*)(a.in[0] + (size_t)row * D + idx), s1 = *(const f32x4*)(sc + idx), s0 = *(const f32x4*)(sh + idx);
            const f32x4 h = xv * (s1 + 1.0f) + s0;
            *(v2u*)(H + (size_t)row * D + idx) = (v2u){pk2(h[0], h[1]), pk2(h[2], h[3])}; } }
}
__device__ __forceinline__ void vec_prep(const Frame& F, const CArgs& a) {
    const int gt = F.vcu * (NWAVES * 64) + F.tid, NGT = F.G * NWAVES * 64;
    const float* ada = (const float*)(a.ws + WS_ADA); float* vec = (float*)(a.ws + WS_VEC);
    for (int i = gt; i < 3 * DEPTH * BATCH * D; i += NGT) { const int d = i % D, sb = i / D, b = sb % BATCH, s = sb / BATCH, l = s / 3, j = s - 3 * l;
        const float* ad = ada + ((size_t)l * BATCH + b) * NADA * D + d;
        const float sh = ad[(3 * j) * D], sc = ad[(3 * j + 1) * D], gt_ = ad[(3 * j + 2) * D];
        const float lg = a.in[5][(size_t)(l * 3 + j) * D + d], lb = a.in[6][(size_t)(l * 3 + j) * D + d];
        float P = DN_ALPHA, Q = 0.f; if (s != 0) { P = DN_ALPHA / (1.0f + sc); Q = -P * sh; }
        float U = lg, W = lb;
        if (s != 3 * DEPTH - 1) { const int s1 = s + 1, l1 = s1 / 3, j1 = s1 - 3 * l1; const float* an = ada + ((size_t)l1 * BATCH + b) * NADA * D + d;
            const float nsh = an[(3 * j1) * D], nsc = an[(3 * j1 + 1) * D]; U = lg * (1.0f + nsc); W = lb * (1.0f + nsc) + nsh; }
        float* o = vec + (size_t)sb * 5 * D + d;
        o[0] = P; o[D] = Q; o[2 * D] = (j == 1 ? 1.0f : 0.5f) * (1.0f + gt_); o[3 * D] = U; o[4 * D] = W; }
}
__device__ __forceinline__ unsigned hl_enc(float h, unsigned hb) { const unsigned eb = hb & 0x7f800000u; if (eb == 0u) return 0u;
    const float inv_ulp254 = __uint_as_float(0x7f000000u - eb) * (254.0f * 128.0f);
    const int q = __float2int_rn((h - __uint_as_float(hb)) * inv_ulp254); return (unsigned)q & 0xffu; }
__device__ __forceinline__ float hl_dec(unsigned hb, unsigned byte) { const unsigned eb = hb & 0x7f800000u; const float H = __uint_as_float(hb);
    const int q = (int)(signed char)(byte & 0xffu); return H + (float)q * (__uint_as_float(eb) * (1.0f / (254.0f * 128.0f))); }
template <bool FIRST>
__device__ __forceinline__ void ln_phase(const Frame& F, const bf16* H, const unsigned char* L, bf16* HO, unsigned char* LO, const bf16* f, const float* vecs  , const float* X32, float* OUT32) {
    const int gw = F.vcu * NWAVES + F.wave, NGW = F.G * NWAVES;
    constexpr int RPW = 8;
    LAS f32x4* lv = (LAS f32x4*)F.lds;
    int staged_b = -1;
    for (int r0 = gw * RPW; r0 < M; r0 += NGW * RPW) { const int b = r0 >> 12;
        if (b != staged_b) {
            if (staged_b >= 0) __syncthreads();
            const f32x4* src = (const f32x4*)(vecs + (size_t)b * 5 * D);
            int t_ = F.tid; asm volatile("" : "+v"(t_));
#pragma unroll
            for (int i = 0; i < 5; ++i) { const int q = t_ + 512 * i, vec = q >> 9, e = (q & 511) * 4, j = e >> 9, ln = (e & 511) >> 3, half = (e >> 2) & 1;
                lv[((vec * 4 + j) * 2 + half) * 64 + ln] = src[q]; }
            __syncthreads(); staged_b = b; }
        constexpr int NS = FIRST ? 1 : 2;
        v4u hq2[NS][4], fq2[NS][4]; v2u lq2[NS][4]; f32x4 xq2[NS][8];
#define LN_LOAD(row_, S_) do { _Pragma("unroll") for (int j = 0; j < 4; ++j) { const int idx = 8 * (F.lane + 64 * j);                                     \
            fq2[S_][j] = *(const v4u*)(f + (size_t)(row_) * D + idx);                                                                                          \
            if (FIRST) { xq2[S_][2 * j] = *(const f32x4*)(X32 + (size_t)(row_) * D + idx); xq2[S_][2 * j + 1] = *(const f32x4*)(X32 + (size_t)(row_) * D + idx + 4); } \
            else { hq2[S_][j] = *(const v4u*)(H + (size_t)(row_) * D + idx); lq2[S_][j] = *(const v2u*)(L + (size_t)(row_) * D + idx); } } } while (0)
        LN_LOAD(r0, 0); if (NS == 2) LN_LOAD(r0 + 1, NS - 1);
#pragma unroll
        for (int i = 0; i < RPW; ++i) { const int row = r0 + i;
            v4u (&hq)[4] = hq2[i % NS]; v4u (&fq)[4] = fq2[i % NS]; v2u (&lq)[4] = lq2[i % NS]; f32x4 (&xq)[8] = xq2[i % NS];
            int ln_ = F.lane; asm volatile("" : "+v"(ln_));
            float v[32]; float s = 0.f;
#pragma unroll
            for (int j = 0; j < 4; ++j) {
                const f32x4 p0 = lv[((0 * 4 + j) * 2 + 0) * 64 + ln_], p1 = lv[((0 * 4 + j) * 2 + 1) * 64 + ln_], q0 = lv[((1 * 4 + j) * 2 + 0) * 64 + ln_], q1 = lv[((1 * 4 + j) * 2 + 1) * 64 + ln_], c0 = lv[((2 * 4 + j) * 2 + 0) * 64 + ln_], c1 = lv[((2 * 4 + j) * 2 + 1) * 64 + ln_];
#pragma unroll
                for (int e = 0; e < 4; ++e) { const float fl = bf_lo(fq[j][e]), fh = bf_hi(fq[j][e]);
                    const float xl = FIRST ? xq[2 * j + (e >> 1)][(e & 1) * 2] : hl_dec(hq[j][e] << 16, lq[j][e >> 1] >> (16 * (e & 1))), xh = FIRST ? xq[2 * j + (e >> 1)][(e & 1) * 2 + 1] : hl_dec(hq[j][e] & 0xffff0000u, lq[j][e >> 1] >> (16 * (e & 1) + 8));
                    const float pl = e < 2 ? p0[2 * e] : p1[2 * e - 4], ph_ = e < 2 ? p0[2 * e + 1] : p1[2 * e - 3], ql = e < 2 ? q0[2 * e] : q1[2 * e - 4], qh = e < 2 ? q0[2 * e + 1] : q1[2 * e - 3], cl = e < 2 ? c0[2 * e] : c1[2 * e - 4], ch = e < 2 ? c0[2 * e + 1] : c1[2 * e - 3];
                    const float vl = pl * xl + ql + cl * fl, vh = ph_ * xh + qh + ch * fh; v[8 * j + 2 * e] = vl; v[8 * j + 2 * e + 1] = vh; s += vl + vh; } }
            if (i + NS < RPW) LN_LOAD(row + NS, i % NS);
            const float mean = wave_sum(s) * (1.0f / D); float s2 = 0.f;
#pragma unroll
            for (int k = 0; k < 32; ++k) { v[k] -= mean; s2 += v[k] * v[k]; }
            const float rstd = 1.0f / sqrtf(wave_sum(s2) * (1.0f / D) + LN_EPS);
#pragma unroll
            for (int j = 0; j < 4; ++j) { const int idx = 8 * (ln_ + 64 * j);
                const f32x4 u0 = lv[((3 * 4 + j) * 2 + 0) * 64 + ln_], u1 = lv[((3 * 4 + j) * 2 + 1) * 64 + ln_], w0 = lv[((4 * 4 + j) * 2 + 0) * 64 + ln_], w1 = lv[((4 * 4 + j) * 2 + 1) * 64 + ln_];
                float o[8];
#pragma unroll
                for (int e = 0; e < 8; ++e) o[e] = v[8 * j + e] * rstd * (e < 4 ? u0[e] : u1[e - 4]) + (e < 4 ? w0[e] : w1[e - 4]);
                if (OUT32) { *(f32x4*)(OUT32 + (size_t)row * D + idx) = (f32x4){o[0], o[1], o[2], o[3]}; *(f32x4*)(OUT32 + (size_t)row * D + idx + 4) = (f32x4){o[4], o[5], o[6], o[7]}; }
                else { v4u hw; v2u lw = {0u, 0u};
#pragma unroll
                    for (int e = 0; e < 4; ++e) { hw[e] = pk2(o[2 * e], o[2 * e + 1]);
                        lw[e >> 1] |= (hl_enc(o[2 * e], hw[e] << 16) | (hl_enc(o[2 * e + 1], hw[e] & 0xffff0000u) << 8)) << (16 * (e & 1)); }
                    *(v4u*)(HO + (size_t)row * D + idx) = hw; *(v2u*)(LO + (size_t)row * D + idx) = lw; } } }
#undef LN_LOAD
    }
    __syncthreads();
}
__device__ __forceinline__ void onorm_phase(const Frame& F, const bf16* O, bf16* ON) {
    const int gw = F.vcu * NWAVES + F.wave, NGW = F.G * NWAVES;
    for (int row = gw; row < M; row += NGW) {
#pragma unroll
        for (int g = 0; g < 2; ++g) { const bf16* p = O + (size_t)row * D + g * 1024 + 16 * F.lane; bf16* po = ON + (size_t)row * D + g * 1024 + 16 * F.lane;
            const v4u w0 = *(const v4u*)p, w1 = *(const v4u*)(p + 8);
            float x[16];
#pragma unroll
            for (int i = 0; i < 4; ++i) { x[2 * i] = bf_lo(w0[i]); x[2 * i + 1] = bf_hi(w0[i]); x[8 + 2 * i] = bf_lo(w1[i]); x[8 + 2 * i + 1] = bf_hi(w1[i]); }
            float s = 0.f;
#pragma unroll
            for (int i = 0; i < 16; ++i) s += x[i] * x[i];
            const float rs = 1.0f / sqrtf(wave_sum(s) * (1.0f / 1024.0f) + RMS_EPS);
            v4u o0, o1;
#pragma unroll
            for (int i = 0; i < 4; ++i) { o0[i] = pk2(x[2 * i] * rs, x[2 * i + 1] * rs); o1[i] = pk2(x[8 + 2 * i] * rs, x[8 + 2 * i + 1] * rs); }
            *(v4u*)po = o0; *(v4u*)(po + 8) = o1; } }
}
__device__ __forceinline__ void attn_phase(const Frame& F, const CArgs& a, int which) {
    unsigned char* ws = a.ws;
    const bf16* QM = (const bf16*)(ws + WS_QM); const bf16* KV = (const bf16*)(ws + WS_KV); const bf16* KPE = (const bf16*)(ws + WS_KPE);
    const bf16* SBQ = (const bf16*)(ws + WS_SBQ); const bf16* SBK = (const bf16*)(ws + WS_SBK); const bf16* SBV = (const bf16*)(ws + WS_SBV);
    bf16* O = (bf16*)(ws + WS_O);
    constexpr int NQB = SEQ / 256, NPAIR = NQB / 2, NITEM = BATCH * NH * NPAIR;
    for (int it = F.vcu; it < NITEM; it += F.G) {
        const int bh = it / NPAIR, x = it - bh * NPAIR, b = bh / NH, h = bh - b * NH;
        const size_t r0 = (size_t)b * SEQ;
#if SITE_ATT & 1
#pragma unroll 1
        for (int pass = 0; pass < ((which & 1) ? 2 : 0); ++pass) { const int qb = pass ? NQB - 1 - x : x; const size_t rq = r0 + (size_t)qb * 256;
            att::attn_block<false>(F.lds, QM + rq * (NH * QKD) + h * QKD, NH * QKD, KV + r0 * D + h * 256, D, KV + r0 * D + h * 256 + 128, D, KPE + r0 * 64, O + rq * D + h * HD, D, qb * 256); }
#endif
#if SITE_ATT & 2
#pragma unroll 1
        for (int pass = 0; pass < ((which & 2) ? 2 : 0); ++pass) { const int qb = pass ? NQB - 1 - x : x; const size_t rq = r0 + (size_t)qb * 256;
            att::attn_block<true>(F.lds, SBQ + rq * 1024 + h * HD, 1024, SBK + r0 * 1024 + h * HD, 1024, SBV + r0 * 1024 + h * HD, 1024, nullptr, O + rq * D + 1024 + h * HD, D, qb * 256); }
#endif
    }
}

__global__ void __launch_bounds__(NWAVES * 64, 2) mk_fwd(Args args_unused) {
    extern __shared__ __attribute__((aligned(16))) unsigned char lds[];
    (void)args_unused;
    CArgs* ap = (CArgs*)__builtin_amdgcn_kernarg_segment_ptr();
    Frame F;
    F.lds = (LAS unsigned char*)lds;
    F.tid = threadIdx.x; F.lane = F.tid & 63; F.wave = __builtin_amdgcn_readfirstlane(F.tid >> 6);
    F.G = gridDim.x; { const int bx = blockIdx.x; F.vcu = (F.G % 8 == 0) ? (bx % 8) * (F.G / 8) + bx / 8 : bx; }
    volatile LAS unsigned* MISC = (volatile LAS unsigned*)(F.lds + MISC_OFF);
    for (int u = F.tid; u < (LDS_BYTES - MISC_OFF) / 4; u += NWAVES * 64) ((LAS unsigned*)(F.lds + MISC_OFF))[u] = 0u;
    __syncthreads();
    XcdBarrier bar; bar.bar = (unsigned*)(ap->ws + WS_CTL) + CW_BAR; bar.x = 0; bar.st = nullptr;
    if (MK_ONE_LAUNCH) bar = xcd_barrier_post((unsigned*)(ap->ws + WS_CTL) + CW_BAR, MISC + 8);
    const int lo = ap->ph_lo, hi = ap->ph_hi; int ph = 0; bool fin_ = false;
#define RUN_PH (ph >= lo && ph < hi)
#define END_PH do { if (MK_ONE_LAUNCH && RUN_PH && ph + 1 < hi && !fin_) xcd_barrier(bar); ++ph; } while (0)
#define WSP(T, off) ((T*)(A->ws + (off)))

REP(DUP_P0) {
#if SITE_P0
    if (RUN_PH) p0_prologue(fresh_frame(F), *fresh_args(ap));
#endif
    END_PH; }
REP(DUP_P1) {
#if SITE_P1
    if (RUN_PH) p1_ada_reduce(fresh_frame(F), *fresh_args(ap));
#endif
    END_PH; }
REP(DUP_P2) {
#if SITE_P2
    if (RUN_PH) { p2_modulate0(fresh_frame(F), *fresh_args(ap)); vec_prep(fresh_frame(F), *fresh_args(ap)); }
#endif
    END_PH; }

#pragma unroll 1
    for (int s = 0; s <= DBG_LAST_S; ++s) {
        const int l = s / 3, j = s - 3 * l;
        if (j != 1) {
REP(DUP_G1) {
#if SITE_G1
            if (RUN_PH) { CArgs* A = fresh_args(ap); const unsigned char* wl = A->ws + WS_W + (size_t)l * W_LAYER;
                pg8::Gemm g{WSP(const bf16, WS_H), (const bf16*)(wl + (j == 0 ? WO_WI1 : WO_WI2)), M, 2 * FF, D}; pg8::StaticOrder S; S.init(M, 2 * FF, F.G, (int)blockIdx.x);
                pg8::EpiSwiGLU E{WSP(bf16, WS_ACT), FF};
                pg8::gemm_phase<pg8::EpiSwiGLU, pg8::StaticOrder, G1_ALIGN, true>(F.lds + RING_OFF, g, S, E);
            }
#endif
            END_PH; }
        } else {
REP(DUP_WIN) {
#if SITE_WIN
            if (RUN_PH) { CArgs* A = fresh_args(ap); const unsigned char* wl = A->ws + WS_W + (size_t)l * W_LAYER;
                pg8::Gemm g{WSP(const bf16, WS_H), (const bf16*)(wl + WO_WIN), M, WIN_ROWS, D}; pg8::StaticOrder S; S.init(M, WIN_ROWS, F.G, (int)blockIdx.x);
                pg8::EpiWin E{WSP(bf16, WS_CQ), WSP(bf16, WS_CKV), WSP(bf16, WS_SBQ), WSP(bf16, WS_SBK), WSP(bf16, WS_SBV), WSP(bf16, WS_KPE), WSP(float, WS_SSQ), WSP(const float, WS_ROPE), SB_QSCALE};
                pg8::gemm_phase<pg8::EpiWin, pg8::StaticOrder, true, true>(F.lds + RING_OFF, g, S, E);
            }
#endif
            END_PH; }
REP(DUP_UQKV) {
#if SITE_UQKV
            if (RUN_PH) {
                { CArgs* A = fresh_args(ap); const unsigned char* wl = A->ws + WS_W + (size_t)l * W_LAYER;
                  pg8::Gemm g{WSP(const bf16, WS_CQ), (const bf16*)(wl + WO_WUQ), M, NH * QKD, QLR}; pg8::StaticOrder S; S.init(M, NH * QKD, F.G, (int)blockIdx.x);
                  pg8::EpiRS<true> E{WSP(bf16, WS_QM), NH * QKD, WSP(const float, WS_SSQ), 0, 3, 1.0f / QLR, RMS_EPS, MLA_QSCALE, WSP(const float, WS_ROPE)};
                  pg8::gemm_phase<pg8::EpiRS<true>, pg8::StaticOrder, true, true>(F.lds + RING_OFF, g, S, E); }
                { CArgs* A = fresh_args(ap); const unsigned char* wl = A->ws + WS_W + (size_t)l * W_LAYER;
                  pg8::Gemm g{WSP(const bf16, WS_CKV), (const bf16*)(wl + WO_WUKV), M, NH * 256, KVLR}; pg8::StaticOrder S; S.init(M, NH * 256, F.G, (int)blockIdx.x);
                  pg8::EpiRS<false> E{WSP(bf16, WS_KV), NH * 256, WSP(const float, WS_SSQ), 3, 2, 1.0f / KVLR, RMS_EPS, 1.0f, nullptr};
                  pg8::gemm_phase<pg8::EpiRS<false>, pg8::StaticOrder, true, true>(F.lds + RING_OFF, g, S, E); }
            }
#endif
            END_PH; }
REP(DUP_ATT) {
#if SITE_ATT
            if (RUN_PH) attn_phase(fresh_frame(F), *fresh_args(ap), rep_ == 0 ? 3 : DUP_ATT_WHICH);
#endif
            END_PH; }
REP(DUP_ONORM) {
#if SITE_ONORM
            if (RUN_PH) { CArgs* A = fresh_args(ap); onorm_phase(fresh_frame(F), WSP(const bf16, WS_O), WSP(bf16, WS_ACT)); }
#endif
            END_PH; }
        }
REP(DUP_GF) {
#if SITE_GF
        if (RUN_PH) { CArgs* A = fresh_args(ap); const unsigned char* wl = A->ws + WS_W + (size_t)l * W_LAYER;
            pg8::Gemm g{WSP(const bf16, WS_ACT), (const bf16*)(wl + (j == 0 ? WO_WO1 : j == 2 ? WO_WO2 : WO_WOUT)), M, D, j != 1 ? FF : D}; pg8::StaticOrder S; S.init(M, D, F.G, (int)blockIdx.x);
            pg8::EpiPlain E{WSP(bf16, WS_F), D};
            pg8::gemm_phase<pg8::EpiPlain, pg8::StaticOrder, GF_ALIGN, true>(F.lds + RING_OFF, g, S, E);
        }
#endif
        END_PH; }
REP(DUP_LN) {
#if SITE_LN
        fin_ = (s == DBG_LAST_S) && (rep_ == DUP_LN);
        if (RUN_PH) { CArgs* A = fresh_args(ap); const bool last = s == DBG_LAST_S; const bool dummy = DUP_LN && rep_ == 0;
            bf16* HO = dummy ? WSP(bf16, WS_DUMMY) : WSP(bf16, WS_H); unsigned char* LO = dummy ? WSP(unsigned char, WS_DUMMY + 64 * MiB) : WSP(unsigned char, WS_HL);
            if (s == 0) ln_phase<true>(fresh_frame(F), WSP(const bf16, WS_H), WSP(const unsigned char, WS_HL), HO, LO, WSP(const bf16, WS_F), WSP(const float, WS_VEC), A->in[0], last ? A->out : nullptr);
            else ln_phase<false>(fresh_frame(F), WSP(const bf16, WS_H), WSP(const unsigned char, WS_HL), HO, LO, WSP(const bf16, WS_F), WSP(const float, WS_VEC) + (size_t)s * BATCH * 5 * D, nullptr, last ? A->out : nullptr);
        }
#endif
        END_PH; }
    }
#undef RUN_PH
#undef END_PH
#undef WSP
}

extern "C" void kernel_launch(void* const* d_in, const int* in_sizes, int n_in, void* d_out, int out_size, void* d_ws, size_t ws_size, hipStream_t stream) {
    static int grid = 0;
    if (grid == 0) {
        if (n_in != 19 || in_sizes[0] != M * D || out_size != M * D || ws_size < WS_END) { fprintf(stderr, "kernel_launch: unexpected shapes (n_in %d, in0 %d, out %d, ws %zu < %zu); nothing launched\n", n_in, n_in > 0 ? in_sizes[0] : -1, out_size, ws_size, (size_t)WS_END); grid = -1; return; }
        int dev = 0, cus = 0, per_cu = 0;
        if (hipGetDevice(&dev) != hipSuccess || hipDeviceGetAttribute(&cus, hipDeviceAttributeMultiprocessorCount, dev) != hipSuccess) { grid = -1; return; }
        if (hipFuncSetAttribute((const void*)mk_fwd, hipFuncAttributeMaxDynamicSharedMemorySize, LDS_BYTES) != hipSuccess) { fprintf(stderr, "kernel_launch: hipFuncSetAttribute failed\n"); grid = -1; return; }
        if (hipOccupancyMaxActiveBlocksPerMultiprocessor(&per_cu, (const void*)mk_fwd, NWAVES * 64, LDS_BYTES) != hipSuccess || per_cu < 1)
            fprintf(stderr, "kernel_launch: note: occupancy query reports %d workgroups per CU\n", per_cu);
        (void)hipGetLastError();
        grid = cus;
    }
    if (grid < 0) return;
    if (hipMemsetAsync((char*)d_ws + WS_CTL, 0, CTL_ZERO_BYTES, stream) != hipSuccess) { fprintf(stderr, "kernel_launch: hipMemsetAsync failed\n"); return; }
    Args a{};
    for (int i = 0; i < 19; ++i) a.in[i] = (const float*)d_in[i];
    a.out = (float*)d_out; a.ws = (unsigned char*)d_ws;
#if MK_ONE_LAUNCH
    a.ph_lo = 0; a.ph_hi = 1 << 20;
    hipLaunchKernelGGL(mk_fwd, dim3(grid), dim3(NWAVES * 64), LDS_BYTES, stream, a);
#else
    for (int p = 0; p < N_PHASES; ++p) { a.ph_lo = p; a.ph_hi = p + 1; hipLaunchKernelGGL(mk_fwd, dim3(grid), dim3(NWAVES * 64), LDS_BYTES, stream, a); }
#endif
}
```

```cpp
#include <hip/hip_runtime.h>
#include <cstdio>
#include <cstdint>
#include <cmath>
namespace pg8 {
#define PG8_LAS __attribute__((address_space(3)))
typedef unsigned short bf16_t;
typedef short bf16x8 __attribute__((ext_vector_type(8)));
typedef float f32x4 __attribute__((ext_vector_type(4)));
typedef unsigned u32x4 __attribute__((ext_vector_type(4)));
constexpr int BM = 256, BK = 64, HALF = 128, HTB = HALF * BK * 2  , STAGE_BYTES = 8 * HTB, NXCD = 8, WGM = 8;

__host__ __device__ __forceinline__ int lds_byte(int r, int c) { const int st = (r >> 4) * 2 + (c >> 5), rr = r & 15, cc = c & 31, ob = rr * 64 + cc * 2; return st * 1024 + (ob ^ (((ob >> 9) & 1) << 5)); }
__host__ __device__ __forceinline__ void stage_rc(int b, int& R, int& C) { const int st = b / 1024, sb = b % 1024, swz = sb ^ (((sb >> 9) & 1) << 5); R = (st >> 1) * 16 + swz / 64; C = (st & 1) * 32 + (swz % 64) / 2; }
__host__ __device__ __forceinline__ int perm32(int rho) { const int n = rho >> 4, i = rho & 15; return 8 * (i >> 2) + 4 * n + (i & 3); }

struct Unit { int pm, pn; };
struct Gemm { const bf16_t* A; const bf16_t* Bt; int M, N, K; };

struct StaticOrder {
    int nM, nN, nwg, G, c;
    __host__ __device__ void init(int M, int N, int G_, int c_) { nM = M / BM; nN = N / BM; nwg = nM * nN; G = G_; c = c_; }
    __host__ __device__ bool next(int i, Unit& u) const {
        const long L = (long)i * G + c; if (L >= nwg) return false;
        int wgid = (int)L; { const int q = nwg / NXCD, r = nwg % NXCD, xcd = wgid % NXCD, off = wgid / NXCD; wgid = (xcd < r ? xcd * (q + 1) : r * (q + 1) + (xcd - r) * q) + off; }
        const int nig = WGM * nN, gid = wgid / nig, fm = gid * WGM, gsz = (nM - fm) < WGM ? (nM - fm) : WGM;
        u.pm = fm + ((wgid % nig) % gsz); u.pn = (wgid % nig) / gsz; return true;
    }
    __device__ __forceinline__ void a_ready(const Unit&) const {}
    __device__ __forceinline__ void done(const Unit&) const {}
};


#ifndef EPI_NT
#define EPI_NT 0
#endif

__device__ __forceinline__ unsigned cvt_pk_bf16(float lo, float hi) { unsigned r; asm volatile("v_cvt_pk_bf16_f32 %0, %1, %2" : "=v"(r) : "v"(lo), "v"(hi)); return r; }
typedef float f32x2 __attribute__((ext_vector_type(2)));
__device__ __forceinline__ u32x4 pack8bf(const f32x4 v0, const f32x4 v1) { u32x4 w; w.x = cvt_pk_bf16(v0[0], v0[1]); w.y = cvt_pk_bf16(v0[2], v0[3]); w.z = cvt_pk_bf16(v1[0], v1[1]); w.w = cvt_pk_bf16(v1[2], v1[3]); return w; }

struct EpiPlain {
    static constexpr bool PERM = true, AFTER_DRAIN = false;
    bf16_t* O; int ldc;
    __device__ __forceinline__ void operator()(const f32x4 (&acc)[2][2][4][2], const Unit& u, int wr, int wc, int fr, int fq) const {
        const int row0 = u.pm * BM + wr * 64 + fr; const int col0 = u.pn * BM + wc * 32 + 8 * fq;
#pragma unroll
        for (int ai = 0; ai < 2; ++ai)
#pragma unroll
            for (int m = 0; m < 4; ++m) { bf16_t* rowp = O + (size_t)(row0 + ai * HALF + m * 16) * ldc + col0;
#pragma unroll
                for (int bj = 0; bj < 2; ++bj) { const u32x4 w = pack8bf(acc[ai][bj][m][0], acc[ai][bj][m][1]); if (EPI_NT) __builtin_nontemporal_store(w, (u32x4*)(rowp + bj * HALF)); else *(u32x4*)(rowp + bj * HALF) = w; } }
    }
};

struct EpiSwiGLU {
    static constexpr bool PERM = true, AFTER_DRAIN = false;
    bf16_t* O; int ldc;
    __device__ __forceinline__ static f32x4 sg(const f32x4 g, const f32x4 up) {
        f32x4 r;
#pragma unroll
        for (int i = 0; i < 4; ++i) { const float e = __builtin_amdgcn_exp2f(g[i] * -1.4426950408889634f); r[i] = g[i] * __builtin_amdgcn_rcpf(1.0f + e) * up[i]; }
        return r;
    }
    __device__ __forceinline__ void operator()(const f32x4 (&acc)[2][2][4][2], const Unit& u, int wr, int wc, int fr, int fq) const {
        const int row0 = u.pm * BM + wr * 64 + fr; const int col0 = u.pn * HALF + wc * 32 + 8 * fq;
#pragma unroll
        for (int ai = 0; ai < 2; ++ai)
#pragma unroll
            for (int m = 0; m < 4; ++m) { bf16_t* rowp = O + (size_t)(row0 + ai * HALF + m * 16) * ldc + col0;
                const f32x4 h0 = sg(acc[ai][0][m][0], acc[ai][1][m][0]), h1 = sg(acc[ai][0][m][1], acc[ai][1][m][1]);
                { const u32x4 w = pack8bf(h0, h1); if (EPI_NT) __builtin_nontemporal_store(w, (u32x4*)rowp); else *(u32x4*)rowp = w; } }
    }
};

__device__ __forceinline__ void rope8(f32x4& v0, f32x4& v1, const f32x4 cs0, const f32x4 cs1) {
    const float a0 = v0[0], b0 = v0[1], a1 = v0[2], b1 = v0[3], a2 = v1[0], b2 = v1[1], a3 = v1[2], b3 = v1[3];
    v0[0] = a0 * cs0[0] - b0 * cs0[1]; v0[1] = a0 * cs0[1] + b0 * cs0[0];
    v0[2] = a1 * cs0[2] - b1 * cs0[3]; v0[3] = a1 * cs0[3] + b1 * cs0[2];
    v1[0] = a2 * cs1[0] - b2 * cs1[1]; v1[1] = a2 * cs1[1] + b2 * cs1[0];
    v1[2] = a3 * cs1[2] - b3 * cs1[3]; v1[3] = a3 * cs1[3] + b3 * cs1[2];
}

struct EpiWin {
    static constexpr bool PERM = true, AFTER_DRAIN = false;
    bf16_t *CQ, *CKV, *SBQ, *SBK, *SBV, *KPE; float* SSQ; const float* ROPE; float sbq_scale;
    __device__ __forceinline__ void operator()(const f32x4 (&acc)[2][2][4][2], const Unit& u, int wr, int wc, int fr, int fq) const {
        const int pn = u.pn; const int row0 = u.pm * BM + wr * 64 + fr;
        if (pn < 17) {
            bf16_t* base; int ldc, colt; float sc = 1.0f; const bool ssq = pn < 5;
            if (pn < 3) { base = CQ; ldc = 768; colt = pn * BM; }
            else if (pn < 5) { base = CKV; ldc = 512; colt = (pn - 3) * BM; }
            else if (pn < 9) { base = SBQ; ldc = 1024; colt = (pn - 5) * BM; sc = sbq_scale; }
            else if (pn < 13) { base = SBK; ldc = 1024; colt = (pn - 9) * BM; }
            else { base = SBV; ldc = 1024; colt = (pn - 13) * BM; }
            const int col0 = colt + wc * 32 + 8 * fq;
#pragma unroll
            for (int ai = 0; ai < 2; ++ai)
#pragma unroll
                for (int m = 0; m < 4; ++m) { const int row = row0 + ai * HALF + m * 16; bf16_t* rowp = base + (size_t)row * ldc + col0; float s = 0.f;
#pragma unroll
                    for (int bj = 0; bj < 2; ++bj) { const f32x4 v0 = acc[ai][bj][m][0] * sc, v1 = acc[ai][bj][m][1] * sc;
                        s += (v0[0] * v0[0] + v0[1] * v0[1]) + (v0[2] * v0[2] + v0[3] * v0[3]) + (v1[0] * v1[0] + v1[1] * v1[1]) + (v1[2] * v1[2] + v1[3] * v1[3]);
                        *(u32x4*)(rowp + bj * HALF) = pack8bf(v0, v1); }
                    if (ssq) { s += __shfl_xor(s, 16); s += __shfl_xor(s, 32); if (fq == 0) SSQ[((size_t)row * 5 + pn) * 4 + wc] = s; } }
        } else if (wc < 2) {
            const int c0 = wc * 32 + 8 * fq;
#pragma unroll
            for (int ai = 0; ai < 2; ++ai)
#pragma unroll
                for (int m = 0; m < 4; ++m) { const int row = row0 + ai * HALF + m * 16;
                    const f32x4 cs0 = *(const f32x4*)(ROPE + (size_t)row * 64 + c0), cs1 = *(const f32x4*)(ROPE + (size_t)row * 64 + c0 + 4);
                    f32x4 v0 = acc[ai][0][m][0], v1 = acc[ai][0][m][1]; rope8(v0, v1, cs0, cs1);
                    *(u32x4*)(KPE + (size_t)row * 64 + c0) = pack8bf(v0, v1); }
        }
    }
};

template <bool ROPE_Q> struct EpiRS {
    static constexpr bool PERM = true, AFTER_DRAIN = false;
    bf16_t* O; int ldc; const float* SSQ; int t0, nt; float invn, eps, oscale; const float* ROPE;
    __device__ __forceinline__ void operator()(const f32x4 (&acc)[2][2][4][2], const Unit& u, int wr, int wc, int fr, int fq) const {
        const int row0 = u.pm * BM + wr * 64 + fr; const int col0 = u.pn * BM + wc * 32 + 8 * fq;
        float rsv[2][4];
#pragma unroll
        for (int ai = 0; ai < 2; ++ai)
#pragma unroll
            for (int m = 0; m < 4; ++m) { const int row = row0 + ai * HALF + m * 16; f32x4 q = {0.f, 0.f, 0.f, 0.f};
                if (fq < nt) q = *(const f32x4*)(SSQ + ((size_t)row * 5 + t0 + fq) * 4);
                rsv[ai][m] = (q[0] + q[1]) + (q[2] + q[3]); }
#pragma unroll
        for (int ai = 0; ai < 2; ++ai)
#pragma unroll
            for (int m = 0; m < 4; ++m) { float ss = rsv[ai][m]; ss += __shfl_xor(ss, 16); ss += __shfl_xor(ss, 32); rsv[ai][m] = oscale / sqrtf(ss * invn + eps); }
#pragma unroll
        for (int ai = 0; ai < 2; ++ai)
#pragma unroll
            for (int m = 0; m < 4; ++m) { const int row = row0 + ai * HALF + m * 16;
                const float rs = rsv[ai][m];
#pragma unroll
                for (int bj = 0; bj < 2; ++bj) { const int c = col0 + bj * HALF; f32x4 v0 = acc[ai][bj][m][0] * rs, v1 = acc[ai][bj][m][1] * rs;
                    if (ROPE_Q) { const int w = c % 192; if (w >= 128) { const float* cs = ROPE + (size_t)row * 64 + (w - 128); rope8(v0, v1, *(const f32x4*)cs, *(const f32x4*)(cs + 4)); } }
                    *(u32x4*)(O + (size_t)row * ldc + c) = pack8bf(v0, v1); } }
    }
};

struct WinOrder : StaticOrder {
    __device__ __forceinline__ bool next(int i, Unit& u) const { if (!StaticOrder::next(i, u)) return false; u.pn = u.pn < 5 ? u.pn : (u.pn == 5 ? 17 : u.pn - 1); return true; }
};
struct ListOrder {
    int first, count, stride, pn0;
    __device__ __forceinline__ bool next(int i, Unit& u) const { if (i >= count) return false; const int L = first + i * stride; u.pm = L & 63; u.pn = pn0 + (L >> 6); return true; }
    __device__ __forceinline__ void a_ready(const Unit&) const {}
    __device__ __forceinline__ void done(const Unit&) const {}
};

#ifndef PG8_EPI_DUP
#define PG8_EPI_DUP 0
#endif
template <class Epi, class Sched, bool ALIGN_EPI = false, bool SP2 = false>
__device__ __forceinline__ void gemm_phase(PG8_LAS unsigned char* lds, const Gemm g, const Sched& S, const Epi& E) {
    int tid_ = threadIdx.x; asm volatile("" : "+v"(tid_));
    const int tid = tid_, wid = __builtin_amdgcn_readfirstlane(tid >> 6), lane = tid & 63, wr = wid >> 2, wc = wid & 3, fr = lane & 15, fq = lane >> 4;
    const int K = g.K, nt = K / BK;
    unsigned voffA[2], voffB[2];
#pragma unroll
    for (int i = 0; i < 2; ++i) { int R, C; stage_rc(tid * 16 + i * 8192, R, C); const int Rb = Epi::PERM ? ((R & ~31) + perm32(R & 31)) : R;
        voffA[i] = (unsigned)(R * K + C) * 2u; voffB[i] = (unsigned)(Rb * K + C) * 2u; }
    const size_t kstep = (size_t)(BK * 2);
    const size_t hstep = (size_t)HALF * K * 2;
    const size_t tstep = 2 * hstep;
    const unsigned ldsw = (unsigned)wid * 1024u;
    const int aoff = lds_byte(wr * 64 + fr, fq * 8), boff = lds_byte(wc * 32 + fr, fq * 8);
#define PG8_SA(b, h) (((b) * 2 + (h)) * HTB)
#define PG8_SB(b, h) ((4 + (b) * 2 + (h)) * HTB)
#define PG8_STAGE(bufoff, gbase, voff) do { _Pragma("unroll") for (int _i = 0; _i < 2; ++_i) \
        __builtin_amdgcn_global_load_lds((const unsigned*)((const char*)(gbase) + (voff)[_i]), (PG8_LAS unsigned*)(lds + (bufoff) + ldsw + _i * 8192), 16, 0, 0); } while (0)
#define PG8_LDA(dst, b, h) do { _Pragma("unroll") for (int m = 0; m < 4; ++m) _Pragma("unroll") for (int k = 0; k < 2; ++k) dst[m][k] = *(const PG8_LAS bf16x8*)(lds + PG8_SA(b, h) + aoff + m * 2048 + k * 1024); } while (0)
#define PG8_LDB(dst, b, h) do { _Pragma("unroll") for (int n = 0; n < 2; ++n) _Pragma("unroll") for (int k = 0; k < 2; ++k) dst[n][k] = *(const PG8_LAS bf16x8*)(lds + PG8_SB(b, h) + boff + n * 2048 + k * 1024); } while (0)
#define PG8_MMA(ai, bj, At, Bt) do { __builtin_amdgcn_s_setprio(1); _Pragma("unroll") for (int m = 0; m < 4; ++m) _Pragma("unroll") for (int n = 0; n < 2; ++n) _Pragma("unroll") for (int k = 0; k < 2; ++k) \
        acc[ai][bj][m][n] = __builtin_amdgcn_mfma_f32_16x16x32_bf16(Bt[n][k], At[m][k], acc[ai][bj][m][n], 0, 0, 0); __builtin_amdgcn_s_setprio(0); } while (0)
#define PG8_WAIT_V(n) asm volatile("s_waitcnt vmcnt(" #n ")" ::: "memory")
#define PG8_WAIT_L(n) asm volatile("s_waitcnt lgkmcnt(" #n ")" ::: "memory")
#define PG8_BAR __builtin_amdgcn_s_barrier()
#define PG8_SCHED __builtin_amdgcn_sched_barrier(0)
    Unit cur, nxt; int ui = 0;
    if (!S.next(0, cur)) return;
    f32x4 acc[2][2][4][2];
#pragma unroll
    for (int a = 0; a < 2; ++a)
#pragma unroll
        for (int b = 0; b < 2; ++b)
#pragma unroll
            for (int m = 0; m < 4; ++m)
#pragma unroll
                for (int n = 0; n < 2; ++n) acc[a][b][m][n] = (f32x4){0.f, 0.f, 0.f, 0.f};
    bf16x8 At[4][2], B0[2][2], B1[2][2];
    const char* cA = (const char*)g.A + (size_t)cur.pm * tstep; const char* cB = (const char*)g.Bt + (size_t)cur.pn * tstep;
    S.a_ready(cur);
    if constexpr (SP2) {
        PG8_STAGE(PG8_SB(0, 0), cB, voffB); PG8_STAGE(PG8_SB(0, 1), cB + hstep, voffB); PG8_STAGE(PG8_SA(0, 0), cA, voffA); PG8_STAGE(PG8_SA(0, 1), cA + hstep, voffA);
        if (wr == 1) PG8_BAR;
        PG8_WAIT_V(2); PG8_BAR;
        PG8_STAGE(PG8_SB(1, 0), cB + kstep, voffB); PG8_STAGE(PG8_SA(1, 0), cA + kstep, voffA); PG8_STAGE(PG8_SB(1, 1), cB + hstep + kstep, voffB);
        PG8_WAIT_V(6); PG8_BAR;
    } else {
        PG8_STAGE(PG8_SB(0, 0), cB, voffB); PG8_STAGE(PG8_SA(0, 0), cA, voffA); PG8_STAGE(PG8_SB(0, 1), cB + hstep, voffB); PG8_STAGE(PG8_SA(0, 1), cA + hstep, voffA);
        if (wr == 1) PG8_BAR;
        PG8_WAIT_V(4); PG8_BAR;
        PG8_STAGE(PG8_SB(1, 0), cB + kstep, voffB); PG8_STAGE(PG8_SA(1, 0), cA + kstep, voffA); PG8_STAGE(PG8_SB(1, 1), cB + hstep + kstep, voffB);
        PG8_WAIT_V(6); PG8_BAR;
    }
    for (;;) {
        const bool has_next = S.next(ui + 1, nxt);
        const char* nA = has_next ? (const char*)g.A + (size_t)nxt.pm * tstep : cA; const char* nB = has_next ? (const char*)g.Bt + (size_t)nxt.pn * tstep : cB;
        for (int t = 0; t < nt; t += 2) {
            const bool last = (t == nt - 2);
            const char* a1 = cA + (size_t)(t + 1) * kstep;
            const char* a2 = last ? nA : cA + (size_t)(t + 2) * kstep; const char* b2 = last ? nB : cB + (size_t)(t + 2) * kstep;
            const char* a3 = a2 + kstep; const char* b3 = b2 + kstep;
            if (last && has_next) S.a_ready(nxt);
            if constexpr (SP2) {
            PG8_LDB(B0, 0, 0); PG8_LDB(B1, 0, 1); PG8_SCHED; PG8_LDA(At, 0, 0); PG8_STAGE(PG8_SA(1, 1), a1 + hstep, voffA);
            PG8_WAIT_V(8); PG8_WAIT_L(0); PG8_BAR; PG8_MMA(0, 0, At, B0); PG8_MMA(0, 1, At, B1); PG8_BAR; PG8_SCHED;
            PG8_LDA(At, 0, 1); PG8_STAGE(PG8_SB(0, 0), b2, voffB); PG8_STAGE(PG8_SB(0, 1), b2 + hstep, voffB); PG8_STAGE(PG8_SA(0, 0), a2, voffA);
            PG8_WAIT_V(8); PG8_WAIT_L(0); PG8_BAR; PG8_MMA(1, 0, At, B0); PG8_MMA(1, 1, At, B1); PG8_BAR; PG8_SCHED;
            PG8_LDB(B0, 1, 0); PG8_LDB(B1, 1, 1); PG8_SCHED; PG8_LDA(At, 1, 0); PG8_STAGE(PG8_SA(0, 1), a2 + hstep, voffA);
            PG8_WAIT_V(8); PG8_WAIT_L(0); PG8_BAR; PG8_MMA(0, 0, At, B0); PG8_MMA(0, 1, At, B1); PG8_BAR; PG8_SCHED;
            PG8_LDA(At, 1, 1); PG8_STAGE(PG8_SB(1, 0), b3, voffB); PG8_STAGE(PG8_SB(1, 1), b3 + hstep, voffB); PG8_STAGE(PG8_SA(1, 0), a3, voffA);
            PG8_WAIT_V(8); PG8_WAIT_L(0); PG8_BAR; PG8_MMA(1, 0, At, B0); PG8_MMA(1, 1, At, B1); PG8_BAR; PG8_SCHED;
            } else {
            PG8_LDB(B0, 0, 0); PG8_SCHED; PG8_LDA(At, 0, 0); PG8_STAGE(PG8_SA(1, 1), a1 + hstep, voffA);
            PG8_WAIT_L(8); PG8_BAR; PG8_WAIT_L(0); PG8_MMA(0, 0, At, B0); PG8_BAR; PG8_SCHED;
            PG8_LDB(B1, 0, 1); PG8_STAGE(PG8_SB(0, 0), b2, voffB);
            PG8_BAR; PG8_WAIT_L(0); PG8_MMA(0, 1, At, B1); PG8_BAR;
            PG8_LDA(At, 0, 1); PG8_STAGE(PG8_SA(0, 0), a2, voffA);
            PG8_BAR; PG8_WAIT_L(0); PG8_MMA(1, 0, At, B0); PG8_BAR; PG8_SCHED;
            PG8_STAGE(PG8_SB(0, 1), b2 + hstep, voffB);
            PG8_WAIT_V(6); PG8_BAR; PG8_MMA(1, 1, At, B1); PG8_BAR;
            PG8_LDB(B0, 1, 0); PG8_SCHED; PG8_LDA(At, 1, 0); PG8_STAGE(PG8_SA(0, 1), a2 + hstep, voffA);
            PG8_WAIT_L(8); PG8_BAR; PG8_WAIT_L(0); PG8_MMA(0, 0, At, B0); PG8_BAR; PG8_SCHED;
            PG8_LDB(B1, 1, 1); PG8_STAGE(PG8_SB(1, 0), b3, voffB);
            PG8_BAR; PG8_WAIT_L(0); PG8_MMA(0, 1, At, B1); PG8_BAR;
            PG8_LDA(At, 1, 1); PG8_STAGE(PG8_SA(1, 0), a3, voffA);
            PG8_BAR; PG8_WAIT_L(0); PG8_MMA(1, 0, At, B0); PG8_BAR; PG8_SCHED;
            PG8_STAGE(PG8_SB(1, 1), b3 + hstep, voffB);
            PG8_WAIT_V(6); PG8_BAR; PG8_MMA(1, 1, At, B1); PG8_BAR;
            }
        }
        if constexpr (ALIGN_EPI) { if (wr == 0) PG8_BAR; }
        if constexpr (!Epi::AFTER_DRAIN) { E(acc, cur, wr, wc, fr, fq); if (PG8_EPI_DUP) { asm volatile("" ::: "memory"); E(acc, cur, wr, wc, fr, fq); } S.done(cur); }
        if (!has_next) break;
#pragma unroll
        for (int a = 0; a < 2; ++a)
#pragma unroll
            for (int b = 0; b < 2; ++b)
#pragma unroll
                for (int m = 0; m < 4; ++m)
#pragma unroll
                    for (int n = 0; n < 2; ++n) acc[a][b][m][n] = (f32x4){0.f, 0.f, 0.f, 0.f};
        cur = nxt; cA = nA; cB = nB; ++ui;
        if constexpr (ALIGN_EPI) { if (wr == 1) PG8_BAR; }
    }
    PG8_WAIT_V(0);
    if constexpr (!ALIGN_EPI) { if (wr == 0) PG8_BAR; }
    PG8_BAR;
    if constexpr (Epi::AFTER_DRAIN) { E.fused(acc, cur, wr, wc, fr, fq, lds, wid, lane); S.done(cur); }
#undef PG8_SA
#undef PG8_SB
#undef PG8_STAGE
#undef PG8_LDA
#undef PG8_LDB
#undef PG8_MMA
#undef PG8_WAIT_V
#undef PG8_WAIT_L
#undef PG8_BAR
#undef PG8_SCHED
}
}


namespace att {
typedef unsigned short bf16_t;
typedef short bf16x8 __attribute__((ext_vector_type(8)));
typedef short s16x4 __attribute__((ext_vector_type(4)));
typedef float f32x16 __attribute__((ext_vector_type(16)));
typedef float f32x4 __attribute__((ext_vector_type(4)));
typedef unsigned u32x4 __attribute__((ext_vector_type(4)));
#define ATT_LAS __attribute__((address_space(3)))
#ifndef ATT_PRIO
#define ATT_PRIO 1
#endif
#ifndef SB_EARLY_EXIT
#define SB_EARLY_EXIT 1
#endif
constexpr int KVBLK = 64, QB = 256;
constexpr int SHM_V = 16384, SHM_K = 16384, SHM_R = 8192;
constexpr int OFF_V = 0, OFF_K = 2 * SHM_V, OFF_R = OFF_K + 2 * SHM_K, OFF_WS = OFF_R + 2 * SHM_R, OFF_FLAG = OFF_WS + 8 * 256, OFF_QR = OFF_FLAG + 64, ATT_LDS_BYTES = OFF_QR + 8 * 4096;
#define KSWZ(row, colB) ((row) * 256 + ((colB) ^ (((row) & 7) << 4)))
#define RSWZ(row, colB) ((row) * 128 + ((colB) ^ (((row) & 7) << 4)))
#define SBAR() __builtin_amdgcn_sched_barrier(0)
__device__ __forceinline__ int v_st(int k, int c) { const int kk = (k & ~0xC) | ((k & 4) << 1) | ((k & 8) >> 1); return ((kk >> 3) * 4 + (c >> 5)) * 512 + ((kk & 7) * 32 + (c & 31)) * 2; }
__device__ __forceinline__ int v_rd_base(int lane) { return ((lane & 3) << 3) | (((lane >> 2) & 3) << 6) | (((lane >> 4) & 1) << 5) | (((lane >> 5) & 1) << 8); }
__device__ __forceinline__ int crow(int r, int hi) { return (r & 3) + 8 * (r >> 2) + 4 * hi; }
__device__ __forceinline__ unsigned cvtpk(float lo, float hi) { unsigned r; asm volatile("v_cvt_pk_bf16_f32 %0, %1, %2" : "=v"(r) : "v"(lo), "v"(hi)); return r; }
__device__ __forceinline__ float other_half(float x, int hi) { auto rr = __builtin_amdgcn_permlane32_swap(__float_as_uint(x), __float_as_uint(x), false, false); return __uint_as_float(hi ? rr[0] : rr[1]); }

__device__ __forceinline__ void pack_p(const f32x16& p0, const f32x16& p1, bf16x8& pa0, bf16x8& pa1, bf16x8& pa2, bf16x8& pa3) {
#define PK4(P, B_, OUT) do { unsigned a0 = cvtpk(P[B_+0], P[B_+1]), a1 = cvtpk(P[B_+2], P[B_+3]);                          \
        unsigned b0 = cvtpk(P[B_+4], P[B_+5]), b1 = cvtpk(P[B_+6], P[B_+7]);                                             \
        auto r0 = __builtin_amdgcn_permlane32_swap(a0, b0, false, false); auto r1 = __builtin_amdgcn_permlane32_swap(a1, b1, false, false); \
        u32x4 w = {r0[0], r1[0], r0[1], r1[1]}; OUT = __builtin_bit_cast(bf16x8, w); } while (0)
    PK4(p0, 0, pa0); PK4(p0, 8, pa1); PK4(p1, 0, pa2); PK4(p1, 8, pa3);
#undef PK4
}
__device__ __forceinline__ void pv_tile(f32x16* o, int vb, bf16x8 pa0, bf16x8 pa1, bf16x8 pa2, bf16x8 pa3) {
#define TRRD(dst, off) asm volatile("ds_read_b64_tr_b16 %0, %1 offset:%2" : "=&v"(dst) : "v"(vb), "i"(off) : "memory")
#define PV_D0(d0) do { s16x4 l0, l1, l2, l3, h0, h1, h2, h3; constexpr int b_ = (d0) * 512;   \
        TRRD(l0, b_); TRRD(h0, b_ + 2048); TRRD(l1, b_ + 4096); TRRD(h1, b_ + 6144); TRRD(l2, b_ + 8192); TRRD(h2, b_ + 10240); TRRD(l3, b_ + 12288); TRRD(h3, b_ + 14336); \
        asm volatile("s_waitcnt lgkmcnt(0)" ::: "memory"); SBAR();   \
        o[d0] = __builtin_amdgcn_mfma_f32_32x32x16_bf16(pa0, (bf16x8){l0[0], l0[1], l0[2], l0[3], h0[0], h0[1], h0[2], h0[3]}, o[d0], 0, 0, 0);   \
        o[d0] = __builtin_amdgcn_mfma_f32_32x32x16_bf16(pa1, (bf16x8){l1[0], l1[1], l1[2], l1[3], h1[0], h1[1], h1[2], h1[3]}, o[d0], 0, 0, 0);   \
        o[d0] = __builtin_amdgcn_mfma_f32_32x32x16_bf16(pa2, (bf16x8){l2[0], l2[1], l2[2], l2[3], h2[0], h2[1], h2[2], h2[3]}, o[d0], 0, 0, 0);   \
        o[d0] = __builtin_amdgcn_mfma_f32_32x32x16_bf16(pa3, (bf16x8){l3[0], l3[1], l3[2], l3[3], h3[0], h3[1], h3[2], h3[3]}, o[d0], 0, 0, 0); } while (0)
    PV_D0(0); PV_D0(1); PV_D0(2); PV_D0(3);
#undef PV_D0
#undef TRRD
}

template <bool SB>
__device__ __forceinline__ void attn_block(ATT_LAS unsigned char* lds, const bf16_t* Qg, int ldq, const bf16_t* Kg, int ldk, const bf16_t* Vg, int ldv, const bf16_t* Rg, bf16_t* Og, int ldo, int P0) {
    constexpr int NQ = 8;
    int tid_ = threadIdx.x; asm volatile("" : "+v"(tid_));
    const int tid = tid_, wid = __builtin_amdgcn_readfirstlane(tid >> 6), lane = tid & 63, r32 = lane & 31, hi = lane >> 5;
    const int qlo = P0 + wid * 32;
    const int NT = (P0 + QB) / KVBLK;
    ATT_LAS unsigned char* V_lds = lds + OFF_V; ATT_LAS unsigned char* K_lds = lds + OFF_K; ATT_LAS unsigned char* R_lds = lds + OFF_R;
    ATT_LAS float* ws = (ATT_LAS float*)(lds + OFF_WS) + wid * 64;
    ATT_LAS unsigned* flags = (ATT_LAS unsigned*)(lds + OFF_FLAG);
    const int sr = tid >> 4, sc = (tid & 15) * 8, rr = tid >> 3, rc = (tid & 7) * 8;
    const int vst0 = v_st(sr, sc), vst1 = v_st(32 + sr, sc), kws = KSWZ(sr, sc * 2), rws = RSWZ(rr, rc * 2);
    const int vb0 = (int)(unsigned)(uintptr_t)V_lds + v_rd_base(lane);
    bf16x8 qr[NQ];
#pragma unroll
    for (int d0 = 0; d0 < NQ; ++d0) qr[d0] = *(const bf16x8*)(Qg + (size_t)(wid * 32 + r32) * ldq + d0 * 16 + hi * 8);
    ATT_LAS unsigned char* qsl = lds + OFF_QR + wid * 4096 + lane * 16;
    if (!SB) {
#pragma unroll
        for (int d0 = 0; d0 < 4; ++d0) *(ATT_LAS bf16x8*)(qsl + d0 * 1024) = *(const bf16x8*)(Qg + (size_t)(wid * 32 + r32) * ldq + 128 + d0 * 16 + hi * 8);
    }
    bf16x8 st_k0, st_k1, st_v0, st_v1, st_r;
#define STAGE_LOAD(t_) do { const size_t k0_ = (size_t)(t_) * KVBLK;                                                                   \
        st_k0 = *(const bf16x8*)(Kg + (k0_ + sr) * ldk + sc); st_k1 = *(const bf16x8*)(Kg + (k0_ + 32 + sr) * ldk + sc);               \
        st_v0 = *(const bf16x8*)(Vg + (k0_ + sr) * ldv + sc); st_v1 = *(const bf16x8*)(Vg + (k0_ + 32 + sr) * ldv + sc);               \
        if (!SB) st_r = *(const bf16x8*)(Rg + (k0_ + rr) * 64 + rc); } while (0)
#define STAGE_WRITE(bf_) do { *(ATT_LAS bf16x8*)(K_lds + (bf_) * SHM_K + kws) = st_k0; *(ATT_LAS bf16x8*)(K_lds + (bf_) * SHM_K + kws + 32 * 256) = st_k1;   \
        *(ATT_LAS bf16x8*)(V_lds + (bf_) * SHM_V + vst0) = st_v0; *(ATT_LAS bf16x8*)(V_lds + (bf_) * SHM_V + vst1) = st_v1;                                  \
        if (!SB) *(ATT_LAS bf16x8*)(R_lds + (bf_) * SHM_R + rws) = st_r; } while (0)
    f32x16 o[4];
#pragma unroll
    for (int d = 0; d < 4; ++d)
#pragma unroll
        for (int r = 0; r < 16; ++r) o[d][r] = 0.f;
    float m_reg = -1e30f, l_reg = 0.f, R = 0.f;
    int kro[4];
#pragma unroll
    for (int dd = 0; dd < 4; ++dd) kro[dd] = KSWZ(r32, (dd * 16 + hi * 8) * 2);
    STAGE_LOAD(SB ? NT - 1 : 0);
    asm volatile("s_waitcnt vmcnt(0)" ::: "memory");
    STAGE_WRITE(0);
    __syncthreads();
    for (int it = 0; it < NT; ++it) {
        const int t = SB ? NT - 1 - it : it; const int buf = it & 1; const bool more = it + 1 < NT;
        if (more) STAGE_LOAD(SB ? t - 1 : t + 1);
        const int kb = t * KVBLK;
        if (kb <= qlo + 31) {
            f32x16 p0, p1;
#pragma unroll
            for (int r = 0; r < 16; ++r) { p0[r] = 0.f; p1[r] = 0.f; }
            ATT_LAS const unsigned char* kt = K_lds + buf * SHM_K;
            __builtin_amdgcn_s_setprio(ATT_PRIO);
#pragma unroll
            for (int d0 = 0; d0 < 8; ++d0) { ATT_LAS const unsigned char* a = kt + kro[d0 & 3] + (d0 >> 2) * 128;
                const bf16x8 b0 = *(ATT_LAS const bf16x8*)a; const bf16x8 b1 = *(ATT_LAS const bf16x8*)(a + 32 * 256);
                p0 = __builtin_amdgcn_mfma_f32_32x32x16_bf16(b0, qr[d0], p0, 0, 0, 0);
                p1 = __builtin_amdgcn_mfma_f32_32x32x16_bf16(b1, qr[d0], p1, 0, 0, 0); }
            if (!SB) { ATT_LAS const unsigned char* rt = R_lds + buf * SHM_R;
#pragma unroll
                for (int d0 = 0; d0 < 4; ++d0) { ATT_LAS const unsigned char* a = rt + (kro[d0] - 128 * r32);
                    const bf16x8 b0 = *(ATT_LAS const bf16x8*)a; const bf16x8 b1 = *(ATT_LAS const bf16x8*)(a + 32 * 128);
                    const bf16x8 qf = *(ATT_LAS const bf16x8*)(qsl + d0 * 1024);
                    p0 = __builtin_amdgcn_mfma_f32_32x32x16_bf16(b0, qf, p0, 0, 0, 0);
                    p1 = __builtin_amdgcn_mfma_f32_32x32x16_bf16(b1, qf, p1, 0, 0, 0); } }
            __builtin_amdgcn_s_setprio(0);
            const int dql = qlo + r32 - kb - 4 * hi - (SB ? 1 : 0);
            const bool need_mask = SB ? (kb + KVBLK - 1 >= qlo) : (kb + KVBLK - 1 > qlo);
            bf16x8 pa0, pa1, pa2, pa3;
            if (!SB) {
                if (need_mask) { const float NEG = -__builtin_inff();
#pragma unroll
                    for (int r = 0; r < 16; ++r) { const int c = (r & 3) + 8 * (r >> 2); if (c > dql) p0[r] = NEG; if (c + 32 > dql) p1[r] = NEG; } }
                float pmax = p0[0];
#pragma unroll
                for (int r = 1; r < 16; ++r) pmax = fmaxf(pmax, p0[r]);
#pragma unroll
                for (int r = 0; r < 16; ++r) pmax = fmaxf(pmax, p1[r]);
                pmax = fmaxf(pmax, other_half(pmax, hi));
                const float mn = fmaxf(m_reg, pmax); const float alpha = __builtin_amdgcn_exp2f(m_reg - mn); m_reg = mn;
                float ps = 0.f;
#pragma unroll
                for (int r = 0; r < 16; ++r) { p0[r] = __builtin_amdgcn_exp2f(p0[r] - mn); ps += p0[r]; }
#pragma unroll
                for (int r = 0; r < 16; ++r) { p1[r] = __builtin_amdgcn_exp2f(p1[r] - mn); ps += p1[r]; }
                ps += other_half(ps, hi);
                l_reg = l_reg * alpha + ps;
                if (__any(alpha < 1.f)) { if (hi == 0) ws[r32] = alpha; asm volatile("s_waitcnt lgkmcnt(0)" ::: "memory");
#pragma unroll
                    for (int r = 0; r < 16; ++r) { const float a = ws[crow(r, hi)];
#pragma unroll
                        for (int d = 0; d < 4; ++d) o[d][r] *= a; }
                    asm volatile("s_waitcnt lgkmcnt(0)" ::: "memory"); }
                pack_p(p0, p1, pa0, pa1, pa2, pa3);
            } else {
                f32x16 l0, l1;
#pragma unroll
                for (int r = 0; r < 16; ++r) { const float z = p0[r]; const float sp = fmaxf(z, 0.f) + __builtin_amdgcn_logf(1.0f + __builtin_amdgcn_exp2f(-fabsf(z))); l0[r] = -sp; p0[r] = z - sp; }
#pragma unroll
                for (int r = 0; r < 16; ++r) { const float z = p1[r]; const float sp = fmaxf(z, 0.f) + __builtin_amdgcn_logf(1.0f + __builtin_amdgcn_exp2f(-fabsf(z))); l1[r] = -sp; p1[r] = z - sp; }
                if (need_mask) { const float NEG = -__builtin_inff();
#pragma unroll
                    for (int r = 0; r < 16; ++r) { const int c = (r & 3) + 8 * (r >> 2); if (c > dql) { p0[r] = NEG; l0[r] = 0.f; } if (c + 32 > dql) { p1[r] = NEG; l1[r] = 0.f; } } }
                float T[8];
#pragma unroll
                for (int g = 0; g < 4; ++g) {
                    { const float a0 = l0[4 * g], a1 = l0[4 * g + 1], a2 = l0[4 * g + 2], a3 = l0[4 * g + 3]; const float x2 = a3, x1 = a3 + a2, x0 = x1 + a1; T[g] = x0 + a0;
                      l0[4 * g] = x0; l0[4 * g + 1] = x1; l0[4 * g + 2] = x2; l0[4 * g + 3] = 0.f; }
                    { const float a0 = l1[4 * g], a1 = l1[4 * g + 1], a2 = l1[4 * g + 2], a3 = l1[4 * g + 3]; const float x2 = a3, x1 = a3 + a2, x0 = x1 + a1; T[4 + g] = x0 + a0;
                      l1[4 * g] = x0; l1[4 * g + 1] = x1; l1[4 * g + 2] = x2; l1[4 * g + 3] = 0.f; }
                }
                float gs[8]; float run = R;
#pragma unroll
                for (int g = 7; g >= 0; --g) { const float To = other_half(T[g], hi); gs[g] = run + (hi == 0 ? To : 0.f); run += T[g] + To; }
                R = run;
#pragma unroll
                for (int g = 0; g < 4; ++g)
#pragma unroll
                    for (int i = 0; i < 4; ++i) { p0[4 * g + i] = __builtin_amdgcn_exp2f(p0[4 * g + i] + l0[4 * g + i] + gs[g]); p1[4 * g + i] = __builtin_amdgcn_exp2f(p1[4 * g + i] + l1[4 * g + i] + gs[4 + g]); }
                pack_p(p0, p1, pa0, pa1, pa2, pa3);
            }
            __builtin_amdgcn_s_setprio(ATT_PRIO); pv_tile(o, vb0 + buf * SHM_V, pa0, pa1, pa2, pa3); __builtin_amdgcn_s_setprio(0);
        }
        if (more) { asm volatile("s_waitcnt vmcnt(0)" ::: "memory"); STAGE_WRITE(buf ^ 1); }
        if (SB && SB_EARLY_EXIT) { const bool dead = __all(R < -160.f); if (lane == 0) flags[buf * 8 + wid] = dead ? 1u : 0u; }
        __syncthreads();
        if (SB && SB_EARLY_EXIT) { const u32x4 f0 = *(ATT_LAS const u32x4*)(flags + buf * 8), f1 = *(ATT_LAS const u32x4*)(flags + buf * 8 + 4);
            if ((f0[0] & f0[1] & f0[2] & f0[3] & f1[0] & f1[1] & f1[2] & f1[3]) != 0u) break; }
    }
    if (!SB) { if (hi == 0) ws[32 + r32] = l_reg; asm volatile("s_waitcnt lgkmcnt(0)" ::: "memory"); }
    bf16_t* Ow = Og + (size_t)(wid * 32) * ldo;
#pragma unroll
    for (int r = 0; r < 16; ++r) { const int orow = crow(r, hi); const float rl = SB ? 1.0f : 1.0f / ws[32 + orow];
#pragma unroll
        for (int d0 = 0; d0 < 4; ++d0) { const float v = o[d0][r] * rl; const float vn = __shfl_xor(v, 1);
            if ((r32 & 1) == 0) *(unsigned*)(Ow + (size_t)orow * ldo + d0 * 32 + r32) = cvtpk(v, vn); } }
    asm volatile("s_waitcnt lgkmcnt(0)" ::: "memory");
    __syncthreads();
#undef STAGE_LOAD
#undef STAGE_WRITE
}
#undef KSWZ
#undef RSWZ
}

#ifdef DUP_LN
#define DUP_LN_ANY DUP_LN
#else
#define DUP_LN_ANY 0
#endif

constexpr int NWAVES = 8;
constexpr int D = 2048, BATCH = 4, SEQ = 4096, DEPTH = 4, M = BATCH * SEQ, FF = 5632, NADA = 9;
constexpr int QLR = 768, KVLR = 512, ROPE_D = 64, NH = 8, HD = 128, QKD = 192;
constexpr int IN_COLS = QLR + KVLR + ROPE_D + 3 * NH * HD;
constexpr int WIN_ROWS = 4608;
constexpr float LN_EPS = 1e-5f, RMS_EPS = 1e-6f;
constexpr float DN_ALPHA = 1.6817928305074290f;
constexpr float LOG2E = 1.4426950408889634f;
constexpr float MLA_QSCALE = 0.07216878364870322f * LOG2E;
constexpr float SB_QSCALE = 0.08838834764831845f * LOG2E;
#ifndef MK_ONE_LAUNCH
#define MK_ONE_LAUNCH 1
#endif
constexpr int N_PHASES = 3 + 8 * 3 + 4 * 6;

constexpr size_t MiB = 1u << 20;
constexpr size_t WS_CTL = 0, CTL_ZERO_BYTES = 1 * MiB;
constexpr size_t WS_ADA = 1 * MiB;
constexpr size_t WS_ADAP = 3 * MiB;
constexpr size_t WS_VEC = 22 * MiB;
constexpr size_t WS_ROPE = 24 * MiB;
constexpr size_t WS_SSQ = 28 * MiB;
constexpr size_t WS_KPE = 30 * MiB;
constexpr size_t WS_HL = 32 * MiB;
constexpr size_t WS_H = 160 * MiB;
constexpr size_t WS_F = 224 * MiB;
constexpr size_t WS_ACT = 288 * MiB;
constexpr size_t WS_CQ = 464 * MiB;
constexpr size_t WS_CKV = 488 * MiB;
constexpr size_t WS_SBQ = 504 * MiB, WS_SBK = 536 * MiB, WS_SBV = 568 * MiB;
constexpr size_t WS_QM = 600 * MiB;
constexpr size_t WS_KV = 648 * MiB;
constexpr size_t WS_O = 712 * MiB;
constexpr size_t WS_W = 776 * MiB;
constexpr size_t W_WI = (size_t)2 * FF * D * 2, W_WO = (size_t)D * FF * 2, W_WIN = (size_t)WIN_ROWS * D * 2, W_WUQ = (size_t)NH * QKD * QLR * 2, W_WUKV = (size_t)NH * 256 * KVLR * 2, W_WOUT = (size_t)D * D * 2;
constexpr size_t WO_WI1 = 0, WO_WO1 = WO_WI1 + W_WI, WO_WI2 = WO_WO1 + W_WO, WO_WO2 = WO_WI2 + W_WI, WO_WIN = WO_WO2 + W_WO, WO_WUQ = WO_WIN + W_WIN, WO_WUKV = WO_WUQ + W_WUQ, WO_WOUT = WO_WUKV + W_WUKV;
constexpr size_t W_LAYER = WO_WOUT + W_WOUT;
constexpr size_t WS_DUMMY = WS_W + DEPTH * W_LAYER;
constexpr size_t WS_END = WS_DUMMY + (size_t)(DUP_LN_ANY ? 128 : 0) * MiB;
static_assert(W_LAYER % 256 == 0 && WS_END < (size_t)1700 * MiB, "ws map");
constexpr int ADA_KS = 16;
constexpr int CW_BAR = 4096;

constexpr int RING_OFF = 0, SCR_BYTES = 135168;
constexpr int MISC_OFF = SCR_BYTES;
constexpr int LDS_BYTES = 147456;

#define GAS __attribute__((address_space(1)))
#define LAS __attribute__((address_space(3)))
typedef unsigned short bf16;
typedef unsigned v4u __attribute__((ext_vector_type(4)));
typedef unsigned v2u __attribute__((ext_vector_type(2)));
typedef float f32x4 __attribute__((ext_vector_type(4)));
#define LDS_WAIT() asm volatile("s_waitcnt lgkmcnt(0)" ::: "memory")
#define VM_WAIT() asm volatile("s_waitcnt vmcnt(0)" ::: "memory")
__device__ __forceinline__ unsigned pk2(float lo, float hi) { unsigned r; asm volatile("v_cvt_pk_bf16_f32 %0, %1, %2" : "=v"(r) : "v"(lo), "v"(hi)); return r; }
__device__ __forceinline__ float bf_lo(unsigned w) { return __uint_as_float(w << 16); }
__device__ __forceinline__ float bf_hi(unsigned w) { return __uint_as_float(w & 0xffff0000u); }
__device__ __forceinline__ float wave_sum(float v) {
#pragma unroll
    for (int o = 1; o < 64; o <<= 1) v += __shfl_xor(v, o);
    return v;
}

#define XB_TMO      128
#define XB_XCNT(j)  (256  + 64 * (j))
#define XB_XSUB(j)  (1280 + 64 * (j))
#define XB_XGEN(j)  (2304 + 64 * (j))
#define XB_TOP      3328
#define XB_TOPGEN   3392
#define XCD_BAR_WORDS 3456
#define XB_SPIN_CAP (1u << 18)

__device__ __forceinline__ unsigned xb_ld(unsigned* p)              { return __hip_atomic_load(p, __ATOMIC_RELAXED, __HIP_MEMORY_SCOPE_AGENT); }
__device__ __forceinline__ unsigned xb_add(unsigned* p, unsigned v) { return __hip_atomic_fetch_add(p, v, __ATOMIC_RELAXED, __HIP_MEMORY_SCOPE_AGENT); }
__device__ __forceinline__ unsigned xb_xcc_id() { return (unsigned)__builtin_amdgcn_s_getreg((3 << 11) | 20) & 0xFu; }
#define XB_SPIN(cond, bar) do { unsigned _sp = 0; while (cond) { __builtin_amdgcn_s_sleep(1); \
    if ((++_sp & 255u) == 0u) { if (xb_ld(&(bar)[XB_TMO])) break; if (_sp > XB_SPIN_CAP) { atomicAdd(&(bar)[XB_TMO], 1u); break; } } } } while (0)

struct XcdBarrier {
    unsigned* bar; unsigned x;
    volatile LAS unsigned* st;
};

__device__ __forceinline__ XcdBarrier xcd_barrier_post(unsigned* bar, volatile LAS unsigned* st) {
    XcdBarrier b; b.bar = bar; b.x = xb_xcc_id(); b.st = st;
    if (threadIdx.x == 0) (void)xb_add(&bar[XB_XCNT(b.x)], 1u);
    return b;
}
__device__ __forceinline__ void xcd_barrier_complete(unsigned* bar, unsigned x, unsigned& nloc, unsigned& nx) {
    const unsigned G = gridDim.x * gridDim.y * gridDim.z;
    unsigned sum, cnt, mine, sp = 0u;
    for (;;) {
        sum = 0u; cnt = 0u; mine = 0u;
#pragma unroll 1
        for (unsigned j = 0; j < 16; ++j) { const unsigned c = xb_ld(&bar[XB_XCNT(j)]); sum += c; cnt += (c > 0u) ? 1u : 0u; mine = (j == x) ? c : mine; }
        if (sum == G) break;
        __builtin_amdgcn_s_sleep(1);
        if ((++sp & 255u) == 0u) { if (xb_ld(&bar[XB_TMO])) break; if (sp > XB_SPIN_CAP) { atomicAdd(&bar[XB_TMO], 1u); break; } }
    }
    nloc = mine > 0u ? mine : 1u; nx = cnt > 0u ? cnt : 1u;
}

__device__ __forceinline__ void xcd_barrier(const XcdBarrier& b) {
    asm volatile("s_waitcnt vmcnt(0)" ::: "memory");
    __syncthreads();
    if (threadIdx.x == 0) {
        unsigned* bar = b.bar;
        __builtin_amdgcn_s_waitcnt(0);
        unsigned nloc = b.st[0], nx = b.st[1];
        if (nloc == 0u) { xcd_barrier_complete(bar, b.x, nloc, nx); b.st[0] = nloc; b.st[1] = nx; }
        const unsigned old = xb_add(&bar[XB_XSUB(b.x)], 1u);
        const unsigned gen = old / nloc;
        if (old + 1u == (gen + 1u) * nloc) {
            __builtin_amdgcn_fence(__ATOMIC_RELEASE, "agent");
            asm volatile("s_waitcnt vmcnt(0)" ::: "memory");
            const unsigned og = xb_add(&bar[XB_TOP], 1u);
            const unsigned tg = og / nx;
            if (og + 1u == (tg + 1u) * nx) xb_add(&bar[XB_TOPGEN], 1u);
            else XB_SPIN(xb_ld(&bar[XB_TOPGEN]) == tg, bar);
            __builtin_amdgcn_fence(__ATOMIC_ACQUIRE, "agent");
            xb_add(&bar[XB_XGEN(b.x)], 1u);
            asm volatile("s_waitcnt vmcnt(0)" ::: "memory");
        } else {
            XB_SPIN(xb_ld(&bar[XB_XGEN(b.x)]) == gen, bar);
            __builtin_amdgcn_fence(__ATOMIC_ACQUIRE, "agent");
            asm volatile("s_waitcnt vmcnt(0)" ::: "memory");
        }
    }
    __syncthreads();
}

#ifndef G1_SP2
#define G1_SP2 true
#endif
#ifndef DUP_BAR
#define DUP_BAR 0
#endif
#ifndef G1_ALIGN
#define G1_ALIGN true
#endif
#ifndef GF_ALIGN
#define GF_ALIGN true
#endif
#ifndef DUP_ATT_WHICH
#define DUP_ATT_WHICH 3
#endif
#ifndef DUP_P0
#define DUP_P0 0
#endif
#ifndef DUP_P1
#define DUP_P1 0
#endif
#ifndef DUP_P2
#define DUP_P2 0
#endif
#ifndef DUP_G1
#define DUP_G1 0
#endif
#ifndef DUP_WIN
#define DUP_WIN 0
#endif
#ifndef DUP_UQKV
#define DUP_UQKV 0
#endif
#ifndef DUP_ATT
#define DUP_ATT 0
#endif
#ifndef DUP_ONORM
#define DUP_ONORM 0
#endif
#ifndef DUP_GF
#define DUP_GF 0
#endif
#ifndef DUP_LN
#define DUP_LN 0
#endif
#define REP(n) for (int rep_ = 0; rep_ < 1 + (n); ++rep_)
#ifndef P0_PARTS
#define P0_PARTS 7
#endif
#ifndef SITE_P0
#define SITE_P0 1
#endif
#ifndef SITE_P1
#define SITE_P1 1
#endif
#ifndef SITE_P2
#define SITE_P2 1
#endif
#ifndef SITE_ATT
#define SITE_ATT 3
#endif
#ifndef SITE_ONORM
#define SITE_ONORM 1
#endif
#ifndef SITE_G1
#define SITE_G1 1
#endif
#ifndef SITE_WIN
#define SITE_WIN 1
#endif
#ifndef SITE_UQKV
#define SITE_UQKV 1
#endif
#ifndef SITE_GF
#define SITE_GF 1
#endif
#ifndef SITE_LN
#define SITE_LN 1
#endif
#ifndef DBG_LAST_S
#define DBG_LAST_S (3 * DEPTH - 1)
#endif
#ifndef P0_PARTS
#define P0_PARTS 7
#endif

struct Frame {
    LAS unsigned char* lds;
    int tid, lane, wave;
    int vcu, G;
};

__device__ __forceinline__ int dst_row(int kind, int n) {
    if (kind == 1) { const int u = n >= FF ? 1 : 0, j = n - u * FF; return (j >> 7) * 256 + u * 128 + (j & 127); }
    if (kind == 2) { if (n < QLR + KVLR) return n; if (n < QLR + KVLR + ROPE_D) { const int j = n - (QLR + KVLR); return 4352 + (j < 32 ? 2 * j : 2 * (j - 32) + 1); } return n - ROPE_D; }
    if (kind == 3) { const int h = n / QKD, w = n - h * QKD; if (w < 128) return n; const int j = w - 128; return h * QKD + 128 + (j < 32 ? 2 * j : 2 * (j - 32) + 1); }
    return n;
}
__device__ __forceinline__ void tr_item(const float* __restrict__ W, int K, int N, bf16* __restrict__ WT, int kind, const float* __restrict__ gk, LAS float* scr, int item, int lane) {
    const int nblk = N >> 6, kb = item / nblk, nb = item - kb * nblk, k0 = kb << 6, n0 = nb << 6;
    const int kk4 = lane >> 4, n4 = (lane & 15) * 4;
    const float* src = W + (size_t)(k0 + kk4) * N + n0 + n4;
    f32x4 wv[16];
#pragma unroll
    for (int i = 0; i < 16; ++i) wv[i] = *(const f32x4*)(src + (size_t)(4 * i) * N);
#pragma unroll
    for (int i = 0; i < 16; ++i) { const int kk = 4 * i + kk4; f32x4 w = wv[i]; if (gk) w = w * gk[k0 + kk];
        LAS float* d = scr + kk * 65 + n4; d[0] = w[0]; d[1] = w[1]; d[2] = w[2]; d[3] = w[3]; }
    LDS_WAIT(); asm volatile("" ::: "memory");
    const int c = lane & 7;
#pragma unroll
    for (int j = 0; j < 8; ++j) { const int n = (lane >> 3) + 8 * j; const LAS float* s = scr + (8 * c) * 65 + n;
        v4u o; o.x = pk2(s[0 * 65], s[1 * 65]); o.y = pk2(s[2 * 65], s[3 * 65]); o.z = pk2(s[4 * 65], s[5 * 65]); o.w = pk2(s[6 * 65], s[7 * 65]);
        *(v4u*)(WT + (size_t)dst_row(kind, n0 + n) * K + k0 + 8 * c) = o; }
    LDS_WAIT(); asm volatile("" ::: "memory");
}

struct Args { const float* in[19]; float* out; unsigned char* ws; int ph_lo, ph_hi; };
typedef const __attribute__((address_space(4))) Args CArgs;
__device__ __forceinline__ CArgs* fresh_args(CArgs* p) { asm volatile("" : "+s"(p)); return p; }
__device__ __forceinline__ Frame fresh_frame(Frame F) { asm volatile("" : "+v"(F.tid)); F.lane = F.tid & 63; return F; }
__constant__ float INVF[32] = {1.000000000e+00f, 7.498942614e-01f, 5.623413324e-01f, 4.216965139e-01f, 3.162277639e-01f, 2.371373773e-01f, 1.778279394e-01f, 1.333521307e-01f, 1.000000015e-01f, 7.498941571e-02f, 5.623413250e-02f, 4.216965288e-02f, 3.162277490e-02f, 2.371373773e-02f, 1.778279431e-02f, 1.333521493e-02f, 9.999999776e-03f, 7.498941850e-03f, 5.623413250e-03f, 4.216964822e-03f, 3.162277630e-03f, 2.371373586e-03f, 1.778279431e-03f, 1.333521446e-03f, 1.000000047e-03f, 7.498942432e-04f, 5.623413017e-04f, 4.216965172e-04f, 3.162277571e-04f, 2.371373703e-04f, 1.778279402e-04f, 1.333521504e-04f};

__device__ __forceinline__ void p0_prologue(const Frame& F, const CArgs& a) {
    unsigned char* ws = a.ws;
    const int gw = F.vcu * NWAVES + F.wave, NGW = F.G * NWAVES;
    const int gt = F.vcu * (NWAVES * 64) + F.tid, NGT = F.G * NWAVES * 64;
#if P0_PARTS & 1
    {
        LAS float* scr = (LAS float*)(F.lds + F.wave * 16640);
        constexpr int I_WI = (D / 64) * (2 * FF / 64), I_WO = (FF / 64) * (D / 64), I_WIN = (D / 64) * (IN_COLS / 64), I_WUQ = (QLR / 64) * (NH * QKD / 64), I_WUKV = (KVLR / 64) * (NH * 256 / 64), I_WOUT = (D / 64) * (D / 64);
        constexpr int I_LAYER = 2 * I_WI + 2 * I_WO + I_WIN + I_WUQ + I_WUKV + I_WOUT;
        for (int it = gw; it < DEPTH * I_LAYER; it += NGW) {
            const int l = it / I_LAYER; int r = it - l * I_LAYER;
            unsigned char* wl = ws + WS_W + (size_t)l * W_LAYER;
            const float* src; const float* gk = nullptr; int K_, N_, kind = 0; size_t dsto;
            if (r < I_WI) { src = a.in[7] + (size_t)l * D * 2 * FF; K_ = D; N_ = 2 * FF; dsto = WO_WI1; kind = 1; }
            else if ((r -= I_WI) < I_WO) { src = a.in[8] + (size_t)l * FF * D; K_ = FF; N_ = D; dsto = WO_WO1; }
            else if ((r -= I_WO) < I_WI) { src = a.in[17] + (size_t)l * D * 2 * FF; K_ = D; N_ = 2 * FF; dsto = WO_WI2; kind = 1; }
            else if ((r -= I_WI) < I_WO) { src = a.in[18] + (size_t)l * FF * D; K_ = FF; N_ = D; dsto = WO_WO2; }
            else if ((r -= I_WO) < I_WIN) { src = a.in[9] + (size_t)l * D * IN_COLS; K_ = D; N_ = IN_COLS; dsto = WO_WIN; kind = 2; }
            else if ((r -= I_WIN) < I_WUQ) { src = a.in[12] + (size_t)l * QLR * NH * QKD; K_ = QLR; N_ = NH * QKD; dsto = WO_WUQ; kind = 3; gk = a.in[10] + l * QLR; }
            else if ((r -= I_WUQ) < I_WUKV) { src = a.in[13] + (size_t)l * KVLR * NH * 256; K_ = KVLR; N_ = NH * 256; dsto = WO_WUKV; gk = a.in[11] + l * KVLR; }
            else { r -= I_WUKV; src = a.in[16] + (size_t)l * D * D; K_ = D; N_ = D; dsto = WO_WOUT;
                   gk = (r / (D / 64)) < 16 ? a.in[14] + l * 1024 : a.in[15] + l * 1024 - 1024; }
            tr_item(src, K_, N_, (bf16*)(wl + dsto), kind, gk, scr, r, F.lane);
        }
        constexpr int PADV = (WIN_ROWS - IN_COLS) * D * 2 / 16;
        for (int i = gt; i < DEPTH * PADV; i += NGT) { const int l = i / PADV, r = i - l * PADV;
            *(v4u*)(ws + WS_W + (size_t)l * W_LAYER + WO_WIN + (size_t)IN_COLS * D * 2 + (size_t)r * 16) = (v4u){0u, 0u, 0u, 0u}; }
    }
#endif
#if P0_PARTS & 2
    {
        const int* pos = (const int*)a.in[2]; float* rope = (float*)(ws + WS_ROPE);
        for (int i = gt; i < M * 32; i += NGT) { const int row = i >> 5, j = i & 31;
            const float ang = (float)pos[row] * INVF[j];
            double rev = (double)ang * 0.15915494309189535; rev -= __builtin_floor(rev);
            const float fr = (float)rev;
            *(float2*)(rope + (size_t)i * 2) = make_float2(__builtin_amdgcn_cosf(fr), __builtin_amdgcn_sinf(fr)); }
    }
#endif
    __syncthreads();
#if P0_PARTS & 4
    {
        LAS f32x4* cact = (LAS f32x4*)F.lds;
        for (int k = F.tid; k < D; k += NWAVES * 64) { f32x4 v;
#pragma unroll
            for (int b = 0; b < 4; ++b) { const float cv = a.in[1][b * D + k]; v[b] = cv / (1.0f + __expf(-cv)); }
            cact[k] = v; }
        __syncthreads();
        constexpr int NCH = NADA * D / 256, KSL = D / ADA_KS;
        float* adap = (float*)(ws + WS_ADAP);
        for (int it = gw; it < DEPTH * NCH * ADA_KS; it += NGW) {
            const int ks = it % ADA_KS, r = it / ADA_KS, ch = r % NCH, l = r / NCH;
            const int n = ch * 256 + 4 * F.lane;
            const float* w = a.in[3] + ((size_t)l * D + (size_t)ks * KSL) * (NADA * D) + n;
            f32x4 acc[4];
#pragma unroll
            for (int b = 0; b < 4; ++b) acc[b] = (f32x4){0.f, 0.f, 0.f, 0.f};
            if (ks == 0) { const f32x4 bv = *(const f32x4*)(a.in[4] + (size_t)l * NADA * D + n);
#pragma unroll
                for (int b = 0; b < 4; ++b) acc[b] = bv; }
#pragma unroll 16
            for (int kk = 0; kk < KSL; ++kk) { const f32x4 wv = *(const f32x4*)(w + (size_t)kk * (NADA * D)); const f32x4 cv = cact[ks * KSL + kk];
#pragma unroll
                for (int b = 0; b < 4; ++b) acc[b] += wv * cv[b]; }
#pragma unroll
            for (int b = 0; b < 4; ++b) *(f32x4*)(adap + (((size_t)ks * DEPTH + l) * BATCH + b) * (NADA * D) + n) = acc[b];
        }
    }
#endif
}
__device__ __forceinline__ void p1_ada_reduce(const Frame& F, const CArgs& a) {
    const int gt = F.vcu * (NWAVES * 64) + F.tid, NGT = F.G * NWAVES * 64;
    const f32x4* adap = (const f32x4*)(a.ws + WS_ADAP); f32x4* ada = (f32x4*)(a.ws + WS_ADA);
    constexpr int NV = DEPTH * BATCH * NADA * D / 4;
    for (int i = gt; i < NV; i += NGT) { f32x4 s = adap[i];
#pragma unroll
        for (int ks = 1; ks < ADA_KS; ++ks) s += adap[(size_t)ks * NV + i];
        ada[i] = s; }
}
__device__ __forceinline__ void p2_modulate0(const Frame& F, const CArgs& a) {
    const int gw = F.vcu * NWAVES + F.wave, NGW = F.G * NWAVES;
    const float* ada = (const float*)(a.ws + WS_ADA); bf16* H = (bf16*)(a.ws + WS_H);
    for (int row = gw; row < M; row += NGW) { const int b = row >> 12;
        const float* sh = ada + (size_t)b * NADA * D, * sc = sh + D;
#pragma unroll
        for (int j = 0; j < 8; ++j) { const int idx = 4 * (F.lane + 64 * j);
            const f32x4 xv = *(const f32x4*)(a.in[0] + (size_t)row * D + idx), s1 = *(const f32x4*)(sc + idx), s0 = *(const f32x4*)(sh + idx);
            const f32x4 h = xv * (s1 + 1.0f) + s0;
            *(v2u*)(H + (size_t)row * D + idx) = (v2u){pk2(h[0], h[1]), pk2(h[2], h[3])}; } }
}
__device__ __forceinline__ void vec_prep(const Frame& F, const CArgs& a) {
    const int gt = F.vcu * (NWAVES * 64) + F.tid, NGT = F.G * NWAVES * 64;
    const float* ada = (const float*)(a.ws + WS_ADA); float* vec = (float*)(a.ws + WS_VEC);
    for (int i = gt; i < 3 * DEPTH * BATCH * D; i += NGT) { const int d = i % D, sb = i / D, b = sb % BATCH, s = sb / BATCH, l = s / 3, j = s - 3 * l;
        const float* ad = ada + ((size_t)l * BATCH + b) * NADA * D + d;
        const float sh = ad[(3 * j) * D], sc = ad[(3 * j + 1) * D], gt_ = ad[(3 * j + 2) * D];
        const float lg = a.in[5][(size_t)(l * 3 + j) * D + d], lb = a.in[6][(size_t)(l * 3 + j) * D + d];
        float P = DN_ALPHA, Q = 0.f; if (s != 0) { P = DN_ALPHA / (1.0f + sc); Q = -P * sh; }
        float U = lg, W = lb;
        if (s != 3 * DEPTH - 1) { const int s1 = s + 1, l1 = s1 / 3, j1 = s1 - 3 * l1; const float* an = ada + ((size_t)l1 * BATCH + b) * NADA * D + d;
            const float nsh = an[(3 * j1) * D], nsc = an[(3 * j1 + 1) * D]; U = lg * (1.0f + nsc); W = lb * (1.0f + nsc) + nsh; }
        float* o = vec + (size_t)sb * 5 * D + d;
        o[0] = P; o[D] = Q; o[2 * D] = (j == 1 ? 1.0f : 0.5f) * (1.0f + gt_); o[3 * D] = U; o[4 * D] = W; }
}
__device__ __forceinline__ unsigned hl_enc(float h, unsigned hb) { const unsigned eb = hb & 0x7f800000u; if (eb == 0u) return 0u;
    const float inv_ulp254 = __uint_as_float(0x7f000000u - eb) * (254.0f * 128.0f);
    const int q = __float2int_rn((h - __uint_as_float(hb)) * inv_ulp254); return (unsigned)q & 0xffu; }
__device__ __forceinline__ float hl_dec(unsigned hb, unsigned byte) { const unsigned eb = hb & 0x7f800000u; const float H = __uint_as_float(hb);
    const int q = (int)(signed char)(byte & 0xffu); return H + (float)q * (__uint_as_float(eb) * (1.0f / (254.0f * 128.0f))); }
template <bool FIRST>
__device__ __forceinline__ void ln_phase(const Frame& F, const bf16* H, const unsigned char* L, bf16* HO, unsigned char* LO, const bf16* f, const float* vecs  , const float* X32, float* OUT32) {
    const int gw = F.vcu * NWAVES + F.wave, NGW = F.G * NWAVES;
    constexpr int RPW = 8;
    LAS f32x4* lv = (LAS f32x4*)F.lds;
    int staged_b = -1;
    for (int r0 = gw * RPW; r0 < M; r0 += NGW * RPW) { const int b = r0 >> 12;
        if (b != staged_b) {
            if (staged_b >= 0) __syncthreads();
            const f32x4* src = (const f32x4*)(vecs + (size_t)b * 5 * D);
            int t_ = F.tid; asm volatile("" : "+v"(t_));
#pragma unroll
            for (int i = 0; i < 5; ++i) { const int q = t_ + 512 * i, vec = q >> 9, e = (q & 511) * 4, j = e >> 9, ln = (e & 511) >> 3, half = (e >> 2) & 1;
                lv[((vec * 4 + j) * 2 + half) * 64 + ln] = src[q]; }
            __syncthreads(); staged_b = b; }
        constexpr int NS = FIRST ? 1 : 2;
        v4u hq2[NS][4], fq2[NS][4]; v2u lq2[NS][4]; f32x4 xq2[NS][8];
#define LN_LOAD(row_, S_) do { _Pragma("unroll") for (int j = 0; j < 4; ++j) { const int idx = 8 * (F.lane + 64 * j);                                     \
            fq2[S_][j] = *(const v4u*)(f + (size_t)(row_) * D + idx);                                                                                          \
            if (FIRST) { xq2[S_][2 * j] = *(const f32x4*)(X32 + (size_t)(row_) * D + idx); xq2[S_][2 * j + 1] = *(const f32x4*)(X32 + (size_t)(row_) * D + idx + 4); } \
            else { hq2[S_][j] = *(const v4u*)(H + (size_t)(row_) * D + idx); lq2[S_][j] = *(const v2u*)(L + (size_t)(row_) * D + idx); } } } while (0)
        LN_LOAD(r0, 0); if (NS == 2) LN_LOAD(r0 + 1, NS - 1);
#pragma unroll
        for (int i = 0; i < RPW; ++i) { const int row = r0 + i;
            v4u (&hq)[4] = hq2[i % NS]; v4u (&fq)[4] = fq2[i % NS]; v2u (&lq)[4] = lq2[i % NS]; f32x4 (&xq)[8] = xq2[i % NS];
            int ln_ = F.lane; asm volatile("" : "+v"(ln_));
            float v[32]; float s = 0.f;
#pragma unroll
            for (int j = 0; j < 4; ++j) {
                const f32x4 p0 = lv[((0 * 4 + j) * 2 + 0) * 64 + ln_], p1 = lv[((0 * 4 + j) * 2 + 1) * 64 + ln_], q0 = lv[((1 * 4 + j) * 2 + 0) * 64 + ln_], q1 = lv[((1 * 4 + j) * 2 + 1) * 64 + ln_], c0 = lv[((2 * 4 + j) * 2 + 0) * 64 + ln_], c1 = lv[((2 * 4 + j) * 2 + 1) * 64 + ln_];
#pragma unroll
                for (int e = 0; e < 4; ++e) { const float fl = bf_lo(fq[j][e]), fh = bf_hi(fq[j][e]);
                    const float xl = FIRST ? xq[2 * j + (e >> 1)][(e & 1) * 2] : hl_dec(hq[j][e] << 16, lq[j][e >> 1] >> (16 * (e & 1))), xh = FIRST ? xq[2 * j + (e >> 1)][(e & 1) * 2 + 1] : hl_dec(hq[j][e] & 0xffff0000u, lq[j][e >> 1] >> (16 * (e & 1) + 8));
                    const float pl = e < 2 ? p0[2 * e] : p1[2 * e - 4], ph_ = e < 2 ? p0[2 * e + 1] : p1[2 * e - 3], ql = e < 2 ? q0[2 * e] : q1[2 * e - 4], qh = e < 2 ? q0[2 * e + 1] : q1[2 * e - 3], cl = e < 2 ? c0[2 * e] : c1[2 * e - 4], ch = e < 2 ? c0[2 * e + 1] : c1[2 * e - 3];
                    const float vl = pl * xl + ql + cl * fl, vh = ph_ * xh + qh + ch * fh; v[8 * j + 2 * e] = vl; v[8 * j + 2 * e + 1] = vh; s += vl + vh; } }
            if (i + NS < RPW) LN_LOAD(row + NS, i % NS);
            const float mean = wave_sum(s) * (1.0f / D); float s2 = 0.f;
#pragma unroll
            for (int k = 0; k < 32; ++k) { v[k] -= mean; s2 += v[k] * v[k]; }
            const float rstd = 1.0f / sqrtf(wave_sum(s2) * (1.0f / D) + LN_EPS);
#pragma unroll
            for (int j = 0; j < 4; ++j) { const int idx = 8 * (ln_ + 64 * j);
                const f32x4 u0 = lv[((3 * 4 + j) * 2 + 0) * 64 + ln_], u1 = lv[((3 * 4 + j) * 2 + 1) * 64 + ln_], w0 = lv[((4 * 4 + j) * 2 + 0) * 64 + ln_], w1 = lv[((4 * 4 + j) * 2 + 1) * 64 + ln_];
                float o[8];
#pragma unroll
                for (int e = 0; e < 8; ++e) o[e] = v[8 * j + e] * rstd * (e < 4 ? u0[e] : u1[e - 4]) + (e < 4 ? w0[e] : w1[e - 4]);
                if (OUT32) { *(f32x4*)(OUT32 + (size_t)row * D + idx) = (f32x4){o[0], o[1], o[2], o[3]}; *(f32x4*)(OUT32 + (size_t)row * D + idx + 4) = (f32x4){o[4], o[5], o[6], o[7]}; }
                else { v4u hw; v2u lw = {0u, 0u};
#pragma unroll
                    for (int e = 0; e < 4; ++e) { hw[e] = pk2(o[2 * e], o[2 * e + 1]);
                        lw[e >> 1] |= (hl_enc(o[2 * e], hw[e] << 16) | (hl_enc(o[2 * e + 1], hw[e] & 0xffff0000u) << 8)) << (16 * (e & 1)); }
                    *(v4u*)(HO + (size_t)row * D + idx) = hw; *(v2u*)(LO + (size_t)row * D + idx) = lw; } } }
#undef LN_LOAD
    }
    __syncthreads();
}
__device__ __forceinline__ void onorm_phase(const Frame& F, const bf16* O, bf16* ON) {
    const int gw = F.vcu * NWAVES + F.wave, NGW = F.G * NWAVES;
    for (int row = gw; row < M; row += NGW) {
#pragma unroll
        for (int g = 0; g < 2; ++g) { const bf16* p = O + (size_t)row * D + g * 1024 + 16 * F.lane; bf16* po = ON + (size_t)row * D + g * 1024 + 16 * F.lane;
            const v4u w0 = *(const v4u*)p, w1 = *(const v4u*)(p + 8);
            float x[16];
#pragma unroll
            for (int i = 0; i < 4; ++i) { x[2 * i] = bf_lo(w0[i]); x[2 * i + 1] = bf_hi(w0[i]); x[8 + 2 * i] = bf_lo(w1[i]); x[8 + 2 * i + 1] = bf_hi(w1[i]); }
            float s = 0.f;
#pragma unroll
            for (int i = 0; i < 16; ++i) s += x[i] * x[i];
            const float rs = 1.0f / sqrtf(wave_sum(s) * (1.0f / 1024.0f) + RMS_EPS);
            v4u o0, o1;
#pragma unroll
            for (int i = 0; i < 4; ++i) { o0[i] = pk2(x[2 * i] * rs, x[2 * i + 1] * rs); o1[i] = pk2(x[8 + 2 * i] * rs, x[8 + 2 * i + 1] * rs); }
            *(v4u*)po = o0; *(v4u*)(po + 8) = o1; } }
}
__device__ __forceinline__ void attn_phase(const Frame& F, const CArgs& a, int which) {
    unsigned char* ws = a.ws;
    const bf16* QM = (const bf16*)(ws + WS_QM); const bf16* KV = (const bf16*)(ws + WS_KV); const bf16* KPE = (const bf16*)(ws + WS_KPE);
    const bf16* SBQ = (const bf16*)(ws + WS_SBQ); const bf16* SBK = (const bf16*)(ws + WS_SBK); const bf16* SBV = (const bf16*)(ws + WS_SBV);
    bf16* O = (bf16*)(ws + WS_O);
    constexpr int NQB = SEQ / 256, NPAIR = NQB / 2, NITEM = BATCH * NH * NPAIR;
    for (int it = F.vcu; it < NITEM; it += F.G) {
        const int bh = it / NPAIR, x = it - bh * NPAIR, b = bh / NH, h = bh - b * NH;
        const size_t r0 = (size_t)b * SEQ;
#if SITE_ATT & 1
#pragma unroll 1
        for (int pass = 0; pass < ((which & 1) ? 2 : 0); ++pass) { const int qb = pass ? NQB - 1 - x : x; const size_t rq = r0 + (size_t)qb * 256;
            att::attn_block<false>(F.lds, QM + rq * (NH * QKD) + h * QKD, NH * QKD, KV + r0 * D + h * 256, D, KV + r0 * D + h * 256 + 128, D, KPE + r0 * 64, O + rq * D + h * HD, D, qb * 256); }
#endif
#if SITE_ATT & 2
#pragma unroll 1
        for (int pass = 0; pass < ((which & 2) ? 2 : 0); ++pass) { const int qb = pass ? NQB - 1 - x : x; const size_t rq = r0 + (size_t)qb * 256;
            att::attn_block<true>(F.lds, SBQ + rq * 1024 + h * HD, 1024, SBK + r0 * 1024 + h * HD, 1024, SBV + r0 * 1024 + h * HD, 1024, nullptr, O + rq * D + 1024 + h * HD, D, qb * 256); }
#endif
    }
}

__global__ void __launch_bounds__(NWAVES * 64, 2) mk_fwd(Args args_unused) {
    extern __shared__ __attribute__((aligned(16))) unsigned char lds[];
    (void)args_unused;
    CArgs* ap = (CArgs*)__builtin_amdgcn_kernarg_segment_ptr();
    Frame F;
    F.lds = (LAS unsigned char*)lds;
    F.tid = threadIdx.x; F.lane = F.tid & 63; F.wave = __builtin_amdgcn_readfirstlane(F.tid >> 6);
    F.G = gridDim.x; { const int bx = blockIdx.x; F.vcu = (F.G % 8 == 0) ? (bx % 8) * (F.G / 8) + bx / 8 : bx; }
    volatile LAS unsigned* MISC = (volatile LAS unsigned*)(F.lds + MISC_OFF);
    for (int u = F.tid; u < (LDS_BYTES - MISC_OFF) / 4; u += NWAVES * 64) ((LAS unsigned*)(F.lds + MISC_OFF))[u] = 0u;
    __syncthreads();
    XcdBarrier bar; bar.bar = (unsigned*)(ap->ws + WS_CTL) + CW_BAR; bar.x = 0; bar.st = nullptr;
    if (MK_ONE_LAUNCH) bar = xcd_barrier_post((unsigned*)(ap->ws + WS_CTL) + CW_BAR, MISC + 8);
    const int lo = ap->ph_lo, hi = ap->ph_hi; int ph = 0; bool fin_ = false;
#define RUN_PH (ph >= lo && ph < hi)
#define END_PH do { if (MK_ONE_LAUNCH && RUN_PH && ph + 1 < hi && !fin_) { xcd_barrier(bar); for (int xb_ = 0; xb_ < DUP_BAR; ++xb_) xcd_barrier(bar); } ++ph; } while (0)
#define WSP(T, off) ((T*)(A->ws + (off)))

REP(DUP_P0) {
#if SITE_P0
    if (RUN_PH) p0_prologue(fresh_frame(F), *fresh_args(ap));
#endif
    END_PH; }
REP(DUP_P1) {
#if SITE_P1
    if (RUN_PH) p1_ada_reduce(fresh_frame(F), *fresh_args(ap));
#endif
    END_PH; }
REP(DUP_P2) {
#if SITE_P2
    if (RUN_PH) { p2_modulate0(fresh_frame(F), *fresh_args(ap)); vec_prep(fresh_frame(F), *fresh_args(ap)); }
#endif
    END_PH; }

#pragma unroll 1
    for (int s = 0; s <= DBG_LAST_S; ++s) {
        const int l = s / 3, j = s - 3 * l;
        if (j != 1) {
REP(DUP_G1) {
#if SITE_G1
            if (RUN_PH) { CArgs* A = fresh_args(ap); const unsigned char* wl = A->ws + WS_W + (size_t)l * W_LAYER;
                pg8::Gemm g{WSP(const bf16, WS_H), (const bf16*)(wl + (j == 0 ? WO_WI1 : WO_WI2)), M, 2 * FF, D}; pg8::StaticOrder S; S.init(M, 2 * FF, F.G, (int)blockIdx.x);
                pg8::EpiSwiGLU E{WSP(bf16, WS_ACT), FF};
                pg8::gemm_phase<pg8::EpiSwiGLU, pg8::StaticOrder, G1_ALIGN, G1_SP2>(F.lds + RING_OFF, g, S, E);
            }
#endif
            END_PH; }
        } else {
REP(DUP_WIN) {
#if SITE_WIN
            if (RUN_PH) { CArgs* A = fresh_args(ap); const unsigned char* wl = A->ws + WS_W + (size_t)l * W_LAYER;
                pg8::Gemm g{WSP(const bf16, WS_H), (const bf16*)(wl + WO_WIN), M, WIN_ROWS, D}; pg8::WinOrder S; S.init(M, 16 * 256, F.G, (int)blockIdx.x);
                pg8::EpiWin E{WSP(bf16, WS_CQ), WSP(bf16, WS_CKV), WSP(bf16, WS_SBQ), WSP(bf16, WS_SBK), WSP(bf16, WS_SBV), WSP(bf16, WS_KPE), WSP(float, WS_SSQ), WSP(const float, WS_ROPE), SB_QSCALE};
                pg8::gemm_phase<pg8::EpiWin, pg8::WinOrder, true, true>(F.lds + RING_OFF, g, S, E);
            }
#endif
            END_PH; }
REP(DUP_UQKV) {
#if SITE_UQKV
            if (RUN_PH) {
                const int c = (int)blockIdx.x, G = F.G; const bool bal = G == 256; const bool grpA = ((c >> 3) & 1) == 0; const int gi = ((c >> 4) << 3) | (c & 7);
                pg8::ListOrder Swt, Suq, Sukv;
                if (bal) { Swt = pg8::ListOrder{gi, grpA ? 1 : 0, 1, 15}; Suq = grpA ? pg8::ListOrder{gi, 1, 1, 0} : pg8::ListOrder{128 + 2 * gi, 2, 1, 0}; Sukv = grpA ? pg8::ListOrder{gi, 1, 1, 0} : pg8::ListOrder{128 + 3 * gi, 3, 1, 0}; }
                else { Swt = pg8::ListOrder{c, c < 128 ? (128 - c + G - 1) / G : 0, G, 15}; Suq = pg8::ListOrder{c, c < 384 ? (384 - c + G - 1) / G : 0, G, 0}; Sukv = pg8::ListOrder{c, c < 512 ? (512 - c + G - 1) / G : 0, G, 0}; }
                { CArgs* A = fresh_args(ap); const unsigned char* wl = A->ws + WS_W + (size_t)l * W_LAYER;
                  pg8::Gemm g{WSP(const bf16, WS_H), (const bf16*)(wl + WO_WIN), M, WIN_ROWS, D};
                  pg8::EpiWin E{WSP(bf16, WS_CQ), WSP(bf16, WS_CKV), WSP(bf16, WS_SBQ), WSP(bf16, WS_SBK), WSP(bf16, WS_SBV), WSP(bf16, WS_KPE), WSP(float, WS_SSQ), WSP(const float, WS_ROPE), SB_QSCALE};
                  pg8::gemm_phase<pg8::EpiWin, pg8::ListOrder, true, true>(F.lds + RING_OFF, g, Swt, E); }
                { CArgs* A = fresh_args(ap); const unsigned char* wl = A->ws + WS_W + (size_t)l * W_LAYER;
                  pg8::Gemm g{WSP(const bf16, WS_CQ), (const bf16*)(wl + WO_WUQ), M, NH * QKD, QLR};
                  pg8::EpiRS<true> E{WSP(bf16, WS_QM), NH * QKD, WSP(const float, WS_SSQ), 0, 3, 1.0f / QLR, RMS_EPS, MLA_QSCALE, WSP(const float, WS_ROPE)};
                  pg8::gemm_phase<pg8::EpiRS<true>, pg8::ListOrder, true, true>(F.lds + RING_OFF, g, Suq, E); }
                { CArgs* A = fresh_args(ap); const unsigned char* wl = A->ws + WS_W + (size_t)l * W_LAYER;
                  pg8::Gemm g{WSP(const bf16, WS_CKV), (const bf16*)(wl + WO_WUKV), M, NH * 256, KVLR};
                  pg8::EpiRS<false> E{WSP(bf16, WS_KV), NH * 256, WSP(const float, WS_SSQ), 3, 2, 1.0f / KVLR, RMS_EPS, 1.0f, nullptr};
                  pg8::gemm_phase<pg8::EpiRS<false>, pg8::ListOrder, true, true>(F.lds + RING_OFF, g, Sukv, E); }
            }
#endif
            END_PH; }
REP(DUP_ATT) {
#if SITE_ATT
            if (RUN_PH) attn_phase(fresh_frame(F), *fresh_args(ap), rep_ == 0 ? 3 : DUP_ATT_WHICH);
#endif
            END_PH; }
REP(DUP_ONORM) {
#if SITE_ONORM
            if (RUN_PH) { CArgs* A = fresh_args(ap); onorm_phase(fresh_frame(F), WSP(const bf16, WS_O), WSP(bf16, WS_ACT)); }
#endif
            END_PH; }
        }
REP(DUP_GF) {
#if SITE_GF
        if (RUN_PH) { CArgs* A = fresh_args(ap); const unsigned char* wl = A->ws + WS_W + (size_t)l * W_LAYER;
            pg8::Gemm g{WSP(const bf16, WS_ACT), (const bf16*)(wl + (j == 0 ? WO_WO1 : j == 2 ? WO_WO2 : WO_WOUT)), M, D, j != 1 ? FF : D}; pg8::StaticOrder S; S.init(M, D, F.G, (int)blockIdx.x);
            pg8::EpiPlain E{WSP(bf16, WS_F), D};
            pg8::gemm_phase<pg8::EpiPlain, pg8::StaticOrder, GF_ALIGN, G1_SP2>(F.lds + RING_OFF, g, S, E);
        }
#endif
        END_PH; }
REP(DUP_LN) {
#if SITE_LN
        fin_ = (s == DBG_LAST_S) && (rep_ == DUP_LN);
        if (RUN_PH) { CArgs* A = fresh_args(ap); const bool last = s == DBG_LAST_S; const bool dummy = DUP_LN && rep_ == 0;
            bf16* HO = dummy ? WSP(bf16, WS_DUMMY) : WSP(bf16, WS_H); unsigned char* LO = dummy ? WSP(unsigned char, WS_DUMMY + 64 * MiB) : WSP(unsigned char, WS_HL);
            if (s == 0) ln_phase<true>(fresh_frame(F), WSP(const bf16, WS_H), WSP(const unsigned char, WS_HL), HO, LO, WSP(const bf16, WS_F), WSP(const float, WS_VEC), A->in[0], last ? A->out : nullptr);
            else ln_phase<false>(fresh_frame(F), WSP(const bf16, WS_H), WSP(const unsigned char, WS_HL), HO, LO, WSP(const bf16, WS_F), WSP(const float, WS_VEC) + (size_t)s * BATCH * 5 * D, nullptr, last ? A->out : nullptr);
        }
#endif
        END_PH; }
    }
#undef RUN_PH
#undef END_PH
#undef WSP
}

extern "C" void kernel_launch(void* const* d_in, const int* in_sizes, int n_in, void* d_out, int out_size, void* d_ws, size_t ws_size, hipStream_t stream) {
    static int grid = 0;
    if (grid == 0) {
        if (n_in != 19 || in_sizes[0] != M * D || out_size != M * D || ws_size < WS_END) { fprintf(stderr, "kernel_launch: unexpected shapes (n_in %d, in0 %d, out %d, ws %zu < %zu); nothing launched\n", n_in, n_in > 0 ? in_sizes[0] : -1, out_size, ws_size, (size_t)WS_END); grid = -1; return; }
        int dev = 0, cus = 0, per_cu = 0;
        if (hipGetDevice(&dev) != hipSuccess || hipDeviceGetAttribute(&cus, hipDeviceAttributeMultiprocessorCount, dev) != hipSuccess) { grid = -1; return; }
        if (hipFuncSetAttribute((const void*)mk_fwd, hipFuncAttributeMaxDynamicSharedMemorySize, LDS_BYTES) != hipSuccess) { fprintf(stderr, "kernel_launch: hipFuncSetAttribute failed\n"); grid = -1; return; }
        if (hipOccupancyMaxActiveBlocksPerMultiprocessor(&per_cu, (const void*)mk_fwd, NWAVES * 64, LDS_BYTES) != hipSuccess || per_cu < 1)
            fprintf(stderr, "kernel_launch: note: occupancy query reports %d workgroups per CU\n", per_cu);
        (void)hipGetLastError();
        grid = cus;
    }
    if (grid < 0) return;
    if (hipMemsetAsync((char*)d_ws + WS_CTL, 0, CTL_ZERO_BYTES, stream) != hipSuccess) { fprintf(stderr, "kernel_launch: hipMemsetAsync failed\n"); return; }
    Args a{};
    for (int i = 0; i < 19; ++i) a.in[i] = (const float*)d_in[i];
    a.out = (float*)d_out; a.ws = (unsigned char*)d_ws;
#if MK_ONE_LAUNCH
    a.ph_lo = 0; a.ph_hi = 1 << 20;
    hipLaunchKernelGGL(mk_fwd, dim3(grid), dim3(NWAVES * 64), LDS_BYTES, stream, a);
#else
    for (int p = 0; p < N_PHASES; ++p) { a.ph_lo = p; a.ph_hi = p + 1; hipLaunchKernelGGL(mk_fwd, dim3(grid), dim3(NWAVES * 64), LDS_BYTES, stream, a); }
#endif
}
```

```cpp
#include <hip/hip_runtime.h>
#include <cstdio>
#include <cstdint>
#include <cmath>
#define PG8_PRIO 3
namespace pg8 {
#define PG8_LAS __attribute__((address_space(3)))
typedef unsigned short bf16_t;
typedef short bf16x8 __attribute__((ext_vector_type(8)));
typedef float f32x4 __attribute__((ext_vector_type(4)));
typedef unsigned u32x4 __attribute__((ext_vector_type(4)));
constexpr int BM = 256, BK = 64, HALF = 128, HTB = HALF * BK * 2  , STAGE_BYTES = 8 * HTB, NXCD = 8, WGM = 8;

__host__ __device__ __forceinline__ int lds_byte(int r, int c) { const int st = (r >> 4) * 2 + (c >> 5), rr = r & 15, cc = c & 31, ob = rr * 64 + cc * 2; return st * 1024 + (ob ^ (((ob >> 9) & 1) << 5)); }
__host__ __device__ __forceinline__ void stage_rc(int b, int& R, int& C) { const int st = b / 1024, sb = b % 1024, swz = sb ^ (((sb >> 9) & 1) << 5); R = (st >> 1) * 16 + swz / 64; C = (st & 1) * 32 + (swz % 64) / 2; }
__host__ __device__ __forceinline__ int perm32(int rho) { const int n = rho >> 4, i = rho & 15; return 8 * (i >> 2) + 4 * n + (i & 3); }

struct Unit { int pm, pn; };
struct Gemm { const bf16_t* A; const bf16_t* Bt; int M, N, K; };

struct StaticOrder {
    int nM, nN, nwg, G, c;
    __host__ __device__ void init(int M, int N, int G_, int c_) { nM = M / BM; nN = N / BM; nwg = nM * nN; G = G_; c = c_; }
    __host__ __device__ bool next(int i, Unit& u) const {
        const long L = (long)i * G + c; if (L >= nwg) return false;
        int wgid = (int)L; { const int q = nwg / NXCD, r = nwg % NXCD, xcd = wgid % NXCD, off = wgid / NXCD; wgid = (xcd < r ? xcd * (q + 1) : r * (q + 1) + (xcd - r) * q) + off; }
        const int nig = WGM * nN, gid = wgid / nig, fm = gid * WGM, gsz = (nM - fm) < WGM ? (nM - fm) : WGM;
        u.pm = fm + ((wgid % nig) % gsz); u.pn = (wgid % nig) / gsz; return true;
    }
    __device__ __forceinline__ void a_ready(const Unit&) const {}
    __device__ __forceinline__ void done(const Unit&) const {}
};


#ifndef EPIRS_SKIP
#define EPIRS_SKIP 0
#endif
#ifndef EPI_NT
#define EPI_NT 0
#endif

__device__ __forceinline__ unsigned cvt_pk_bf16(float lo, float hi) { unsigned r; asm volatile("v_cvt_pk_bf16_f32 %0, %1, %2" : "=v"(r) : "v"(lo), "v"(hi)); return r; }
typedef float f32x2 __attribute__((ext_vector_type(2)));
__device__ __forceinline__ u32x4 pack8bf(const f32x4 v0, const f32x4 v1) { u32x4 w; w.x = cvt_pk_bf16(v0[0], v0[1]); w.y = cvt_pk_bf16(v0[2], v0[3]); w.z = cvt_pk_bf16(v1[0], v1[1]); w.w = cvt_pk_bf16(v1[2], v1[3]); return w; }

__device__ __forceinline__ float add_xor16(float x) { auto a = __builtin_amdgcn_permlane16_swap(__float_as_uint(x), __float_as_uint(x), false, false); return __uint_as_float(a[0]) + __uint_as_float(a[1]); }
__device__ __forceinline__ float add_xor32(float x) { auto a = __builtin_amdgcn_permlane32_swap(__float_as_uint(x), __float_as_uint(x), false, false); return __uint_as_float(a[0]) + __uint_as_float(a[1]); }
struct EpiPlain {
    static constexpr bool PERM = true, AFTER_DRAIN = false, MID = false;
    bf16_t* O; int ldc;
    __device__ __forceinline__ void operator()(const f32x4 (&acc)[2][2][4][2], const Unit& u, int wr, int wc, int fr, int fq) const {
        const int row0 = u.pm * BM + wr * 64 + fr; const int col0 = u.pn * BM + wc * 32 + 8 * fq;
#pragma unroll
        for (int ai = 0; ai < 2; ++ai)
#pragma unroll
            for (int m = 0; m < 4; ++m) { bf16_t* rowp = O + (size_t)(row0 + ai * HALF + m * 16) * ldc + col0;
#pragma unroll
                for (int bj = 0; bj < 2; ++bj) { const u32x4 w = pack8bf(acc[ai][bj][m][0], acc[ai][bj][m][1]); if (EPI_NT) __builtin_nontemporal_store(w, (u32x4*)(rowp + bj * HALF)); else *(u32x4*)(rowp + bj * HALF) = w; } }
    }
};

struct EpiMixOut {
    static constexpr bool PERM = true, AFTER_DRAIN = false, MID = true;
    bf16_t* O; int ldc; const float* OSSQ; int mid_t; float invn, eps;
    __device__ __forceinline__ void group_ssq(const Unit& u, int wr, int fr, int fq, float (&sm)[2][4], float (&ss)[2][4]) const {
        int fr_ = fr; asm volatile("" : "+v"(fr_));
        const int row0 = u.pm * BM + wr * 64 + fr_;
#pragma unroll
        for (int ai = 0; ai < 2; ++ai)
#pragma unroll
            for (int m = 0; m < 4; ++m) { const f32x4 q = *(const f32x4*)(OSSQ + (size_t)(row0 + ai * HALF + m * 16) * 16 + 4 * fq); sm[ai][m] = (q[0] + q[1]) + (q[2] + q[3]); }
#pragma unroll
        for (int ai = 0; ai < 2; ++ai)
#pragma unroll
            for (int m = 0; m < 4; ++m) { const float s = add_xor16(sm[ai][m]); auto b = __builtin_amdgcn_permlane32_swap(__float_as_uint(s), __float_as_uint(s), false, false); const float o = __uint_as_float(fq < 2 ? b[1] : b[0]); sm[ai][m] = fq < 2 ? s : o; ss[ai][m] = fq < 2 ? o : s; }
    }
    __device__ __forceinline__ void mid(f32x4 (&acc)[2][2][4][2], const Unit& u, int wr, int wc, int fr, int fq) const {
        float sm[2][4], ss[2][4]; group_ssq(u, wr, fr, fq, sm, ss);
#pragma unroll
        for (int ai = 0; ai < 2; ++ai)
#pragma unroll
            for (int m = 0; m < 4; ++m) { const float ratio = sqrtf((ss[ai][m] * invn + eps) / (sm[ai][m] * invn + eps));
#pragma unroll
                for (int bj = 0; bj < 2; ++bj) { acc[ai][bj][m][0] = acc[ai][bj][m][0] * ratio; acc[ai][bj][m][1] = acc[ai][bj][m][1] * ratio; } }
    }
    __device__ __forceinline__ void operator()(const f32x4 (&acc)[2][2][4][2], const Unit& u, int wr, int wc, int fr, int fq) const {
        float sm[2][4], ss[2][4]; group_ssq(u, wr, fr, fq, sm, ss);
        const int row0 = u.pm * BM + wr * 64 + fr; const int col0 = u.pn * BM + wc * 32 + 8 * fq;
#pragma unroll
        for (int ai = 0; ai < 2; ++ai)
#pragma unroll
            for (int m = 0; m < 4; ++m) { bf16_t* rowp = O + (size_t)(row0 + ai * HALF + m * 16) * ldc + col0; const float rs = 1.0f / sqrtf(ss[ai][m] * invn + eps);
#pragma unroll
                for (int bj = 0; bj < 2; ++bj) *(u32x4*)(rowp + bj * HALF) = pack8bf(acc[ai][bj][m][0] * rs, acc[ai][bj][m][1] * rs); }
    }
};

struct EpiSwiGLU {
    static constexpr bool PERM = true, AFTER_DRAIN = false, MID = false;
    bf16_t* O; int ldc;
    __device__ __forceinline__ static f32x4 sg(const f32x4 g, const f32x4 up) {
        f32x4 r;
#pragma unroll
        for (int i = 0; i < 4; ++i) { const float e = __builtin_amdgcn_exp2f(g[i] * -1.4426950408889634f); r[i] = g[i] * __builtin_amdgcn_rcpf(1.0f + e) * up[i]; }
        return r;
    }
    __device__ __forceinline__ void operator()(const f32x4 (&acc)[2][2][4][2], const Unit& u, int wr, int wc, int fr, int fq) const {
        const int row0 = u.pm * BM + wr * 64 + fr; const int col0 = u.pn * HALF + wc * 32 + 8 * fq;
#pragma unroll
        for (int ai = 0; ai < 2; ++ai) { f32x4 t[4][2];
#pragma unroll
            for (int m = 0; m < 4; ++m)
#pragma unroll
                for (int n = 0; n < 2; ++n) t[m][n] = acc[ai][0][m][n] * -1.4426950408889634f;
#pragma unroll
            for (int m = 0; m < 4; ++m)
#pragma unroll
                for (int n = 0; n < 2; ++n)
#pragma unroll
                    for (int i = 0; i < 4; ++i) t[m][n][i] = __builtin_amdgcn_exp2f(t[m][n][i]);
#pragma unroll
            for (int m = 0; m < 4; ++m)
#pragma unroll
                for (int n = 0; n < 2; ++n) t[m][n] = t[m][n] + 1.0f;
#pragma unroll
            for (int m = 0; m < 4; ++m)
#pragma unroll
                for (int n = 0; n < 2; ++n)
#pragma unroll
                    for (int i = 0; i < 4; ++i) t[m][n][i] = __builtin_amdgcn_rcpf(t[m][n][i]);
#pragma unroll
            for (int m = 0; m < 4; ++m)
#pragma unroll
                for (int n = 0; n < 2; ++n) t[m][n] = acc[ai][0][m][n] * t[m][n] * acc[ai][1][m][n];
#pragma unroll
            for (int m = 0; m < 4; ++m) { bf16_t* rowp = O + (size_t)(row0 + ai * HALF + m * 16) * ldc + col0; *(u32x4*)rowp = pack8bf(t[m][0], t[m][1]); } }
    }
};

__device__ __forceinline__ void rope8(f32x4& v0, f32x4& v1, const f32x4 cs0, const f32x4 cs1) {
    const float a0 = v0[0], b0 = v0[1], a1 = v0[2], b1 = v0[3], a2 = v1[0], b2 = v1[1], a3 = v1[2], b3 = v1[3];
    v0[0] = a0 * cs0[0] - b0 * cs0[1]; v0[1] = a0 * cs0[1] + b0 * cs0[0];
    v0[2] = a1 * cs0[2] - b1 * cs0[3]; v0[3] = a1 * cs0[3] + b1 * cs0[2];
    v1[0] = a2 * cs1[0] - b2 * cs1[1]; v1[1] = a2 * cs1[1] + b2 * cs1[0];
    v1[2] = a3 * cs1[2] - b3 * cs1[3]; v1[3] = a3 * cs1[3] + b3 * cs1[2];
}

struct EpiWin {
    static constexpr bool PERM = true, AFTER_DRAIN = false, MID = false;
    bf16_t *CQ, *CKV, *SBQ, *SBK, *SBV, *KPE; float* SSQ; const float* ROPE; float sbq_scale;
    __device__ __forceinline__ void operator()(const f32x4 (&acc)[2][2][4][2], const Unit& u, int wr, int wc, int fr, int fq) const {
        const int pn = u.pn; const int row0 = u.pm * BM + wr * 64 + fr;
        if (pn < 17) {
            bf16_t* base; int ldc, colt; float sc = 1.0f; const bool ssq = pn < 5;
            if (pn < 3) { base = CQ; ldc = 768; colt = pn * BM; }
            else if (pn < 5) { base = CKV; ldc = 512; colt = (pn - 3) * BM; }
            else if (pn < 9) { base = SBQ; ldc = 1024; colt = (pn - 5) * BM; sc = sbq_scale; }
            else if (pn < 13) { base = SBK; ldc = 1024; colt = (pn - 9) * BM; }
            else { base = SBV; ldc = 1024; colt = (pn - 13) * BM; }
            const int col0 = colt + wc * 32 + 8 * fq;
#pragma unroll
            for (int ai = 0; ai < 2; ++ai)
#pragma unroll
                for (int m = 0; m < 4; ++m) { const int row = row0 + ai * HALF + m * 16; bf16_t* rowp = base + (size_t)row * ldc + col0; float s = 0.f;
#pragma unroll
                    for (int bj = 0; bj < 2; ++bj) { const f32x4 v0 = acc[ai][bj][m][0] * sc, v1 = acc[ai][bj][m][1] * sc;
                        s += (v0[0] * v0[0] + v0[1] * v0[1]) + (v0[2] * v0[2] + v0[3] * v0[3]) + (v1[0] * v1[0] + v1[1] * v1[1]) + (v1[2] * v1[2] + v1[3] * v1[3]);
                        *(u32x4*)(rowp + bj * HALF) = pack8bf(v0, v1); }
                    if (ssq) { s = add_xor32(add_xor16(s)); if (fq == 0) SSQ[((size_t)row * 5 + pn) * 4 + wc] = s; } }
        } else if (wc < 2) {
            const int c0 = wc * 32 + 8 * fq;
#pragma unroll
            for (int ai = 0; ai < 2; ++ai)
#pragma unroll
                for (int m = 0; m < 4; ++m) { const int row = row0 + ai * HALF + m * 16;
                    const f32x4 cs0 = *(const f32x4*)(ROPE + (size_t)row * 64 + c0), cs1 = *(const f32x4*)(ROPE + (size_t)row * 64 + c0 + 4);
                    f32x4 v0 = acc[ai][0][m][0], v1 = acc[ai][0][m][1]; rope8(v0, v1, cs0, cs1);
                    *(u32x4*)(KPE + (size_t)row * 64 + c0) = pack8bf(v0, v1); }
        }
    }
};

template <bool ROPE_Q> struct EpiRS {
    static constexpr bool PERM = true, AFTER_DRAIN = false, MID = false;
    bf16_t* O; int ldc; const float* SSQ; int t0, nt; float invn, eps, oscale; const float* ROPE;
    __device__ __forceinline__ void operator()(const f32x4 (&acc)[2][2][4][2], const Unit& u, int wr, int wc, int fr, int fq) const {
        const int row0 = u.pm * BM + wr * 64 + fr; const int col0 = u.pn * BM + wc * 32 + 8 * fq;
        float rsv[2][4];
#pragma unroll
        for (int ai = 0; ai < 2; ++ai)
#pragma unroll
            for (int m = 0; m < 4; ++m) { const int row = row0 + ai * HALF + m * 16; f32x4 q = {0.f, 0.f, 0.f, 0.f};
                if (fq < nt && !(EPIRS_SKIP & 2)) q = *(const f32x4*)(SSQ + ((size_t)row * 5 + t0 + fq) * 4);
                rsv[ai][m] = (q[0] + q[1]) + (q[2] + q[3]); }
#pragma unroll
        for (int ai = 0; ai < 2; ++ai)
#pragma unroll
            for (int m = 0; m < 4; ++m) { const float ss = add_xor32(add_xor16(rsv[ai][m])); rsv[ai][m] = oscale / sqrtf(ss * invn + eps); }
#pragma unroll
        for (int ai = 0; ai < 2; ++ai)
#pragma unroll
            for (int m = 0; m < 4; ++m) { const int row = row0 + ai * HALF + m * 16;
                const float rs = rsv[ai][m];
#pragma unroll
                for (int bj = 0; bj < 2; ++bj) { const int c = col0 + bj * HALF; f32x4 v0 = acc[ai][bj][m][0] * rs, v1 = acc[ai][bj][m][1] * rs;
                    if (ROPE_Q && !(EPIRS_SKIP & 1)) { const int w = c % 192; if (w >= 128) { const float* cs = ROPE + (size_t)row * 64 + (w - 128); rope8(v0, v1, *(const f32x4*)cs, *(const f32x4*)(cs + 4)); } }
                    *(u32x4*)(O + (size_t)row * ldc + c) = pack8bf(v0, v1); } }
    }
};

struct WinOrder : StaticOrder {
    __device__ __forceinline__ bool next(int i, Unit& u) const { if (!StaticOrder::next(i, u)) return false; u.pn = u.pn < 5 ? u.pn : (u.pn == 5 ? 17 : u.pn - 1); return true; }
};
struct ListOrder {
    int first, count, stride, pn0;
    __device__ __forceinline__ bool next(int i, Unit& u) const { if (i >= count) return false; const int L = first + i * stride; u.pm = L & 63; u.pn = pn0 + (L >> 6); return true; }
    __device__ __forceinline__ void a_ready(const Unit&) const {}
    __device__ __forceinline__ void done(const Unit&) const {}
};

#ifndef PG8_PRIO
#define PG8_PRIO 1
#endif
#ifndef PG8_EPI_DUP
#define PG8_EPI_DUP 0
#endif
template <class Epi, class Sched, bool ALIGN_EPI = false, bool SP2 = false>
__device__ __forceinline__ void gemm_phase(PG8_LAS unsigned char* lds, const Gemm g, const Sched& S, const Epi& E) {
    int tid_ = threadIdx.x; asm volatile("" : "+v"(tid_));
    const int tid = tid_, wid = __builtin_amdgcn_readfirstlane(tid >> 6), lane = tid & 63, wr = wid >> 2, wc = wid & 3, fr = lane & 15, fq = lane >> 4;
    const int K = g.K, nt = K / BK;
    unsigned voffA[2], voffB[2];
#pragma unroll
    for (int i = 0; i < 2; ++i) { int R, C; stage_rc(tid * 16 + i * 8192, R, C); const int Rb = Epi::PERM ? ((R & ~31) + perm32(R & 31)) : R;
        voffA[i] = (unsigned)(R * K + C) * 2u; voffB[i] = (unsigned)(Rb * K + C) * 2u; }
    const size_t kstep = (size_t)(BK * 2);
    const size_t hstep = (size_t)HALF * K * 2;
    const size_t tstep = 2 * hstep;
    const unsigned ldsw = (unsigned)wid * 1024u;
    const int aoff = lds_byte(wr * 64 + fr, fq * 8), boff = lds_byte(wc * 32 + fr, fq * 8);
#define PG8_SA(b, h) (((b) * 2 + (h)) * HTB)
#define PG8_SB(b, h) ((4 + (b) * 2 + (h)) * HTB)
#define PG8_STAGE(bufoff, gbase, voff) do { _Pragma("unroll") for (int _i = 0; _i < 2; ++_i) \
        __builtin_amdgcn_global_load_lds((const unsigned*)((const char*)(gbase) + (voff)[_i]), (PG8_LAS unsigned*)(lds + (bufoff) + ldsw + _i * 8192), 16, 0, 0); } while (0)
#define PG8_LDA(dst, b, h) do { _Pragma("unroll") for (int m = 0; m < 4; ++m) _Pragma("unroll") for (int k = 0; k < 2; ++k) dst[m][k] = *(const PG8_LAS bf16x8*)(lds + PG8_SA(b, h) + aoff + m * 2048 + k * 1024); } while (0)
#define PG8_LDB(dst, b, h) do { _Pragma("unroll") for (int n = 0; n < 2; ++n) _Pragma("unroll") for (int k = 0; k < 2; ++k) dst[n][k] = *(const PG8_LAS bf16x8*)(lds + PG8_SB(b, h) + boff + n * 2048 + k * 1024); } while (0)
#define PG8_MMA(ai, bj, At, Bt) do { if (PG8_PRIO) __builtin_amdgcn_s_setprio(PG8_PRIO); _Pragma("unroll") for (int m = 0; m < 4; ++m) _Pragma("unroll") for (int n = 0; n < 2; ++n) _Pragma("unroll") for (int k = 0; k < 2; ++k) \
        acc[ai][bj][m][n] = __builtin_amdgcn_mfma_f32_16x16x32_bf16(Bt[n][k], At[m][k], acc[ai][bj][m][n], 0, 0, 0); if (PG8_PRIO) __builtin_amdgcn_s_setprio(0); } while (0)
#define PG8_WAIT_V(n) asm volatile("s_waitcnt vmcnt(" #n ")" ::: "memory")
#define PG8_WAIT_L(n) asm volatile("s_waitcnt lgkmcnt(" #n ")" ::: "memory")
#define PG8_BAR __builtin_amdgcn_s_barrier()
#define PG8_SCHED __builtin_amdgcn_sched_barrier(0)
    Unit cur, nxt; int ui = 0;
    if (!S.next(0, cur)) return;
    f32x4 acc[2][2][4][2];
#pragma unroll
    for (int a = 0; a < 2; ++a)
#pragma unroll
        for (int b = 0; b < 2; ++b)
#pragma unroll
            for (int m = 0; m < 4; ++m)
#pragma unroll
                for (int n = 0; n < 2; ++n) acc[a][b][m][n] = (f32x4){0.f, 0.f, 0.f, 0.f};
    bf16x8 At[4][2], B0[2][2], B1[2][2];
    const char* cA = (const char*)g.A + (size_t)cur.pm * tstep; const char* cB = (const char*)g.Bt + (size_t)cur.pn * tstep;
    S.a_ready(cur);
    if constexpr (SP2) {
        PG8_STAGE(PG8_SB(0, 0), cB, voffB); PG8_STAGE(PG8_SB(0, 1), cB + hstep, voffB); PG8_STAGE(PG8_SA(0, 0), cA, voffA); PG8_STAGE(PG8_SA(0, 1), cA + hstep, voffA);
        if (wr == 1) PG8_BAR;
        PG8_WAIT_V(2); PG8_BAR;
        PG8_STAGE(PG8_SB(1, 0), cB + kstep, voffB); PG8_STAGE(PG8_SA(1, 0), cA + kstep, voffA); PG8_STAGE(PG8_SB(1, 1), cB + hstep + kstep, voffB);
        PG8_WAIT_V(6); PG8_BAR;
    } else {
        PG8_STAGE(PG8_SB(0, 0), cB, voffB); PG8_STAGE(PG8_SA(0, 0), cA, voffA); PG8_STAGE(PG8_SB(0, 1), cB + hstep, voffB); PG8_STAGE(PG8_SA(0, 1), cA + hstep, voffA);
        if (wr == 1) PG8_BAR;
        PG8_WAIT_V(4); PG8_BAR;
        PG8_STAGE(PG8_SB(1, 0), cB + kstep, voffB); PG8_STAGE(PG8_SA(1, 0), cA + kstep, voffA); PG8_STAGE(PG8_SB(1, 1), cB + hstep + kstep, voffB);
        PG8_WAIT_V(6); PG8_BAR;
    }
    for (;;) {
        const bool has_next = S.next(ui + 1, nxt);
        const char* nA = has_next ? (const char*)g.A + (size_t)nxt.pm * tstep : cA; const char* nB = has_next ? (const char*)g.Bt + (size_t)nxt.pn * tstep : cB;
        for (int t = 0; t < nt; t += 2) {
            if constexpr (Epi::MID) { if (t == E.mid_t) E.mid(acc, cur, wr, wc, fr, fq); }
            const bool last = (t == nt - 2);
            const char* a1 = cA + (size_t)(t + 1) * kstep;
            const char* a2 = last ? nA : cA + (size_t)(t + 2) * kstep; const char* b2 = last ? nB : cB + (size_t)(t + 2) * kstep;
            const char* a3 = a2 + kstep; const char* b3 = b2 + kstep;
            if (last && has_next) S.a_ready(nxt);
            if constexpr (SP2) {
            PG8_LDB(B0, 0, 0); PG8_LDB(B1, 0, 1); PG8_SCHED; PG8_LDA(At, 0, 0); PG8_STAGE(PG8_SA(1, 1), a1 + hstep, voffA);
            PG8_WAIT_V(8); PG8_WAIT_L(0); PG8_BAR; PG8_MMA(0, 0, At, B0); PG8_MMA(0, 1, At, B1); PG8_BAR; PG8_SCHED;
            PG8_LDA(At, 0, 1); PG8_STAGE(PG8_SB(0, 0), b2, voffB); PG8_STAGE(PG8_SB(0, 1), b2 + hstep, voffB); PG8_STAGE(PG8_SA(0, 0), a2, voffA);
            PG8_WAIT_V(8); PG8_WAIT_L(0); PG8_BAR; PG8_MMA(1, 0, At, B0); PG8_MMA(1, 1, At, B1); PG8_BAR; PG8_SCHED;
            PG8_LDB(B0, 1, 0); PG8_LDB(B1, 1, 1); PG8_SCHED; PG8_LDA(At, 1, 0); PG8_STAGE(PG8_SA(0, 1), a2 + hstep, voffA);
            PG8_WAIT_V(8); PG8_WAIT_L(0); PG8_BAR; PG8_MMA(0, 0, At, B0); PG8_MMA(0, 1, At, B1); PG8_BAR; PG8_SCHED;
            PG8_LDA(At, 1, 1); PG8_STAGE(PG8_SB(1, 0), b3, voffB); PG8_STAGE(PG8_SB(1, 1), b3 + hstep, voffB); PG8_STAGE(PG8_SA(1, 0), a3, voffA);
            PG8_WAIT_V(8); PG8_WAIT_L(0); PG8_BAR; PG8_MMA(1, 0, At, B0); PG8_MMA(1, 1, At, B1); PG8_BAR; PG8_SCHED;
            } else {
            PG8_LDB(B0, 0, 0); PG8_SCHED; PG8_LDA(At, 0, 0); PG8_STAGE(PG8_SA(1, 1), a1 + hstep, voffA);
            PG8_WAIT_L(8); PG8_BAR; PG8_WAIT_L(0); PG8_MMA(0, 0, At, B0); PG8_BAR; PG8_SCHED;
            PG8_LDB(B1, 0, 1); PG8_STAGE(PG8_SB(0, 0), b2, voffB);
            PG8_BAR; PG8_WAIT_L(0); PG8_MMA(0, 1, At, B1); PG8_BAR;
            PG8_LDA(At, 0, 1); PG8_STAGE(PG8_SA(0, 0), a2, voffA);
            PG8_BAR; PG8_WAIT_L(0); PG8_MMA(1, 0, At, B0); PG8_BAR; PG8_SCHED;
            PG8_STAGE(PG8_SB(0, 1), b2 + hstep, voffB);
            PG8_WAIT_V(6); PG8_BAR; PG8_MMA(1, 1, At, B1); PG8_BAR;
            PG8_LDB(B0, 1, 0); PG8_SCHED; PG8_LDA(At, 1, 0); PG8_STAGE(PG8_SA(0, 1), a2 + hstep, voffA);
            PG8_WAIT_L(8); PG8_BAR; PG8_WAIT_L(0); PG8_MMA(0, 0, At, B0); PG8_BAR; PG8_SCHED;
            PG8_LDB(B1, 1, 1); PG8_STAGE(PG8_SB(1, 0), b3, voffB);
            PG8_BAR; PG8_WAIT_L(0); PG8_MMA(0, 1, At, B1); PG8_BAR;
            PG8_LDA(At, 1, 1); PG8_STAGE(PG8_SA(1, 0), a3, voffA);
            PG8_BAR; PG8_WAIT_L(0); PG8_MMA(1, 0, At, B0); PG8_BAR; PG8_SCHED;
            PG8_STAGE(PG8_SB(1, 1), b3 + hstep, voffB);
            PG8_WAIT_V(6); PG8_BAR; PG8_MMA(1, 1, At, B1); PG8_BAR;
            }
        }
        if constexpr (ALIGN_EPI) { if (wr == 0) PG8_BAR; }
        if constexpr (!Epi::AFTER_DRAIN) { E(acc, cur, wr, wc, fr, fq); if (PG8_EPI_DUP) { asm volatile("" ::: "memory"); E(acc, cur, wr, wc, fr, fq); } S.done(cur); }
        if (!has_next) break;
#pragma unroll
        for (int a = 0; a < 2; ++a)
#pragma unroll
            for (int b = 0; b < 2; ++b)
#pragma unroll
                for (int m = 0; m < 4; ++m)
#pragma unroll
                    for (int n = 0; n < 2; ++n) acc[a][b][m][n] = (f32x4){0.f, 0.f, 0.f, 0.f};
        cur = nxt; cA = nA; cB = nB; ++ui;
        if constexpr (ALIGN_EPI) { if (wr == 1) PG8_BAR; }
    }
    PG8_WAIT_V(0);
    if constexpr (!ALIGN_EPI) { if (wr == 0) PG8_BAR; }
    PG8_BAR;
    if constexpr (Epi::AFTER_DRAIN) { E.fused(acc, cur, wr, wc, fr, fq, lds, wid, lane); S.done(cur); }
#undef PG8_SA
#undef PG8_SB
#undef PG8_STAGE
#undef PG8_LDA
#undef PG8_LDB
#undef PG8_MMA
#undef PG8_WAIT_V
#undef PG8_WAIT_L
#undef PG8_BAR
#undef PG8_SCHED
}
}


namespace att {
typedef unsigned short bf16_t;
typedef short bf16x8 __attribute__((ext_vector_type(8)));
typedef short s16x4 __attribute__((ext_vector_type(4)));
typedef float f32x16 __attribute__((ext_vector_type(16)));
typedef float f32x4 __attribute__((ext_vector_type(4)));
typedef unsigned u32x4 __attribute__((ext_vector_type(4)));
#define ATT_LAS __attribute__((address_space(3)))
#ifndef ATT_THR
#define ATT_THR 8.0f
#endif
#ifndef ATT_SKIP
#define ATT_SKIP 0
#endif
#ifndef ATT_NOCOMPUTE
#define ATT_NOCOMPUTE 0
#endif
#ifndef ATT_PRIO
#define ATT_PRIO 1
#endif
#ifndef SB_EARLY_EXIT
#define SB_EARLY_EXIT 1
#endif
constexpr int KVBLK = 64, QB = 256;
constexpr int SHM_V = 16384, SHM_K = 16384, SHM_R = 8192;
#ifndef ATT_SKEW
#define ATT_SKEW 0
#endif
constexpr int NVS = (ATT_SKEW != 0) ? 4 : 3, NKS = 3;
constexpr int OFF_V = 0, OFF_K = NVS * SHM_V, OFF_R = OFF_K + NKS * SHM_K, OFF_WS = OFF_R + NKS * SHM_R, OFF_FLAG = OFF_WS + 8 * 256, ATT_LDS_BYTES = OFF_FLAG + 64;
#define KSWZ(row, colB) ((row) * 256 + ((colB) ^ (((row) & 7) << 4)))
#define RSWZ(row, colB) ((row) * 128 + ((colB) ^ (((row) & 7) << 4)))
#define SBAR() __builtin_amdgcn_sched_barrier(0)
__device__ __forceinline__ int v_st(int k, int c) { const int kk = (k & ~0xC) | ((k & 4) << 1) | ((k & 8) >> 1); return ((kk >> 3) * 4 + (c >> 5)) * 512 + ((kk & 7) * 32 + (c & 31)) * 2; }
__device__ __forceinline__ int v_rd_base(int lane) { return ((lane & 3) << 3) | (((lane >> 2) & 3) << 6) | (((lane >> 4) & 1) << 5) | (((lane >> 5) & 1) << 8); }
__device__ __forceinline__ int crow(int r, int hi) { return (r & 3) + 8 * (r >> 2) + 4 * hi; }
__device__ __forceinline__ unsigned cvtpk(float lo, float hi) { unsigned r; asm volatile("v_cvt_pk_bf16_f32 %0, %1, %2" : "=v"(r) : "v"(lo), "v"(hi)); return r; }
__device__ __forceinline__ float other_half(float x, int hi) { auto rr = __builtin_amdgcn_permlane32_swap(__float_as_uint(x), __float_as_uint(x), false, false); return __uint_as_float(hi ? rr[0] : rr[1]); }

__device__ __forceinline__ void pack_p(const f32x16& p0, const f32x16& p1, bf16x8& pa0, bf16x8& pa1, bf16x8& pa2, bf16x8& pa3) {
#define PK4(P, B_, OUT) do { unsigned a0 = cvtpk(P[B_+0], P[B_+1]), a1 = cvtpk(P[B_+2], P[B_+3]);                          \
        unsigned b0 = cvtpk(P[B_+4], P[B_+5]), b1 = cvtpk(P[B_+6], P[B_+7]);                                             \
        auto r0 = __builtin_amdgcn_permlane32_swap(a0, b0, false, false); auto r1 = __builtin_amdgcn_permlane32_swap(a1, b1, false, false); \
        u32x4 w = {r0[0], r1[0], r0[1], r1[1]}; OUT = __builtin_bit_cast(bf16x8, w); } while (0)
    PK4(p0, 0, pa0); PK4(p0, 8, pa1); PK4(p1, 0, pa2); PK4(p1, 8, pa3);
#undef PK4
}
__device__ __forceinline__ void pv_tile(f32x16* o, int vb, bf16x8 pa0, bf16x8 pa1, bf16x8 pa2, bf16x8 pa3) {
#define TRRD(dst, off) asm volatile("ds_read_b64_tr_b16 %0, %1 offset:%2" : "=&v"(dst) : "v"(vb), "i"(off) : "memory")
#define PV_D0(d0) do { s16x4 l0, l1, l2, l3, h0, h1, h2, h3; constexpr int b_ = (d0) * 512;   \
        TRRD(l0, b_); TRRD(h0, b_ + 2048); TRRD(l1, b_ + 4096); TRRD(h1, b_ + 6144); TRRD(l2, b_ + 8192); TRRD(h2, b_ + 10240); TRRD(l3, b_ + 12288); TRRD(h3, b_ + 14336); \
        asm volatile("s_waitcnt lgkmcnt(0)" ::: "memory"); SBAR();   \
        o[d0] = __builtin_amdgcn_mfma_f32_32x32x16_bf16((bf16x8){l0[0], l0[1], l0[2], l0[3], h0[0], h0[1], h0[2], h0[3]}, pa0, o[d0], 0, 0, 0);   \
        o[d0] = __builtin_amdgcn_mfma_f32_32x32x16_bf16((bf16x8){l1[0], l1[1], l1[2], l1[3], h1[0], h1[1], h1[2], h1[3]}, pa1, o[d0], 0, 0, 0);   \
        o[d0] = __builtin_amdgcn_mfma_f32_32x32x16_bf16((bf16x8){l2[0], l2[1], l2[2], l2[3], h2[0], h2[1], h2[2], h2[3]}, pa2, o[d0], 0, 0, 0);   \
        o[d0] = __builtin_amdgcn_mfma_f32_32x32x16_bf16((bf16x8){l3[0], l3[1], l3[2], l3[3], h3[0], h3[1], h3[2], h3[3]}, pa3, o[d0], 0, 0, 0); } while (0)
    PV_D0(0); PV_D0(1); PV_D0(2); PV_D0(3);
#undef PV_D0
#undef TRRD
}

template <bool SB>
__device__ __forceinline__ void attn_block(ATT_LAS unsigned char* lds, const bf16_t* Qg, int ldq, const bf16_t* Kg, int ldk, const bf16_t* Vg, int ldv, const bf16_t* Rg, bf16_t* Og, int ldo, float* Sq  , int P0) {
    constexpr int NQ = SB ? 8 : 12;
    constexpr int NDMA = SB ? 4 : 5;
    int tid_ = threadIdx.x; asm volatile("" : "+v"(tid_));
    const int tid = tid_, wid = __builtin_amdgcn_readfirstlane(tid >> 6), lane = tid & 63, r32 = lane & 31, hi = lane >> 5;
    const int qlo = P0 + wid * 32;
    const int NT = (P0 + QB) / KVBLK;
    ATT_LAS unsigned char* V_lds = lds + OFF_V; ATT_LAS unsigned char* K_lds = lds + OFF_K; ATT_LAS unsigned char* R_lds = lds + OFF_R;
    ATT_LAS float* ws = (ATT_LAS float*)(lds + OFF_WS) + wid * 64;
    ATT_LAS unsigned* flags = (ATT_LAS unsigned*)(lds + OFF_FLAG);
    const int vb0 = (int)(unsigned)(uintptr_t)V_lds + v_rd_base(lane);
    int kofs, vofs, rofs;
    { const int row = 4 * wid + (lane >> 4); kofs = row * ldk + ((((lane & 15) * 16) ^ ((row & 7) << 4)) >> 1); }
    { const int sub = 2 * wid + (lane >> 5), kk = (sub >> 2) * 8 + ((lane & 31) >> 2), k = (kk & ~0xC) | ((kk & 4) << 1) | ((kk & 8) >> 1); vofs = k * ldv + (sub & 3) * 32 + (lane & 3) * 8; }
    { const int row = 8 * wid + (lane >> 3); rofs = row * 64 + ((((lane & 7) ^ (row & 7)) * 16) >> 1); }
#define STAGE_DMA(t_, ks_, vs_) do { const size_t k0_ = (size_t)(t_) * KVBLK;                                                                                   \
        __builtin_amdgcn_global_load_lds((const unsigned*)(Kg + k0_ * ldk + kofs), (ATT_LAS unsigned*)(K_lds + (ks_) * SHM_K + wid * 1024), 16, 0, 0);                 \
        __builtin_amdgcn_global_load_lds((const unsigned*)(Kg + (k0_ + 32) * ldk + kofs), (ATT_LAS unsigned*)(K_lds + (ks_) * SHM_K + 8192 + wid * 1024), 16, 0, 0);   \
        __builtin_amdgcn_global_load_lds((const unsigned*)(Vg + k0_ * ldv + vofs), (ATT_LAS unsigned*)(V_lds + (vs_) * SHM_V + wid * 1024), 16, 0, 0);                 \
        __builtin_amdgcn_global_load_lds((const unsigned*)(Vg + (k0_ + 32) * ldv + vofs), (ATT_LAS unsigned*)(V_lds + (vs_) * SHM_V + 8192 + wid * 1024), 16, 0, 0);   \
        if (!SB) __builtin_amdgcn_global_load_lds((const unsigned*)(Rg + k0_ * 64 + rofs), (ATT_LAS unsigned*)(R_lds + (ks_) * SHM_R + wid * 1024), 16, 0, 0); } while (0)
#define TILE_OF(it_) (SB ? NT - 1 - (it_) : (it_))
#define WAIT_BAR(n_) do { if ((n_) == 0) asm volatile("s_waitcnt vmcnt(0) lgkmcnt(0)\n\ts_barrier" ::: "memory"); else if (SB) asm volatile("s_waitcnt vmcnt(4) lgkmcnt(0)\n\ts_barrier" ::: "memory"); else asm volatile("s_waitcnt vmcnt(5) lgkmcnt(0)\n\ts_barrier" ::: "memory"); } while (0)
    bf16x8 qr[NQ];
#pragma unroll
    for (int d0 = 0; d0 < NQ; ++d0) qr[d0] = *(const bf16x8*)(Qg + (size_t)(wid * 32 + r32) * ldq + d0 * 16 + hi * 8);
    f32x16 o[4];
#pragma unroll
    for (int d = 0; d < 4; ++d)
#pragma unroll
        for (int r = 0; r < 16; ++r) o[d][r] = 0.f;
    float m_reg = 0.f, l_reg = 0.f, R = 1.f; bool first_tile = true;
    int kro[4];
#pragma unroll
    for (int dd = 0; dd < 4; ++dd) kro[dd] = KSWZ(r32, (dd * 16 + hi * 8) * 2);
    STAGE_DMA(TILE_OF(0), 0, 0);
    if (NT > 1) { STAGE_DMA(TILE_OF(1), 1, 1); WAIT_BAR(NDMA); } else WAIT_BAR(0);
    const bool skew = ATT_SKEW && (ATT_SKEW == 1 ? wid >= 4 : (ATT_SKEW == 2 ? (wid & 1) : ((wid >> 1) & 1)));
    f32x16 p0, p1;
    bool pend = false; int pend_kb = 0, pend_vs = 0;
    int vs = 0, ks = 0, nt_eff = NT;
    for (int it = 0; it < nt_eff + ((ATT_SKEW != 0) ? 1 : 0); ++it) {
        const bool tile = it < nt_eff;
        const int t = TILE_OF(it); const int buf = it & 1; const bool more2 = tile && it + 2 < NT;
        { const int ks2 = ks == 0 ? 2 : ks - 1, vs2 = vs + 2 >= NVS ? vs + 2 - NVS : vs + 2;
          if (more2) STAGE_DMA(TILE_OF(it + 2), ks2, vs2); }
        const int kb = t * KVBLK;
        const bool act = tile && kb <= qlo + 31 && !ATT_NOCOMPUTE;
        bool do_sm; int sm_kb, sm_vs;
        if (!skew) { do_sm = act; sm_kb = kb; sm_vs = vs;
            if (act) {
#pragma unroll
            for (int r = 0; r < 16; ++r) { p0[r] = SB ? 0.f : -m_reg; p1[r] = SB ? 0.f : -m_reg; }
            ATT_LAS const unsigned char* kt = K_lds + ks * SHM_K;
            __builtin_amdgcn_s_setprio(ATT_PRIO);
            if (ATT_SKIP & 1) { p0[0] = (float)r32; p1[3] = (float)hi; } else {
#pragma unroll
            for (int d0 = 0; d0 < 8; ++d0) { ATT_LAS const unsigned char* a = kt + kro[d0 & 3] + (d0 >> 2) * 128;
                const bf16x8 b0 = *(ATT_LAS const bf16x8*)a; const bf16x8 b1 = *(ATT_LAS const bf16x8*)(a + 32 * 256);
                p0 = __builtin_amdgcn_mfma_f32_32x32x16_bf16(b0, qr[d0], p0, 0, 0, 0);
                p1 = __builtin_amdgcn_mfma_f32_32x32x16_bf16(b1, qr[d0], p1, 0, 0, 0); }
            if (!SB) { ATT_LAS const unsigned char* rt = R_lds + ks * SHM_R;
#pragma unroll
                for (int d0 = 0; d0 < 4; ++d0) { ATT_LAS const unsigned char* a = rt + (kro[d0] - 128 * r32);
                    const bf16x8 b0 = *(ATT_LAS const bf16x8*)a; const bf16x8 b1 = *(ATT_LAS const bf16x8*)(a + 32 * 128);
                    const bf16x8 qf = qr[SB ? 0 : 8 + d0];
                    p0 = __builtin_amdgcn_mfma_f32_32x32x16_bf16(b0, qf, p0, 0, 0, 0);
                    p1 = __builtin_amdgcn_mfma_f32_32x32x16_bf16(b1, qf, p1, 0, 0, 0); } }
            }
            __builtin_amdgcn_s_setprio(0);
            }
        } else { do_sm = pend; sm_kb = pend_kb; sm_vs = pend_vs; }
        if (do_sm) {
            const int dql = qlo + r32 - sm_kb - 4 * hi - (SB ? 1 : 0);
            const bool need_mask = SB ? (sm_kb + KVBLK - 1 >= qlo) : (sm_kb + KVBLK - 1 > qlo);
            bf16x8 pa0, pa1, pa2, pa3;
            if (ATT_SKIP & 2) { pa0 = __builtin_bit_cast(bf16x8, (f32x4){p0[0], p0[5], p0[10], p0[15]}); pa1 = __builtin_bit_cast(bf16x8, (f32x4){p1[0], p1[5], p1[10], p1[15]}); pa2 = pa0; pa3 = pa1; }
            else if (!SB) {
                if (need_mask) { const float NEG = -__builtin_inff();
#pragma unroll
                    for (int r = 0; r < 16; ++r) { const int c = (r & 3) + 8 * (r >> 2); if (c > dql) p0[r] = NEG; if (c + 32 > dql) p1[r] = NEG; } }
                float pmax = p0[0];
#pragma unroll
                for (int r = 1; r < 16; ++r) pmax = fmaxf(pmax, p0[r]);
#pragma unroll
                for (int r = 0; r < 16; ++r) pmax = fmaxf(pmax, p1[r]);
                pmax = fmaxf(pmax, other_half(pmax, hi));
                if (first_tile || __any(pmax > ATT_THR)) { const float dl = first_tile ? pmax : fmaxf(pmax, 0.f);
                    m_reg += dl;
#pragma unroll
                    for (int r = 0; r < 16; ++r) { p0[r] -= dl; p1[r] -= dl; }
                    if (!first_tile) { const float alpha = __builtin_amdgcn_exp2f(-dl); l_reg *= alpha;
#pragma unroll
                        for (int d = 0; d < 4; ++d)
#pragma unroll
                            for (int r = 0; r < 16; ++r) o[d][r] *= alpha; }
                    first_tile = false; }
                float ps = 0.f;
#pragma unroll
                for (int r = 0; r < 16; ++r) { p0[r] = __builtin_amdgcn_exp2f(p0[r]); ps += p0[r]; }
#pragma unroll
                for (int r = 0; r < 16; ++r) { p1[r] = __builtin_amdgcn_exp2f(p1[r]); ps += p1[r]; }
                ps += other_half(ps, hi);
                l_reg += ps;
                pack_p(p0, p1, pa0, pa1, pa2, pa3);
            } else {
                f32x16 l0, l1;
#pragma unroll
                for (int r = 0; r < 16; ++r) { const float e = __builtin_amdgcn_exp2f(fminf(-p0[r], 126.f)); const float be = __builtin_amdgcn_rcpf(1.0f + e); p0[r] = be; l0[r] = e * be; }
#pragma unroll
                for (int r = 0; r < 16; ++r) { const float e = __builtin_amdgcn_exp2f(fminf(-p1[r], 126.f)); const float be = __builtin_amdgcn_rcpf(1.0f + e); p1[r] = be; l1[r] = e * be; }
                if (need_mask) {
#pragma unroll
                    for (int r = 0; r < 16; ++r) { const int c = (r & 3) + 8 * (r >> 2); if (c > dql) { p0[r] = 0.f; l0[r] = 1.f; } if (c + 32 > dql) { p1[r] = 0.f; l1[r] = 1.f; } } }
                float T[8];
#pragma unroll
                for (int g = 0; g < 4; ++g) {
                    { const float a0 = l0[4 * g], a1 = l0[4 * g + 1], a2 = l0[4 * g + 2], a3 = l0[4 * g + 3]; const float x2 = a3, x1 = a3 * a2, x0 = x1 * a1; T[g] = x0 * a0;
                      l0[4 * g] = x0; l0[4 * g + 1] = x1; l0[4 * g + 2] = x2; l0[4 * g + 3] = 1.f; }
                    { const float a0 = l1[4 * g], a1 = l1[4 * g + 1], a2 = l1[4 * g + 2], a3 = l1[4 * g + 3]; const float x2 = a3, x1 = a3 * a2, x0 = x1 * a1; T[4 + g] = x0 * a0;
                      l1[4 * g] = x0; l1[4 * g + 1] = x1; l1[4 * g + 2] = x2; l1[4 * g + 3] = 1.f; }
                }
                float gs[8]; float run = R;
#pragma unroll
                for (int g = 7; g >= 0; --g) { const float To = other_half(T[g], hi); gs[g] = hi == 0 ? run * To : run; run *= T[g] * To; }
                R = run;
#pragma unroll
                for (int g = 0; g < 4; ++g)
#pragma unroll
                    for (int i = 0; i < 4; ++i) { p0[4 * g + i] = p0[4 * g + i] * (l0[4 * g + i] * gs[g]); p1[4 * g + i] = p1[4 * g + i] * (l1[4 * g + i] * gs[4 + g]); }
                pack_p(p0, p1, pa0, pa1, pa2, pa3);
            }
            if (!(ATT_SKIP & 4)) { __builtin_amdgcn_s_setprio(ATT_PRIO); pv_tile(o, vb0 + sm_vs * SHM_V, pa0, pa1, pa2, pa3); __builtin_amdgcn_s_setprio(0); } else { o[0][0] += __builtin_bit_cast(f32x4, pa0)[0] + __builtin_bit_cast(f32x4, pa1)[0] + __builtin_bit_cast(f32x4, pa2)[0] + __builtin_bit_cast(f32x4, pa3)[0]; }
        }
        if (skew) { pend = act; pend_kb = kb; pend_vs = vs;
            if (act) {
#pragma unroll
            for (int r = 0; r < 16; ++r) { p0[r] = SB ? 0.f : -m_reg; p1[r] = SB ? 0.f : -m_reg; }
            ATT_LAS const unsigned char* kt = K_lds + ks * SHM_K;
            __builtin_amdgcn_s_setprio(ATT_PRIO);
            if (ATT_SKIP & 1) { p0[0] = (float)r32; p1[3] = (float)hi; } else {
#pragma unroll
            for (int d0 = 0; d0 < 8; ++d0) { ATT_LAS const unsigned char* a = kt + kro[d0 & 3] + (d0 >> 2) * 128;
                const bf16x8 b0 = *(ATT_LAS const bf16x8*)a; const bf16x8 b1 = *(ATT_LAS const bf16x8*)(a + 32 * 256);
                p0 = __builtin_amdgcn_mfma_f32_32x32x16_bf16(b0, qr[d0], p0, 0, 0, 0);
                p1 = __builtin_amdgcn_mfma_f32_32x32x16_bf16(b1, qr[d0], p1, 0, 0, 0); }
            if (!SB) { ATT_LAS const unsigned char* rt = R_lds + ks * SHM_R;
#pragma unroll
                for (int d0 = 0; d0 < 4; ++d0) { ATT_LAS const unsigned char* a = rt + (kro[d0] - 128 * r32);
                    const bf16x8 b0 = *(ATT_LAS const bf16x8*)a; const bf16x8 b1 = *(ATT_LAS const bf16x8*)(a + 32 * 128);
                    const bf16x8 qf = qr[SB ? 0 : 8 + d0];
                    p0 = __builtin_amdgcn_mfma_f32_32x32x16_bf16(b0, qf, p0, 0, 0, 0);
                    p1 = __builtin_amdgcn_mfma_f32_32x32x16_bf16(b1, qf, p1, 0, 0, 0); } }
            }
            __builtin_amdgcn_s_setprio(0);
            }
        }
        if (SB && SB_EARLY_EXIT && tile) { const bool dead = __all(R == 0.f); if (lane == 0) flags[buf * 8 + wid] = dead ? 1u : 0u; }
        asm volatile("" ::: "memory");
        if (more2) WAIT_BAR(NDMA); else WAIT_BAR(0);
        asm volatile("" ::: "memory");
        if (SB && SB_EARLY_EXIT && tile) { const u32x4 f0 = *(ATT_LAS const u32x4*)(flags + buf * 8), f1 = *(ATT_LAS const u32x4*)(flags + buf * 8 + 4);
            if ((f0[0] & f0[1] & f0[2] & f0[3] & f1[0] & f1[1] & f1[2] & f1[3]) != 0u) nt_eff = it + 1; }
        vs = vs + 1 == NVS ? 0 : vs + 1; ks = ks == 2 ? 0 : ks + 1;
    }
    { const float rl = SB ? 1.0f : ((ATT_NOCOMPUTE && !(l_reg > 0.f)) ? 0.f : 1.0f / l_reg);
      unsigned char* rowb = (unsigned char*)(Og + (size_t)(wid * 32 + r32) * ldo) + (hi ? 16 : 0);
      { float sq = 0.f;
#pragma unroll
        for (int d = 0; d < 4; ++d)
#pragma unroll
            for (int r = 0; r < 16; ++r) { const float v = o[d][r] * rl; sq += v * v; }
        sq += other_half(sq, hi);
        if (hi == 0) Sq[(size_t)(wid * 32 + r32) * 16] = sq; }
#pragma unroll
      for (int k = 0; k < 16; k += 2) { const int d0 = k >> 2, ra = (k & 3) * 4, rb = ra + 4;
          unsigned ax = cvtpk(o[d0][ra] * rl, o[d0][ra + 1] * rl), ay = cvtpk(o[d0][ra + 2] * rl, o[d0][ra + 3] * rl);
          unsigned bx = cvtpk(o[d0][rb] * rl, o[d0][rb + 1] * rl), by = cvtpk(o[d0][rb + 2] * rl, o[d0][rb + 3] * rl);
          auto sx = __builtin_amdgcn_permlane32_swap(ax, bx, false, false); auto sy = __builtin_amdgcn_permlane32_swap(ay, by, false, false);
          *(u32x4*)(rowb + 16 * k) = (u32x4){sx[0], sy[0], sx[1], sy[1]}; } }
    asm volatile("" ::: "memory");
    asm volatile("s_waitcnt vmcnt(0) lgkmcnt(0)\n\ts_barrier" ::: "memory");
    asm volatile("" ::: "memory");
#undef STAGE_DMA
#undef TILE_OF
#undef WAIT_BAR
}
#undef KSWZ
#undef RSWZ
}

#ifdef DUP_LN
#define DUP_LN_ANY DUP_LN
#else
#define DUP_LN_ANY 0
#endif

constexpr int NWAVES = 8;
constexpr int D = 2048, BATCH = 4, SEQ = 4096, DEPTH = 4, M = BATCH * SEQ, FF = 5632, NADA = 9;
constexpr int QLR = 768, KVLR = 512, ROPE_D = 64, NH = 8, HD = 128, QKD = 192;
constexpr int IN_COLS = QLR + KVLR + ROPE_D + 3 * NH * HD;
constexpr int WIN_ROWS = 4608;
constexpr float LN_EPS = 1e-5f, RMS_EPS = 1e-6f;
constexpr float DN_ALPHA = 1.6817928305074290f;
constexpr float LOG2E = 1.4426950408889634f;
constexpr float MLA_QSCALE = 0.07216878364870322f * LOG2E;
constexpr float SB_QSCALE = 0.08838834764831845f * LOG2E;
#ifndef MK_ONE_LAUNCH
#define MK_ONE_LAUNCH 1
#endif
constexpr int N_PHASES = 3 + 8 * 3 + 4 * 5;

constexpr size_t MiB = 1u << 20;
#ifndef TPROBE
#define TPROBE 0
#endif
constexpr size_t WS_CTL = 0, CTL_ZERO_BYTES = TPROBE ? 1 * MiB : 64 * 1024;
constexpr size_t WS_ADA = 1 * MiB;
constexpr size_t WS_ADAP = 3 * MiB;
constexpr size_t WS_VEC = 22 * MiB;
constexpr size_t WS_ROPE = 24 * MiB;
constexpr size_t WS_SSQ = 28 * MiB;
constexpr size_t WS_KPE = 30 * MiB;
constexpr size_t WS_HL = 32 * MiB;
constexpr size_t WS_OSSQ = 64 * MiB;
constexpr size_t WS_H = 160 * MiB;
constexpr size_t WS_F = 224 * MiB;
constexpr size_t WS_ACT = 288 * MiB;
constexpr size_t WS_CQ = 464 * MiB;
constexpr size_t WS_CKV = 488 * MiB;
constexpr size_t WS_SBQ = 504 * MiB, WS_SBK = 536 * MiB, WS_SBV = 568 * MiB;
constexpr size_t WS_QM = 600 * MiB;
constexpr size_t WS_KV = 648 * MiB;
constexpr size_t WS_O = 712 * MiB;
constexpr size_t WS_W = 776 * MiB;
constexpr size_t W_WI = (size_t)2 * FF * D * 2, W_WO = (size_t)D * FF * 2, W_WIN = (size_t)WIN_ROWS * D * 2, W_WUQ = (size_t)NH * QKD * QLR * 2, W_WUKV = (size_t)NH * 256 * KVLR * 2, W_WOUT = (size_t)D * D * 2;
constexpr size_t WO_WI1 = 0, WO_WO1 = WO_WI1 + W_WI, WO_WI2 = WO_WO1 + W_WO, WO_WO2 = WO_WI2 + W_WI, WO_WIN = WO_WO2 + W_WO, WO_WUQ = WO_WIN + W_WIN, WO_WUKV = WO_WUQ + W_WUQ, WO_WOUT = WO_WUKV + W_WUKV;
constexpr size_t W_LAYER = WO_WOUT + W_WOUT;
constexpr size_t WS_DUMMY = WS_W + DEPTH * W_LAYER;
constexpr size_t WS_END = WS_DUMMY + (size_t)(DUP_LN_ANY ? 128 : 0) * MiB;
static_assert(W_LAYER % 256 == 0 && WS_END < (size_t)1700 * MiB, "ws map");
constexpr int ADA_KS = 16;
constexpr int CW_BAR = 4096;

constexpr int RING_OFF = 0, SCR_BYTES = 147200;
constexpr int MISC_OFF = SCR_BYTES;
constexpr int LDS_BYTES = 147456;

#define GAS __attribute__((address_space(1)))
#define LAS __attribute__((address_space(3)))
typedef unsigned short bf16;
typedef unsigned v4u __attribute__((ext_vector_type(4)));
typedef unsigned v2u __attribute__((ext_vector_type(2)));
typedef float f32x4 __attribute__((ext_vector_type(4)));
#define LDS_WAIT() asm volatile("s_waitcnt lgkmcnt(0)" ::: "memory")
#define VM_WAIT() asm volatile("s_waitcnt vmcnt(0)" ::: "memory")
__device__ __forceinline__ unsigned pk2(float lo, float hi) { unsigned r; asm volatile("v_cvt_pk_bf16_f32 %0, %1, %2" : "=v"(r) : "v"(lo), "v"(hi)); return r; }
__device__ __forceinline__ float bf_lo(unsigned w) { return __uint_as_float(w << 16); }
__device__ __forceinline__ float bf_hi(unsigned w) { return __uint_as_float(w & 0xffff0000u); }
__device__ __forceinline__ float wave_sum(float v) {
    v += __builtin_bit_cast(float, __builtin_amdgcn_update_dpp(0, __builtin_bit_cast(int, v), 0xB1, 0xF, 0xF, false));
    v += __builtin_bit_cast(float, __builtin_amdgcn_update_dpp(0, __builtin_bit_cast(int, v), 0x4E, 0xF, 0xF, false));
    v += __builtin_bit_cast(float, __builtin_amdgcn_update_dpp(0, __builtin_bit_cast(int, v), 0x124, 0xF, 0xF, false));
    v += __builtin_bit_cast(float, __builtin_amdgcn_update_dpp(0, __builtin_bit_cast(int, v), 0x128, 0xF, 0xF, false));
    { auto a = __builtin_amdgcn_permlane16_swap(__float_as_uint(v), __float_as_uint(v), false, false); v = __uint_as_float(a[0]) + __uint_as_float(a[1]); }
    { auto b = __builtin_amdgcn_permlane32_swap(__float_as_uint(v), __float_as_uint(v), false, false); v = __uint_as_float(b[0]) + __uint_as_float(b[1]); }
    return v;
}

#define XB_TMO      128
#define XB_XCNT(j)  (256  + 64 * (j))
#define XB_XSUB(j)  (1280 + 64 * (j))
#define XB_XGEN(j)  (2304 + 64 * (j))
#define XB_TOP      3328
#define XB_TOPGEN   3392
#define XCD_BAR_WORDS 3456
#define XB_SPIN_CAP (1u << 18)

__device__ __forceinline__ unsigned xb_ld(unsigned* p)              { return __hip_atomic_load(p, __ATOMIC_RELAXED, __HIP_MEMORY_SCOPE_AGENT); }
__device__ __forceinline__ unsigned xb_add(unsigned* p, unsigned v) { return __hip_atomic_fetch_add(p, v, __ATOMIC_RELAXED, __HIP_MEMORY_SCOPE_AGENT); }
__device__ __forceinline__ unsigned xb_xcc_id() { return (unsigned)__builtin_amdgcn_s_getreg((3 << 11) | 20) & 0xFu; }
#define XB_SPIN(cond, bar) do { unsigned _sp = 0; while (cond) { __builtin_amdgcn_s_sleep(1); \
    if ((++_sp & 255u) == 0u) { if (xb_ld(&(bar)[XB_TMO])) break; if (_sp > XB_SPIN_CAP) { atomicAdd(&(bar)[XB_TMO], 1u); break; } } } } while (0)

struct XcdBarrier {
    unsigned* bar; unsigned x;
    volatile LAS unsigned* st;
};

__device__ __forceinline__ XcdBarrier xcd_barrier_post(unsigned* bar, volatile LAS unsigned* st) {
    XcdBarrier b; b.bar = bar; b.x = xb_xcc_id(); b.st = st;
    if (threadIdx.x == 0) (void)xb_add(&bar[XB_XCNT(b.x)], 1u);
    return b;
}
__device__ __forceinline__ void xcd_barrier_complete(unsigned* bar, unsigned x, unsigned& nloc, unsigned& nx) {
    const unsigned G = gridDim.x * gridDim.y * gridDim.z;
    unsigned sum, cnt, mine, sp = 0u;
    for (;;) {
        sum = 0u; cnt = 0u; mine = 0u;
#pragma unroll 1
        for (unsigned j = 0; j < 16; ++j) { const unsigned c = xb_ld(&bar[XB_XCNT(j)]); sum += c; cnt += (c > 0u) ? 1u : 0u; mine = (j == x) ? c : mine; }
        if (sum == G) break;
        __builtin_amdgcn_s_sleep(1);
        if ((++sp & 255u) == 0u) { if (xb_ld(&bar[XB_TMO])) break; if (sp > XB_SPIN_CAP) { atomicAdd(&bar[XB_TMO], 1u); break; } }
    }
    nloc = mine > 0u ? mine : 1u; nx = cnt > 0u ? cnt : 1u;
}

__device__ __forceinline__ void xcd_barrier(const XcdBarrier& b) {
    asm volatile("s_waitcnt vmcnt(0)" ::: "memory");
    __syncthreads();
    if (threadIdx.x == 0) {
        unsigned* bar = b.bar;
        __builtin_amdgcn_s_waitcnt(0);
        unsigned nloc = b.st[0], nx = b.st[1];
        if (nloc == 0u) { xcd_barrier_complete(bar, b.x, nloc, nx); b.st[0] = nloc; b.st[1] = nx; }
        const unsigned old = xb_add(&bar[XB_XSUB(b.x)], 1u);
        const unsigned gen = old / nloc;
        if (old + 1u == (gen + 1u) * nloc) {
            __builtin_amdgcn_fence(__ATOMIC_RELEASE, "agent");
            asm volatile("s_waitcnt vmcnt(0)" ::: "memory");
            const unsigned og = xb_add(&bar[XB_TOP], 1u);
            const unsigned tg = og / nx;
            if (og + 1u == (tg + 1u) * nx) xb_add(&bar[XB_TOPGEN], 1u);
            else XB_SPIN(xb_ld(&bar[XB_TOPGEN]) == tg, bar);
            __builtin_amdgcn_fence(__ATOMIC_ACQUIRE, "agent");
            xb_add(&bar[XB_XGEN(b.x)], 1u);
            asm volatile("s_waitcnt vmcnt(0)" ::: "memory");
        } else {
            XB_SPIN(xb_ld(&bar[XB_XGEN(b.x)]) == gen, bar);
            __builtin_amdgcn_fence(__ATOMIC_ACQUIRE, "agent");
            asm volatile("s_waitcnt vmcnt(0)" ::: "memory");
        }
    }
    __syncthreads();
}

#ifndef LN_NS
#define LN_NS 1
#endif
#ifndef W_MANT_DROP
#define W_MANT_DROP 0
#endif
#ifndef TPROBE_SCALE
#define TPROBE_SCALE 1.0f
#endif
#ifndef TPROBE
#define TPROBE 0
#endif
#ifndef TPROBE_WG
#define TPROBE_WG 0
#endif
#ifndef TPROBE_A
#define TPROBE_A 6
#endif
#ifndef TPROBE_B
#define TPROBE_B 7
#endif
#ifndef G1_SP2
#define G1_SP2 true
#endif
#ifndef DUP_BAR
#define DUP_BAR 0
#endif
#ifndef G1_ALIGN
#define G1_ALIGN true
#endif
#ifndef GF_ALIGN
#define GF_ALIGN true
#endif
#ifndef DUP_ATT_WHICH
#define DUP_ATT_WHICH 3
#endif
#ifndef DUP_P0
#define DUP_P0 0
#endif
#ifndef DUP_P1
#define DUP_P1 0
#endif
#ifndef DUP_P2
#define DUP_P2 0
#endif
#ifndef DUP_G1
#define DUP_G1 0
#endif
#ifndef DUP_WIN
#define DUP_WIN 0
#endif
#ifndef DUP_UQKV
#define DUP_UQKV 0
#endif
#ifndef DUP_ATT
#define DUP_ATT 0
#endif
#ifndef DUP_ONORM
#define DUP_ONORM 0
#endif
#ifndef DUP_GF
#define DUP_GF 0
#endif
#ifndef DUP_LN
#define DUP_LN 0
#endif
#define REP(n) for (int rep_ = 0; rep_ < 1 + (n); ++rep_)
#ifndef P0_PARTS
#define P0_PARTS 7
#endif
#ifndef SITE_P0
#define SITE_P0 1
#endif
#ifndef SITE_P1
#define SITE_P1 1
#endif
#ifndef SITE_P2
#define SITE_P2 1
#endif
#ifndef SITE_ATT
#define SITE_ATT 3
#endif
#ifndef SITE_ONORM
#define SITE_ONORM 1
#endif
#ifndef SITE_G1
#define SITE_G1 1
#endif
#ifndef SITE_WIN
#define SITE_WIN 1
#endif
#ifndef SITE_UQKV
#define SITE_UQKV 1
#endif
#ifndef SITE_GF
#define SITE_GF 1
#endif
#ifndef SITE_LN
#define SITE_LN 1
#endif
#ifndef DBG_LAST_S
#define DBG_LAST_S (3 * DEPTH - 1)
#endif
#ifndef P0_PARTS
#define P0_PARTS 7
#endif

struct Frame {
    LAS unsigned char* lds;
    int tid, lane, wave;
    int vcu, G;
};

__device__ __forceinline__ int dst_row(int kind, int n) {
    if (kind == 1) { const int u = n >= FF ? 1 : 0, j = n - u * FF; return (j >> 7) * 256 + u * 128 + (j & 127); }
    if (kind == 2) { if (n < QLR + KVLR) return n; if (n < QLR + KVLR + ROPE_D) { const int j = n - (QLR + KVLR); return 4352 + (j < 32 ? 2 * j : 2 * (j - 32) + 1); } return n - ROPE_D; }
    if (kind == 3) { const int h = n / QKD, w = n - h * QKD; if (w < 128) return n; const int j = w - 128; return h * QKD + 128 + (j < 32 ? 2 * j : 2 * (j - 32) + 1); }
    return n;
}
__device__ __forceinline__ void tr_item(const float* __restrict__ W, int K, int N, bf16* __restrict__ WT, int kind, const float* __restrict__ gk, LAS float* scr, int item, int lane) {
    const int nblk = N >> 6, kb = item / nblk, nb = item - kb * nblk, k0 = kb << 6, n0 = nb << 6;
    const int kk4 = lane >> 4, n4 = (lane & 15) * 4;
    const float* src = W + (size_t)(k0 + kk4) * N + n0 + n4;
    f32x4 wv[16];
#pragma unroll
    for (int i = 0; i < 16; ++i) wv[i] = *(const f32x4*)(src + (size_t)(4 * i) * N);
#pragma unroll
    for (int i = 0; i < 16; ++i) { const int kk = 4 * i + kk4; f32x4 w = wv[i]; if (gk) w = w * gk[k0 + kk];
        LAS float* d = scr + kk * 65 + n4; d[0] = w[0]; d[1] = w[1]; d[2] = w[2]; d[3] = w[3]; }
    LDS_WAIT(); asm volatile("" ::: "memory");
    const int c = lane & 7;
#pragma unroll
    for (int j = 0; j < 8; ++j) { const int n = (lane >> 3) + 8 * j; const LAS float* s = scr + (8 * c) * 65 + n;
        v4u o; o.x = pk2(s[0 * 65], s[1 * 65]); o.y = pk2(s[2 * 65], s[3 * 65]); o.z = pk2(s[4 * 65], s[5 * 65]); o.w = pk2(s[6 * 65], s[7 * 65]);
#if W_MANT_DROP
        { const unsigned hb = (1u << (W_MANT_DROP - 1)) * 0x00010001u, mk = ~(((1u << W_MANT_DROP) - 1u) * 0x00010001u);
#pragma unroll
          for (int e = 0; e < 4; ++e) o[e] = (o[e] + hb) & mk; }
#endif
        *(v4u*)(WT + (size_t)dst_row(kind, n0 + n) * K + k0 + 8 * c) = o; }
    LDS_WAIT(); asm volatile("" ::: "memory");
}

struct Args { const float* in[19]; float* out; unsigned char* ws; int ph_lo, ph_hi; };
typedef const __attribute__((address_space(4))) Args CArgs;
__device__ __forceinline__ CArgs* fresh_args(CArgs* p) { asm volatile("" : "+s"(p)); return p; }
__device__ __forceinline__ Frame fresh_frame(Frame F) { asm volatile("" : "+v"(F.tid)); F.lane = F.tid & 63; return F; }
__constant__ float INVF[32] = {1.000000000e+00f, 7.498942614e-01f, 5.623413324e-01f, 4.216965139e-01f, 3.162277639e-01f, 2.371373773e-01f, 1.778279394e-01f, 1.333521307e-01f, 1.000000015e-01f, 7.498941571e-02f, 5.623413250e-02f, 4.216965288e-02f, 3.162277490e-02f, 2.371373773e-02f, 1.778279431e-02f, 1.333521493e-02f, 9.999999776e-03f, 7.498941850e-03f, 5.623413250e-03f, 4.216964822e-03f, 3.162277630e-03f, 2.371373586e-03f, 1.778279431e-03f, 1.333521446e-03f, 1.000000047e-03f, 7.498942432e-04f, 5.623413017e-04f, 4.216965172e-04f, 3.162277571e-04f, 2.371373703e-04f, 1.778279402e-04f, 1.333521504e-04f};

__device__ __forceinline__ void p0_prologue(const Frame& F, const CArgs& a) {
    unsigned char* ws = a.ws;
    const int gw = F.vcu * NWAVES + F.wave, NGW = F.G * NWAVES;
    const int gt = F.vcu * (NWAVES * 64) + F.tid, NGT = F.G * NWAVES * 64;
#if P0_PARTS & 1
    {
        LAS float* scr = (LAS float*)(F.lds + F.wave * 16640);
        constexpr int I_WI = (D / 64) * (2 * FF / 64), I_WO = (FF / 64) * (D / 64), I_WIN = (D / 64) * (IN_COLS / 64), I_WUQ = (QLR / 64) * (NH * QKD / 64), I_WUKV = (KVLR / 64) * (NH * 256 / 64), I_WOUT = (D / 64) * (D / 64);
        constexpr int I_LAYER = 2 * I_WI + 2 * I_WO + I_WIN + I_WUQ + I_WUKV + I_WOUT;
        for (int it = gw; it < DEPTH * I_LAYER; it += NGW) {
            const int l = it / I_LAYER; int r = it - l * I_LAYER;
            unsigned char* wl = ws + WS_W + (size_t)l * W_LAYER;
            const float* src; const float* gk = nullptr; int K_, N_, kind = 0; size_t dsto;
            if (r < I_WI) { src = a.in[7] + (size_t)l * D * 2 * FF; K_ = D; N_ = 2 * FF; dsto = WO_WI1; kind = 1; }
            else if ((r -= I_WI) < I_WO) { src = a.in[8] + (size_t)l * FF * D; K_ = FF; N_ = D; dsto = WO_WO1; }
            else if ((r -= I_WO) < I_WI) { src = a.in[17] + (size_t)l * D * 2 * FF; K_ = D; N_ = 2 * FF; dsto = WO_WI2; kind = 1; }
            else if ((r -= I_WI) < I_WO) { src = a.in[18] + (size_t)l * FF * D; K_ = FF; N_ = D; dsto = WO_WO2; }
            else if ((r -= I_WO) < I_WIN) { src = a.in[9] + (size_t)l * D * IN_COLS; K_ = D; N_ = IN_COLS; dsto = WO_WIN; kind = 2; }
            else if ((r -= I_WIN) < I_WUQ) { src = a.in[12] + (size_t)l * QLR * NH * QKD; K_ = QLR; N_ = NH * QKD; dsto = WO_WUQ; kind = 3; gk = a.in[10] + l * QLR; }
            else if ((r -= I_WUQ) < I_WUKV) { src = a.in[13] + (size_t)l * KVLR * NH * 256; K_ = KVLR; N_ = NH * 256; dsto = WO_WUKV; gk = a.in[11] + l * KVLR; }
            else { r -= I_WUKV; src = a.in[16] + (size_t)l * D * D; K_ = D; N_ = D; dsto = WO_WOUT;
                   gk = (r / (D / 64)) < 16 ? a.in[14] + l * 1024 : a.in[15] + l * 1024 - 1024; }
            tr_item(src, K_, N_, (bf16*)(wl + dsto), kind, gk, scr, r, F.lane);
        }
        constexpr int PADV = (WIN_ROWS - IN_COLS) * D * 2 / 16;
        for (int i = gt; i < DEPTH * PADV; i += NGT) { const int l = i / PADV, r = i - l * PADV;
            *(v4u*)(ws + WS_W + (size_t)l * W_LAYER + WO_WIN + (size_t)IN_COLS * D * 2 + (size_t)r * 16) = (v4u){0u, 0u, 0u, 0u}; }
    }
#endif
#if P0_PARTS & 2
    {
        const int* pos = (const int*)a.in[2]; float* rope = (float*)(ws + WS_ROPE);
        for (int i = gt; i < M * 32; i += NGT) { const int row = i >> 5, j = i & 31;
            const float ang = (float)pos[row] * INVF[j];
            double rev = (double)ang * 0.15915494309189535; rev -= __builtin_floor(rev);
            const float fr = (float)rev;
            *(float2*)(rope + (size_t)i * 2) = make_float2(__builtin_amdgcn_cosf(fr), __builtin_amdgcn_sinf(fr)); }
    }
#endif
    __syncthreads();
#if P0_PARTS & 4
    {
        LAS f32x4* cact = (LAS f32x4*)F.lds;
        for (int k = F.tid; k < D; k += NWAVES * 64) { f32x4 v;
#pragma unroll
            for (int b = 0; b < 4; ++b) { const float cv = a.in[1][b * D + k]; v[b] = cv / (1.0f + __expf(-cv)); }
            cact[k] = v; }
        __syncthreads();
        constexpr int NCH = NADA * D / 256, KSL = D / ADA_KS;
        float* adap = (float*)(ws + WS_ADAP);
        for (int it = gw; it < DEPTH * NCH * ADA_KS; it += NGW) {
            const int ks = it % ADA_KS, r = it / ADA_KS, ch = r % NCH, l = r / NCH;
            const int n = ch * 256 + 4 * F.lane;
            const float* w = a.in[3] + ((size_t)l * D + (size_t)ks * KSL) * (NADA * D) + n;
            f32x4 acc[4];
#pragma unroll
            for (int b = 0; b < 4; ++b) acc[b] = (f32x4){0.f, 0.f, 0.f, 0.f};
            if (ks == 0) { const f32x4 bv = *(const f32x4*)(a.in[4] + (size_t)l * NADA * D + n);
#pragma unroll
                for (int b = 0; b < 4; ++b) acc[b] = bv; }
#pragma unroll 16
            for (int kk = 0; kk < KSL; ++kk) { const f32x4 wv = *(const f32x4*)(w + (size_t)kk * (NADA * D)); const f32x4 cv = cact[ks * KSL + kk];
#pragma unroll
                for (int b = 0; b < 4; ++b) acc[b] += wv * cv[b]; }
#pragma unroll
            for (int b = 0; b < 4; ++b) *(f32x4*)(adap + (((size_t)ks * DEPTH + l) * BATCH + b) * (NADA * D) + n) = acc[b];
        }
    }
#endif
}
__device__ __forceinline__ void p1_ada_reduce(const Frame& F, const CArgs& a) {
    const int gt = F.vcu * (NWAVES * 64) + F.tid, NGT = F.G * NWAVES * 64;
    const f32x4* adap = (const f32x4*)(a.ws + WS_ADAP); f32x4* ada = (f32x4*)(a.ws + WS_ADA);
    constexpr int NV = DEPTH * BATCH * NADA * D / 4;
    for (int i = gt; i < NV; i += NGT) { f32x4 s = adap[i];
#pragma unroll
        for (int ks = 1; ks < ADA_KS; ++ks) s += adap[(size_t)ks * NV + i];
        ada[i] = s; }
}
__device__ __forceinline__ void p2_modulate0(const Frame& F, const CArgs& a) {
    const int gw = F.vcu * NWAVES + F.wave, NGW = F.G * NWAVES;
    const float* ada = (const float*)(a.ws + WS_ADA); bf16* H = (bf16*)(a.ws + WS_H);
    for (int row = gw; row < M; row += NGW) { const int b = row >> 12;
        const float* sh = ada + (size_t)b * NADA * D, * sc = sh + D;
#pragma unroll
        for (int j = 0; j < 8; ++j) { const int idx = 4 * (F.lane + 64 * j);
            const f32x4 xv = *(const f32x4*)(a.in[0] + (size_t)row * D + idx), s1 = *(const f32x4*)(sc + idx), s0 = *(const f32x4*)(sh + idx);
            const f32x4 h = xv * (s1 + 1.0f) + s0;
            *(v2u*)(H + (size_t)row * D + idx) = (v2u){pk2(h[0], h[1]), pk2(h[2], h[3])}; } }
}
__device__ __forceinline__ void vec_prep(const Frame& F, const CArgs& a) {
    const int gt = F.vcu * (NWAVES * 64) + F.tid, NGT = F.G * NWAVES * 64;
    const float* ada = (const float*)(a.ws + WS_ADA); float* vec = (float*)(a.ws + WS_VEC);
    for (int i = gt; i < 3 * DEPTH * BATCH * D; i += NGT) { const int d = i % D, sb = i / D, b = sb % BATCH, s = sb / BATCH, l = s / 3, j = s - 3 * l;
        const float* ad = ada + ((size_t)l * BATCH + b) * NADA * D + d;
        const float sh = ad[(3 * j) * D], sc = ad[(3 * j + 1) * D], gt_ = ad[(3 * j + 2) * D];
        const float lg = a.in[5][(size_t)(l * 3 + j) * D + d], lb = a.in[6][(size_t)(l * 3 + j) * D + d];
        float P = DN_ALPHA, Q = 0.f; if (s != 0) { P = DN_ALPHA / (1.0f + sc); Q = -P * sh; }
        float U = lg, W = lb;
        if (s != 3 * DEPTH - 1) { const int s1 = s + 1, l1 = s1 / 3, j1 = s1 - 3 * l1; const float* an = ada + ((size_t)l1 * BATCH + b) * NADA * D + d;
            const float nsh = an[(3 * j1) * D], nsc = an[(3 * j1 + 1) * D]; U = lg * (1.0f + nsc); W = lb * (1.0f + nsc) + nsh; }
        float* o = vec + (size_t)sb * 5 * D + d;
        o[0] = P; o[D] = Q; o[2 * D] = (j == 1 ? 1.0f : 0.5f) * (1.0f + gt_); o[3 * D] = U; o[4 * D] = W; }
}
__device__ __forceinline__ unsigned hl_enc(float h, unsigned hb) { const int d = (int)(__float_as_uint(h) - hb); int q = (d + 0x80) >> 8; q = q > 127 ? 127 : q; return (unsigned)q & 0xffu; }
__device__ __forceinline__ float hl_dec(unsigned hb, unsigned byte) { const int q = (int)(signed char)(byte & 0xffu); return __uint_as_float(hb + (unsigned)(q * 256)); }
template <bool FIRST>
__device__ __forceinline__ void ln_phase(const Frame& F, const bf16* H, const unsigned char* L, bf16* HO, unsigned char* LO, const bf16* f, const float* vecs  , const float* X32, float* OUT32) {
    const int gw = F.vcu * NWAVES + F.wave, NGW = F.G * NWAVES;
    constexpr int RPW = 8;
    int tid0_ = threadIdx.x; asm volatile("" : "+v"(tid0_)); const int Flane = tid0_ & 63, Ftid = tid0_;
    LAS f32x4* lv = (LAS f32x4*)F.lds;
    int staged_b = -1;
    for (int r0 = gw * RPW; r0 < M; r0 += NGW * RPW) { const int b = r0 >> 12;
        if (b != staged_b) {
            if (staged_b >= 0) __syncthreads();
            const f32x4* src = (const f32x4*)(vecs + (size_t)b * 5 * D);
            int t_ = Ftid; asm volatile("" : "+v"(t_));
#pragma unroll
            for (int i = 0; i < 5; ++i) { const int q = t_ + 512 * i, vec = q >> 9, e = (q & 511) * 4, j = e >> 9, ln = (e & 511) >> 3, half = (e >> 2) & 1;
                lv[((vec * 4 + j) * 2 + half) * 64 + ln] = src[q]; }
            __syncthreads(); staged_b = b; }
        constexpr int NS = FIRST ? 1 : LN_NS;
        v4u hq2[NS][4], fq2[NS][4]; v2u lq2[NS][4]; f32x4 xq2[NS][8];
#define LN_LOAD(row_, S_) do { _Pragma("unroll") for (int j = 0; j < 4; ++j) { const int idx = 8 * (Flane + 64 * j);                                     \
            fq2[S_][j] = *(const v4u*)(f + (size_t)(row_) * D + idx);                                                                                          \
            if (FIRST) { xq2[S_][2 * j] = *(const f32x4*)(X32 + (size_t)(row_) * D + idx); xq2[S_][2 * j + 1] = *(const f32x4*)(X32 + (size_t)(row_) * D + idx + 4); } \
            else { hq2[S_][j] = *(const v4u*)(H + (size_t)(row_) * D + idx); lq2[S_][j] = *(const v2u*)(L + (size_t)(row_) * D + idx); } } } while (0)
        LN_LOAD(r0, 0); if (NS == 2) LN_LOAD(r0 + 1, NS - 1);
#pragma unroll
        for (int i = 0; i < RPW; ++i) { const int row = r0 + i;
            v4u (&hq)[4] = hq2[i % NS]; v4u (&fq)[4] = fq2[i % NS]; v2u (&lq)[4] = lq2[i % NS]; f32x4 (&xq)[8] = xq2[i % NS];
            int ln_ = Flane; asm volatile("" : "+v"(ln_));
            float v[32]; float s = 0.f;
#pragma unroll
            for (int j = 0; j < 4; ++j) {
                const f32x4 p0 = lv[((0 * 4 + j) * 2 + 0) * 64 + ln_], p1 = lv[((0 * 4 + j) * 2 + 1) * 64 + ln_], q0 = lv[((1 * 4 + j) * 2 + 0) * 64 + ln_], q1 = lv[((1 * 4 + j) * 2 + 1) * 64 + ln_], c0 = lv[((2 * 4 + j) * 2 + 0) * 64 + ln_], c1 = lv[((2 * 4 + j) * 2 + 1) * 64 + ln_];
#pragma unroll
                for (int e = 0; e < 4; ++e) { const float fl = bf_lo(fq[j][e]), fh = bf_hi(fq[j][e]);
                    const float xl = FIRST ? xq[2 * j + (e >> 1)][(e & 1) * 2] : hl_dec(hq[j][e] << 16, lq[j][e >> 1] >> (16 * (e & 1))), xh = FIRST ? xq[2 * j + (e >> 1)][(e & 1) * 2 + 1] : hl_dec(hq[j][e] & 0xffff0000u, lq[j][e >> 1] >> (16 * (e & 1) + 8));
                    const float pl = e < 2 ? p0[2 * e] : p1[2 * e - 4], ph_ = e < 2 ? p0[2 * e + 1] : p1[2 * e - 3], ql = e < 2 ? q0[2 * e] : q1[2 * e - 4], qh = e < 2 ? q0[2 * e + 1] : q1[2 * e - 3], cl = e < 2 ? c0[2 * e] : c1[2 * e - 4], ch = e < 2 ? c0[2 * e + 1] : c1[2 * e - 3];
                    const float vl = pl * xl + ql + cl * fl, vh = ph_ * xh + qh + ch * fh; v[8 * j + 2 * e] = vl; v[8 * j + 2 * e + 1] = vh; s += vl + vh; } }
            if (i + NS < RPW) LN_LOAD(row + NS, i % NS);
            const float mean = wave_sum(s) * (1.0f / D); float s2 = 0.f;
#pragma unroll
            for (int k = 0; k < 32; ++k) { v[k] -= mean; s2 += v[k] * v[k]; }
            const float rstd = 1.0f / sqrtf(wave_sum(s2) * (1.0f / D) + LN_EPS);
#pragma unroll
            for (int j = 0; j < 4; ++j) { const int idx = 8 * (ln_ + 64 * j);
                const f32x4 u0 = lv[((3 * 4 + j) * 2 + 0) * 64 + ln_], u1 = lv[((3 * 4 + j) * 2 + 1) * 64 + ln_], w0 = lv[((4 * 4 + j) * 2 + 0) * 64 + ln_], w1 = lv[((4 * 4 + j) * 2 + 1) * 64 + ln_];
                float o[8];
#pragma unroll
                for (int e = 0; e < 8; ++e) o[e] = v[8 * j + e] * rstd * (e < 4 ? u0[e] : u1[e - 4]) + (e < 4 ? w0[e] : w1[e - 4]);
                if (OUT32) { *(f32x4*)(OUT32 + (size_t)row * D + idx) = (f32x4){o[0], o[1], o[2], o[3]}; *(f32x4*)(OUT32 + (size_t)row * D + idx + 4) = (f32x4){o[4], o[5], o[6], o[7]}; }
                else { v4u hw; v2u lw = {0u, 0u};
#pragma unroll
                    for (int e = 0; e < 4; ++e) { hw[e] = pk2(o[2 * e], o[2 * e + 1]);
                        lw[e >> 1] |= (hl_enc(o[2 * e], hw[e] << 16) | (hl_enc(o[2 * e + 1], hw[e] & 0xffff0000u) << 8)) << (16 * (e & 1)); }
                    *(v4u*)(HO + (size_t)row * D + idx) = hw; *(v2u*)(LO + (size_t)row * D + idx) = lw; } } }
#undef LN_LOAD
    }
    __syncthreads();
}
__device__ __forceinline__ void attn_phase(const Frame& F, const CArgs& a, int which) {
    unsigned char* ws = a.ws;
    const bf16* QM = (const bf16*)(ws + WS_QM); const bf16* KV = (const bf16*)(ws + WS_KV); const bf16* KPE = (const bf16*)(ws + WS_KPE);
    const bf16* SBQ = (const bf16*)(ws + WS_SBQ); const bf16* SBK = (const bf16*)(ws + WS_SBK); const bf16* SBV = (const bf16*)(ws + WS_SBV);
    bf16* O = (bf16*)(ws + WS_O); float* OSSQ = (float*)(ws + WS_OSSQ);
    constexpr int NQB = SEQ / 256, NPAIR = NQB / 2, NITEM = BATCH * NH * NPAIR;
    for (int it = F.vcu; it < NITEM; it += F.G) {
        const int bh = it / NPAIR, x = it - bh * NPAIR, b = bh / NH, h = bh - b * NH;
        const size_t r0 = (size_t)b * SEQ;
#if SITE_ATT & 1
#pragma unroll 1
        for (int pass = 0; pass < ((which & 1) ? 2 : 0); ++pass) { const int qb = pass ? NQB - 1 - x : x; const size_t rq = r0 + (size_t)qb * 256;
            att::attn_block<false>(F.lds, QM + rq * (NH * QKD) + h * QKD, NH * QKD, KV + r0 * D + h * 256, D, KV + r0 * D + h * 256 + 128, D, KPE + r0 * 64, O + rq * D + h * HD, D, OSSQ + rq * 16 + h, qb * 256); }
#endif
#if SITE_ATT & 2
#pragma unroll 1
        for (int pass = 0; pass < ((which & 2) ? 2 : 0); ++pass) { const int qb = pass ? NQB - 1 - x : x; const size_t rq = r0 + (size_t)qb * 256;
            att::attn_block<true>(F.lds, SBQ + rq * 1024 + h * HD, 1024, SBK + r0 * 1024 + h * HD, 1024, SBV + r0 * 1024 + h * HD, 1024, nullptr, O + rq * D + 1024 + h * HD, D, OSSQ + rq * 16 + 8 + h, qb * 256); }
#endif
    }
}

__global__ void __launch_bounds__(NWAVES * 64, 2) mk_fwd(Args args_unused) {
    extern __shared__ __attribute__((aligned(16))) unsigned char lds[];
    (void)args_unused;
    CArgs* ap = (CArgs*)__builtin_amdgcn_kernarg_segment_ptr();
    Frame F;
    F.lds = (LAS unsigned char*)lds;
    F.tid = threadIdx.x; F.lane = F.tid & 63; F.wave = __builtin_amdgcn_readfirstlane(F.tid >> 6);
    F.G = gridDim.x; { const int bx = blockIdx.x; F.vcu = (F.G % 8 == 0) ? (bx % 8) * (F.G / 8) + bx / 8 : bx; }
    volatile LAS unsigned* MISC = (volatile LAS unsigned*)(F.lds + MISC_OFF);
    for (int u = F.tid; u < (LDS_BYTES - MISC_OFF) / 4; u += NWAVES * 64) ((LAS unsigned*)(F.lds + MISC_OFF))[u] = 0u;
    __syncthreads();
    XcdBarrier bar; bar.bar = (unsigned*)(ap->ws + WS_CTL) + CW_BAR; bar.x = 0; bar.st = nullptr;
    if (MK_ONE_LAUNCH) bar = xcd_barrier_post((unsigned*)(ap->ws + WS_CTL) + CW_BAR, MISC + 8);
    const int lo = ap->ph_lo, hi = ap->ph_hi; int ph = 0; bool fin_ = false;
#define RUN_PH (ph >= lo && ph < hi)
#if TPROBE
#define TP_BASE ((unsigned long long*)(fresh_args(ap)->ws + WS_CTL + 524288))
#define TP_BEGIN(k) do { if (blockIdx.x == TPROBE_WG && threadIdx.x == 0) { unsigned long long* tp = TP_BASE; tp[30] = __builtin_amdgcn_s_memrealtime(); int kk_ = (k); asm volatile("" : "+s"(kk_)); ((unsigned*)tp)[64] = (unsigned)kk_; } } while (0)
#define TP_MID do { if (blockIdx.x == TPROBE_WG && threadIdx.x == 0) { asm volatile("s_waitcnt vmcnt(0)" ::: "memory"); TP_BASE[31] = __builtin_amdgcn_s_memrealtime(); } } while (0)
#define TP_END do { if (blockIdx.x == TPROBE_WG && threadIdx.x == 0) { unsigned long long* tp = TP_BASE; const unsigned long long t2 = __builtin_amdgcn_s_memrealtime(), t0 = tp[30], t1 = tp[31]; const int k = (int)((unsigned*)tp)[64]; tp[2 * k] += t1 - t0; tp[2 * k + 1] += t2 - t1; } } while (0)
#else
#define TP_BEGIN(k) do { } while (0)
#define TP_MID do { } while (0)
#define TP_END do { } while (0)
#endif
#define END_PH do { TP_MID; if (MK_ONE_LAUNCH && RUN_PH && ph + 1 < hi && !fin_) { xcd_barrier(bar); for (int xb_ = 0; xb_ < DUP_BAR; ++xb_) xcd_barrier(bar); } TP_END; ++ph; } while (0)
#define WSP(T, off) ((T*)(A->ws + (off)))

REP(DUP_P0) { TP_BEGIN(0);
#if SITE_P0
    if (RUN_PH) p0_prologue(fresh_frame(F), *fresh_args(ap));
#endif
    END_PH; }
REP(DUP_P1) { TP_BEGIN(1);
#if SITE_P1
    if (RUN_PH) p1_ada_reduce(fresh_frame(F), *fresh_args(ap));
#endif
    END_PH; }
REP(DUP_P2) { TP_BEGIN(2);
#if SITE_P2
    if (RUN_PH) { p2_modulate0(fresh_frame(F), *fresh_args(ap)); vec_prep(fresh_frame(F), *fresh_args(ap)); }
#endif
    END_PH; }

#pragma unroll 1
    for (int s = 0; s <= DBG_LAST_S; ++s) {
        const int l = s / 3, j = s - 3 * l;
        if (j != 1) {
REP(DUP_G1) { TP_BEGIN(3);
#if SITE_G1
            if (RUN_PH) { CArgs* A = fresh_args(ap); const unsigned char* wl = A->ws + WS_W + (size_t)l * W_LAYER;
                pg8::Gemm g{WSP(const bf16, WS_H), (const bf16*)(wl + (j == 0 ? WO_WI1 : WO_WI2)), M, 2 * FF, D}; pg8::StaticOrder S; S.init(M, 2 * FF, F.G, (int)blockIdx.x);
                pg8::EpiSwiGLU E{WSP(bf16, WS_ACT), FF};
                pg8::gemm_phase<pg8::EpiSwiGLU, pg8::StaticOrder, G1_ALIGN, G1_SP2>(F.lds + RING_OFF, g, S, E);
            }
#endif
            END_PH; }
        } else {
REP(DUP_WIN) { TP_BEGIN(4);
#if SITE_WIN
            if (RUN_PH) { CArgs* A = fresh_args(ap); const unsigned char* wl = A->ws + WS_W + (size_t)l * W_LAYER;
                pg8::Gemm g{WSP(const bf16, WS_H), (const bf16*)(wl + WO_WIN), M, WIN_ROWS, D}; pg8::WinOrder S; S.init(M, 16 * 256, F.G, (int)blockIdx.x);
                pg8::EpiWin E{WSP(bf16, WS_CQ), WSP(bf16, WS_CKV), WSP(bf16, WS_SBQ), WSP(bf16, WS_SBK), WSP(bf16, WS_SBV), WSP(bf16, WS_KPE), WSP(float, WS_SSQ), WSP(const float, WS_ROPE), SB_QSCALE};
                pg8::gemm_phase<pg8::EpiWin, pg8::WinOrder, true, true>(F.lds + RING_OFF, g, S, E);
            }
#endif
            END_PH; }
REP(DUP_UQKV) { TP_BEGIN(5);
#if SITE_UQKV
            if (RUN_PH) {
                const int c = (int)blockIdx.x, G = F.G; const bool bal = G == 256; const bool grpA = ((c >> 3) & 1) == 0; const int gi = ((c >> 4) << 3) | (c & 7);
                pg8::ListOrder Swt, Suq, Sukv;
                if (bal) { Swt = pg8::ListOrder{gi, grpA ? 1 : 0, 1, 15}; Suq = grpA ? pg8::ListOrder{gi, 1, 1, 0} : pg8::ListOrder{128 + 2 * gi, 2, 1, 0}; Sukv = grpA ? pg8::ListOrder{gi, 1, 1, 0} : pg8::ListOrder{128 + 3 * gi, 3, 1, 0}; }
                else { Swt = pg8::ListOrder{c, c < 128 ? (128 - c + G - 1) / G : 0, G, 15}; Suq = pg8::ListOrder{c, c < 384 ? (384 - c + G - 1) / G : 0, G, 0}; Sukv = pg8::ListOrder{c, c < 512 ? (512 - c + G - 1) / G : 0, G, 0}; }
                { CArgs* A = fresh_args(ap); const unsigned char* wl = A->ws + WS_W + (size_t)l * W_LAYER;
                  pg8::Gemm g{WSP(const bf16, WS_H), (const bf16*)(wl + WO_WIN), M, WIN_ROWS, D};
                  pg8::EpiWin E{WSP(bf16, WS_CQ), WSP(bf16, WS_CKV), WSP(bf16, WS_SBQ), WSP(bf16, WS_SBK), WSP(bf16, WS_SBV), WSP(bf16, WS_KPE), WSP(float, WS_SSQ), WSP(const float, WS_ROPE), SB_QSCALE};
                  pg8::gemm_phase<pg8::EpiWin, pg8::ListOrder, true, true>(F.lds + RING_OFF, g, Swt, E); }
                { CArgs* A = fresh_args(ap); const unsigned char* wl = A->ws + WS_W + (size_t)l * W_LAYER;
                  pg8::Gemm g{WSP(const bf16, WS_CQ), (const bf16*)(wl + WO_WUQ), M, NH * QKD, QLR};
                  pg8::EpiRS<true> E{WSP(bf16, WS_QM), NH * QKD, WSP(const float, WS_SSQ), 0, 3, 1.0f / QLR, RMS_EPS, MLA_QSCALE, WSP(const float, WS_ROPE)};
                  pg8::gemm_phase<pg8::EpiRS<true>, pg8::ListOrder, true, true>(F.lds + RING_OFF, g, Suq, E); }
                { CArgs* A = fresh_args(ap); const unsigned char* wl = A->ws + WS_W + (size_t)l * W_LAYER;
                  pg8::Gemm g{WSP(const bf16, WS_CKV), (const bf16*)(wl + WO_WUKV), M, NH * 256, KVLR};
                  pg8::EpiRS<false> E{WSP(bf16, WS_KV), NH * 256, WSP(const float, WS_SSQ), 3, 2, 1.0f / KVLR, RMS_EPS, 1.0f, nullptr};
                  pg8::gemm_phase<pg8::EpiRS<false>, pg8::ListOrder, true, true>(F.lds + RING_OFF, g, Sukv, E); }
            }
#endif
            END_PH; }
REP(DUP_ATT) { TP_BEGIN(6);
#if SITE_ATT
            if (RUN_PH) attn_phase(fresh_frame(F), *fresh_args(ap), rep_ == 0 ? 3 : DUP_ATT_WHICH);
#endif
            END_PH; }
        }
REP(DUP_GF) { TP_BEGIN(8);
#if SITE_GF
        if (RUN_PH) { CArgs* A = fresh_args(ap); const unsigned char* wl = A->ws + WS_W + (size_t)l * W_LAYER;
            if (j != 1) { pg8::Gemm g{WSP(const bf16, WS_ACT), (const bf16*)(wl + (j == 0 ? WO_WO1 : WO_WO2)), M, D, FF}; pg8::StaticOrder S; S.init(M, D, F.G, (int)blockIdx.x);
                pg8::EpiPlain E{WSP(bf16, WS_F), D};
                pg8::gemm_phase<pg8::EpiPlain, pg8::StaticOrder, GF_ALIGN, G1_SP2>(F.lds + RING_OFF, g, S, E); }
            else { pg8::Gemm g{WSP(const bf16, WS_O), (const bf16*)(wl + WO_WOUT), M, D, D}; pg8::StaticOrder S; S.init(M, D, F.G, (int)blockIdx.x);
                pg8::EpiMixOut E{WSP(bf16, WS_F), D, WSP(const float, WS_OSSQ), 16, 1.0f / 1024.0f, RMS_EPS};
                pg8::gemm_phase<pg8::EpiMixOut, pg8::StaticOrder, GF_ALIGN, G1_SP2>(F.lds + RING_OFF, g, S, E); }
        }
#endif
        END_PH; }
REP(DUP_LN) { TP_BEGIN(9);
#if SITE_LN
        fin_ = (s == DBG_LAST_S) && (rep_ == DUP_LN);
        if (RUN_PH) { CArgs* A = fresh_args(ap); const bool last = s == DBG_LAST_S; const bool dummy = DUP_LN && rep_ == 0;
            bf16* HO = dummy ? WSP(bf16, WS_DUMMY) : WSP(bf16, WS_H); unsigned char* LO = dummy ? WSP(unsigned char, WS_DUMMY + 64 * MiB) : WSP(unsigned char, WS_HL);
            if (s == 0) ln_phase<true>(F, WSP(const bf16, WS_H), WSP(const unsigned char, WS_HL), HO, LO, WSP(const bf16, WS_F), WSP(const float, WS_VEC), A->in[0], last ? A->out : nullptr);
            else ln_phase<false>(F, WSP(const bf16, WS_H), WSP(const unsigned char, WS_HL), HO, LO, WSP(const bf16, WS_F), WSP(const float, WS_VEC) + (size_t)s * BATCH * 5 * D, nullptr, last ? A->out : nullptr);
        }
#endif
        END_PH; }
    }
#if TPROBE
    xcd_barrier(bar);
    { CArgs* A = fresh_args(ap); const unsigned long long* tp = (const unsigned long long*)(A->ws + WS_CTL + 524288); const float dall = 0.f * (float)tp[TPROBE_B], done_ = (TPROBE_A == 99 ? (float)(tp[1] + tp[3] + tp[5] + tp[7] + tp[9] + tp[11] + tp[13] + tp[15] + tp[17] + tp[19]) : (float)(tp[TPROBE_A] + tp[TPROBE_B])) * 1e-5f * TPROBE_SCALE;
      float* o = A->out; const int gt = (int)blockIdx.x * 512 + (int)threadIdx.x;
      for (int i = gt; i < M * D / 4; i += (int)gridDim.x * 512) { f32x4 v = *(f32x4*)(o + (size_t)i * 4); v = v + dall; if (i == 0) v[0] += done_; *(f32x4*)(o + (size_t)i * 4) = v; } }
#endif
#undef RUN_PH
#undef END_PH
#undef WSP
}

extern "C" void kernel_launch(void* const* d_in, const int* in_sizes, int n_in, void* d_out, int out_size, void* d_ws, size_t ws_size, hipStream_t stream) {
    static int grid = 0;
    if (grid == 0) {
        if (n_in != 19 || in_sizes[0] != M * D || out_size != M * D || ws_size < WS_END) { fprintf(stderr, "kernel_launch: unexpected shapes (n_in %d, in0 %d, out %d, ws %zu < %zu); nothing launched\n", n_in, n_in > 0 ? in_sizes[0] : -1, out_size, ws_size, (size_t)WS_END); grid = -1; return; }
        int dev = 0, cus = 0, per_cu = 0;
        if (hipGetDevice(&dev) != hipSuccess || hipDeviceGetAttribute(&cus, hipDeviceAttributeMultiprocessorCount, dev) != hipSuccess) { grid = -1; return; }
        if (hipFuncSetAttribute((const void*)mk_fwd, hipFuncAttributeMaxDynamicSharedMemorySize, LDS_BYTES) != hipSuccess) { fprintf(stderr, "kernel_launch: hipFuncSetAttribute failed\n"); grid = -1; return; }
        if (hipOccupancyMaxActiveBlocksPerMultiprocessor(&per_cu, (const void*)mk_fwd, NWAVES * 64, LDS_BYTES) != hipSuccess || per_cu < 1)
            fprintf(stderr, "kernel_launch: note: occupancy query reports %d workgroups per CU\n", per_cu);
        (void)hipGetLastError();
        grid = cus;
    }
    if (grid < 0) return;
    if (hipMemsetAsync((char*)d_ws + WS_CTL, 0, CTL_ZERO_BYTES, stream) != hipSuccess) { fprintf(stderr, "kernel_launch: hipMemsetAsync failed\n"); return; }
    Args a{};
    for (int i = 0; i < 19; ++i) a.in[i] = (const float*)d_in[i];
    a.out = (float*)d_out; a.ws = (unsigned char*)d_ws;
#if MK_ONE_LAUNCH
    a.ph_lo = 0; a.ph_hi = 1 << 20;
    hipLaunchKernelGGL(mk_fwd, dim3(grid), dim3(NWAVES * 64), LDS_BYTES, stream, a);
#else
    for (int p = 0; p < N_PHASES; ++p) { a.ph_lo = p; a.ph_hi = p + 1; hipLaunchKernelGGL(mk_fwd, dim3(grid), dim3(NWAVES * 64), LDS_BYTES, stream, a); }
#endif
}
```

```cpp
#include <hip/hip_runtime.h>
#include <cstdio>
#include <cstdint>
#include <cmath>
namespace pg8 {
#define PG8_LAS __attribute__((address_space(3)))
typedef unsigned short bf16_t;
typedef short bf16x8 __attribute__((ext_vector_type(8)));
typedef float f32x4 __attribute__((ext_vector_type(4)));
typedef unsigned u32x4 __attribute__((ext_vector_type(4)));
constexpr int BM = 256, BK = 64, HALF = 128, HTB = HALF * BK * 2  , STAGE_BYTES = 8 * HTB, NXCD = 8, WGM = 8;

__host__ __device__ __forceinline__ int lds_byte(int r, int c) { const int st = (r >> 4) * 2 + (c >> 5), rr = r & 15, cc = c & 31, ob = rr * 64 + cc * 2; return st * 1024 + (ob ^ (((ob >> 9) & 1) << 5)); }
__host__ __device__ __forceinline__ void stage_rc(int b, int& R, int& C) { const int st = b / 1024, sb = b % 1024, swz = sb ^ (((sb >> 9) & 1) << 5); R = (st >> 1) * 16 + swz / 64; C = (st & 1) * 32 + (swz % 64) / 2; }
__host__ __device__ __forceinline__ int perm32(int rho) { const int n = rho >> 4, i = rho & 15; return 8 * (i >> 2) + 4 * n + (i & 3); }

struct Unit { int pm, pn; };
struct Gemm { const bf16_t* A; const bf16_t* Bt; int M, N, K; };

struct StaticOrder {
    int nM, nN, nwg, G, c;
    __host__ __device__ void init(int M, int N, int G_, int c_) { nM = M / BM; nN = N / BM; nwg = nM * nN; G = G_; c = c_; }
    __host__ __device__ bool next(int i, Unit& u) const {
        const long L = (long)i * G + c; if (L >= nwg) return false;
        int wgid = (int)L; { const int q = nwg / NXCD, r = nwg % NXCD, xcd = wgid % NXCD, off = wgid / NXCD; wgid = (xcd < r ? xcd * (q + 1) : r * (q + 1) + (xcd - r) * q) + off; }
        const int nig = WGM * nN, gid = wgid / nig, fm = gid * WGM, gsz = (nM - fm) < WGM ? (nM - fm) : WGM;
        u.pm = fm + ((wgid % nig) % gsz); u.pn = (wgid % nig) / gsz; return true;
    }
    __device__ __forceinline__ void a_ready(const Unit&) const {}
    __device__ __forceinline__ void done(const Unit&) const {}
};


#ifndef EPIRS_SKIP
#define EPIRS_SKIP 0
#endif
#ifndef EPI_NT
#define EPI_NT 0
#endif

__device__ __forceinline__ unsigned cvt_pk_bf16(float lo, float hi) { unsigned r; asm volatile("v_cvt_pk_bf16_f32 %0, %1, %2" : "=v"(r) : "v"(lo), "v"(hi)); return r; }
typedef float f32x2 __attribute__((ext_vector_type(2)));
__device__ __forceinline__ u32x4 pack8bf(const f32x4 v0, const f32x4 v1) { u32x4 w; w.x = cvt_pk_bf16(v0[0], v0[1]); w.y = cvt_pk_bf16(v0[2], v0[3]); w.z = cvt_pk_bf16(v1[0], v1[1]); w.w = cvt_pk_bf16(v1[2], v1[3]); return w; }

__device__ __forceinline__ float add_xor16(float x) { auto a = __builtin_amdgcn_permlane16_swap(__float_as_uint(x), __float_as_uint(x), false, false); return __uint_as_float(a[0]) + __uint_as_float(a[1]); }
__device__ __forceinline__ float add_xor32(float x) { auto a = __builtin_amdgcn_permlane32_swap(__float_as_uint(x), __float_as_uint(x), false, false); return __uint_as_float(a[0]) + __uint_as_float(a[1]); }
struct EpiPlain {
    static constexpr bool PERM = true, AFTER_DRAIN = false, MID = false;
    bf16_t* O; int ldc;
    __device__ __forceinline__ void operator()(const f32x4 (&acc)[2][2][4][2], const Unit& u, int wr, int wc, int fr, int fq) const {
        const int row0 = u.pm * BM + wr * 64 + fr; const int col0 = u.pn * BM + wc * 32 + 8 * fq;
#pragma unroll
        for (int ai = 0; ai < 2; ++ai)
#pragma unroll
            for (int m = 0; m < 4; ++m) { bf16_t* rowp = O + (size_t)(row0 + ai * HALF + m * 16) * ldc + col0;
#pragma unroll
                for (int bj = 0; bj < 2; ++bj) { const u32x4 w = pack8bf(acc[ai][bj][m][0], acc[ai][bj][m][1]); if (EPI_NT) __builtin_nontemporal_store(w, (u32x4*)(rowp + bj * HALF)); else *(u32x4*)(rowp + bj * HALF) = w; } }
    }
};

struct EpiMixOut {
    static constexpr bool PERM = true, AFTER_DRAIN = false, MID = true;
    bf16_t* O; int ldc; const float* OSSQ; int mid_t; float invn, eps;
    __device__ __forceinline__ void group_ssq(const Unit& u, int wr, int fr, int fq, float (&sm)[2][4], float (&ss)[2][4]) const {
        int fr_ = fr; asm volatile("" : "+v"(fr_));
        const int row0 = u.pm * BM + wr * 64 + fr_;
#pragma unroll
        for (int ai = 0; ai < 2; ++ai)
#pragma unroll
            for (int m = 0; m < 4; ++m) { const f32x4 q = *(const f32x4*)(OSSQ + (size_t)(row0 + ai * HALF + m * 16) * 16 + 4 * fq); sm[ai][m] = (q[0] + q[1]) + (q[2] + q[3]); }
#pragma unroll
        for (int ai = 0; ai < 2; ++ai)
#pragma unroll
            for (int m = 0; m < 4; ++m) { const float s = add_xor16(sm[ai][m]); auto b = __builtin_amdgcn_permlane32_swap(__float_as_uint(s), __float_as_uint(s), false, false); const float o = __uint_as_float(fq < 2 ? b[1] : b[0]); sm[ai][m] = fq < 2 ? s : o; ss[ai][m] = fq < 2 ? o : s; }
    }
    __device__ __forceinline__ void mid(f32x4 (&acc)[2][2][4][2], const Unit& u, int wr, int wc, int fr, int fq) const {
        float sm[2][4], ss[2][4]; group_ssq(u, wr, fr, fq, sm, ss);
#pragma unroll
        for (int ai = 0; ai < 2; ++ai)
#pragma unroll
            for (int m = 0; m < 4; ++m) { const float ratio = sqrtf((ss[ai][m] * invn + eps) / (sm[ai][m] * invn + eps));
#pragma unroll
                for (int bj = 0; bj < 2; ++bj) { acc[ai][bj][m][0] = acc[ai][bj][m][0] * ratio; acc[ai][bj][m][1] = acc[ai][bj][m][1] * ratio; } }
    }
    __device__ __forceinline__ void operator()(const f32x4 (&acc)[2][2][4][2], const Unit& u, int wr, int wc, int fr, int fq) const {
        float sm[2][4], ss[2][4]; group_ssq(u, wr, fr, fq, sm, ss);
        const int row0 = u.pm * BM + wr * 64 + fr; const int col0 = u.pn * BM + wc * 32 + 8 * fq;
#pragma unroll
        for (int ai = 0; ai < 2; ++ai)
#pragma unroll
            for (int m = 0; m < 4; ++m) { bf16_t* rowp = O + (size_t)(row0 + ai * HALF + m * 16) * ldc + col0; const float rs = 1.0f / sqrtf(ss[ai][m] * invn + eps);
#pragma unroll
                for (int bj = 0; bj < 2; ++bj) *(u32x4*)(rowp + bj * HALF) = pack8bf(acc[ai][bj][m][0] * rs, acc[ai][bj][m][1] * rs); }
    }
};

struct EpiSwiGLU {
    static constexpr bool PERM = true, AFTER_DRAIN = false, MID = false;
    bf16_t* O; int ldc;
    __device__ __forceinline__ static f32x4 sg(const f32x4 g, const f32x4 up) {
        f32x4 r;
#pragma unroll
        for (int i = 0; i < 4; ++i) { const float e = __builtin_amdgcn_exp2f(g[i] * -1.4426950408889634f); r[i] = g[i] * __builtin_amdgcn_rcpf(1.0f + e) * up[i]; }
        return r;
    }
    __device__ __forceinline__ void operator()(const f32x4 (&acc)[2][2][4][2], const Unit& u, int wr, int wc, int fr, int fq) const {
        const int row0 = u.pm * BM + wr * 64 + fr; const int col0 = u.pn * HALF + wc * 32 + 8 * fq;
#pragma unroll
        for (int ai = 0; ai < 2; ++ai) { f32x4 t[4][2];
#pragma unroll
            for (int m = 0; m < 4; ++m)
#pragma unroll
                for (int n = 0; n < 2; ++n) t[m][n] = acc[ai][0][m][n] * -1.4426950408889634f;
#pragma unroll
            for (int m = 0; m < 4; ++m)
#pragma unroll
                for (int n = 0; n < 2; ++n)
#pragma unroll
                    for (int i = 0; i < 4; ++i) t[m][n][i] = __builtin_amdgcn_exp2f(t[m][n][i]);
#pragma unroll
            for (int m = 0; m < 4; ++m)
#pragma unroll
                for (int n = 0; n < 2; ++n) t[m][n] = t[m][n] + 1.0f;
#pragma unroll
            for (int m = 0; m < 4; ++m)
#pragma unroll
                for (int n = 0; n < 2; ++n)
#pragma unroll
                    for (int i = 0; i < 4; ++i) t[m][n][i] = __builtin_amdgcn_rcpf(t[m][n][i]);
#pragma unroll
            for (int m = 0; m < 4; ++m)
#pragma unroll
                for (int n = 0; n < 2; ++n) t[m][n] = acc[ai][0][m][n] * t[m][n] * acc[ai][1][m][n];
#pragma unroll
            for (int m = 0; m < 4; ++m) { bf16_t* rowp = O + (size_t)(row0 + ai * HALF + m * 16) * ldc + col0; *(u32x4*)rowp = pack8bf(t[m][0], t[m][1]); } }
    }
};

__device__ __forceinline__ void rope8(f32x4& v0, f32x4& v1, const f32x4 cs0, const f32x4 cs1) {
    const float a0 = v0[0], b0 = v0[1], a1 = v0[2], b1 = v0[3], a2 = v1[0], b2 = v1[1], a3 = v1[2], b3 = v1[3];
    v0[0] = a0 * cs0[0] - b0 * cs0[1]; v0[1] = a0 * cs0[1] + b0 * cs0[0];
    v0[2] = a1 * cs0[2] - b1 * cs0[3]; v0[3] = a1 * cs0[3] + b1 * cs0[2];
    v1[0] = a2 * cs1[0] - b2 * cs1[1]; v1[1] = a2 * cs1[1] + b2 * cs1[0];
    v1[2] = a3 * cs1[2] - b3 * cs1[3]; v1[3] = a3 * cs1[3] + b3 * cs1[2];
}

struct EpiWin {
    static constexpr bool PERM = true, AFTER_DRAIN = false, MID = false;
    bf16_t *CQ, *CKV, *SBQ, *SBK, *SBV, *KPE; float* SSQ; const float* ROPE; float sbq_scale;
    __device__ __forceinline__ void operator()(const f32x4 (&acc)[2][2][4][2], const Unit& u, int wr, int wc, int fr, int fq) const {
        const int pn = u.pn; const int row0 = u.pm * BM + wr * 64 + fr;
        if (pn < 17) {
            bf16_t* base; int ldc, colt; float sc = 1.0f; const bool ssq = pn < 5;
            if (pn < 3) { base = CQ; ldc = 768; colt = pn * BM; }
            else if (pn < 5) { base = CKV; ldc = 512; colt = (pn - 3) * BM; }
            else if (pn < 9) { base = SBQ; ldc = 1024; colt = (pn - 5) * BM; sc = sbq_scale; }
            else if (pn < 13) { base = SBK; ldc = 1024; colt = (pn - 9) * BM; }
            else { base = SBV; ldc = 1024; colt = (pn - 13) * BM; }
            const int col0 = colt + wc * 32 + 8 * fq;
#pragma unroll
            for (int ai = 0; ai < 2; ++ai)
#pragma unroll
                for (int m = 0; m < 4; ++m) { const int row = row0 + ai * HALF + m * 16; bf16_t* rowp = base + (size_t)row * ldc + col0; float s = 0.f;
#pragma unroll
                    for (int bj = 0; bj < 2; ++bj) { const f32x4 v0 = acc[ai][bj][m][0] * sc, v1 = acc[ai][bj][m][1] * sc;
                        s += (v0[0] * v0[0] + v0[1] * v0[1]) + (v0[2] * v0[2] + v0[3] * v0[3]) + (v1[0] * v1[0] + v1[1] * v1[1]) + (v1[2] * v1[2] + v1[3] * v1[3]);
                        *(u32x4*)(rowp + bj * HALF) = pack8bf(v0, v1); }
                    if (ssq) { s = add_xor32(add_xor16(s)); if (fq == 0) SSQ[((size_t)row * 5 + pn) * 4 + wc] = s; } }
        } else if (wc < 2) {
            const int c0 = wc * 32 + 8 * fq;
#pragma unroll
            for (int ai = 0; ai < 2; ++ai)
#pragma unroll
                for (int m = 0; m < 4; ++m) { const int row = row0 + ai * HALF + m * 16;
                    const f32x4 cs0 = *(const f32x4*)(ROPE + (size_t)row * 64 + c0), cs1 = *(const f32x4*)(ROPE + (size_t)row * 64 + c0 + 4);
                    f32x4 v0 = acc[ai][0][m][0], v1 = acc[ai][0][m][1]; rope8(v0, v1, cs0, cs1);
                    *(u32x4*)(KPE + (size_t)row * 64 + c0) = pack8bf(v0, v1); }
        }
    }
};

template <bool ROPE_Q> struct EpiRS {
    static constexpr bool PERM = true, AFTER_DRAIN = false, MID = false;
    bf16_t* O; int ldc; const float* SSQ; int t0, nt; float invn, eps, oscale; const float* ROPE;
    __device__ __forceinline__ void operator()(const f32x4 (&acc)[2][2][4][2], const Unit& u, int wr, int wc, int fr, int fq) const {
        const int row0 = u.pm * BM + wr * 64 + fr; const int col0 = u.pn * BM + wc * 32 + 8 * fq;
        float rsv[2][4];
#pragma unroll
        for (int ai = 0; ai < 2; ++ai)
#pragma unroll
            for (int m = 0; m < 4; ++m) { const int row = row0 + ai * HALF + m * 16; f32x4 q = {0.f, 0.f, 0.f, 0.f};
                if (fq < nt && !(EPIRS_SKIP & 2)) q = *(const f32x4*)(SSQ + ((size_t)row * 5 + t0 + fq) * 4);
                rsv[ai][m] = (q[0] + q[1]) + (q[2] + q[3]); }
#pragma unroll
        for (int ai = 0; ai < 2; ++ai)
#pragma unroll
            for (int m = 0; m < 4; ++m) { const float ss = add_xor32(add_xor16(rsv[ai][m])); rsv[ai][m] = oscale / sqrtf(ss * invn + eps); }
#pragma unroll
        for (int ai = 0; ai < 2; ++ai)
#pragma unroll
            for (int m = 0; m < 4; ++m) { const int row = row0 + ai * HALF + m * 16;
                const float rs = rsv[ai][m];
#pragma unroll
                for (int bj = 0; bj < 2; ++bj) { const int c = col0 + bj * HALF; f32x4 v0 = acc[ai][bj][m][0] * rs, v1 = acc[ai][bj][m][1] * rs;
                    if (ROPE_Q && !(EPIRS_SKIP & 1)) { const int w = c % 192; if (w >= 128) { const float* cs = ROPE + (size_t)row * 64 + (w - 128); rope8(v0, v1, *(const f32x4*)cs, *(const f32x4*)(cs + 4)); } }
                    *(u32x4*)(O + (size_t)row * ldc + c) = pack8bf(v0, v1); } }
    }
};

struct WinOrder : StaticOrder {
    __device__ __forceinline__ bool next(int i, Unit& u) const { if (!StaticOrder::next(i, u)) return false; u.pn = u.pn < 5 ? u.pn : (u.pn == 5 ? 17 : u.pn - 1); return true; }
};
struct ListOrder {
    int first, count, stride, pn0;
    __device__ __forceinline__ bool next(int i, Unit& u) const { if (i >= count) return false; const int L = first + i * stride; u.pm = L & 63; u.pn = pn0 + (L >> 6); return true; }
    __device__ __forceinline__ void a_ready(const Unit&) const {}
    __device__ __forceinline__ void done(const Unit&) const {}
};

#ifndef PG8_EPI_DUP
#define PG8_EPI_DUP 0
#endif
template <class Epi, class Sched, bool ALIGN_EPI = false, bool SP2 = false>
__device__ __forceinline__ void gemm_phase(PG8_LAS unsigned char* lds, const Gemm g, const Sched& S, const Epi& E) {
    int tid_ = threadIdx.x; asm volatile("" : "+v"(tid_));
    const int tid = tid_, wid = __builtin_amdgcn_readfirstlane(tid >> 6), lane = tid & 63, wr = wid >> 2, wc = wid & 3, fr = lane & 15, fq = lane >> 4;
    const int K = g.K, nt = K / BK;
    unsigned voffA[2], voffB[2];
#pragma unroll
    for (int i = 0; i < 2; ++i) { int R, C; stage_rc(tid * 16 + i * 8192, R, C); const int Rb = Epi::PERM ? ((R & ~31) + perm32(R & 31)) : R;
        voffA[i] = (unsigned)(R * K + C) * 2u; voffB[i] = (unsigned)(Rb * K + C) * 2u; }
    const size_t kstep = (size_t)(BK * 2);
    const size_t hstep = (size_t)HALF * K * 2;
    const size_t tstep = 2 * hstep;
    const unsigned ldsw = (unsigned)wid * 1024u;
    const int aoff = lds_byte(wr * 64 + fr, fq * 8), boff = lds_byte(wc * 32 + fr, fq * 8);
#define PG8_SA(b, h) (((b) * 2 + (h)) * HTB)
#define PG8_SB(b, h) ((4 + (b) * 2 + (h)) * HTB)
#define PG8_STAGE(bufoff, gbase, voff) do { _Pragma("unroll") for (int _i = 0; _i < 2; ++_i) \
        __builtin_amdgcn_global_load_lds((const unsigned*)((const char*)(gbase) + (voff)[_i]), (PG8_LAS unsigned*)(lds + (bufoff) + ldsw + _i * 8192), 16, 0, 0); } while (0)
#define PG8_LDA(dst, b, h) do { _Pragma("unroll") for (int m = 0; m < 4; ++m) _Pragma("unroll") for (int k = 0; k < 2; ++k) dst[m][k] = *(const PG8_LAS bf16x8*)(lds + PG8_SA(b, h) + aoff + m * 2048 + k * 1024); } while (0)
#define PG8_LDB(dst, b, h) do { _Pragma("unroll") for (int n = 0; n < 2; ++n) _Pragma("unroll") for (int k = 0; k < 2; ++k) dst[n][k] = *(const PG8_LAS bf16x8*)(lds + PG8_SB(b, h) + boff + n * 2048 + k * 1024); } while (0)
#define PG8_MMA(ai, bj, At, Bt) do { __builtin_amdgcn_s_setprio(1); _Pragma("unroll") for (int m = 0; m < 4; ++m) _Pragma("unroll") for (int n = 0; n < 2; ++n) _Pragma("unroll") for (int k = 0; k < 2; ++k) \
        acc[ai][bj][m][n] = __builtin_amdgcn_mfma_f32_16x16x32_bf16(Bt[n][k], At[m][k], acc[ai][bj][m][n], 0, 0, 0); __builtin_amdgcn_s_setprio(0); } while (0)
#define PG8_WAIT_V(n) asm volatile("s_waitcnt vmcnt(" #n ")" ::: "memory")
#define PG8_WAIT_L(n) asm volatile("s_waitcnt lgkmcnt(" #n ")" ::: "memory")
#define PG8_BAR __builtin_amdgcn_s_barrier()
#define PG8_SCHED __builtin_amdgcn_sched_barrier(0)
    Unit cur, nxt; int ui = 0;
    if (!S.next(0, cur)) return;
    f32x4 acc[2][2][4][2];
#pragma unroll
    for (int a = 0; a < 2; ++a)
#pragma unroll
        for (int b = 0; b < 2; ++b)
#pragma unroll
            for (int m = 0; m < 4; ++m)
#pragma unroll
                for (int n = 0; n < 2; ++n) acc[a][b][m][n] = (f32x4){0.f, 0.f, 0.f, 0.f};
    bf16x8 At[4][2], B0[2][2], B1[2][2];
    const char* cA = (const char*)g.A + (size_t)cur.pm * tstep; const char* cB = (const char*)g.Bt + (size_t)cur.pn * tstep;
    S.a_ready(cur);
    if constexpr (SP2) {
        PG8_STAGE(PG8_SB(0, 0), cB, voffB); PG8_STAGE(PG8_SB(0, 1), cB + hstep, voffB); PG8_STAGE(PG8_SA(0, 0), cA, voffA); PG8_STAGE(PG8_SA(0, 1), cA + hstep, voffA);
        if (wr == 1) PG8_BAR;
        PG8_WAIT_V(2); PG8_BAR;
        PG8_STAGE(PG8_SB(1, 0), cB + kstep, voffB); PG8_STAGE(PG8_SA(1, 0), cA + kstep, voffA); PG8_STAGE(PG8_SB(1, 1), cB + hstep + kstep, voffB);
        PG8_WAIT_V(6); PG8_BAR;
    } else {
        PG8_STAGE(PG8_SB(0, 0), cB, voffB); PG8_STAGE(PG8_SA(0, 0), cA, voffA); PG8_STAGE(PG8_SB(0, 1), cB + hstep, voffB); PG8_STAGE(PG8_SA(0, 1), cA + hstep, voffA);
        if (wr == 1) PG8_BAR;
        PG8_WAIT_V(4); PG8_BAR;
        PG8_STAGE(PG8_SB(1, 0), cB + kstep, voffB); PG8_STAGE(PG8_SA(1, 0), cA + kstep, voffA); PG8_STAGE(PG8_SB(1, 1), cB + hstep + kstep, voffB);
        PG8_WAIT_V(6); PG8_BAR;
    }
    for (;;) {
        const bool has_next = S.next(ui + 1, nxt);
        const char* nA = has_next ? (const char*)g.A + (size_t)nxt.pm * tstep : cA; const char* nB = has_next ? (const char*)g.Bt + (size_t)nxt.pn * tstep : cB;
        for (int t = 0; t < nt; t += 2) {
            if constexpr (Epi::MID) { if (t == E.mid_t) E.mid(acc, cur, wr, wc, fr, fq); }
            const bool last = (t == nt - 2);
            const char* a1 = cA + (size_t)(t + 1) * kstep;
            const char* a2 = last ? nA : cA + (size_t)(t + 2) * kstep; const char* b2 = last ? nB : cB + (size_t)(t + 2) * kstep;
            const char* a3 = a2 + kstep; const char* b3 = b2 + kstep;
            if (last && has_next) S.a_ready(nxt);
            if constexpr (SP2) {
            PG8_LDB(B0, 0, 0); PG8_LDB(B1, 0, 1); PG8_SCHED; PG8_LDA(At, 0, 0); PG8_STAGE(PG8_SA(1, 1), a1 + hstep, voffA);
            PG8_WAIT_V(8); PG8_WAIT_L(0); PG8_BAR; PG8_MMA(0, 0, At, B0); PG8_MMA(0, 1, At, B1); PG8_BAR; PG8_SCHED;
            PG8_LDA(At, 0, 1); PG8_STAGE(PG8_SB(0, 0), b2, voffB); PG8_STAGE(PG8_SB(0, 1), b2 + hstep, voffB); PG8_STAGE(PG8_SA(0, 0), a2, voffA);
            PG8_WAIT_V(8); PG8_WAIT_L(0); PG8_BAR; PG8_MMA(1, 0, At, B0); PG8_MMA(1, 1, At, B1); PG8_BAR; PG8_SCHED;
            PG8_LDB(B0, 1, 0); PG8_LDB(B1, 1, 1); PG8_SCHED; PG8_LDA(At, 1, 0); PG8_STAGE(PG8_SA(0, 1), a2 + hstep, voffA);
            PG8_WAIT_V(8); PG8_WAIT_L(0); PG8_BAR; PG8_MMA(0, 0, At, B0); PG8_MMA(0, 1, At, B1); PG8_BAR; PG8_SCHED;
            PG8_LDA(At, 1, 1); PG8_STAGE(PG8_SB(1, 0), b3, voffB); PG8_STAGE(PG8_SB(1, 1), b3 + hstep, voffB); PG8_STAGE(PG8_SA(1, 0), a3, voffA);
            PG8_WAIT_V(8); PG8_WAIT_L(0); PG8_BAR; PG8_MMA(1, 0, At, B0); PG8_MMA(1, 1, At, B1); PG8_BAR; PG8_SCHED;
            } else {
            PG8_LDB(B0, 0, 0); PG8_SCHED; PG8_LDA(At, 0, 0); PG8_STAGE(PG8_SA(1, 1), a1 + hstep, voffA);
            PG8_WAIT_L(8); PG8_BAR; PG8_WAIT_L(0); PG8_MMA(0, 0, At, B0); PG8_BAR; PG8_SCHED;
            PG8_LDB(B1, 0, 1); PG8_STAGE(PG8_SB(0, 0), b2, voffB);
            PG8_BAR; PG8_WAIT_L(0); PG8_MMA(0, 1, At, B1); PG8_BAR;
            PG8_LDA(At, 0, 1); PG8_STAGE(PG8_SA(0, 0), a2, voffA);
            PG8_BAR; PG8_WAIT_L(0); PG8_MMA(1, 0, At, B0); PG8_BAR; PG8_SCHED;
            PG8_STAGE(PG8_SB(0, 1), b2 + hstep, voffB);
            PG8_WAIT_V(6); PG8_BAR; PG8_MMA(1, 1, At, B1); PG8_BAR;
            PG8_LDB(B0, 1, 0); PG8_SCHED; PG8_LDA(At, 1, 0); PG8_STAGE(PG8_SA(0, 1), a2 + hstep, voffA);
            PG8_WAIT_L(8); PG8_BAR; PG8_WAIT_L(0); PG8_MMA(0, 0, At, B0); PG8_BAR; PG8_SCHED;
            PG8_LDB(B1, 1, 1); PG8_STAGE(PG8_SB(1, 0), b3, voffB);
            PG8_BAR; PG8_WAIT_L(0); PG8_MMA(0, 1, At, B1); PG8_BAR;
            PG8_LDA(At, 1, 1); PG8_STAGE(PG8_SA(1, 0), a3, voffA);
            PG8_BAR; PG8_WAIT_L(0); PG8_MMA(1, 0, At, B0); PG8_BAR; PG8_SCHED;
            PG8_STAGE(PG8_SB(1, 1), b3 + hstep, voffB);
            PG8_WAIT_V(6); PG8_BAR; PG8_MMA(1, 1, At, B1); PG8_BAR;
            }
        }
        if constexpr (ALIGN_EPI) { if (wr == 0) PG8_BAR; }
        if constexpr (!Epi::AFTER_DRAIN) { E(acc, cur, wr, wc, fr, fq); if (PG8_EPI_DUP) { asm volatile("" ::: "memory"); E(acc, cur, wr, wc, fr, fq); } S.done(cur); }
        if (!has_next) break;
#pragma unroll
        for (int a = 0; a < 2; ++a)
#pragma unroll
            for (int b = 0; b < 2; ++b)
#pragma unroll
                for (int m = 0; m < 4; ++m)
#pragma unroll
                    for (int n = 0; n < 2; ++n) acc[a][b][m][n] = (f32x4){0.f, 0.f, 0.f, 0.f};
        cur = nxt; cA = nA; cB = nB; ++ui;
        if constexpr (ALIGN_EPI) { if (wr == 1) PG8_BAR; }
    }
    PG8_WAIT_V(0);
    if constexpr (!ALIGN_EPI) { if (wr == 0) PG8_BAR; }
    PG8_BAR;
    if constexpr (Epi::AFTER_DRAIN) { E.fused(acc, cur, wr, wc, fr, fq, lds, wid, lane); S.done(cur); }
#undef PG8_SA
#undef PG8_SB
#undef PG8_STAGE
#undef PG8_LDA
#undef PG8_LDB
#undef PG8_MMA
#undef PG8_WAIT_V
#undef PG8_WAIT_L
#undef PG8_BAR
#undef PG8_SCHED
}
}


namespace att {
typedef unsigned short bf16_t;
typedef short bf16x8 __attribute__((ext_vector_type(8)));
typedef short s16x4 __attribute__((ext_vector_type(4)));
typedef float f32x16 __attribute__((ext_vector_type(16)));
typedef float f32x4 __attribute__((ext_vector_type(4)));
typedef unsigned u32x4 __attribute__((ext_vector_type(4)));
#define ATT_LAS __attribute__((address_space(3)))
#ifndef ATT_THR
#define ATT_THR 8.0f
#endif
#ifndef ATT_SKIP
#define ATT_SKIP 0
#endif
#ifndef ATT_NOCOMPUTE
#define ATT_NOCOMPUTE 0
#endif
#ifndef ATT_PRIO
#define ATT_PRIO 1
#endif
#ifndef SB_EARLY_EXIT
#define SB_EARLY_EXIT 1
#endif
constexpr int KVBLK = 64, QB = 256;
constexpr int SHM_V = 16384, SHM_K = 16384, SHM_R = 8192;
#ifndef ATT_SKEW
#define ATT_SKEW 0
#endif
constexpr int NVS = (ATT_SKEW != 0) ? 4 : 3, NKS = 3;
constexpr int OFF_V = 0, OFF_K = NVS * SHM_V, OFF_R = OFF_K + NKS * SHM_K, OFF_WS = OFF_R + NKS * SHM_R, OFF_FLAG = OFF_WS + 8 * 256, ATT_LDS_BYTES = OFF_FLAG + 64;
#define KSWZ(row, colB) ((row) * 256 + ((colB) ^ (((row) & 7) << 4)))
#define RSWZ(row, colB) ((row) * 128 + ((colB) ^ (((row) & 7) << 4)))
#define SBAR() __builtin_amdgcn_sched_barrier(0)
__device__ __forceinline__ int v_st(int k, int c) { const int kk = (k & ~0xC) | ((k & 4) << 1) | ((k & 8) >> 1); return ((kk >> 3) * 4 + (c >> 5)) * 512 + ((kk & 7) * 32 + (c & 31)) * 2; }
__device__ __forceinline__ int v_rd_base(int lane) { return ((lane & 3) << 3) | (((lane >> 2) & 3) << 6) | (((lane >> 4) & 1) << 5) | (((lane >> 5) & 1) << 8); }
__device__ __forceinline__ int crow(int r, int hi) { return (r & 3) + 8 * (r >> 2) + 4 * hi; }
__device__ __forceinline__ unsigned cvtpk(float lo, float hi) { unsigned r; asm volatile("v_cvt_pk_bf16_f32 %0, %1, %2" : "=v"(r) : "v"(lo), "v"(hi)); return r; }
__device__ __forceinline__ float other_half(float x, int hi) { auto rr = __builtin_amdgcn_permlane32_swap(__float_as_uint(x), __float_as_uint(x), false, false); return __uint_as_float(hi ? rr[0] : rr[1]); }

__device__ __forceinline__ void pack_p(const f32x16& p0, const f32x16& p1, bf16x8& pa0, bf16x8& pa1, bf16x8& pa2, bf16x8& pa3) {
#define PK4(P, B_, OUT) do { unsigned a0 = cvtpk(P[B_+0], P[B_+1]), a1 = cvtpk(P[B_+2], P[B_+3]);                          \
        unsigned b0 = cvtpk(P[B_+4], P[B_+5]), b1 = cvtpk(P[B_+6], P[B_+7]);                                             \
        auto r0 = __builtin_amdgcn_permlane32_swap(a0, b0, false, false); auto r1 = __builtin_amdgcn_permlane32_swap(a1, b1, false, false); \
        u32x4 w = {r0[0], r1[0], r0[1], r1[1]}; OUT = __builtin_bit_cast(bf16x8, w); } while (0)
    PK4(p0, 0, pa0); PK4(p0, 8, pa1); PK4(p1, 0, pa2); PK4(p1, 8, pa3);
#undef PK4
}
__device__ __forceinline__ void pv_tile(f32x16* o, int vb, bf16x8 pa0, bf16x8 pa1, bf16x8 pa2, bf16x8 pa3) {
#define TRRD(dst, off) asm volatile("ds_read_b64_tr_b16 %0, %1 offset:%2" : "=&v"(dst) : "v"(vb), "i"(off) : "memory")
#define PV_D0(d0) do { s16x4 l0, l1, l2, l3, h0, h1, h2, h3; constexpr int b_ = (d0) * 512;   \
        TRRD(l0, b_); TRRD(h0, b_ + 2048); TRRD(l1, b_ + 4096); TRRD(h1, b_ + 6144); TRRD(l2, b_ + 8192); TRRD(h2, b_ + 10240); TRRD(l3, b_ + 12288); TRRD(h3, b_ + 14336); \
        asm volatile("s_waitcnt lgkmcnt(0)" ::: "memory"); SBAR();   \
        o[d0] = __builtin_amdgcn_mfma_f32_32x32x16_bf16((bf16x8){l0[0], l0[1], l0[2], l0[3], h0[0], h0[1], h0[2], h0[3]}, pa0, o[d0], 0, 0, 0);   \
        o[d0] = __builtin_amdgcn_mfma_f32_32x32x16_bf16((bf16x8){l1[0], l1[1], l1[2], l1[3], h1[0], h1[1], h1[2], h1[3]}, pa1, o[d0], 0, 0, 0);   \
        o[d0] = __builtin_amdgcn_mfma_f32_32x32x16_bf16((bf16x8){l2[0], l2[1], l2[2], l2[3], h2[0], h2[1], h2[2], h2[3]}, pa2, o[d0], 0, 0, 0);   \
        o[d0] = __builtin_amdgcn_mfma_f32_32x32x16_bf16((bf16x8){l3[0], l3[1], l3[2], l3[3], h3[0], h3[1], h3[2], h3[3]}, pa3, o[d0], 0, 0, 0); } while (0)
    PV_D0(0); PV_D0(1); PV_D0(2); PV_D0(3);
#undef PV_D0
#undef TRRD
}

template <bool SB>
__device__ __forceinline__ void attn_block(ATT_LAS unsigned char* lds, const bf16_t* Qg, int ldq, const bf16_t* Kg, int ldk, const bf16_t* Vg, int ldv, const bf16_t* Rg, bf16_t* Og, int ldo, float* Sq  , int P0) {
    constexpr int NQ = SB ? 8 : 12;
    constexpr int NDMA = SB ? 4 : 5;
    int tid_ = threadIdx.x; asm volatile("" : "+v"(tid_));
    const int tid = tid_, wid = __builtin_amdgcn_readfirstlane(tid >> 6), lane = tid & 63, r32 = lane & 31, hi = lane >> 5;
    const int qlo = P0 + wid * 32;
    const int NT = (P0 + QB) / KVBLK;
    ATT_LAS unsigned char* V_lds = lds + OFF_V; ATT_LAS unsigned char* K_lds = lds + OFF_K; ATT_LAS unsigned char* R_lds = lds + OFF_R;
    ATT_LAS float* ws = (ATT_LAS float*)(lds + OFF_WS) + wid * 64;
    ATT_LAS unsigned* flags = (ATT_LAS unsigned*)(lds + OFF_FLAG);
    const int vb0 = (int)(unsigned)(uintptr_t)V_lds + v_rd_base(lane);
    int kofs, vofs, rofs;
    { const int row = 4 * wid + (lane >> 4); kofs = row * ldk + ((((lane & 15) * 16) ^ ((row & 7) << 4)) >> 1); }
    { const int sub = 2 * wid + (lane >> 5), kk = (sub >> 2) * 8 + ((lane & 31) >> 2), k = (kk & ~0xC) | ((kk & 4) << 1) | ((kk & 8) >> 1); vofs = k * ldv + (sub & 3) * 32 + (lane & 3) * 8; }
    { const int row = 8 * wid + (lane >> 3); rofs = row * 64 + ((((lane & 7) ^ (row & 7)) * 16) >> 1); }
#define STAGE_DMA(t_, ks_, vs_) do { const size_t k0_ = (size_t)(t_) * KVBLK;                                                                                   \
        __builtin_amdgcn_global_load_lds((const unsigned*)(Kg + k0_ * ldk + kofs), (ATT_LAS unsigned*)(K_lds + (ks_) * SHM_K + wid * 1024), 16, 0, 0);                 \
        __builtin_amdgcn_global_load_lds((const unsigned*)(Kg + (k0_ + 32) * ldk + kofs), (ATT_LAS unsigned*)(K_lds + (ks_) * SHM_K + 8192 + wid * 1024), 16, 0, 0);   \
        __builtin_amdgcn_global_load_lds((const unsigned*)(Vg + k0_ * ldv + vofs), (ATT_LAS unsigned*)(V_lds + (vs_) * SHM_V + wid * 1024), 16, 0, 0);                 \
        __builtin_amdgcn_global_load_lds((const unsigned*)(Vg + (k0_ + 32) * ldv + vofs), (ATT_LAS unsigned*)(V_lds + (vs_) * SHM_V + 8192 + wid * 1024), 16, 0, 0);   \
        if (!SB) __builtin_amdgcn_global_load_lds((const unsigned*)(Rg + k0_ * 64 + rofs), (ATT_LAS unsigned*)(R_lds + (ks_) * SHM_R + wid * 1024), 16, 0, 0); } while (0)
#define TILE_OF(it_) (SB ? NT - 1 - (it_) : (it_))
#define WAIT_BAR(n_) do { if ((n_) == 0) asm volatile("s_waitcnt vmcnt(0) lgkmcnt(0)\n\ts_barrier" ::: "memory"); else if (SB) asm volatile("s_waitcnt vmcnt(4) lgkmcnt(0)\n\ts_barrier" ::: "memory"); else asm volatile("s_waitcnt vmcnt(5) lgkmcnt(0)\n\ts_barrier" ::: "memory"); } while (0)
    bf16x8 qr[NQ];
#pragma unroll
    for (int d0 = 0; d0 < NQ; ++d0) qr[d0] = *(const bf16x8*)(Qg + (size_t)(wid * 32 + r32) * ldq + d0 * 16 + hi * 8);
    f32x16 o[4];
#pragma unroll
    for (int d = 0; d < 4; ++d)
#pragma unroll
        for (int r = 0; r < 16; ++r) o[d][r] = 0.f;
    float m_reg = 0.f, l_reg = 0.f, R = 1.f; bool first_tile = true;
    int kro[4];
#pragma unroll
    for (int dd = 0; dd < 4; ++dd) kro[dd] = KSWZ(r32, (dd * 16 + hi * 8) * 2);
    STAGE_DMA(TILE_OF(0), 0, 0);
    if (NT > 1) { STAGE_DMA(TILE_OF(1), 1, 1); WAIT_BAR(NDMA); } else WAIT_BAR(0);
    const bool skew = ATT_SKEW && (ATT_SKEW == 1 ? wid >= 4 : (ATT_SKEW == 2 ? (wid & 1) : ((wid >> 1) & 1)));
    f32x16 p0, p1;
    bool pend = false; int pend_kb = 0, pend_vs = 0;
    int vs = 0, ks = 0, nt_eff = NT;
    for (int it = 0; it < nt_eff + ((ATT_SKEW != 0) ? 1 : 0); ++it) {
        const bool tile = it < nt_eff;
        const int t = TILE_OF(it); const int buf = it & 1; const bool more2 = tile && it + 2 < NT;
        { const int ks2 = ks == 0 ? 2 : ks - 1, vs2 = vs + 2 >= NVS ? vs + 2 - NVS : vs + 2;
          if (more2) STAGE_DMA(TILE_OF(it + 2), ks2, vs2); }
        const int kb = t * KVBLK;
        const bool act = tile && kb <= qlo + 31 && !ATT_NOCOMPUTE;
        bool do_sm; int sm_kb, sm_vs;
        if (!skew) { do_sm = act; sm_kb = kb; sm_vs = vs;
            if (act) {
#pragma unroll
            for (int r = 0; r < 16; ++r) { p0[r] = SB ? 0.f : -m_reg; p1[r] = SB ? 0.f : -m_reg; }
            ATT_LAS const unsigned char* kt = K_lds + ks * SHM_K;
            __builtin_amdgcn_s_setprio(ATT_PRIO);
            if (ATT_SKIP & 1) { p0[0] = (float)r32; p1[3] = (float)hi; } else {
#pragma unroll
            for (int d0 = 0; d0 < 8; ++d0) { ATT_LAS const unsigned char* a = kt + kro[d0 & 3] + (d0 >> 2) * 128;
                const bf16x8 b0 = *(ATT_LAS const bf16x8*)a; const bf16x8 b1 = *(ATT_LAS const bf16x8*)(a + 32 * 256);
                p0 = __builtin_amdgcn_mfma_f32_32x32x16_bf16(b0, qr[d0], p0, 0, 0, 0);
                p1 = __builtin_amdgcn_mfma_f32_32x32x16_bf16(b1, qr[d0], p1, 0, 0, 0); }
            if (!SB) { ATT_LAS const unsigned char* rt = R_lds + ks * SHM_R;
#pragma unroll
                for (int d0 = 0; d0 < 4; ++d0) { ATT_LAS const unsigned char* a = rt + (kro[d0] - 128 * r32);
                    const bf16x8 b0 = *(ATT_LAS const bf16x8*)a; const bf16x8 b1 = *(ATT_LAS const bf16x8*)(a + 32 * 128);
                    const bf16x8 qf = qr[SB ? 0 : 8 + d0];
                    p0 = __builtin_amdgcn_mfma_f32_32x32x16_bf16(b0, qf, p0, 0, 0, 0);
                    p1 = __builtin_amdgcn_mfma_f32_32x32x16_bf16(b1, qf, p1, 0, 0, 0); } }
            }
            __builtin_amdgcn_s_setprio(0);
            }
        } else { do_sm = pend; sm_kb = pend_kb; sm_vs = pend_vs; }
        if (do_sm) {
            const int dql = qlo + r32 - sm_kb - 4 * hi - (SB ? 1 : 0);
            const bool need_mask = SB ? (sm_kb + KVBLK - 1 >= qlo) : (sm_kb + KVBLK - 1 > qlo);
            bf16x8 pa0, pa1, pa2, pa3;
            if (ATT_SKIP & 2) { pa0 = __builtin_bit_cast(bf16x8, (f32x4){p0[0], p0[5], p0[10], p0[15]}); pa1 = __builtin_bit_cast(bf16x8, (f32x4){p1[0], p1[5], p1[10], p1[15]}); pa2 = pa0; pa3 = pa1; }
            else if (!SB) {
                if (need_mask) { const float NEG = -__builtin_inff();
#pragma unroll
                    for (int r = 0; r < 16; ++r) { const int c = (r & 3) + 8 * (r >> 2); if (c > dql) p0[r] = NEG; if (c + 32 > dql) p1[r] = NEG; } }
                float pmax = p0[0];
#pragma unroll
                for (int r = 1; r < 16; ++r) pmax = fmaxf(pmax, p0[r]);
#pragma unroll
                for (int r = 0; r < 16; ++r) pmax = fmaxf(pmax, p1[r]);
                pmax = fmaxf(pmax, other_half(pmax, hi));
                if (first_tile || __any(pmax > ATT_THR)) { const float dl = first_tile ? pmax : fmaxf(pmax, 0.f);
                    m_reg += dl;
#pragma unroll
                    for (int r = 0; r < 16; ++r) { p0[r] -= dl; p1[r] -= dl; }
                    if (!first_tile) { const float alpha = __builtin_amdgcn_exp2f(-dl); l_reg *= alpha;
#pragma unroll
                        for (int d = 0; d < 4; ++d)
#pragma unroll
                            for (int r = 0; r < 16; ++r) o[d][r] *= alpha; }
                    first_tile = false; }
                float ps = 0.f;
#pragma unroll
                for (int r = 0; r < 16; ++r) { p0[r] = __builtin_amdgcn_exp2f(p0[r]); ps += p0[r]; }
#pragma unroll
                for (int r = 0; r < 16; ++r) { p1[r] = __builtin_amdgcn_exp2f(p1[r]); ps += p1[r]; }
                ps += other_half(ps, hi);
                l_reg += ps;
                pack_p(p0, p1, pa0, pa1, pa2, pa3);
            } else {
                f32x16 l0, l1;
#pragma unroll
                for (int r = 0; r < 16; ++r) { const float e = __builtin_amdgcn_exp2f(fminf(-p0[r], 126.f)); const float be = __builtin_amdgcn_rcpf(1.0f + e); p0[r] = be; l0[r] = e * be; }
#pragma unroll
                for (int r = 0; r < 16; ++r) { const float e = __builtin_amdgcn_exp2f(fminf(-p1[r], 126.f)); const float be = __builtin_amdgcn_rcpf(1.0f + e); p1[r] = be; l1[r] = e * be; }
                if (need_mask) {
#pragma unroll
                    for (int r = 0; r < 16; ++r) { const int c = (r & 3) + 8 * (r >> 2); if (c > dql) { p0[r] = 0.f; l0[r] = 1.f; } if (c + 32 > dql) { p1[r] = 0.f; l1[r] = 1.f; } } }
                float T[8];
#pragma unroll
                for (int g = 0; g < 4; ++g) {
                    { const float a0 = l0[4 * g], a1 = l0[4 * g + 1], a2 = l0[4 * g + 2], a3 = l0[4 * g + 3]; const float x2 = a3, x1 = a3 * a2, x0 = x1 * a1; T[g] = x0 * a0;
                      l0[4 * g] = x0; l0[4 * g + 1] = x1; l0[4 * g + 2] = x2; l0[4 * g + 3] = 1.f; }
                    { const float a0 = l1[4 * g], a1 = l1[4 * g + 1], a2 = l1[4 * g + 2], a3 = l1[4 * g + 3]; const float x2 = a3, x1 = a3 * a2, x0 = x1 * a1; T[4 + g] = x0 * a0;
                      l1[4 * g] = x0; l1[4 * g + 1] = x1; l1[4 * g + 2] = x2; l1[4 * g + 3] = 1.f; }
                }
                float gs[8]; float run = R;
#pragma unroll
                for (int g = 7; g >= 0; --g) { const float To = other_half(T[g], hi); gs[g] = hi == 0 ? run * To : run; run *= T[g] * To; }
                R = run;
#pragma unroll
                for (int g = 0; g < 4; ++g)
#pragma unroll
                    for (int i = 0; i < 4; ++i) { p0[4 * g + i] = p0[4 * g + i] * (l0[4 * g + i] * gs[g]); p1[4 * g + i] = p1[4 * g + i] * (l1[4 * g + i] * gs[4 + g]); }
                pack_p(p0, p1, pa0, pa1, pa2, pa3);
            }
            if (!(ATT_SKIP & 4)) { __builtin_amdgcn_s_setprio(ATT_PRIO); pv_tile(o, vb0 + sm_vs * SHM_V, pa0, pa1, pa2, pa3); __builtin_amdgcn_s_setprio(0); } else { o[0][0] += __builtin_bit_cast(f32x4, pa0)[0] + __builtin_bit_cast(f32x4, pa1)[0] + __builtin_bit_cast(f32x4, pa2)[0] + __builtin_bit_cast(f32x4, pa3)[0]; }
        }
        if (skew) { pend = act; pend_kb = kb; pend_vs = vs;
            if (act) {
#pragma unroll
            for (int r = 0; r < 16; ++r) { p0[r] = SB ? 0.f : -m_reg; p1[r] = SB ? 0.f : -m_reg; }
            ATT_LAS const unsigned char* kt = K_lds + ks * SHM_K;
            __builtin_amdgcn_s_setprio(ATT_PRIO);
            if (ATT_SKIP & 1) { p0[0] = (float)r32; p1[3] = (float)hi; } else {
#pragma unroll
            for (int d0 = 0; d0 < 8; ++d0) { ATT_LAS const unsigned char* a = kt + kro[d0 & 3] + (d0 >> 2) * 128;
                const bf16x8 b0 = *(ATT_LAS const bf16x8*)a; const bf16x8 b1 = *(ATT_LAS const bf16x8*)(a + 32 * 256);
                p0 = __builtin_amdgcn_mfma_f32_32x32x16_bf16(b0, qr[d0], p0, 0, 0, 0);
                p1 = __builtin_amdgcn_mfma_f32_32x32x16_bf16(b1, qr[d0], p1, 0, 0, 0); }
            if (!SB) { ATT_LAS const unsigned char* rt = R_lds + ks * SHM_R;
#pragma unroll
                for (int d0 = 0; d0 < 4; ++d0) { ATT_LAS const unsigned char* a = rt + (kro[d0] - 128 * r32);
                    const bf16x8 b0 = *(ATT_LAS const bf16x8*)a; const bf16x8 b1 = *(ATT_LAS const bf16x8*)(a + 32 * 128);
                    const bf16x8 qf = qr[SB ? 0 : 8 + d0];
                    p0 = __builtin_amdgcn_mfma_f32_32x32x16_bf16(b0, qf, p0, 0, 0, 0);
                    p1 = __builtin_amdgcn_mfma_f32_32x32x16_bf16(b1, qf, p1, 0, 0, 0); } }
            }
            __builtin_amdgcn_s_setprio(0);
            }
        }
        if (SB && SB_EARLY_EXIT && tile) { const bool dead = __all(R == 0.f); if (lane == 0) flags[buf * 8 + wid] = dead ? 1u : 0u; }
        asm volatile("" ::: "memory");
        if (more2) WAIT_BAR(NDMA); else WAIT_BAR(0);
        asm volatile("" ::: "memory");
        if (SB && SB_EARLY_EXIT && tile) { const u32x4 f0 = *(ATT_LAS const u32x4*)(flags + buf * 8), f1 = *(ATT_LAS const u32x4*)(flags + buf * 8 + 4);
            if ((f0[0] & f0[1] & f0[2] & f0[3] & f1[0] & f1[1] & f1[2] & f1[3]) != 0u) nt_eff = it + 1; }
        vs = vs + 1 == NVS ? 0 : vs + 1; ks = ks == 2 ? 0 : ks + 1;
    }
    { const float rl = SB ? 1.0f : ((ATT_NOCOMPUTE && !(l_reg > 0.f)) ? 0.f : 1.0f / l_reg);
      unsigned char* rowb = (unsigned char*)(Og + (size_t)(wid * 32 + r32) * ldo) + (hi ? 16 : 0);
      { float sq = 0.f;
#pragma unroll
        for (int d = 0; d < 4; ++d)
#pragma unroll
            for (int r = 0; r < 16; ++r) { const float v = o[d][r] * rl; sq += v * v; }
        sq += other_half(sq, hi);
        if (hi == 0) Sq[(size_t)(wid * 32 + r32) * 16] = sq; }
#pragma unroll
      for (int k = 0; k < 16; k += 2) { const int d0 = k >> 2, ra = (k & 3) * 4, rb = ra + 4;
          unsigned ax = cvtpk(o[d0][ra] * rl, o[d0][ra + 1] * rl), ay = cvtpk(o[d0][ra + 2] * rl, o[d0][ra + 3] * rl);
          unsigned bx = cvtpk(o[d0][rb] * rl, o[d0][rb + 1] * rl), by = cvtpk(o[d0][rb + 2] * rl, o[d0][rb + 3] * rl);
          auto sx = __builtin_amdgcn_permlane32_swap(ax, bx, false, false); auto sy = __builtin_amdgcn_permlane32_swap(ay, by, false, false);
          *(u32x4*)(rowb + 16 * k) = (u32x4){sx[0], sy[0], sx[1], sy[1]}; } }
    asm volatile("" ::: "memory");
    asm volatile("s_waitcnt vmcnt(0) lgkmcnt(0)\n\ts_barrier" ::: "memory");
    asm volatile("" ::: "memory");
#undef STAGE_DMA
#undef TILE_OF
#undef WAIT_BAR
}
#undef KSWZ
#undef RSWZ
}

#ifdef DUP_LN
#define DUP_LN_ANY DUP_LN
#else
#define DUP_LN_ANY 0
#endif

constexpr int NWAVES = 8;
constexpr int D = 2048, BATCH = 4, SEQ = 4096, DEPTH = 4, M = BATCH * SEQ, FF = 5632, NADA = 9;
constexpr int QLR = 768, KVLR = 512, ROPE_D = 64, NH = 8, HD = 128, QKD = 192;
constexpr int IN_COLS = QLR + KVLR + ROPE_D + 3 * NH * HD;
constexpr int WIN_ROWS = 4608;
constexpr float LN_EPS = 1e-5f, RMS_EPS = 1e-6f;
constexpr float DN_ALPHA = 1.6817928305074290f;
constexpr float LOG2E = 1.4426950408889634f;
constexpr float MLA_QSCALE = 0.07216878364870322f * LOG2E;
constexpr float SB_QSCALE = 0.08838834764831845f * LOG2E;
#ifndef MK_ONE_LAUNCH
#define MK_ONE_LAUNCH 1
#endif
constexpr int N_PHASES = 3 + 8 * 3 + 4 * 5;

constexpr size_t MiB = 1u << 20;
#ifndef TPROBE
#define TPROBE 0
#endif
constexpr size_t WS_CTL = 0, CTL_ZERO_BYTES = TPROBE ? 1 * MiB : 64 * 1024;
constexpr size_t WS_ADA = 1 * MiB;
constexpr size_t WS_ADAP = 3 * MiB;
constexpr size_t WS_VEC = 22 * MiB;
constexpr size_t WS_ROPE = 24 * MiB;
constexpr size_t WS_SSQ = 28 * MiB;
constexpr size_t WS_KPE = 30 * MiB;
constexpr size_t WS_HL = 32 * MiB;
constexpr size_t WS_OSSQ = 64 * MiB;
constexpr size_t WS_H = 160 * MiB;
constexpr size_t WS_F = 224 * MiB;
constexpr size_t WS_ACT = 288 * MiB;
constexpr size_t WS_CQ = 464 * MiB;
constexpr size_t WS_CKV = 488 * MiB;
constexpr size_t WS_SBQ = 504 * MiB, WS_SBK = 536 * MiB, WS_SBV = 568 * MiB;
constexpr size_t WS_QM = 600 * MiB;
constexpr size_t WS_KV = 648 * MiB;
constexpr size_t WS_O = 712 * MiB;
constexpr size_t WS_W = 776 * MiB;
constexpr size_t W_WI = (size_t)2 * FF * D * 2, W_WO = (size_t)D * FF * 2, W_WIN = (size_t)WIN_ROWS * D * 2, W_WUQ = (size_t)NH * QKD * QLR * 2, W_WUKV = (size_t)NH * 256 * KVLR * 2, W_WOUT = (size_t)D * D * 2;
constexpr size_t WO_WI1 = 0, WO_WO1 = WO_WI1 + W_WI, WO_WI2 = WO_WO1 + W_WO, WO_WO2 = WO_WI2 + W_WI, WO_WIN = WO_WO2 + W_WO, WO_WUQ = WO_WIN + W_WIN, WO_WUKV = WO_WUQ + W_WUQ, WO_WOUT = WO_WUKV + W_WUKV;
constexpr size_t W_LAYER = WO_WOUT + W_WOUT;
constexpr size_t WS_DUMMY = WS_W + DEPTH * W_LAYER;
constexpr size_t WS_END = WS_DUMMY + (size_t)(DUP_LN_ANY ? 128 : 0) * MiB;
static_assert(W_LAYER % 256 == 0 && WS_END < (size_t)1700 * MiB, "ws map");
constexpr int ADA_KS = 16;
constexpr int CW_BAR = 4096;

constexpr int RING_OFF = 0, SCR_BYTES = 147200;
constexpr int MISC_OFF = SCR_BYTES;
constexpr int LDS_BYTES = 147456;

#define GAS __attribute__((address_space(1)))
#define LAS __attribute__((address_space(3)))
typedef unsigned short bf16;
typedef unsigned v4u __attribute__((ext_vector_type(4)));
typedef unsigned v2u __attribute__((ext_vector_type(2)));
typedef float f32x4 __attribute__((ext_vector_type(4)));
#define LDS_WAIT() asm volatile("s_waitcnt lgkmcnt(0)" ::: "memory")
#define VM_WAIT() asm volatile("s_waitcnt vmcnt(0)" ::: "memory")
__device__ __forceinline__ unsigned pk2(float lo, float hi) { unsigned r; asm volatile("v_cvt_pk_bf16_f32 %0, %1, %2" : "=v"(r) : "v"(lo), "v"(hi)); return r; }
__device__ __forceinline__ float bf_lo(unsigned w) { return __uint_as_float(w << 16); }
__device__ __forceinline__ float bf_hi(unsigned w) { return __uint_as_float(w & 0xffff0000u); }
__device__ __forceinline__ float wave_sum(float v) {
    v += __builtin_bit_cast(float, __builtin_amdgcn_update_dpp(0, __builtin_bit_cast(int, v), 0xB1, 0xF, 0xF, false));
    v += __builtin_bit_cast(float, __builtin_amdgcn_update_dpp(0, __builtin_bit_cast(int, v), 0x4E, 0xF, 0xF, false));
    v += __builtin_bit_cast(float, __builtin_amdgcn_update_dpp(0, __builtin_bit_cast(int, v), 0x124, 0xF, 0xF, false));
    v += __builtin_bit_cast(float, __builtin_amdgcn_update_dpp(0, __builtin_bit_cast(int, v), 0x128, 0xF, 0xF, false));
    { auto a = __builtin_amdgcn_permlane16_swap(__float_as_uint(v), __float_as_uint(v), false, false); v = __uint_as_float(a[0]) + __uint_as_float(a[1]); }
    { auto b = __builtin_amdgcn_permlane32_swap(__float_as_uint(v), __float_as_uint(v), false, false); v = __uint_as_float(b[0]) + __uint_as_float(b[1]); }
    return v;
}

#define XB_TMO      128
#define XB_XCNT(j)  (256  + 64 * (j))
#define XB_XSUB(j)  (1280 + 64 * (j))
#define XB_XGEN(j)  (2304 + 64 * (j))
#define XB_TOP      3328
#define XB_TOPGEN   3392
#define XCD_BAR_WORDS 3456
#define XB_SPIN_CAP (1u << 18)

__device__ __forceinline__ unsigned xb_ld(unsigned* p)              { return __hip_atomic_load(p, __ATOMIC_RELAXED, __HIP_MEMORY_SCOPE_AGENT); }
__device__ __forceinline__ unsigned xb_add(unsigned* p, unsigned v) { return __hip_atomic_fetch_add(p, v, __ATOMIC_RELAXED, __HIP_MEMORY_SCOPE_AGENT); }
__device__ __forceinline__ unsigned xb_xcc_id() { return (unsigned)__builtin_amdgcn_s_getreg((3 << 11) | 20) & 0xFu; }
#define XB_SPIN(cond, bar) do { unsigned _sp = 0; while (cond) { __builtin_amdgcn_s_sleep(1); \
    if ((++_sp & 255u) == 0u) { if (xb_ld(&(bar)[XB_TMO])) break; if (_sp > XB_SPIN_CAP) { atomicAdd(&(bar)[XB_TMO], 1u); break; } } } } while (0)

struct XcdBarrier {
    unsigned* bar; unsigned x;
    volatile LAS unsigned* st;
};

__device__ __forceinline__ XcdBarrier xcd_barrier_post(unsigned* bar, volatile LAS unsigned* st) {
    XcdBarrier b; b.bar = bar; b.x = xb_xcc_id(); b.st = st;
    if (threadIdx.x == 0) (void)xb_add(&bar[XB_XCNT(b.x)], 1u);
    return b;
}
__device__ __forceinline__ void xcd_barrier_complete(unsigned* bar, unsigned x, unsigned& nloc, unsigned& nx) {
    const unsigned G = gridDim.x * gridDim.y * gridDim.z;
    unsigned sum, cnt, mine, sp = 0u;
    for (;;) {
        sum = 0u; cnt = 0u; mine = 0u;
#pragma unroll 1
        for (unsigned j = 0; j < 16; ++j) { const unsigned c = xb_ld(&bar[XB_XCNT(j)]); sum += c; cnt += (c > 0u) ? 1u : 0u; mine = (j == x) ? c : mine; }
        if (sum == G) break;
        __builtin_amdgcn_s_sleep(1);
        if ((++sp & 255u) == 0u) { if (xb_ld(&bar[XB_TMO])) break; if (sp > XB_SPIN_CAP) { atomicAdd(&bar[XB_TMO], 1u); break; } }
    }
    nloc = mine > 0u ? mine : 1u; nx = cnt > 0u ? cnt : 1u;
}

__device__ __forceinline__ void xcd_barrier(const XcdBarrier& b) {
    asm volatile("s_waitcnt vmcnt(0)" ::: "memory");
    __syncthreads();
    if (threadIdx.x == 0) {
        unsigned* bar = b.bar;
        __builtin_amdgcn_s_waitcnt(0);
        unsigned nloc = b.st[0], nx = b.st[1];
        if (nloc == 0u) { xcd_barrier_complete(bar, b.x, nloc, nx); b.st[0] = nloc; b.st[1] = nx; }
        const unsigned old = xb_add(&bar[XB_XSUB(b.x)], 1u);
        const unsigned gen = old / nloc;
        if (old + 1u == (gen + 1u) * nloc) {
            __builtin_amdgcn_fence(__ATOMIC_RELEASE, "agent");
            asm volatile("s_waitcnt vmcnt(0)" ::: "memory");
            const unsigned og = xb_add(&bar[XB_TOP], 1u);
            const unsigned tg = og / nx;
            if (og + 1u == (tg + 1u) * nx) xb_add(&bar[XB_TOPGEN], 1u);
            else XB_SPIN(xb_ld(&bar[XB_TOPGEN]) == tg, bar);
            __builtin_amdgcn_fence(__ATOMIC_ACQUIRE, "agent");
            xb_add(&bar[XB_XGEN(b.x)], 1u);
            asm volatile("s_waitcnt vmcnt(0)" ::: "memory");
        } else {
            XB_SPIN(xb_ld(&bar[XB_XGEN(b.x)]) == gen, bar);
            __builtin_amdgcn_fence(__ATOMIC_ACQUIRE, "agent");
            asm volatile("s_waitcnt vmcnt(0)" ::: "memory");
        }
    }
    __syncthreads();
}

#ifndef LN_NS
#define LN_NS 1
#endif
#ifndef W_MANT_DROP
#define W_MANT_DROP 0
#endif
#ifndef TPROBE_SCALE
#define TPROBE_SCALE 1.0f
#endif
#ifndef TPROBE
#define TPROBE 0
#endif
#ifndef TPROBE_WG
#define TPROBE_WG 0
#endif
#ifndef TPROBE_A
#define TPROBE_A 6
#endif
#ifndef TPROBE_B
#define TPROBE_B 7
#endif
#ifndef G1_SP2
#define G1_SP2 true
#endif
#ifndef DUP_BAR
#define DUP_BAR 0
#endif
#ifndef G1_ALIGN
#define G1_ALIGN true
#endif
#ifndef GF_ALIGN
#define GF_ALIGN true
#endif
#ifndef DUP_ATT_WHICH
#define DUP_ATT_WHICH 3
#endif
#ifndef DUP_P0
#define DUP_P0 0
#endif
#ifndef DUP_P1
#define DUP_P1 0
#endif
#ifndef DUP_P2
#define DUP_P2 0
#endif
#ifndef DUP_G1
#define DUP_G1 0
#endif
#ifndef DUP_WIN
#define DUP_WIN 0
#endif
#ifndef DUP_UQKV
#define DUP_UQKV 0
#endif
#ifndef DUP_ATT
#define DUP_ATT 0
#endif
#ifndef DUP_ONORM
#define DUP_ONORM 0
#endif
#ifndef DUP_GF
#define DUP_GF 0
#endif
#ifndef DUP_LN
#define DUP_LN 0
#endif
#define REP(n) for (int rep_ = 0; rep_ < 1 + (n); ++rep_)
#ifndef P0_PARTS
#define P0_PARTS 7
#endif
#ifndef BG_ON
#define BG_ON 1
#endif
#ifndef BG_SITES
#define BG_SITES 31
#endif
#ifndef SITE_P0
#define SITE_P0 1
#endif
#ifndef SITE_P1
#define SITE_P1 1
#endif
#ifndef SITE_P2
#define SITE_P2 1
#endif
#ifndef SITE_ATT
#define SITE_ATT 3
#endif
#ifndef SITE_ONORM
#define SITE_ONORM 1
#endif
#ifndef SITE_G1
#define SITE_G1 1
#endif
#ifndef SITE_WIN
#define SITE_WIN 1
#endif
#ifndef SITE_UQKV
#define SITE_UQKV 1
#endif
#ifndef SITE_GF
#define SITE_GF 1
#endif
#ifndef SITE_LN
#define SITE_LN 1
#endif
#ifndef DBG_LAST_S
#define DBG_LAST_S (3 * DEPTH - 1)
#endif
#ifndef P0_PARTS
#define P0_PARTS 7
#endif
#ifndef BG_ON
#define BG_ON 1
#endif
#ifndef BG_SITES
#define BG_SITES 31
#endif

struct Frame {
    LAS unsigned char* lds;
    int tid, lane, wave;
    int vcu, G;
};

__device__ __forceinline__ int dst_row(int kind, int n) {
    if (kind == 1) { const int u = n >= FF ? 1 : 0, j = n - u * FF; return (j >> 7) * 256 + u * 128 + (j & 127); }
    if (kind == 2) { if (n < QLR + KVLR) return n; if (n < QLR + KVLR + ROPE_D) { const int j = n - (QLR + KVLR); return 4352 + (j < 32 ? 2 * j : 2 * (j - 32) + 1); } return n - ROPE_D; }
    if (kind == 3) { const int h = n / QKD, w = n - h * QKD; if (w < 128) return n; const int j = w - 128; return h * QKD + 128 + (j < 32 ? 2 * j : 2 * (j - 32) + 1); }
    return n;
}
__device__ __forceinline__ void tr_item(const float* __restrict__ W, int K, int N, bf16* __restrict__ WT, int kind, const float* __restrict__ gk, LAS float* scr, int item, int lane) {
    const int nblk = N >> 6, kb = item / nblk, nb = item - kb * nblk, k0 = kb << 6, n0 = nb << 6;
    const int kk4 = lane >> 4, n4 = (lane & 15) * 4;
    const float* src = W + (size_t)(k0 + kk4) * N + n0 + n4;
    f32x4 wv[16];
#pragma unroll
    for (int i = 0; i < 16; ++i) wv[i] = *(const f32x4*)(src + (size_t)(4 * i) * N);
#pragma unroll
    for (int i = 0; i < 16; ++i) { const int kk = 4 * i + kk4; f32x4 w = wv[i]; if (gk) w = w * gk[k0 + kk];
        LAS float* d = scr + kk * 65 + n4; d[0] = w[0]; d[1] = w[1]; d[2] = w[2]; d[3] = w[3]; }
    LDS_WAIT(); asm volatile("" ::: "memory");
    const int c = lane & 7;
#pragma unroll
    for (int j = 0; j < 8; ++j) { const int n = (lane >> 3) + 8 * j; const LAS float* s = scr + (8 * c) * 65 + n;
        v4u o; o.x = pk2(s[0 * 65], s[1 * 65]); o.y = pk2(s[2 * 65], s[3 * 65]); o.z = pk2(s[4 * 65], s[5 * 65]); o.w = pk2(s[6 * 65], s[7 * 65]);
#if W_MANT_DROP
        { const unsigned hb = (1u << (W_MANT_DROP - 1)) * 0x00010001u, mk = ~(((1u << W_MANT_DROP) - 1u) * 0x00010001u);
#pragma unroll
          for (int e = 0; e < 4; ++e) o[e] = (o[e] + hb) & mk; }
#endif
        *(v4u*)(WT + (size_t)dst_row(kind, n0 + n) * K + k0 + 8 * c) = o; }
    LDS_WAIT(); asm volatile("" ::: "memory");
}

struct Args { const float* in[19]; float* out; unsigned char* ws; int ph_lo, ph_hi; };
typedef const __attribute__((address_space(4))) Args CArgs;
__device__ __forceinline__ CArgs* fresh_args(CArgs* p) { asm volatile("" : "+s"(p)); return p; }
__device__ __forceinline__ Frame fresh_frame(Frame F) { asm volatile("" : "+v"(F.tid)); F.lane = F.tid & 63; return F; }
__constant__ float INVF[32] = {1.000000000e+00f, 7.498942614e-01f, 5.623413324e-01f, 4.216965139e-01f, 3.162277639e-01f, 2.371373773e-01f, 1.778279394e-01f, 1.333521307e-01f, 1.000000015e-01f, 7.498941571e-02f, 5.623413250e-02f, 4.216965288e-02f, 3.162277490e-02f, 2.371373773e-02f, 1.778279431e-02f, 1.333521493e-02f, 9.999999776e-03f, 7.498941850e-03f, 5.623413250e-03f, 4.216964822e-03f, 3.162277630e-03f, 2.371373586e-03f, 1.778279431e-03f, 1.333521446e-03f, 1.000000047e-03f, 7.498942432e-04f, 5.623413017e-04f, 4.216965172e-04f, 3.162277571e-04f, 2.371373703e-04f, 1.778279402e-04f, 1.333521504e-04f};

constexpr int I_WI = (D / 64) * (2 * FF / 64), I_WO = (FF / 64) * (D / 64), I_WIN = (D / 64) * (IN_COLS / 64), I_WUQ = (QLR / 64) * (NH * QKD / 64), I_WUKV = (KVLR / 64) * (NH * 256 / 64), I_WOUT = (D / 64) * (D / 64);
constexpr int I_LAYER = 2 * I_WI + 2 * I_WO + I_WIN + I_WUQ + I_WUKV + I_WOUT;
__device__ __forceinline__ void pack_item(const CArgs& a, int it, LAS float* scr, int lane) {
    const int l = it / I_LAYER; int r = it - l * I_LAYER;
    unsigned char* wl = a.ws + WS_W + (size_t)l * W_LAYER;
    const float* src; const float* gk = nullptr; int K_, N_, kind = 0; size_t dsto;
    if (r < I_WI) { src = a.in[7] + (size_t)l * D * 2 * FF; K_ = D; N_ = 2 * FF; dsto = WO_WI1; kind = 1; }
    else if ((r -= I_WI) < I_WO) { src = a.in[8] + (size_t)l * FF * D; K_ = FF; N_ = D; dsto = WO_WO1; }
    else if ((r -= I_WO) < I_WI) { src = a.in[17] + (size_t)l * D * 2 * FF; K_ = D; N_ = 2 * FF; dsto = WO_WI2; kind = 1; }
    else if ((r -= I_WI) < I_WO) { src = a.in[18] + (size_t)l * FF * D; K_ = FF; N_ = D; dsto = WO_WO2; }
    else if ((r -= I_WO) < I_WIN) { src = a.in[9] + (size_t)l * D * IN_COLS; K_ = D; N_ = IN_COLS; dsto = WO_WIN; kind = 2; }
    else if ((r -= I_WIN) < I_WUQ) { src = a.in[12] + (size_t)l * QLR * NH * QKD; K_ = QLR; N_ = NH * QKD; dsto = WO_WUQ; kind = 3; gk = a.in[10] + l * QLR; }
    else if ((r -= I_WUQ) < I_WUKV) { src = a.in[13] + (size_t)l * KVLR * NH * 256; K_ = KVLR; N_ = NH * 256; dsto = WO_WUKV; gk = a.in[11] + l * KVLR; }
    else { r -= I_WUKV; src = a.in[16] + (size_t)l * D * D; K_ = D; N_ = D; dsto = WO_WOUT;
           gk = (r / (D / 64)) < 16 ? a.in[14] + l * 1024 : a.in[15] + l * 1024 - 1024; }
    tr_item(src, K_, N_, (bf16*)(wl + dsto), kind, gk, scr, r, lane);
}

constexpr int CW_BGQ = 8192;
constexpr unsigned BG_TOTAL = (unsigned)(DEPTH - 1) * I_LAYER;
__device__ __forceinline__ unsigned rfl(unsigned v) { return (unsigned)__builtin_amdgcn_readfirstlane((int)v); }
__device__ __forceinline__ void bg_items(const Frame& F, const CArgs& a, unsigned base) {
    const unsigned q = base + (unsigned)F.wave;
    if (q < BG_TOTAL) pack_item(a, (int)(I_LAYER + q), (LAS float*)(F.lds + F.wave * 16640), F.lane);
}
__device__ __forceinline__ void bg_drain(const XcdBarrier& b, const Frame& F, const CArgs& a, unsigned limit) {
    unsigned* q = (unsigned*)(a.ws + WS_CTL) + CW_BGQ;
    for (;;) {
        if (F.tid == 0) { unsigned base = 0xFFFFFFFFu; if (xb_ld(q) < limit) base = xb_add(q, 8u); b.st[5] = base; }
        __syncthreads();
        const unsigned base = rfl(b.st[5]);
        __syncthreads();
        if (base >= BG_TOTAL) break;
        bg_items(F, a, base);
    }
}
__device__ __forceinline__ void xcd_barrier_bg(const XcdBarrier& b, const Frame& F, const CArgs& a) {
    asm volatile("s_waitcnt vmcnt(0)" ::: "memory");
    __syncthreads();
    if (threadIdx.x == 0) {
        unsigned* bar = b.bar;
        __builtin_amdgcn_s_waitcnt(0);
        unsigned nloc = b.st[0], nx = b.st[1];
        if (nloc == 0u) { xcd_barrier_complete(bar, b.x, nloc, nx); b.st[0] = nloc; b.st[1] = nx; }
        const unsigned old = xb_add(&bar[XB_XSUB(b.x)], 1u);
        const unsigned gen = old / nloc;
        if (old + 1u == (gen + 1u) * nloc) {
            __builtin_amdgcn_fence(__ATOMIC_RELEASE, "agent");
            asm volatile("s_waitcnt vmcnt(0)" ::: "memory");
            const unsigned og = xb_add(&bar[XB_TOP], 1u);
            const unsigned tg = og / nx;
            if (og + 1u == (tg + 1u) * nx) xb_add(&bar[XB_TOPGEN], 1u);
            else XB_SPIN(xb_ld(&bar[XB_TOPGEN]) == tg, bar);
            __builtin_amdgcn_fence(__ATOMIC_ACQUIRE, "agent");
            xb_add(&bar[XB_XGEN(b.x)], 1u);
            asm volatile("s_waitcnt vmcnt(0)" ::: "memory");
            b.st[2] = 1u;
        } else { b.st[2] = 0u; b.st[3] = gen; }
    }
    __syncthreads();
    if (rfl(b.st[2]) == 0u) {
        const unsigned gen = rfl(b.st[3]);
        unsigned* q = (unsigned*)(a.ws + WS_CTL) + CW_BGQ;
        for (;;) {
            if (threadIdx.x == 0) { const unsigned rel = xb_ld(&b.bar[XB_XGEN(b.x)]) != gen ? 1u : 0u; unsigned base = 0xFFFFFFFFu; if (!rel && xb_ld(q) < BG_TOTAL) base = xb_add(q, 8u); b.st[4] = rel; b.st[5] = base; }
            __syncthreads();
            const unsigned rel = rfl(b.st[4]), base = rfl(b.st[5]);
            __syncthreads();
            if (rel) break;
            if (base >= BG_TOTAL) { if (threadIdx.x == 0) XB_SPIN(xb_ld(&b.bar[XB_XGEN(b.x)]) == gen, b.bar); break; }
            bg_items(F, a, base);
        }
        if (threadIdx.x == 0) { __builtin_amdgcn_fence(__ATOMIC_ACQUIRE, "agent"); asm volatile("s_waitcnt vmcnt(0)" ::: "memory"); }
        __syncthreads();
    }
}

__device__ __forceinline__ void p0_prologue(const Frame& F, const CArgs& a) {
    unsigned char* ws = a.ws;
    const int gw = F.vcu * NWAVES + F.wave, NGW = F.G * NWAVES;
    const int gt = F.vcu * (NWAVES * 64) + F.tid, NGT = F.G * NWAVES * 64;
#if P0_PARTS & 1
    {
        LAS float* scr = (LAS float*)(F.lds + F.wave * 16640);
        for (int it = gw; it < (BG_ON ? I_LAYER : DEPTH * I_LAYER); it += NGW) pack_item(a, it, scr, F.lane);
        constexpr int PADV = (WIN_ROWS - IN_COLS) * D * 2 / 16;
        for (int i = gt; i < DEPTH * PADV; i += NGT) { const int l = i / PADV, r = i - l * PADV;
            *(v4u*)(ws + WS_W + (size_t)l * W_LAYER + WO_WIN + (size_t)IN_COLS * D * 2 + (size_t)r * 16) = (v4u){0u, 0u, 0u, 0u}; }
    }
#endif
#if P0_PARTS & 2
    {
        const int* pos = (const int*)a.in[2]; float* rope = (float*)(ws + WS_ROPE);
        for (int i = gt; i < M * 32; i += NGT) { const int row = i >> 5, j = i & 31;
            const float ang = (float)pos[row] * INVF[j];
            double rev = (double)ang * 0.15915494309189535; rev -= __builtin_floor(rev);
            const float fr = (float)rev;
            *(float2*)(rope + (size_t)i * 2) = make_float2(__builtin_amdgcn_cosf(fr), __builtin_amdgcn_sinf(fr)); }
    }
#endif
    __syncthreads();
#if P0_PARTS & 4
    {
        LAS f32x4* cact = (LAS f32x4*)F.lds;
        for (int k = F.tid; k < D; k += NWAVES * 64) { f32x4 v;
#pragma unroll
            for (int b = 0; b < 4; ++b) { const float cv = a.in[1][b * D + k]; v[b] = cv / (1.0f + __expf(-cv)); }
            cact[k] = v; }
        __syncthreads();
        constexpr int NCH = NADA * D / 256, KSL = D / ADA_KS;
        float* adap = (float*)(ws + WS_ADAP);
        for (int it = gw; it < DEPTH * NCH * ADA_KS; it += NGW) {
            const int ks = it % ADA_KS, r = it / ADA_KS, ch = r % NCH, l = r / NCH;
            const int n = ch * 256 + 4 * F.lane;
            const float* w = a.in[3] + ((size_t)l * D + (size_t)ks * KSL) * (NADA * D) + n;
            f32x4 acc[4];
#pragma unroll
            for (int b = 0; b < 4; ++b) acc[b] = (f32x4){0.f, 0.f, 0.f, 0.f};
            if (ks == 0) { const f32x4 bv = *(const f32x4*)(a.in[4] + (size_t)l * NADA * D + n);
#pragma unroll
                for (int b = 0; b < 4; ++b) acc[b] = bv; }
#pragma unroll 16
            for (int kk = 0; kk < KSL; ++kk) { const f32x4 wv = *(const f32x4*)(w + (size_t)kk * (NADA * D)); const f32x4 cv = cact[ks * KSL + kk];
#pragma unroll
                for (int b = 0; b < 4; ++b) acc[b] += wv * cv[b]; }
#pragma unroll
            for (int b = 0; b < 4; ++b) *(f32x4*)(adap + (((size_t)ks * DEPTH + l) * BATCH + b) * (NADA * D) + n) = acc[b];
        }
    }
#endif
}
__device__ __forceinline__ void p1_ada_reduce(const Frame& F, const CArgs& a) {
    const int gt = F.vcu * (NWAVES * 64) + F.tid, NGT = F.G * NWAVES * 64;
    const f32x4* adap = (const f32x4*)(a.ws + WS_ADAP); f32x4* ada = (f32x4*)(a.ws + WS_ADA);
    constexpr int NV = DEPTH * BATCH * NADA * D / 4;
    for (int i = gt; i < NV; i += NGT) { f32x4 s = adap[i];
#pragma unroll
        for (int ks = 1; ks < ADA_KS; ++ks) s += adap[(size_t)ks * NV + i];
        ada[i] = s; }
}
__device__ __forceinline__ void p2_modulate0(const Frame& F, const CArgs& a) {
    const int gw = F.vcu * NWAVES + F.wave, NGW = F.G * NWAVES;
    const float* ada = (const float*)(a.ws + WS_ADA); bf16* H = (bf16*)(a.ws + WS_H);
    for (int row = gw; row < M; row += NGW) { const int b = row >> 12;
        const float* sh = ada + (size_t)b * NADA * D, * sc = sh + D;
#pragma unroll
        for (int j = 0; j < 8; ++j) { const int idx = 4 * (F.lane + 64 * j);
            const f32x4 xv = *(const f32x4*)(a.in[0] + (size_t)row * D + idx), s1 = *(const f32x4*)(sc + idx), s0 = *(const f32x4*)(sh + idx);
            const f32x4 h = xv * (s1 + 1.0f) + s0;
            *(v2u*)(H + (size_t)row * D + idx) = (v2u){pk2(h[0], h[1]), pk2(h[2], h[3])}; } }
}
__device__ __forceinline__ void vec_prep(const Frame& F, const CArgs& a) {
    const int gt = F.vcu * (NWAVES * 64) + F.tid, NGT = F.G * NWAVES * 64;
    const float* ada = (const float*)(a.ws + WS_ADA); float* vec = (float*)(a.ws + WS_VEC);
    for (int i = gt; i < 3 * DEPTH * BATCH * D; i += NGT) { const int d = i % D, sb = i / D, b = sb % BATCH, s = sb / BATCH, l = s / 3, j = s - 3 * l;
        const float* ad = ada + ((size_t)l * BATCH + b) * NADA * D + d;
        const float sh = ad[(3 * j) * D], sc = ad[(3 * j + 1) * D], gt_ = ad[(3 * j + 2) * D];
        const float lg = a.in[5][(size_t)(l * 3 + j) * D + d], lb = a.in[6][(size_t)(l * 3 + j) * D + d];
        float P = DN_ALPHA, Q = 0.f; if (s != 0) { P = DN_ALPHA / (1.0f + sc); Q = -P * sh; }
        float U = lg, W = lb;
        if (s != 3 * DEPTH - 1) { const int s1 = s + 1, l1 = s1 / 3, j1 = s1 - 3 * l1; const float* an = ada + ((size_t)l1 * BATCH + b) * NADA * D + d;
            const float nsh = an[(3 * j1) * D], nsc = an[(3 * j1 + 1) * D]; U = lg * (1.0f + nsc); W = lb * (1.0f + nsc) + nsh; }
        float* o = vec + (size_t)sb * 5 * D + d;
        o[0] = P; o[D] = Q; o[2 * D] = (j == 1 ? 1.0f : 0.5f) * (1.0f + gt_); o[3 * D] = U; o[4 * D] = W; }
}
__device__ __forceinline__ unsigned hl_enc(float h, unsigned hb) { const int d = (int)(__float_as_uint(h) - hb); int q = (d + 0x80) >> 8; q = q > 127 ? 127 : q; return (unsigned)q & 0xffu; }
__device__ __forceinline__ float hl_dec(unsigned hb, unsigned byte) { const int q = (int)(signed char)(byte & 0xffu); return __uint_as_float(hb + (unsigned)(q * 256)); }
template <bool FIRST>
__device__ __forceinline__ void ln_phase(const Frame& F, const bf16* H, const unsigned char* L, bf16* HO, unsigned char* LO, const bf16* f, const float* vecs  , const float* X32, float* OUT32) {
    const int gw = F.vcu * NWAVES + F.wave, NGW = F.G * NWAVES;
    constexpr int RPW = 8;
    int tid0_ = threadIdx.x; asm volatile("" : "+v"(tid0_)); const int Flane = tid0_ & 63, Ftid = tid0_;
    LAS f32x4* lv = (LAS f32x4*)F.lds;
    int staged_b = -1;
    for (int r0 = gw * RPW; r0 < M; r0 += NGW * RPW) { const int b = r0 >> 12;
        if (b != staged_b) {
            if (staged_b >= 0) __syncthreads();
            const f32x4* src = (const f32x4*)(vecs + (size_t)b * 5 * D);
            int t_ = Ftid; asm volatile("" : "+v"(t_));
#pragma unroll
            for (int i = 0; i < 5; ++i) { const int q = t_ + 512 * i, vec = q >> 9, e = (q & 511) * 4, j = e >> 9, ln = (e & 511) >> 3, half = (e >> 2) & 1;
                lv[((vec * 4 + j) * 2 + half) * 64 + ln] = src[q]; }
            __syncthreads(); staged_b = b; }
        constexpr int NS = FIRST ? 1 : LN_NS;
        v4u hq2[NS][4], fq2[NS][4]; v2u lq2[NS][4]; f32x4 xq2[NS][8];
#define LN_LOAD(row_, S_) do { _Pragma("unroll") for (int j = 0; j < 4; ++j) { const int idx = 8 * (Flane + 64 * j);                                     \
            fq2[S_][j] = *(const v4u*)(f + (size_t)(row_) * D + idx);                                                                                          \
            if (FIRST) { xq2[S_][2 * j] = *(const f32x4*)(X32 + (size_t)(row_) * D + idx); xq2[S_][2 * j + 1] = *(const f32x4*)(X32 + (size_t)(row_) * D + idx + 4); } \
            else { hq2[S_][j] = *(const v4u*)(H + (size_t)(row_) * D + idx); lq2[S_][j] = *(const v2u*)(L + (size_t)(row_) * D + idx); } } } while (0)
        LN_LOAD(r0, 0); if (NS == 2) LN_LOAD(r0 + 1, NS - 1);
#pragma unroll
        for (int i = 0; i < RPW; ++i) { const int row = r0 + i;
            v4u (&hq)[4] = hq2[i % NS]; v4u (&fq)[4] = fq2[i % NS]; v2u (&lq)[4] = lq2[i % NS]; f32x4 (&xq)[8] = xq2[i % NS];
            int ln_ = Flane; asm volatile("" : "+v"(ln_));
            float v[32]; float s = 0.f;
#pragma unroll
            for (int j = 0; j < 4; ++j) {
                const f32x4 p0 = lv[((0 * 4 + j) * 2 + 0) * 64 + ln_], p1 = lv[((0 * 4 + j) * 2 + 1) * 64 + ln_], q0 = lv[((1 * 4 + j) * 2 + 0) * 64 + ln_], q1 = lv[((1 * 4 + j) * 2 + 1) * 64 + ln_], c0 = lv[((2 * 4 + j) * 2 + 0) * 64 + ln_], c1 = lv[((2 * 4 + j) * 2 + 1) * 64 + ln_];
#pragma unroll
                for (int e = 0; e < 4; ++e) { const float fl = bf_lo(fq[j][e]), fh = bf_hi(fq[j][e]);
                    const float xl = FIRST ? xq[2 * j + (e >> 1)][(e & 1) * 2] : hl_dec(hq[j][e] << 16, lq[j][e >> 1] >> (16 * (e & 1))), xh = FIRST ? xq[2 * j + (e >> 1)][(e & 1) * 2 + 1] : hl_dec(hq[j][e] & 0xffff0000u, lq[j][e >> 1] >> (16 * (e & 1) + 8));
                    const float pl = e < 2 ? p0[2 * e] : p1[2 * e - 4], ph_ = e < 2 ? p0[2 * e + 1] : p1[2 * e - 3], ql = e < 2 ? q0[2 * e] : q1[2 * e - 4], qh = e < 2 ? q0[2 * e + 1] : q1[2 * e - 3], cl = e < 2 ? c0[2 * e] : c1[2 * e - 4], ch = e < 2 ? c0[2 * e + 1] : c1[2 * e - 3];
                    const float vl = pl * xl + ql + cl * fl, vh = ph_ * xh + qh + ch * fh; v[8 * j + 2 * e] = vl; v[8 * j + 2 * e + 1] = vh; s += vl + vh; } }
            if (i + NS < RPW) LN_LOAD(row + NS, i % NS);
            const float mean = wave_sum(s) * (1.0f / D); float s2 = 0.f;
#pragma unroll
            for (int k = 0; k < 32; ++k) { v[k] -= mean; s2 += v[k] * v[k]; }
            const float rstd = 1.0f / sqrtf(wave_sum(s2) * (1.0f / D) + LN_EPS);
#pragma unroll
            for (int j = 0; j < 4; ++j) { const int idx = 8 * (ln_ + 64 * j);
                const f32x4 u0 = lv[((3 * 4 + j) * 2 + 0) * 64 + ln_], u1 = lv[((3 * 4 + j) * 2 + 1) * 64 + ln_], w0 = lv[((4 * 4 + j) * 2 + 0) * 64 + ln_], w1 = lv[((4 * 4 + j) * 2 + 1) * 64 + ln_];
                float o[8];
#pragma unroll
                for (int e = 0; e < 8; ++e) o[e] = v[8 * j + e] * rstd * (e < 4 ? u0[e] : u1[e - 4]) + (e < 4 ? w0[e] : w1[e - 4]);
                if (OUT32) { *(f32x4*)(OUT32 + (size_t)row * D + idx) = (f32x4){o[0], o[1], o[2], o[3]}; *(f32x4*)(OUT32 + (size_t)row * D + idx + 4) = (f32x4){o[4], o[5], o[6], o[7]}; }
                else { v4u hw; v2u lw = {0u, 0u};
#pragma unroll
                    for (int e = 0; e < 4; ++e) { hw[e] = pk2(o[2 * e], o[2 * e + 1]);
                        lw[e >> 1] |= (hl_enc(o[2 * e], hw[e] << 16) | (hl_enc(o[2 * e + 1], hw[e] & 0xffff0000u) << 8)) << (16 * (e & 1)); }
                    *(v4u*)(HO + (size_t)row * D + idx) = hw; *(v2u*)(LO + (size_t)row * D + idx) = lw; } } }
#undef LN_LOAD
    }
    __syncthreads();
}
__device__ __forceinline__ void attn_phase(const Frame& F, const CArgs& a, int which) {
    unsigned char* ws = a.ws;
    const bf16* QM = (const bf16*)(ws + WS_QM); const bf16* KV = (const bf16*)(ws + WS_KV); const bf16* KPE = (const bf16*)(ws + WS_KPE);
    const bf16* SBQ = (const bf16*)(ws + WS_SBQ); const bf16* SBK = (const bf16*)(ws + WS_SBK); const bf16* SBV = (const bf16*)(ws + WS_SBV);
    bf16* O = (bf16*)(ws + WS_O); float* OSSQ = (float*)(ws + WS_OSSQ);
    constexpr int NQB = SEQ / 256, NPAIR = NQB / 2, NITEM = BATCH * NH * NPAIR;
    for (int it = F.vcu; it < NITEM; it += F.G) {
        const int bh = it / NPAIR, x = it - bh * NPAIR, b = bh / NH, h = bh - b * NH;
        const size_t r0 = (size_t)b * SEQ;
#if SITE_ATT & 1
#pragma unroll 1
        for (int pass = 0; pass < ((which & 1) ? 2 : 0); ++pass) { const int qb = pass ? NQB - 1 - x : x; const size_t rq = r0 + (size_t)qb * 256;
            att::attn_block<false>(F.lds, QM + rq * (NH * QKD) + h * QKD, NH * QKD, KV + r0 * D + h * 256, D, KV + r0 * D + h * 256 + 128, D, KPE + r0 * 64, O + rq * D + h * HD, D, OSSQ + rq * 16 + h, qb * 256); }
#endif
#if SITE_ATT & 2
#pragma unroll 1
        for (int pass = 0; pass < ((which & 2) ? 2 : 0); ++pass) { const int qb = pass ? NQB - 1 - x : x; const size_t rq = r0 + (size_t)qb * 256;
            att::attn_block<true>(F.lds, SBQ + rq * 1024 + h * HD, 1024, SBK + r0 * 1024 + h * HD, 1024, SBV + r0 * 1024 + h * HD, 1024, nullptr, O + rq * D + 1024 + h * HD, D, OSSQ + rq * 16 + 8 + h, qb * 256); }
#endif
    }
}

__global__ void __launch_bounds__(NWAVES * 64, 2) mk_fwd(Args args_unused) {
    extern __shared__ __attribute__((aligned(16))) unsigned char lds[];
    (void)args_unused;
    CArgs* ap = (CArgs*)__builtin_amdgcn_kernarg_segment_ptr();
    Frame F;
    F.lds = (LAS unsigned char*)lds;
    F.tid = threadIdx.x; F.lane = F.tid & 63; F.wave = __builtin_amdgcn_readfirstlane(F.tid >> 6);
    F.G = gridDim.x; { const int bx = blockIdx.x; F.vcu = (F.G % 8 == 0) ? (bx % 8) * (F.G / 8) + bx / 8 : bx; }
    volatile LAS unsigned* MISC = (volatile LAS unsigned*)(F.lds + MISC_OFF);
    for (int u = F.tid; u < (LDS_BYTES - MISC_OFF) / 4; u += NWAVES * 64) ((LAS unsigned*)(F.lds + MISC_OFF))[u] = 0u;
    __syncthreads();
    XcdBarrier bar; bar.bar = (unsigned*)(ap->ws + WS_CTL) + CW_BAR; bar.x = 0; bar.st = nullptr;
    if (MK_ONE_LAUNCH) bar = xcd_barrier_post((unsigned*)(ap->ws + WS_CTL) + CW_BAR, MISC + 8);
    const int lo = ap->ph_lo, hi = ap->ph_hi; int ph = 0; bool fin_ = false;
#define RUN_PH (ph >= lo && ph < hi)
#if TPROBE
#define TP_BASE ((unsigned long long*)(fresh_args(ap)->ws + WS_CTL + 524288))
#define TP_BEGIN(k) do { if (blockIdx.x == TPROBE_WG && threadIdx.x == 0) { unsigned long long* tp = TP_BASE; tp[30] = __builtin_amdgcn_s_memrealtime(); int kk_ = (k); asm volatile("" : "+s"(kk_)); ((unsigned*)tp)[64] = (unsigned)kk_; } } while (0)
#define TP_MID do { if (blockIdx.x == TPROBE_WG && threadIdx.x == 0) { asm volatile("s_waitcnt vmcnt(0)" ::: "memory"); TP_BASE[31] = __builtin_amdgcn_s_memrealtime(); } } while (0)
#define TP_END do { if (blockIdx.x == TPROBE_WG && threadIdx.x == 0) { unsigned long long* tp = TP_BASE; const unsigned long long t2 = __builtin_amdgcn_s_memrealtime(), t0 = tp[30], t1 = tp[31]; const int k = (int)((unsigned*)tp)[64]; tp[2 * k] += t1 - t0; tp[2 * k + 1] += t2 - t1; } } while (0)
#else
#define TP_BEGIN(k) do { } while (0)
#define TP_MID do { } while (0)
#define TP_END do { } while (0)
#endif
#define END_PH do { TP_MID; if (MK_ONE_LAUNCH && RUN_PH && ph + 1 < hi && !fin_) { xcd_barrier(bar); for (int xb_ = 0; xb_ < DUP_BAR; ++xb_) xcd_barrier(bar); } TP_END; ++ph; } while (0)
#define END_PH_BG(bit) do { TP_MID; if (MK_ONE_LAUNCH && RUN_PH && ph + 1 < hi && !fin_) { if (BG_ON && (BG_SITES & (bit))) xcd_barrier_bg(bar, fresh_frame(F), *fresh_args(ap)); else xcd_barrier(bar); for (int xb_ = 0; xb_ < DUP_BAR; ++xb_) xcd_barrier(bar); } TP_END; ++ph; } while (0)
#define WSP(T, off) ((T*)(A->ws + (off)))

REP(DUP_P0) { TP_BEGIN(0);
#if SITE_P0
    if (RUN_PH) p0_prologue(fresh_frame(F), *fresh_args(ap));
#endif
    END_PH; }
REP(DUP_P1) { TP_BEGIN(1);
#if SITE_P1
    if (RUN_PH) p1_ada_reduce(fresh_frame(F), *fresh_args(ap));
#endif
    END_PH; }
REP(DUP_P2) { TP_BEGIN(2);
#if SITE_P2
    if (RUN_PH) { p2_modulate0(fresh_frame(F), *fresh_args(ap)); vec_prep(fresh_frame(F), *fresh_args(ap)); }
#endif
    END_PH; }

#pragma unroll 1
    for (int s = 0; s <= DBG_LAST_S; ++s) {
        const int l = s / 3, j = s - 3 * l;
        if (j != 1) {
REP(DUP_G1) { TP_BEGIN(3);
#if SITE_G1
            if (RUN_PH) { CArgs* A = fresh_args(ap); const unsigned char* wl = A->ws + WS_W + (size_t)l * W_LAYER;
                pg8::Gemm g{WSP(const bf16, WS_H), (const bf16*)(wl + (j == 0 ? WO_WI1 : WO_WI2)), M, 2 * FF, D}; pg8::StaticOrder S; S.init(M, 2 * FF, F.G, (int)blockIdx.x);
                pg8::EpiSwiGLU E{WSP(bf16, WS_ACT), FF};
                pg8::gemm_phase<pg8::EpiSwiGLU, pg8::StaticOrder, G1_ALIGN, G1_SP2>(F.lds + RING_OFF, g, S, E);
            }
#endif
            END_PH_BG(1); }
        } else {
REP(DUP_WIN) { TP_BEGIN(4);
#if SITE_WIN
            if (RUN_PH) { CArgs* A = fresh_args(ap); const unsigned char* wl = A->ws + WS_W + (size_t)l * W_LAYER;
                pg8::Gemm g{WSP(const bf16, WS_H), (const bf16*)(wl + WO_WIN), M, WIN_ROWS, D}; pg8::WinOrder S; S.init(M, 16 * 256, F.G, (int)blockIdx.x);
                pg8::EpiWin E{WSP(bf16, WS_CQ), WSP(bf16, WS_CKV), WSP(bf16, WS_SBQ), WSP(bf16, WS_SBK), WSP(bf16, WS_SBV), WSP(bf16, WS_KPE), WSP(float, WS_SSQ), WSP(const float, WS_ROPE), SB_QSCALE};
                pg8::gemm_phase<pg8::EpiWin, pg8::WinOrder, true, true>(F.lds + RING_OFF, g, S, E);
            }
#endif
            END_PH_BG(2); }
REP(DUP_UQKV) { TP_BEGIN(5);
#if SITE_UQKV
            if (RUN_PH) {
                const int c = (int)blockIdx.x, G = F.G; const bool bal = G == 256; const bool grpA = ((c >> 3) & 1) == 0; const int gi = ((c >> 4) << 3) | (c & 7);
                pg8::ListOrder Swt, Suq, Sukv;
                if (bal) { Swt = pg8::ListOrder{gi, grpA ? 1 : 0, 1, 15}; Suq = grpA ? pg8::ListOrder{gi, 1, 1, 0} : pg8::ListOrder{128 + 2 * gi, 2, 1, 0}; Sukv = grpA ? pg8::ListOrder{gi, 1, 1, 0} : pg8::ListOrder{128 + 3 * gi, 3, 1, 0}; }
                else { Swt = pg8::ListOrder{c, c < 128 ? (128 - c + G - 1) / G : 0, G, 15}; Suq = pg8::ListOrder{c, c < 384 ? (384 - c + G - 1) / G : 0, G, 0}; Sukv = pg8::ListOrder{c, c < 512 ? (512 - c + G - 1) / G : 0, G, 0}; }
                { CArgs* A = fresh_args(ap); const unsigned char* wl = A->ws + WS_W + (size_t)l * W_LAYER;
                  pg8::Gemm g{WSP(const bf16, WS_H), (const bf16*)(wl + WO_WIN), M, WIN_ROWS, D};
                  pg8::EpiWin E{WSP(bf16, WS_CQ), WSP(bf16, WS_CKV), WSP(bf16, WS_SBQ), WSP(bf16, WS_SBK), WSP(bf16, WS_SBV), WSP(bf16, WS_KPE), WSP(float, WS_SSQ), WSP(const float, WS_ROPE), SB_QSCALE};
                  pg8::gemm_phase<pg8::EpiWin, pg8::ListOrder, true, true>(F.lds + RING_OFF, g, Swt, E); }
                { CArgs* A = fresh_args(ap); const unsigned char* wl = A->ws + WS_W + (size_t)l * W_LAYER;
                  pg8::Gemm g{WSP(const bf16, WS_CQ), (const bf16*)(wl + WO_WUQ), M, NH * QKD, QLR};
                  pg8::EpiRS<true> E{WSP(bf16, WS_QM), NH * QKD, WSP(const float, WS_SSQ), 0, 3, 1.0f / QLR, RMS_EPS, MLA_QSCALE, WSP(const float, WS_ROPE)};
                  pg8::gemm_phase<pg8::EpiRS<true>, pg8::ListOrder, true, true>(F.lds + RING_OFF, g, Suq, E); }
                { CArgs* A = fresh_args(ap); const unsigned char* wl = A->ws + WS_W + (size_t)l * W_LAYER;
                  pg8::Gemm g{WSP(const bf16, WS_CKV), (const bf16*)(wl + WO_WUKV), M, NH * 256, KVLR};
                  pg8::EpiRS<false> E{WSP(bf16, WS_KV), NH * 256, WSP(const float, WS_SSQ), 3, 2, 1.0f / KVLR, RMS_EPS, 1.0f, nullptr};
                  pg8::gemm_phase<pg8::EpiRS<false>, pg8::ListOrder, true, true>(F.lds + RING_OFF, g, Sukv, E); }
            }
#endif
            END_PH_BG(4); }
REP(DUP_ATT) { TP_BEGIN(6);
#if SITE_ATT
            if (RUN_PH) attn_phase(fresh_frame(F), *fresh_args(ap), rep_ == 0 ? 3 : DUP_ATT_WHICH);
#endif
            END_PH_BG(8); }
        }
REP(DUP_GF) { TP_BEGIN(8);
#if SITE_GF
        if (RUN_PH) { CArgs* A = fresh_args(ap); const unsigned char* wl = A->ws + WS_W + (size_t)l * W_LAYER;
            if (j != 1) { pg8::Gemm g{WSP(const bf16, WS_ACT), (const bf16*)(wl + (j == 0 ? WO_WO1 : WO_WO2)), M, D, FF}; pg8::StaticOrder S; S.init(M, D, F.G, (int)blockIdx.x);
                pg8::EpiPlain E{WSP(bf16, WS_F), D};
                pg8::gemm_phase<pg8::EpiPlain, pg8::StaticOrder, GF_ALIGN, G1_SP2>(F.lds + RING_OFF, g, S, E); }
            else { pg8::Gemm g{WSP(const bf16, WS_O), (const bf16*)(wl + WO_WOUT), M, D, D}; pg8::StaticOrder S; S.init(M, D, F.G, (int)blockIdx.x);
                pg8::EpiMixOut E{WSP(bf16, WS_F), D, WSP(const float, WS_OSSQ), 16, 1.0f / 1024.0f, RMS_EPS};
                pg8::gemm_phase<pg8::EpiMixOut, pg8::StaticOrder, GF_ALIGN, G1_SP2>(F.lds + RING_OFF, g, S, E); }
        }
#endif
        END_PH_BG(16); }
REP(DUP_LN) { TP_BEGIN(9);
#if SITE_LN
        fin_ = (s == DBG_LAST_S) && (rep_ == DUP_LN);
        if (RUN_PH) { CArgs* A = fresh_args(ap); const bool last = s == DBG_LAST_S; const bool dummy = DUP_LN && rep_ == 0;
            bf16* HO = dummy ? WSP(bf16, WS_DUMMY) : WSP(bf16, WS_H); unsigned char* LO = dummy ? WSP(unsigned char, WS_DUMMY + 64 * MiB) : WSP(unsigned char, WS_HL);
            if (s == 0) ln_phase<true>(F, WSP(const bf16, WS_H), WSP(const unsigned char, WS_HL), HO, LO, WSP(const bf16, WS_F), WSP(const float, WS_VEC), A->in[0], last ? A->out : nullptr);
            else ln_phase<false>(F, WSP(const bf16, WS_H), WSP(const unsigned char, WS_HL), HO, LO, WSP(const bf16, WS_F), WSP(const float, WS_VEC) + (size_t)s * BATCH * 5 * D, nullptr, last ? A->out : nullptr);
        }
#endif
        if (BG_ON && MK_ONE_LAUNCH && RUN_PH && j == 2 && l + 1 < DEPTH) bg_drain(bar, fresh_frame(F), *fresh_args(ap), (unsigned)(l + 1) * I_LAYER);
        END_PH; }
    }
#if TPROBE
    xcd_barrier(bar);
    { CArgs* A = fresh_args(ap); const unsigned long long* tp = (const unsigned long long*)(A->ws + WS_CTL + 524288); const float dall = 0.f * (float)tp[TPROBE_B], done_ = (TPROBE_A == 99 ? (float)(tp[1] + tp[3] + tp[5] + tp[7] + tp[9] + tp[11] + tp[13] + tp[15] + tp[17] + tp[19]) : (float)(tp[TPROBE_A] + tp[TPROBE_B])) * 1e-5f * TPROBE_SCALE;
      float* o = A->out; const int gt = (int)blockIdx.x * 512 + (int)threadIdx.x;
      for (int i = gt; i < M * D / 4; i += (int)gridDim.x * 512) { f32x4 v = *(f32x4*)(o + (size_t)i * 4); v = v + dall; if (i == 0) v[0] += done_; *(f32x4*)(o + (size_t)i * 4) = v; } }
#endif
#undef RUN_PH
#undef END_PH
#undef WSP
}

extern "C" void kernel_launch(void* const* d_in, const int* in_sizes, int n_in, void* d_out, int out_size, void* d_ws, size_t ws_size, hipStream_t stream) {
    static int grid = 0;
    if (grid == 0) {
        if (n_in != 19 || in_sizes[0] != M * D || out_size != M * D || ws_size < WS_END) { fprintf(stderr, "kernel_launch: unexpected shapes (n_in %d, in0 %d, out %d, ws %zu < %zu); nothing launched\n", n_in, n_in > 0 ? in_sizes[0] : -1, out_size, ws_size, (size_t)WS_END); grid = -1; return; }
        int dev = 0, cus = 0, per_cu = 0;
        if (hipGetDevice(&dev) != hipSuccess || hipDeviceGetAttribute(&cus, hipDeviceAttributeMultiprocessorCount, dev) != hipSuccess) { grid = -1; return; }
        if (hipFuncSetAttribute((const void*)mk_fwd, hipFuncAttributeMaxDynamicSharedMemorySize, LDS_BYTES) != hipSuccess) { fprintf(stderr, "kernel_launch: hipFuncSetAttribute failed\n"); grid = -1; return; }
        if (hipOccupancyMaxActiveBlocksPerMultiprocessor(&per_cu, (const void*)mk_fwd, NWAVES * 64, LDS_BYTES) != hipSuccess || per_cu < 1)
            fprintf(stderr, "kernel_launch: note: occupancy query reports %d workgroups per CU\n", per_cu);
        (void)hipGetLastError();
        grid = cus;
    }
    if (grid < 0) return;
    if (hipMemsetAsync((char*)d_ws + WS_CTL, 0, CTL_ZERO_BYTES, stream) != hipSuccess) { fprintf(stderr, "kernel_launch: hipMemsetAsync failed\n"); return; }
    Args a{};
    for (int i = 0; i < 19; ++i) a.in[i] = (const float*)d_in[i];
    a.out = (float*)d_out; a.ws = (unsigned char*)d_ws;
#if MK_ONE_LAUNCH
    a.ph_lo = 0; a.ph_hi = 1 << 20;
    hipLaunchKernelGGL(mk_fwd, dim3(grid), dim3(NWAVES * 64), LDS_BYTES, stream, a);
#else
    for (int p = 0; p < N_PHASES; ++p) { a.ph_lo = p; a.ph_hi = p + 1; hipLaunchKernelGGL(mk_fwd, dim3(grid), dim3(NWAVES * 64), LDS_BYTES, stream, a); }
#endif
}
```

```cpp
#include <hip/hip_runtime.h>
#include <cstdio>
#include <cstdint>
#include <cmath>
namespace pg8 {
#define PG8_LAS __attribute__((address_space(3)))
typedef unsigned short bf16_t;
typedef short bf16x8 __attribute__((ext_vector_type(8)));
typedef float f32x4 __attribute__((ext_vector_type(4)));
typedef unsigned u32x4 __attribute__((ext_vector_type(4)));
constexpr int BM = 256, BK = 64, HALF = 128, HTB = HALF * BK * 2  , STAGE_BYTES = 8 * HTB, NXCD = 8, WGM = 8;

__host__ __device__ __forceinline__ int lds_byte(int r, int c) { const int st = (r >> 4) * 2 + (c >> 5), rr = r & 15, cc = c & 31, ob = rr * 64 + cc * 2; return st * 1024 + (ob ^ (((ob >> 9) & 1) << 5)); }
__host__ __device__ __forceinline__ void stage_rc(int b, int& R, int& C) { const int st = b / 1024, sb = b % 1024, swz = sb ^ (((sb >> 9) & 1) << 5); R = (st >> 1) * 16 + swz / 64; C = (st & 1) * 32 + (swz % 64) / 2; }
__host__ __device__ __forceinline__ int perm32(int rho) { const int n = rho >> 4, i = rho & 15; return 8 * (i >> 2) + 4 * n + (i & 3); }

struct Unit { int pm, pn; };
struct Gemm { const bf16_t* A; const bf16_t* Bt; int M, N, K; };

struct StaticOrder {
    int nM, nN, nwg, G, c;
    __host__ __device__ void init(int M, int N, int G_, int c_) { nM = M / BM; nN = N / BM; nwg = nM * nN; G = G_; c = c_; }
    __host__ __device__ __forceinline__ bool next(int i, Unit& u) const {
        const long L = (long)i * G + c; if (L >= nwg) return false;
        int wgid = (int)L; { const int q = nwg / NXCD, r = nwg % NXCD, xcd = wgid % NXCD, off = wgid / NXCD; wgid = (xcd < r ? xcd * (q + 1) : r * (q + 1) + (xcd - r) * q) + off; }
        const int nig = WGM * nN, gid = wgid / nig, fm = gid * WGM, gsz = (nM - fm) < WGM ? (nM - fm) : WGM;
        u.pm = fm + ((wgid % nig) % gsz); u.pn = (wgid % nig) / gsz; return true;
    }
    __device__ __forceinline__ void a_ready(const Unit&) const {}
    __device__ __forceinline__ void done(const Unit&) const {}
};


#ifndef EPIRS_SKIP
#define EPIRS_SKIP 0
#endif
#ifndef EPI_NT
#define EPI_NT 0
#endif

__device__ __forceinline__ unsigned cvt_pk_bf16(float lo, float hi) { unsigned r; asm volatile("v_cvt_pk_bf16_f32 %0, %1, %2" : "=v"(r) : "v"(lo), "v"(hi)); return r; }
typedef float f32x2 __attribute__((ext_vector_type(2)));
__device__ __forceinline__ u32x4 pack8bf(const f32x4 v0, const f32x4 v1) { u32x4 w; w.x = cvt_pk_bf16(v0[0], v0[1]); w.y = cvt_pk_bf16(v0[2], v0[3]); w.z = cvt_pk_bf16(v1[0], v1[1]); w.w = cvt_pk_bf16(v1[2], v1[3]); return w; }

__device__ __forceinline__ float add_xor16(float x) { auto a = __builtin_amdgcn_permlane16_swap(__float_as_uint(x), __float_as_uint(x), false, false); return __uint_as_float(a[0]) + __uint_as_float(a[1]); }
__device__ __forceinline__ float add_xor32(float x) { auto a = __builtin_amdgcn_permlane32_swap(__float_as_uint(x), __float_as_uint(x), false, false); return __uint_as_float(a[0]) + __uint_as_float(a[1]); }
struct EpiPlain {
    static constexpr bool PERM = true, AFTER_DRAIN = false, MID = false;
    bf16_t* O; int ldc;
    __device__ __forceinline__ void operator()(const f32x4 (&acc)[2][2][4][2], const Unit& u, int wr, int wc, int fr, int fq) const {
        const int row0 = u.pm * BM + wr * 64 + fr; const int col0 = u.pn * BM + wc * 32 + 8 * fq;
#pragma unroll
        for (int ai = 0; ai < 2; ++ai)
#pragma unroll
            for (int m = 0; m < 4; ++m) { bf16_t* rowp = O + (size_t)(row0 + ai * HALF + m * 16) * ldc + col0;
#pragma unroll
                for (int bj = 0; bj < 2; ++bj) { const u32x4 w = pack8bf(acc[ai][bj][m][0], acc[ai][bj][m][1]); if (EPI_NT) __builtin_nontemporal_store(w, (u32x4*)(rowp + bj * HALF)); else *(u32x4*)(rowp + bj * HALF) = w; } }
    }
};

struct EpiMixOut {
    static constexpr bool PERM = true, AFTER_DRAIN = false, MID = true;
    bf16_t* O; int ldc; const float* OSSQ; int mid_t; float invn, eps;
    const PG8_LAS float* sc; int pm0;
    static constexpr int SC_SLOT = 512;
    __device__ __forceinline__ void prep(const Unit& u, int slot, PG8_LAS float* scw, int tid) const {
        const int r = tid >> 1, g = tid & 1;
        const float* p = OSSQ + (size_t)(u.pm * BM + r) * 16 + 8 * g;
        const f32x4 a = *(const f32x4*)p, b = *(const f32x4*)(p + 4);
        const float s = ((a[0] + a[1]) + (a[2] + a[3])) + ((b[0] + b[1]) + (b[2] + b[3]));
        const float o = __builtin_bit_cast(float, __builtin_amdgcn_update_dpp(0, __builtin_bit_cast(int, s), 0xB1, 0xF, 0xF, false));
        const float sm = g ? o : s, ss = g ? s : o;
        if (g == 0) { scw[slot * SC_SLOT + r] = sqrtf((ss * invn + eps) / (sm * invn + eps)); scw[slot * SC_SLOT + 256 + r] = 1.0f / sqrtf(ss * invn + eps); }
    }
    __device__ __forceinline__ void scales(const Unit& u, int wr, int fr, int fq, int which, float (&v)[2][4]) const {
        int fr_ = fr; asm volatile("" : "+v"(fr_));
        const PG8_LAS float* p = sc + (u.pm != pm0 ? SC_SLOT : 0) + which * 256 + wr * 64 + fr_;
#pragma unroll
        for (int ai = 0; ai < 2; ++ai)
#pragma unroll
            for (int m = 0; m < 4; ++m) v[ai][m] = p[ai * HALF + m * 16];
    }
    __device__ __forceinline__ void mid(f32x4 (&acc)[2][2][4][2], const Unit& u, int wr, int wc, int fr, int fq) const {
        float v[2][4]; scales(u, wr, fr, fq, 0, v);
#pragma unroll
        for (int ai = 0; ai < 2; ++ai)
#pragma unroll
            for (int m = 0; m < 4; ++m) { const float ratio = v[ai][m];
#pragma unroll
                for (int bj = 0; bj < 2; ++bj) { acc[ai][bj][m][0] = acc[ai][bj][m][0] * ratio; acc[ai][bj][m][1] = acc[ai][bj][m][1] * ratio; } }
    }
    __device__ __forceinline__ void operator()(const f32x4 (&acc)[2][2][4][2], const Unit& u, int wr, int wc, int fr, int fq) const {
        float v[2][4]; scales(u, wr, fr, fq, 1, v);
        const int row0 = u.pm * BM + wr * 64 + fr; const int col0 = u.pn * BM + wc * 32 + 8 * fq;
#pragma unroll
        for (int ai = 0; ai < 2; ++ai)
#pragma unroll
            for (int m = 0; m < 4; ++m) { bf16_t* rowp = O + (size_t)(row0 + ai * HALF + m * 16) * ldc + col0; const float rs = v[ai][m];
#pragma unroll
                for (int bj = 0; bj < 2; ++bj) *(u32x4*)(rowp + bj * HALF) = pack8bf(acc[ai][bj][m][0] * rs, acc[ai][bj][m][1] * rs); }
    }
};

struct EpiSwiGLU {
    static constexpr bool PERM = true, AFTER_DRAIN = false, MID = false;
    bf16_t* O; int ldc;
    __device__ __forceinline__ static f32x4 sg(const f32x4 g, const f32x4 up) {
        f32x4 r;
#pragma unroll
        for (int i = 0; i < 4; ++i) { const float e = __builtin_amdgcn_exp2f(g[i] * -1.4426950408889634f); r[i] = g[i] * __builtin_amdgcn_rcpf(1.0f + e) * up[i]; }
        return r;
    }
    __device__ __forceinline__ void operator()(const f32x4 (&acc)[2][2][4][2], const Unit& u, int wr, int wc, int fr, int fq) const {
        const int row0 = u.pm * BM + wr * 64 + fr; const int col0 = u.pn * HALF + wc * 32 + 8 * fq;
#pragma unroll
        for (int ai = 0; ai < 2; ++ai) { f32x4 t[4][2];
#pragma unroll
            for (int m = 0; m < 4; ++m)
#pragma unroll
                for (int n = 0; n < 2; ++n) t[m][n] = acc[ai][0][m][n] * -1.4426950408889634f;
#pragma unroll
            for (int m = 0; m < 4; ++m)
#pragma unroll
                for (int n = 0; n < 2; ++n)
#pragma unroll
                    for (int i = 0; i < 4; ++i) t[m][n][i] = __builtin_amdgcn_exp2f(t[m][n][i]);
#pragma unroll
            for (int m = 0; m < 4; ++m)
#pragma unroll
                for (int n = 0; n < 2; ++n) t[m][n] = t[m][n] + 1.0f;
#pragma unroll
            for (int m = 0; m < 4; ++m)
#pragma unroll
                for (int n = 0; n < 2; ++n)
#pragma unroll
                    for (int i = 0; i < 4; ++i) t[m][n][i] = __builtin_amdgcn_rcpf(t[m][n][i]);
#pragma unroll
            for (int m = 0; m < 4; ++m)
#pragma unroll
                for (int n = 0; n < 2; ++n) t[m][n] = acc[ai][0][m][n] * t[m][n] * acc[ai][1][m][n];
#pragma unroll
            for (int m = 0; m < 4; ++m) { bf16_t* rowp = O + (size_t)(row0 + ai * HALF + m * 16) * ldc + col0; *(u32x4*)rowp = pack8bf(t[m][0], t[m][1]); } }
    }
};

__device__ __forceinline__ void rope8(f32x4& v0, f32x4& v1, const f32x4 cs0, const f32x4 cs1) {
    const float a0 = v0[0], b0 = v0[1], a1 = v0[2], b1 = v0[3], a2 = v1[0], b2 = v1[1], a3 = v1[2], b3 = v1[3];
    v0[0] = a0 * cs0[0] - b0 * cs0[1]; v0[1] = a0 * cs0[1] + b0 * cs0[0];
    v0[2] = a1 * cs0[2] - b1 * cs0[3]; v0[3] = a1 * cs0[3] + b1 * cs0[2];
    v1[0] = a2 * cs1[0] - b2 * cs1[1]; v1[1] = a2 * cs1[1] + b2 * cs1[0];
    v1[2] = a3 * cs1[2] - b3 * cs1[3]; v1[3] = a3 * cs1[3] + b3 * cs1[2];
}

struct EpiWin {
    static constexpr bool PERM = true, AFTER_DRAIN = false, MID = false;
    bf16_t *CQ, *CKV, *SBQ, *SBK, *SBV, *KPE; float* SSQ; const float* ROPE; float sbq_scale;
    __device__ __forceinline__ void operator()(const f32x4 (&acc)[2][2][4][2], const Unit& u, int wr, int wc, int fr, int fq) const {
        const int pn = u.pn; const int row0 = u.pm * BM + wr * 64 + fr;
        if (pn < 17) {
            bf16_t* base; int ldc, colt; float sc = 1.0f; const bool ssq = pn < 5;
            if (pn < 3) { base = CQ; ldc = 768; colt = pn * BM; }
            else if (pn < 5) { base = CKV; ldc = 512; colt = (pn - 3) * BM; }
            else if (pn < 9) { base = SBQ; ldc = 1024; colt = (pn - 5) * BM; sc = sbq_scale; }
            else if (pn < 13) { base = SBK; ldc = 1024; colt = (pn - 9) * BM; }
            else { base = SBV; ldc = 1024; colt = (pn - 13) * BM; }
            const int col0 = colt + wc * 32 + 8 * fq;
#pragma unroll
            for (int ai = 0; ai < 2; ++ai)
#pragma unroll
                for (int m = 0; m < 4; ++m) { const int row = row0 + ai * HALF + m * 16; bf16_t* rowp = base + (size_t)row * ldc + col0; float s = 0.f;
#pragma unroll
                    for (int bj = 0; bj < 2; ++bj) { const f32x4 v0 = acc[ai][bj][m][0] * sc, v1 = acc[ai][bj][m][1] * sc;
                        s += (v0[0] * v0[0] + v0[1] * v0[1]) + (v0[2] * v0[2] + v0[3] * v0[3]) + (v1[0] * v1[0] + v1[1] * v1[1]) + (v1[2] * v1[2] + v1[3] * v1[3]);
                        *(u32x4*)(rowp + bj * HALF) = pack8bf(v0, v1); }
                    if (ssq) { s = add_xor32(add_xor16(s)); if (fq == 0) SSQ[((size_t)row * 5 + pn) * 4 + wc] = s; } }
        } else if (wc < 2) {
            const int c0 = wc * 32 + 8 * fq;
#pragma unroll
            for (int ai = 0; ai < 2; ++ai)
#pragma unroll
                for (int m = 0; m < 4; ++m) { const int row = row0 + ai * HALF + m * 16;
                    const f32x4 cs0 = *(const f32x4*)(ROPE + (size_t)row * 64 + c0), cs1 = *(const f32x4*)(ROPE + (size_t)row * 64 + c0 + 4);
                    f32x4 v0 = acc[ai][0][m][0], v1 = acc[ai][0][m][1]; rope8(v0, v1, cs0, cs1);
                    *(u32x4*)(KPE + (size_t)row * 64 + c0) = pack8bf(v0, v1); }
        }
    }
};

template <bool ROPE_Q> struct EpiRS {
    static constexpr bool PERM = true, AFTER_DRAIN = false, MID = false;
    bf16_t* O; int ldc; const float* SSQ; int t0, nt; float invn, eps, oscale; const float* ROPE;
    __device__ __forceinline__ void operator()(const f32x4 (&acc)[2][2][4][2], const Unit& u, int wr, int wc, int fr, int fq) const {
        const int row0 = u.pm * BM + wr * 64 + fr; const int col0 = u.pn * BM + wc * 32 + 8 * fq;
        float rsv[2][4];
#pragma unroll
        for (int ai = 0; ai < 2; ++ai)
#pragma unroll
            for (int m = 0; m < 4; ++m) { const int row = row0 + ai * HALF + m * 16; f32x4 q = {0.f, 0.f, 0.f, 0.f};
                if (fq < nt && !(EPIRS_SKIP & 2)) q = *(const f32x4*)(SSQ + ((size_t)row * 5 + t0 + fq) * 4);
                rsv[ai][m] = (q[0] + q[1]) + (q[2] + q[3]); }
#pragma unroll
        for (int ai = 0; ai < 2; ++ai)
#pragma unroll
            for (int m = 0; m < 4; ++m) { const float ss = add_xor32(add_xor16(rsv[ai][m])); rsv[ai][m] = oscale / sqrtf(ss * invn + eps); }
#pragma unroll
        for (int ai = 0; ai < 2; ++ai)
#pragma unroll
            for (int m = 0; m < 4; ++m) { const int row = row0 + ai * HALF + m * 16;
                const float rs = rsv[ai][m];
#pragma unroll
                for (int bj = 0; bj < 2; ++bj) { const int c = col0 + bj * HALF; f32x4 v0 = acc[ai][bj][m][0] * rs, v1 = acc[ai][bj][m][1] * rs;
                    if (ROPE_Q && !(EPIRS_SKIP & 1)) { const int w = c % 192; if (w >= 128) { const float* cs = ROPE + (size_t)row * 64 + (w - 128); rope8(v0, v1, *(const f32x4*)cs, *(const f32x4*)(cs + 4)); } }
                    *(u32x4*)(O + (size_t)row * ldc + c) = pack8bf(v0, v1); } }
    }
};

struct WinOrder : StaticOrder {
    __device__ __forceinline__ bool next(int i, Unit& u) const { if (!StaticOrder::next(i, u)) return false; u.pn = u.pn < 5 ? u.pn : (u.pn == 5 ? 17 : u.pn - 1); return true; }
};
struct ListOrder {
    int first, count, stride, pn0;
    __device__ __forceinline__ bool next(int i, Unit& u) const { if (i >= count) return false; const int L = first + i * stride; u.pm = L & 63; u.pn = pn0 + (L >> 6); return true; }
    __device__ __forceinline__ void a_ready(const Unit&) const {}
    __device__ __forceinline__ void done(const Unit&) const {}
};

#ifndef PG8_EPI_DUP
#define PG8_EPI_DUP 0
#endif
template <class Epi, class Sched, bool ALIGN_EPI = false, bool SP2 = false>
__device__ __forceinline__ void gemm_phase(PG8_LAS unsigned char* lds, const Gemm g, const Sched& S, const Epi& E) {
    int tid_ = threadIdx.x; asm volatile("" : "+v"(tid_));
    const int tid = tid_, wid = __builtin_amdgcn_readfirstlane(tid >> 6), lane = tid & 63, wr = wid >> 2, wc = wid & 3, fr = lane & 15, fq = lane >> 4;
    const int K = g.K, nt = K / BK;
    unsigned voffA[2], voffB[2];
#pragma unroll
    for (int i = 0; i < 2; ++i) { int R, C; stage_rc(tid * 16 + i * 8192, R, C); const int Rb = Epi::PERM ? ((R & ~31) + perm32(R & 31)) : R;
        voffA[i] = (unsigned)(R * K + C) * 2u; voffB[i] = (unsigned)(Rb * K + C) * 2u; }
    const size_t kstep = (size_t)(BK * 2);
    const size_t hstep = (size_t)HALF * K * 2;
    const size_t tstep = 2 * hstep;
    const unsigned ldsw = (unsigned)wid * 1024u;
    const int aoff = lds_byte(wr * 64 + fr, fq * 8), boff = lds_byte(wc * 32 + fr, fq * 8);
#define PG8_SA(b, h) (((b) * 2 + (h)) * HTB)
#define PG8_SB(b, h) ((4 + (b) * 2 + (h)) * HTB)
#define PG8_STAGE(bufoff, gbase, voff) do { _Pragma("unroll") for (int _i = 0; _i < 2; ++_i) \
        __builtin_amdgcn_global_load_lds((const unsigned*)((const char*)(gbase) + (voff)[_i]), (PG8_LAS unsigned*)(lds + (bufoff) + ldsw + _i * 8192), 16, 0, 0); } while (0)
#define PG8_LDA(dst, b, h) do { _Pragma("unroll") for (int m = 0; m < 4; ++m) _Pragma("unroll") for (int k = 0; k < 2; ++k) dst[m][k] = *(const PG8_LAS bf16x8*)(lds + PG8_SA(b, h) + aoff + m * 2048 + k * 1024); } while (0)
#define PG8_LDB(dst, b, h) do { _Pragma("unroll") for (int n = 0; n < 2; ++n) _Pragma("unroll") for (int k = 0; k < 2; ++k) dst[n][k] = *(const PG8_LAS bf16x8*)(lds + PG8_SB(b, h) + boff + n * 2048 + k * 1024); } while (0)
#define PG8_MMA(ai, bj, At, Bt) do { __builtin_amdgcn_s_setprio(1); _Pragma("unroll") for (int m = 0; m < 4; ++m) _Pragma("unroll") for (int n = 0; n < 2; ++n) _Pragma("unroll") for (int k = 0; k < 2; ++k) \
        acc[ai][bj][m][n] = __builtin_amdgcn_mfma_f32_16x16x32_bf16(Bt[n][k], At[m][k], acc[ai][bj][m][n], 0, 0, 0); __builtin_amdgcn_s_setprio(0); } while (0)
#define PG8_WAIT_V(n) asm volatile("s_waitcnt vmcnt(" #n ")" ::: "memory")
#define PG8_WAIT_L(n) asm volatile("s_waitcnt lgkmcnt(" #n ")" ::: "memory")
#define PG8_BAR __builtin_amdgcn_s_barrier()
#define PG8_SCHED __builtin_amdgcn_sched_barrier(0)
    Unit cur, nxt; int ui = 0;
    if (!S.next(0, cur)) return;
    f32x4 acc[2][2][4][2];
#pragma unroll
    for (int a = 0; a < 2; ++a)
#pragma unroll
        for (int b = 0; b < 2; ++b)
#pragma unroll
            for (int m = 0; m < 4; ++m)
#pragma unroll
                for (int n = 0; n < 2; ++n) acc[a][b][m][n] = (f32x4){0.f, 0.f, 0.f, 0.f};
    bf16x8 At[4][2], B0[2][2], B1[2][2];
    const char* cA = (const char*)g.A + (size_t)cur.pm * tstep; const char* cB = (const char*)g.Bt + (size_t)cur.pn * tstep;
    S.a_ready(cur);
    if constexpr (SP2) {
        PG8_STAGE(PG8_SB(0, 0), cB, voffB); PG8_STAGE(PG8_SB(0, 1), cB + hstep, voffB); PG8_STAGE(PG8_SA(0, 0), cA, voffA); PG8_STAGE(PG8_SA(0, 1), cA + hstep, voffA);
        if (wr == 1) PG8_BAR;
        PG8_WAIT_V(2); PG8_BAR;
        PG8_STAGE(PG8_SB(1, 0), cB + kstep, voffB); PG8_STAGE(PG8_SA(1, 0), cA + kstep, voffA); PG8_STAGE(PG8_SB(1, 1), cB + hstep + kstep, voffB);
        PG8_WAIT_V(6); PG8_BAR;
    } else {
        PG8_STAGE(PG8_SB(0, 0), cB, voffB); PG8_STAGE(PG8_SA(0, 0), cA, voffA); PG8_STAGE(PG8_SB(0, 1), cB + hstep, voffB); PG8_STAGE(PG8_SA(0, 1), cA + hstep, voffA);
        if (wr == 1) PG8_BAR;
        PG8_WAIT_V(4); PG8_BAR;
        PG8_STAGE(PG8_SB(1, 0), cB + kstep, voffB); PG8_STAGE(PG8_SA(1, 0), cA + kstep, voffA); PG8_STAGE(PG8_SB(1, 1), cB + hstep + kstep, voffB);
        PG8_WAIT_V(6); PG8_BAR;
    }
    for (;;) {
        const bool has_next = S.next(ui + 1, nxt);
        const char* nA = has_next ? (const char*)g.A + (size_t)nxt.pm * tstep : cA; const char* nB = has_next ? (const char*)g.Bt + (size_t)nxt.pn * tstep : cB;
        for (int t = 0; t < nt; t += 2) {
            if constexpr (Epi::MID) { if (t == E.mid_t) E.mid(acc, cur, wr, wc, fr, fq); }
            const bool last = (t == nt - 2);
            const char* a1 = cA + (size_t)(t + 1) * kstep;
            const char* a2 = last ? nA : cA + (size_t)(t + 2) * kstep; const char* b2 = last ? nB : cB + (size_t)(t + 2) * kstep;
            const char* a3 = a2 + kstep; const char* b3 = b2 + kstep;
            if (last && has_next) S.a_ready(nxt);
            if constexpr (SP2) {
            PG8_LDB(B0, 0, 0); PG8_LDB(B1, 0, 1); PG8_SCHED; PG8_LDA(At, 0, 0); PG8_STAGE(PG8_SA(1, 1), a1 + hstep, voffA);
            PG8_WAIT_V(8); PG8_WAIT_L(0); PG8_BAR; PG8_MMA(0, 0, At, B0); PG8_MMA(0, 1, At, B1); PG8_BAR; PG8_SCHED;
            PG8_LDA(At, 0, 1); PG8_STAGE(PG8_SB(0, 0), b2, voffB); PG8_STAGE(PG8_SB(0, 1), b2 + hstep, voffB); PG8_STAGE(PG8_SA(0, 0), a2, voffA);
            PG8_WAIT_V(8); PG8_WAIT_L(0); PG8_BAR; PG8_MMA(1, 0, At, B0); PG8_MMA(1, 1, At, B1); PG8_BAR; PG8_SCHED;
            PG8_LDB(B0, 1, 0); PG8_LDB(B1, 1, 1); PG8_SCHED; PG8_LDA(At, 1, 0); PG8_STAGE(PG8_SA(0, 1), a2 + hstep, voffA);
            PG8_WAIT_V(8); PG8_WAIT_L(0); PG8_BAR; PG8_MMA(0, 0, At, B0); PG8_MMA(0, 1, At, B1); PG8_BAR; PG8_SCHED;
            PG8_LDA(At, 1, 1); PG8_STAGE(PG8_SB(1, 0), b3, voffB); PG8_STAGE(PG8_SB(1, 1), b3 + hstep, voffB); PG8_STAGE(PG8_SA(1, 0), a3, voffA);
            PG8_WAIT_V(8); PG8_WAIT_L(0); PG8_BAR; PG8_MMA(1, 0, At, B0); PG8_MMA(1, 1, At, B1); PG8_BAR; PG8_SCHED;
            } else {
            PG8_LDB(B0, 0, 0); PG8_SCHED; PG8_LDA(At, 0, 0); PG8_STAGE(PG8_SA(1, 1), a1 + hstep, voffA);
            PG8_WAIT_L(8); PG8_BAR; PG8_WAIT_L(0); PG8_MMA(0, 0, At, B0); PG8_BAR; PG8_SCHED;
            PG8_LDB(B1, 0, 1); PG8_STAGE(PG8_SB(0, 0), b2, voffB);
            PG8_BAR; PG8_WAIT_L(0); PG8_MMA(0, 1, At, B1); PG8_BAR;
            PG8_LDA(At, 0, 1); PG8_STAGE(PG8_SA(0, 0), a2, voffA);
            PG8_BAR; PG8_WAIT_L(0); PG8_MMA(1, 0, At, B0); PG8_BAR; PG8_SCHED;
            PG8_STAGE(PG8_SB(0, 1), b2 + hstep, voffB);
            PG8_WAIT_V(6); PG8_BAR; PG8_MMA(1, 1, At, B1); PG8_BAR;
            PG8_LDB(B0, 1, 0); PG8_SCHED; PG8_LDA(At, 1, 0); PG8_STAGE(PG8_SA(0, 1), a2 + hstep, voffA);
            PG8_WAIT_L(8); PG8_BAR; PG8_WAIT_L(0); PG8_MMA(0, 0, At, B0); PG8_BAR; PG8_SCHED;
            PG8_LDB(B1, 1, 1); PG8_STAGE(PG8_SB(1, 0), b3, voffB);
            PG8_BAR; PG8_WAIT_L(0); PG8_MMA(0, 1, At, B1); PG8_BAR;
            PG8_LDA(At, 1, 1); PG8_STAGE(PG8_SA(1, 0), a3, voffA);
            PG8_BAR; PG8_WAIT_L(0); PG8_MMA(1, 0, At, B0); PG8_BAR; PG8_SCHED;
            PG8_STAGE(PG8_SB(1, 1), b3 + hstep, voffB);
            PG8_WAIT_V(6); PG8_BAR; PG8_MMA(1, 1, At, B1); PG8_BAR;
            }
        }
        if constexpr (ALIGN_EPI) { if (wr == 0) PG8_BAR; }
        if constexpr (!Epi::AFTER_DRAIN) { E(acc, cur, wr, wc, fr, fq); if (PG8_EPI_DUP) { asm volatile("" ::: "memory"); E(acc, cur, wr, wc, fr, fq); } S.done(cur); }
        if (!has_next) break;
#pragma unroll
        for (int a = 0; a < 2; ++a)
#pragma unroll
            for (int b = 0; b < 2; ++b)
#pragma unroll
                for (int m = 0; m < 4; ++m)
#pragma unroll
                    for (int n = 0; n < 2; ++n) acc[a][b][m][n] = (f32x4){0.f, 0.f, 0.f, 0.f};
        cur = nxt; cA = nA; cB = nB; ++ui;
        if constexpr (ALIGN_EPI) { if (wr == 1) PG8_BAR; }
    }
    PG8_WAIT_V(0);
    if constexpr (!ALIGN_EPI) { if (wr == 0) PG8_BAR; }
    PG8_BAR;
    if constexpr (Epi::AFTER_DRAIN) { E.fused(acc, cur, wr, wc, fr, fq, lds, wid, lane); S.done(cur); }
#undef PG8_SA
#undef PG8_SB
#undef PG8_STAGE
#undef PG8_LDA
#undef PG8_LDB
#undef PG8_MMA
#undef PG8_WAIT_V
#undef PG8_WAIT_L
#undef PG8_BAR
#undef PG8_SCHED
}
}


namespace att {
typedef unsigned short bf16_t;
typedef short bf16x8 __attribute__((ext_vector_type(8)));
typedef short s16x4 __attribute__((ext_vector_type(4)));
typedef float f32x16 __attribute__((ext_vector_type(16)));
typedef float f32x4 __attribute__((ext_vector_type(4)));
typedef unsigned u32x4 __attribute__((ext_vector_type(4)));
#define ATT_LAS __attribute__((address_space(3)))
#ifndef ATT_THR
#define ATT_THR 8.0f
#endif
#ifndef ATT_SKIP
#define ATT_SKIP 0
#endif
#ifndef ATT_NOCOMPUTE
#define ATT_NOCOMPUTE 0
#endif
#ifndef ATT_PRIO
#define ATT_PRIO 1
#endif
#ifndef SB_EARLY_EXIT
#define SB_EARLY_EXIT 1
#endif
constexpr int KVBLK = 64, QB = 256;
constexpr int SHM_V = 16384, SHM_K = 16384, SHM_R = 8192;
#ifndef ATT_SKEW
#define ATT_SKEW 0
#endif
constexpr int NVS = (ATT_SKEW != 0) ? 4 : 3, NKS = 3;
constexpr int OFF_V = 0, OFF_K = NVS * SHM_V, OFF_R = OFF_K + NKS * SHM_K, OFF_WS = OFF_R + NKS * SHM_R, OFF_FLAG = OFF_WS + 8 * 256, ATT_LDS_BYTES = OFF_FLAG + 64;
#define KSWZ(row, colB) ((row) * 256 + ((colB) ^ (((row) & 7) << 4)))
#define RSWZ(row, colB) ((row) * 128 + ((colB) ^ (((row) & 7) << 4)))
#define SBAR() __builtin_amdgcn_sched_barrier(0)
__device__ __forceinline__ int v_st(int k, int c) { const int kk = (k & ~0xC) | ((k & 4) << 1) | ((k & 8) >> 1); return ((kk >> 3) * 4 + (c >> 5)) * 512 + ((kk & 7) * 32 + (c & 31)) * 2; }
__device__ __forceinline__ int v_rd_base(int lane) { return ((lane & 3) << 3) | (((lane >> 2) & 3) << 6) | (((lane >> 4) & 1) << 5) | (((lane >> 5) & 1) << 8); }
__device__ __forceinline__ int crow(int r, int hi) { return (r & 3) + 8 * (r >> 2) + 4 * hi; }
__device__ __forceinline__ unsigned cvtpk(float lo, float hi) { unsigned r; asm volatile("v_cvt_pk_bf16_f32 %0, %1, %2" : "=v"(r) : "v"(lo), "v"(hi)); return r; }
__device__ __forceinline__ float other_half(float x, int hi) { auto rr = __builtin_amdgcn_permlane32_swap(__float_as_uint(x), __float_as_uint(x), false, false); return __uint_as_float(hi ? rr[0] : rr[1]); }

__device__ __forceinline__ void pack_p(const f32x16& p0, const f32x16& p1, bf16x8& pa0, bf16x8& pa1, bf16x8& pa2, bf16x8& pa3) {
#define PK4(P, B_, OUT) do { unsigned a0 = cvtpk(P[B_+0], P[B_+1]), a1 = cvtpk(P[B_+2], P[B_+3]);                          \
        unsigned b0 = cvtpk(P[B_+4], P[B_+5]), b1 = cvtpk(P[B_+6], P[B_+7]);                                             \
        auto r0 = __builtin_amdgcn_permlane32_swap(a0, b0, false, false); auto r1 = __builtin_amdgcn_permlane32_swap(a1, b1, false, false); \
        u32x4 w = {r0[0], r1[0], r0[1], r1[1]}; OUT = __builtin_bit_cast(bf16x8, w); } while (0)
    PK4(p0, 0, pa0); PK4(p0, 8, pa1); PK4(p1, 0, pa2); PK4(p1, 8, pa3);
#undef PK4
}
__device__ __forceinline__ void pv_tile(f32x16* o, int vb, bf16x8 pa0, bf16x8 pa1, bf16x8 pa2, bf16x8 pa3) {
#define TRRD(dst, off) asm volatile("ds_read_b64_tr_b16 %0, %1 offset:%2" : "=&v"(dst) : "v"(vb), "i"(off) : "memory")
#define PV_D0(d0) do { s16x4 l0, l1, l2, l3, h0, h1, h2, h3; constexpr int b_ = (d0) * 512;   \
        TRRD(l0, b_); TRRD(h0, b_ + 2048); TRRD(l1, b_ + 4096); TRRD(h1, b_ + 6144); TRRD(l2, b_ + 8192); TRRD(h2, b_ + 10240); TRRD(l3, b_ + 12288); TRRD(h3, b_ + 14336); \
        asm volatile("s_waitcnt lgkmcnt(0)" ::: "memory"); SBAR();   \
        o[d0] = __builtin_amdgcn_mfma_f32_32x32x16_bf16((bf16x8){l0[0], l0[1], l0[2], l0[3], h0[0], h0[1], h0[2], h0[3]}, pa0, o[d0], 0, 0, 0);   \
        o[d0] = __builtin_amdgcn_mfma_f32_32x32x16_bf16((bf16x8){l1[0], l1[1], l1[2], l1[3], h1[0], h1[1], h1[2], h1[3]}, pa1, o[d0], 0, 0, 0);   \
        o[d0] = __builtin_amdgcn_mfma_f32_32x32x16_bf16((bf16x8){l2[0], l2[1], l2[2], l2[3], h2[0], h2[1], h2[2], h2[3]}, pa2, o[d0], 0, 0, 0);   \
        o[d0] = __builtin_amdgcn_mfma_f32_32x32x16_bf16((bf16x8){l3[0], l3[1], l3[2], l3[3], h3[0], h3[1], h3[2], h3[3]}, pa3, o[d0], 0, 0, 0); } while (0)
    PV_D0(0); PV_D0(1); PV_D0(2); PV_D0(3);
#undef PV_D0
#undef TRRD
}

template <bool SB>
__device__ __forceinline__ void attn_block(ATT_LAS unsigned char* lds, const bf16_t* Qg, int ldq, const bf16_t* Kg, int ldk, const bf16_t* Vg, int ldv, const bf16_t* Rg, bf16_t* Og, int ldo, float* Sq  , int P0) {
    constexpr int NQ = SB ? 8 : 12;
    constexpr int NDMA = SB ? 4 : 5;
    int tid_ = threadIdx.x; asm volatile("" : "+v"(tid_));
    const int tid = tid_, wid = __builtin_amdgcn_readfirstlane(tid >> 6), lane = tid & 63, r32 = lane & 31, hi = lane >> 5;
    const int qlo = P0 + wid * 32;
    const int NT = (P0 + QB) / KVBLK;
    ATT_LAS unsigned char* V_lds = lds + OFF_V; ATT_LAS unsigned char* K_lds = lds + OFF_K; ATT_LAS unsigned char* R_lds = lds + OFF_R;
    ATT_LAS float* ws = (ATT_LAS float*)(lds + OFF_WS) + wid * 64;
    ATT_LAS unsigned* flags = (ATT_LAS unsigned*)(lds + OFF_FLAG);
    const int vb0 = (int)(unsigned)(uintptr_t)V_lds + v_rd_base(lane);
    int kofs, vofs, rofs;
    { const int row = 4 * wid + (lane >> 4); kofs = row * ldk + ((((lane & 15) * 16) ^ ((row & 7) << 4)) >> 1); }
    { const int sub = 2 * wid + (lane >> 5), kk = (sub >> 2) * 8 + ((lane & 31) >> 2), k = (kk & ~0xC) | ((kk & 4) << 1) | ((kk & 8) >> 1); vofs = k * ldv + (sub & 3) * 32 + (lane & 3) * 8; }
    { const int row = 8 * wid + (lane >> 3); rofs = row * 64 + ((((lane & 7) ^ (row & 7)) * 16) >> 1); }
#define STAGE_DMA(t_, ks_, vs_) do { const size_t k0_ = (size_t)(t_) * KVBLK;                                                                                   \
        __builtin_amdgcn_global_load_lds((const unsigned*)(Kg + k0_ * ldk + kofs), (ATT_LAS unsigned*)(K_lds + (ks_) * SHM_K + wid * 1024), 16, 0, 0);                 \
        __builtin_amdgcn_global_load_lds((const unsigned*)(Kg + (k0_ + 32) * ldk + kofs), (ATT_LAS unsigned*)(K_lds + (ks_) * SHM_K + 8192 + wid * 1024), 16, 0, 0);   \
        __builtin_amdgcn_global_load_lds((const unsigned*)(Vg + k0_ * ldv + vofs), (ATT_LAS unsigned*)(V_lds + (vs_) * SHM_V + wid * 1024), 16, 0, 0);                 \
        __builtin_amdgcn_global_load_lds((const unsigned*)(Vg + (k0_ + 32) * ldv + vofs), (ATT_LAS unsigned*)(V_lds + (vs_) * SHM_V + 8192 + wid * 1024), 16, 0, 0);   \
        if (!SB) __builtin_amdgcn_global_load_lds((const unsigned*)(Rg + k0_ * 64 + rofs), (ATT_LAS unsigned*)(R_lds + (ks_) * SHM_R + wid * 1024), 16, 0, 0); } while (0)
#define TILE_OF(it_) (SB ? NT - 1 - (it_) : (it_))
#define WAIT_BAR(n_) do { if ((n_) == 0) asm volatile("s_waitcnt vmcnt(0) lgkmcnt(0)\n\ts_barrier" ::: "memory"); else if (SB) asm volatile("s_waitcnt vmcnt(4) lgkmcnt(0)\n\ts_barrier" ::: "memory"); else asm volatile("s_waitcnt vmcnt(5) lgkmcnt(0)\n\ts_barrier" ::: "memory"); } while (0)
    bf16x8 qr[NQ];
#pragma unroll
    for (int d0 = 0; d0 < NQ; ++d0) qr[d0] = *(const bf16x8*)(Qg + (size_t)(wid * 32 + r32) * ldq + d0 * 16 + hi * 8);
    f32x16 o[4];
#pragma unroll
    for (int d = 0; d < 4; ++d)
#pragma unroll
        for (int r = 0; r < 16; ++r) o[d][r] = 0.f;
    float m_reg = 0.f, l_reg = 0.f, R = 1.f; bool first_tile = true;
    int kro[4];
#pragma unroll
    for (int dd = 0; dd < 4; ++dd) kro[dd] = KSWZ(r32, (dd * 16 + hi * 8) * 2);
    STAGE_DMA(TILE_OF(0), 0, 0);
    if (NT > 1) { STAGE_DMA(TILE_OF(1), 1, 1); WAIT_BAR(NDMA); } else WAIT_BAR(0);
    const bool skew = ATT_SKEW && (ATT_SKEW == 1 ? wid >= 4 : (ATT_SKEW == 2 ? (wid & 1) : ((wid >> 1) & 1)));
    f32x16 p0, p1;
    bool pend = false; int pend_kb = 0, pend_vs = 0;
    int vs = 0, ks = 0, nt_eff = NT;
    for (int it = 0; it < nt_eff + ((ATT_SKEW != 0) ? 1 : 0); ++it) {
        const bool tile = it < nt_eff;
        const int t = TILE_OF(it); const int buf = it & 1; const bool more2 = tile && it + 2 < NT;
        { const int ks2 = ks == 0 ? 2 : ks - 1, vs2 = vs + 2 >= NVS ? vs + 2 - NVS : vs + 2;
          if (more2) STAGE_DMA(TILE_OF(it + 2), ks2, vs2); }
        const int kb = t * KVBLK;
        const bool act = tile && kb <= qlo + 31 && !ATT_NOCOMPUTE;
        bool do_sm; int sm_kb, sm_vs;
        if (!skew) { do_sm = act; sm_kb = kb; sm_vs = vs;
            if (act) {
#pragma unroll
            for (int r = 0; r < 16; ++r) { p0[r] = SB ? 0.f : -m_reg; p1[r] = SB ? 0.f : -m_reg; }
            ATT_LAS const unsigned char* kt = K_lds + ks * SHM_K;
            __builtin_amdgcn_s_setprio(ATT_PRIO);
            if (ATT_SKIP & 1) { p0[0] = (float)r32; p1[3] = (float)hi; } else {
#pragma unroll
            for (int d0 = 0; d0 < 8; ++d0) { ATT_LAS const unsigned char* a = kt + kro[d0 & 3] + (d0 >> 2) * 128;
                const bf16x8 b0 = *(ATT_LAS const bf16x8*)a; const bf16x8 b1 = *(ATT_LAS const bf16x8*)(a + 32 * 256);
                p0 = __builtin_amdgcn_mfma_f32_32x32x16_bf16(b0, qr[d0], p0, 0, 0, 0);
                p1 = __builtin_amdgcn_mfma_f32_32x32x16_bf16(b1, qr[d0], p1, 0, 0, 0); }
            if (!SB) { ATT_LAS const unsigned char* rt = R_lds + ks * SHM_R;
#pragma unroll
                for (int d0 = 0; d0 < 4; ++d0) { ATT_LAS const unsigned char* a = rt + (kro[d0] - 128 * r32);
                    const bf16x8 b0 = *(ATT_LAS const bf16x8*)a; const bf16x8 b1 = *(ATT_LAS const bf16x8*)(a + 32 * 128);
                    const bf16x8 qf = qr[SB ? 0 : 8 + d0];
                    p0 = __builtin_amdgcn_mfma_f32_32x32x16_bf16(b0, qf, p0, 0, 0, 0);
                    p1 = __builtin_amdgcn_mfma_f32_32x32x16_bf16(b1, qf, p1, 0, 0, 0); } }
            }
            __builtin_amdgcn_s_setprio(0);
            }
        } else { do_sm = pend; sm_kb = pend_kb; sm_vs = pend_vs; }
        if (do_sm) {
            const int dql = qlo + r32 - sm_kb - 4 * hi - (SB ? 1 : 0);
            const bool need_mask = SB ? (sm_kb + KVBLK - 1 >= qlo) : (sm_kb + KVBLK - 1 > qlo);
            bf16x8 pa0, pa1, pa2, pa3;
            if (ATT_SKIP & 2) { pa0 = __builtin_bit_cast(bf16x8, (f32x4){p0[0], p0[5], p0[10], p0[15]}); pa1 = __builtin_bit_cast(bf16x8, (f32x4){p1[0], p1[5], p1[10], p1[15]}); pa2 = pa0; pa3 = pa1; }
            else if (!SB) {
                if (need_mask) { const float NEG = -__builtin_inff();
#pragma unroll
                    for (int r = 0; r < 16; ++r) { const int c = (r & 3) + 8 * (r >> 2); if (c > dql) p0[r] = NEG; if (c + 32 > dql) p1[r] = NEG; } }
                float pmax = p0[0];
#pragma unroll
                for (int r = 1; r < 16; ++r) pmax = fmaxf(pmax, p0[r]);
#pragma unroll
                for (int r = 0; r < 16; ++r) pmax = fmaxf(pmax, p1[r]);
                pmax = fmaxf(pmax, other_half(pmax, hi));
                if (first_tile || __any(pmax > ATT_THR)) { const float dl = first_tile ? pmax : fmaxf(pmax, 0.f);
                    m_reg += dl;
#pragma unroll
                    for (int r = 0; r < 16; ++r) { p0[r] -= dl; p1[r] -= dl; }
                    if (!first_tile) { const float alpha = __builtin_amdgcn_exp2f(-dl); l_reg *= alpha;
#pragma unroll
                        for (int d = 0; d < 4; ++d)
#pragma unroll
                            for (int r = 0; r < 16; ++r) o[d][r] *= alpha; }
                    first_tile = false; }
                float ps = 0.f;
#pragma unroll
                for (int r = 0; r < 16; ++r) { p0[r] = __builtin_amdgcn_exp2f(p0[r]); ps += p0[r]; }
#pragma unroll
                for (int r = 0; r < 16; ++r) { p1[r] = __builtin_amdgcn_exp2f(p1[r]); ps += p1[r]; }
                ps += other_half(ps, hi);
                l_reg += ps;
                pack_p(p0, p1, pa0, pa1, pa2, pa3);
            } else {
                f32x16 l0, l1;
#pragma unroll
                for (int r = 0; r < 16; ++r) { const float e = __builtin_amdgcn_exp2f(fminf(-p0[r], 126.f)); const float be = __builtin_amdgcn_rcpf(1.0f + e); p0[r] = be; l0[r] = e * be; }
#pragma unroll
                for (int r = 0; r < 16; ++r) { const float e = __builtin_amdgcn_exp2f(fminf(-p1[r], 126.f)); const float be = __builtin_amdgcn_rcpf(1.0f + e); p1[r] = be; l1[r] = e * be; }
                if (need_mask) {
#pragma unroll
                    for (int r = 0; r < 16; ++r) { const int c = (r & 3) + 8 * (r >> 2); if (c > dql) { p0[r] = 0.f; l0[r] = 1.f; } if (c + 32 > dql) { p1[r] = 0.f; l1[r] = 1.f; } } }
                float T[8];
#pragma unroll
                for (int g = 0; g < 4; ++g) {
                    { const float a0 = l0[4 * g], a1 = l0[4 * g + 1], a2 = l0[4 * g + 2], a3 = l0[4 * g + 3]; const float x2 = a3, x1 = a3 * a2, x0 = x1 * a1; T[g] = x0 * a0;
                      l0[4 * g] = x0; l0[4 * g + 1] = x1; l0[4 * g + 2] = x2; l0[4 * g + 3] = 1.f; }
                    { const float a0 = l1[4 * g], a1 = l1[4 * g + 1], a2 = l1[4 * g + 2], a3 = l1[4 * g + 3]; const float x2 = a3, x1 = a3 * a2, x0 = x1 * a1; T[4 + g] = x0 * a0;
                      l1[4 * g] = x0; l1[4 * g + 1] = x1; l1[4 * g + 2] = x2; l1[4 * g + 3] = 1.f; }
                }
                float gs[8]; float run = R;
#pragma unroll
                for (int g = 7; g >= 0; --g) { const float To = other_half(T[g], hi); gs[g] = hi == 0 ? run * To : run; run *= T[g] * To; }
                R = run;
#pragma unroll
                for (int g = 0; g < 4; ++g)
#pragma unroll
                    for (int i = 0; i < 4; ++i) { p0[4 * g + i] = p0[4 * g + i] * (l0[4 * g + i] * gs[g]); p1[4 * g + i] = p1[4 * g + i] * (l1[4 * g + i] * gs[4 + g]); }
                pack_p(p0, p1, pa0, pa1, pa2, pa3);
            }
            if (!(ATT_SKIP & 4)) { __builtin_amdgcn_s_setprio(ATT_PRIO); pv_tile(o, vb0 + sm_vs * SHM_V, pa0, pa1, pa2, pa3); __builtin_amdgcn_s_setprio(0); } else { o[0][0] += __builtin_bit_cast(f32x4, pa0)[0] + __builtin_bit_cast(f32x4, pa1)[0] + __builtin_bit_cast(f32x4, pa2)[0] + __builtin_bit_cast(f32x4, pa3)[0]; }
        }
        if (skew) { pend = act; pend_kb = kb; pend_vs = vs;
            if (act) {
#pragma unroll
            for (int r = 0; r < 16; ++r) { p0[r] = SB ? 0.f : -m_reg; p1[r] = SB ? 0.f : -m_reg; }
            ATT_LAS const unsigned char* kt = K_lds + ks * SHM_K;
            __builtin_amdgcn_s_setprio(ATT_PRIO);
            if (ATT_SKIP & 1) { p0[0] = (float)r32; p1[3] = (float)hi; } else {
#pragma unroll
            for (int d0 = 0; d0 < 8; ++d0) { ATT_LAS const unsigned char* a = kt + kro[d0 & 3] + (d0 >> 2) * 128;
                const bf16x8 b0 = *(ATT_LAS const bf16x8*)a; const bf16x8 b1 = *(ATT_LAS const bf16x8*)(a + 32 * 256);
                p0 = __builtin_amdgcn_mfma_f32_32x32x16_bf16(b0, qr[d0], p0, 0, 0, 0);
                p1 = __builtin_amdgcn_mfma_f32_32x32x16_bf16(b1, qr[d0], p1, 0, 0, 0); }
            if (!SB) { ATT_LAS const unsigned char* rt = R_lds + ks * SHM_R;
#pragma unroll
                for (int d0 = 0; d0 < 4; ++d0) { ATT_LAS const unsigned char* a = rt + (kro[d0] - 128 * r32);
                    const bf16x8 b0 = *(ATT_LAS const bf16x8*)a; const bf16x8 b1 = *(ATT_LAS const bf16x8*)(a + 32 * 128);
                    const bf16x8 qf = qr[SB ? 0 : 8 + d0];
                    p0 = __builtin_amdgcn_mfma_f32_32x32x16_bf16(b0, qf, p0, 0, 0, 0);
                    p1 = __builtin_amdgcn_mfma_f32_32x32x16_bf16(b1, qf, p1, 0, 0, 0); } }
            }
            __builtin_amdgcn_s_setprio(0);
            }
        }
        if (SB && SB_EARLY_EXIT && tile) { const bool dead = __all(R == 0.f); if (lane == 0) flags[buf * 8 + wid] = dead ? 1u : 0u; }
        asm volatile("" ::: "memory");
        if (more2) WAIT_BAR(NDMA); else WAIT_BAR(0);
        asm volatile("" ::: "memory");
        if (SB && SB_EARLY_EXIT && tile) { const u32x4 f0 = *(ATT_LAS const u32x4*)(flags + buf * 8), f1 = *(ATT_LAS const u32x4*)(flags + buf * 8 + 4);
            if ((f0[0] & f0[1] & f0[2] & f0[3] & f1[0] & f1[1] & f1[2] & f1[3]) != 0u) nt_eff = it + 1; }
        vs = vs + 1 == NVS ? 0 : vs + 1; ks = ks == 2 ? 0 : ks + 1;
    }
    { const float rl = SB ? 1.0f : ((ATT_NOCOMPUTE && !(l_reg > 0.f)) ? 0.f : 1.0f / l_reg);
      unsigned char* rowb = (unsigned char*)(Og + (size_t)(wid * 32 + r32) * ldo) + (hi ? 16 : 0);
      { float sq = 0.f;
#pragma unroll
        for (int d = 0; d < 4; ++d)
#pragma unroll
            for (int r = 0; r < 16; ++r) { const float v = o[d][r] * rl; sq += v * v; }
        sq += other_half(sq, hi);
        if (hi == 0) Sq[(size_t)(wid * 32 + r32) * 16] = sq; }
#pragma unroll
      for (int k = 0; k < 16; k += 2) { const int d0 = k >> 2, ra = (k & 3) * 4, rb = ra + 4;
          unsigned ax = cvtpk(o[d0][ra] * rl, o[d0][ra + 1] * rl), ay = cvtpk(o[d0][ra + 2] * rl, o[d0][ra + 3] * rl);
          unsigned bx = cvtpk(o[d0][rb] * rl, o[d0][rb + 1] * rl), by = cvtpk(o[d0][rb + 2] * rl, o[d0][rb + 3] * rl);
          auto sx = __builtin_amdgcn_permlane32_swap(ax, bx, false, false); auto sy = __builtin_amdgcn_permlane32_swap(ay, by, false, false);
          *(u32x4*)(rowb + 16 * k) = (u32x4){sx[0], sy[0], sx[1], sy[1]}; } }
    asm volatile("" ::: "memory");
    asm volatile("s_waitcnt vmcnt(0) lgkmcnt(0)\n\ts_barrier" ::: "memory");
    asm volatile("" ::: "memory");
#undef STAGE_DMA
#undef TILE_OF
#undef WAIT_BAR
}
#undef KSWZ
#undef RSWZ
}

#ifdef DUP_LN
#define DUP_LN_ANY DUP_LN
#else
#define DUP_LN_ANY 0
#endif

constexpr int NWAVES = 8;
constexpr int D = 2048, BATCH = 4, SEQ = 4096, DEPTH = 4, M = BATCH * SEQ, FF = 5632, NADA = 9;
constexpr int QLR = 768, KVLR = 512, ROPE_D = 64, NH = 8, HD = 128, QKD = 192;
constexpr int IN_COLS = QLR + KVLR + ROPE_D + 3 * NH * HD;
constexpr int WIN_ROWS = 4608;
constexpr float LN_EPS = 1e-5f, RMS_EPS = 1e-6f;
constexpr float DN_ALPHA = 1.6817928305074290f;
constexpr float LOG2E = 1.4426950408889634f;
constexpr float MLA_QSCALE = 0.07216878364870322f * LOG2E;
constexpr float SB_QSCALE = 0.08838834764831845f * LOG2E;
#ifndef MK_ONE_LAUNCH
#define MK_ONE_LAUNCH 1
#endif
constexpr int N_PHASES = 3 + 8 * 3 + 4 * 5;

constexpr size_t MiB = 1u << 20;
#ifndef TPROBE
#define TPROBE 0
#endif
constexpr size_t WS_CTL = 0, CTL_ZERO_BYTES = TPROBE ? 1 * MiB : 64 * 1024;
constexpr size_t WS_ADA = 1 * MiB;
constexpr size_t WS_ADAP = 3 * MiB;
constexpr size_t WS_VEC = 22 * MiB;
constexpr size_t WS_ROPE = 24 * MiB;
constexpr size_t WS_SSQ = 28 * MiB;
constexpr size_t WS_KPE = 30 * MiB;
constexpr size_t WS_HL = 32 * MiB;
constexpr size_t WS_OSSQ = 64 * MiB;
constexpr size_t WS_H = 160 * MiB;
constexpr size_t WS_F = 224 * MiB;
constexpr size_t WS_ACT = 288 * MiB;
constexpr size_t WS_CQ = 464 * MiB;
constexpr size_t WS_CKV = 488 * MiB;
constexpr size_t WS_SBQ = 504 * MiB, WS_SBK = 536 * MiB, WS_SBV = 568 * MiB;
constexpr size_t WS_QM = 600 * MiB;
constexpr size_t WS_KV = 648 * MiB;
constexpr size_t WS_O = 712 * MiB;
constexpr size_t WS_W = 776 * MiB;
constexpr size_t W_WI = (size_t)2 * FF * D * 2, W_WO = (size_t)D * FF * 2, W_WIN = (size_t)WIN_ROWS * D * 2, W_WUQ = (size_t)NH * QKD * QLR * 2, W_WUKV = (size_t)NH * 256 * KVLR * 2, W_WOUT = (size_t)D * D * 2;
constexpr size_t WO_WI1 = 0, WO_WO1 = WO_WI1 + W_WI, WO_WI2 = WO_WO1 + W_WO, WO_WO2 = WO_WI2 + W_WI, WO_WIN = WO_WO2 + W_WO, WO_WUQ = WO_WIN + W_WIN, WO_WUKV = WO_WUQ + W_WUQ, WO_WOUT = WO_WUKV + W_WUKV;
constexpr size_t W_LAYER = WO_WOUT + W_WOUT;
constexpr size_t WS_DUMMY = WS_W + DEPTH * W_LAYER;
constexpr size_t WS_END = WS_DUMMY + (size_t)(DUP_LN_ANY ? 128 : 0) * MiB;
static_assert(W_LAYER % 256 == 0 && WS_END < (size_t)1700 * MiB, "ws map");
constexpr int ADA_KS = 16;
constexpr int CW_BAR = 4096;

constexpr int RING_OFF = 0, SCR_BYTES = 147200;
constexpr int MISC_OFF = SCR_BYTES;
constexpr int LDS_BYTES = 147456;

#define GAS __attribute__((address_space(1)))
#define LAS __attribute__((address_space(3)))
typedef unsigned short bf16;
typedef unsigned v4u __attribute__((ext_vector_type(4)));
typedef unsigned v2u __attribute__((ext_vector_type(2)));
typedef float f32x4 __attribute__((ext_vector_type(4)));
#define LDS_WAIT() asm volatile("s_waitcnt lgkmcnt(0)" ::: "memory")
#define VM_WAIT() asm volatile("s_waitcnt vmcnt(0)" ::: "memory")
__device__ __forceinline__ unsigned pk2(float lo, float hi) { unsigned r; asm volatile("v_cvt_pk_bf16_f32 %0, %1, %2" : "=v"(r) : "v"(lo), "v"(hi)); return r; }
__device__ __forceinline__ float bf_lo(unsigned w) { return __uint_as_float(w << 16); }
__device__ __forceinline__ float bf_hi(unsigned w) { return __uint_as_float(w & 0xffff0000u); }
__device__ __forceinline__ float wave_sum(float v) {
    v += __builtin_bit_cast(float, __builtin_amdgcn_update_dpp(0, __builtin_bit_cast(int, v), 0xB1, 0xF, 0xF, false));
    v += __builtin_bit_cast(float, __builtin_amdgcn_update_dpp(0, __builtin_bit_cast(int, v), 0x4E, 0xF, 0xF, false));
    v += __builtin_bit_cast(float, __builtin_amdgcn_update_dpp(0, __builtin_bit_cast(int, v), 0x124, 0xF, 0xF, false));
    v += __builtin_bit_cast(float, __builtin_amdgcn_update_dpp(0, __builtin_bit_cast(int, v), 0x128, 0xF, 0xF, false));
    { auto a = __builtin_amdgcn_permlane16_swap(__float_as_uint(v), __float_as_uint(v), false, false); v = __uint_as_float(a[0]) + __uint_as_float(a[1]); }
    { auto b = __builtin_amdgcn_permlane32_swap(__float_as_uint(v), __float_as_uint(v), false, false); v = __uint_as_float(b[0]) + __uint_as_float(b[1]); }
    return v;
}

#define XB_TMO      128
#define XB_XCNT(j)  (256  + 64 * (j))
#define XB_XSUB(j)  (1280 + 64 * (j))
#define XB_XGEN(j)  (2304 + 64 * (j))
#define XB_TOP      3328
#define XB_TOPGEN   3392
#define XCD_BAR_WORDS 3456
#define XB_SPIN_CAP (1u << 18)

__device__ __forceinline__ unsigned xb_ld(unsigned* p)              { return __hip_atomic_load(p, __ATOMIC_RELAXED, __HIP_MEMORY_SCOPE_AGENT); }
__device__ __forceinline__ unsigned xb_add(unsigned* p, unsigned v) { return __hip_atomic_fetch_add(p, v, __ATOMIC_RELAXED, __HIP_MEMORY_SCOPE_AGENT); }
__device__ __forceinline__ unsigned xb_xcc_id() { return (unsigned)__builtin_amdgcn_s_getreg((3 << 11) | 20) & 0xFu; }
#define XB_SPIN(cond, bar) do { unsigned _sp = 0; while (cond) { __builtin_amdgcn_s_sleep(1); \
    if ((++_sp & 255u) == 0u) { if (xb_ld(&(bar)[XB_TMO])) break; if (_sp > XB_SPIN_CAP) { atomicAdd(&(bar)[XB_TMO], 1u); break; } } } } while (0)

struct XcdBarrier {
    unsigned* bar; unsigned x;
    volatile LAS unsigned* st;
};

__device__ __forceinline__ XcdBarrier xcd_barrier_post(unsigned* bar, volatile LAS unsigned* st) {
    XcdBarrier b; b.bar = bar; b.x = xb_xcc_id(); b.st = st;
    if (threadIdx.x == 0) (void)xb_add(&bar[XB_XCNT(b.x)], 1u);
    return b;
}
__device__ __forceinline__ void xcd_barrier_complete(unsigned* bar, unsigned x, unsigned& nloc, unsigned& nx) {
    const unsigned G = gridDim.x * gridDim.y * gridDim.z;
    unsigned sum, cnt, mine, sp = 0u;
    for (;;) {
        sum = 0u; cnt = 0u; mine = 0u;
#pragma unroll 1
        for (unsigned j = 0; j < 16; ++j) { const unsigned c = xb_ld(&bar[XB_XCNT(j)]); sum += c; cnt += (c > 0u) ? 1u : 0u; mine = (j == x) ? c : mine; }
        if (sum == G) break;
        __builtin_amdgcn_s_sleep(1);
        if ((++sp & 255u) == 0u) { if (xb_ld(&bar[XB_TMO])) break; if (sp > XB_SPIN_CAP) { atomicAdd(&bar[XB_TMO], 1u); break; } }
    }
    nloc = mine > 0u ? mine : 1u; nx = cnt > 0u ? cnt : 1u;
}

__device__ __forceinline__ void xcd_barrier(const XcdBarrier& b) {
    asm volatile("s_waitcnt vmcnt(0)" ::: "memory");
    __syncthreads();
    if (threadIdx.x == 0) {
        unsigned* bar = b.bar;
        __builtin_amdgcn_s_waitcnt(0);
        unsigned nloc = b.st[0], nx = b.st[1];
        if (nloc == 0u) { xcd_barrier_complete(bar, b.x, nloc, nx); b.st[0] = nloc; b.st[1] = nx; }
        const unsigned old = xb_add(&bar[XB_XSUB(b.x)], 1u);
        const unsigned gen = old / nloc;
        if (old + 1u == (gen + 1u) * nloc) {
            __builtin_amdgcn_fence(__ATOMIC_RELEASE, "agent");
            asm volatile("s_waitcnt vmcnt(0)" ::: "memory");
            const unsigned og = xb_add(&bar[XB_TOP], 1u);
            const unsigned tg = og / nx;
            if (og + 1u == (tg + 1u) * nx) xb_add(&bar[XB_TOPGEN], 1u);
            else XB_SPIN(xb_ld(&bar[XB_TOPGEN]) == tg, bar);
            __builtin_amdgcn_fence(__ATOMIC_ACQUIRE, "agent");
            xb_add(&bar[XB_XGEN(b.x)], 1u);
            asm volatile("s_waitcnt vmcnt(0)" ::: "memory");
        } else {
            XB_SPIN(xb_ld(&bar[XB_XGEN(b.x)]) == gen, bar);
            __builtin_amdgcn_fence(__ATOMIC_ACQUIRE, "agent");
            asm volatile("s_waitcnt vmcnt(0)" ::: "memory");
        }
    }
    __syncthreads();
}

#ifndef LN_NS
#define LN_NS 1
#endif
#ifndef W_MANT_DROP
#define W_MANT_DROP 0
#endif
#ifndef TPROBE_SCALE
#define TPROBE_SCALE 1.0f
#endif
#ifndef TPROBE
#define TPROBE 0
#endif
#ifndef TPROBE_WG
#define TPROBE_WG 0
#endif
#ifndef TPROBE_A
#define TPROBE_A 6
#endif
#ifndef TPROBE_B
#define TPROBE_B 7
#endif
#ifndef G1_SP2
#define G1_SP2 true
#endif
#ifndef DUP_BAR
#define DUP_BAR 0
#endif
#ifndef G1_ALIGN
#define G1_ALIGN true
#endif
#ifndef GF_ALIGN
#define GF_ALIGN true
#endif
#ifndef DUP_ATT_WHICH
#define DUP_ATT_WHICH 3
#endif
#ifndef DUP_P0
#define DUP_P0 0
#endif
#ifndef DUP_P1
#define DUP_P1 0
#endif
#ifndef DUP_P2
#define DUP_P2 0
#endif
#ifndef DUP_G1
#define DUP_G1 0
#endif
#ifndef DUP_WIN
#define DUP_WIN 0
#endif
#ifndef DUP_UQKV
#define DUP_UQKV 0
#endif
#ifndef DUP_ATT
#define DUP_ATT 0
#endif
#ifndef DUP_ONORM
#define DUP_ONORM 0
#endif
#ifndef DUP_GF
#define DUP_GF 0
#endif
#ifndef DUP_LN
#define DUP_LN 0
#endif
#define REP(n) for (int rep_ = 0; rep_ < 1 + (n); ++rep_)
#ifndef P0_PARTS
#define P0_PARTS 7
#endif
#ifndef BG_ON
#define BG_ON 1
#endif
#ifndef BG_SITES
#define BG_SITES 31
#endif
#ifndef BG_DIV
#define BG_DIV 0u
#endif
#ifndef BG_XDONE
#define BG_XDONE 1
#endif
#ifndef BG_EST0
#define BG_EST0 400u
#endif
#ifndef SITE_P0
#define SITE_P0 1
#endif
#ifndef SITE_P1
#define SITE_P1 1
#endif
#ifndef SITE_P2
#define SITE_P2 1
#endif
#ifndef SITE_ATT
#define SITE_ATT 3
#endif
#ifndef SITE_ONORM
#define SITE_ONORM 1
#endif
#ifndef SITE_G1
#define SITE_G1 1
#endif
#ifndef SITE_WIN
#define SITE_WIN 1
#endif
#ifndef SITE_UQKV
#define SITE_UQKV 1
#endif
#ifndef SITE_GF
#define SITE_GF 1
#endif
#ifndef SITE_LN
#define SITE_LN 1
#endif
#ifndef DBG_LAST_S
#define DBG_LAST_S (3 * DEPTH - 1)
#endif
#ifndef P0_PARTS
#define P0_PARTS 7
#endif
#ifndef BG_ON
#define BG_ON 1
#endif
#ifndef BG_SITES
#define BG_SITES 31
#endif
#ifndef BG_DIV
#define BG_DIV 0u
#endif
#ifndef BG_XDONE
#define BG_XDONE 1
#endif
#ifndef BG_EST0
#define BG_EST0 400u
#endif

struct Frame {
    LAS unsigned char* lds;
    int tid, lane, wave;
    int vcu, G;
};

__device__ __forceinline__ int dst_row(int kind, int n) {
    if (kind == 1) { const int u = n >= FF ? 1 : 0, j = n - u * FF; return (j >> 7) * 256 + u * 128 + (j & 127); }
    if (kind == 2) { if (n < QLR + KVLR) return n; if (n < QLR + KVLR + ROPE_D) { const int j = n - (QLR + KVLR); return 4352 + (j < 32 ? 2 * j : 2 * (j - 32) + 1); } return n - ROPE_D; }
    if (kind == 3) { const int h = n / QKD, w = n - h * QKD; if (w < 128) return n; const int j = w - 128; return h * QKD + 128 + (j < 32 ? 2 * j : 2 * (j - 32) + 1); }
    return n;
}
__device__ __forceinline__ void tr_item(const float* __restrict__ W, int K, int N, bf16* __restrict__ WT, int kind, const float* __restrict__ gk, LAS float* scr, int item, int lane) {
    const int nblk = N >> 6, kb = item / nblk, nb = item - kb * nblk, k0 = kb << 6, n0 = nb << 6;
    const int kk4 = lane >> 4, n4 = (lane & 15) * 4;
    const float* src = W + (size_t)(k0 + kk4) * N + n0 + n4;
    f32x4 wv[16];
#pragma unroll
    for (int i = 0; i < 16; ++i) wv[i] = *(const f32x4*)(src + (size_t)(4 * i) * N);
#pragma unroll
    for (int i = 0; i < 16; ++i) { const int kk = 4 * i + kk4; f32x4 w = wv[i]; if (gk) w = w * gk[k0 + kk];
        LAS float* d = scr + kk * 65 + n4; d[0] = w[0]; d[1] = w[1]; d[2] = w[2]; d[3] = w[3]; }
    LDS_WAIT(); asm volatile("" ::: "memory");
    const int c = lane & 7;
#pragma unroll
    for (int j = 0; j < 8; ++j) { const int n = (lane >> 3) + 8 * j; const LAS float* s = scr + (8 * c) * 65 + n;
        v4u o; o.x = pk2(s[0 * 65], s[1 * 65]); o.y = pk2(s[2 * 65], s[3 * 65]); o.z = pk2(s[4 * 65], s[5 * 65]); o.w = pk2(s[6 * 65], s[7 * 65]);
#if W_MANT_DROP
        { const unsigned hb = (1u << (W_MANT_DROP - 1)) * 0x00010001u, mk = ~(((1u << W_MANT_DROP) - 1u) * 0x00010001u);
#pragma unroll
          for (int e = 0; e < 4; ++e) o[e] = (o[e] + hb) & mk; }
#endif
        *(v4u*)(WT + (size_t)dst_row(kind, n0 + n) * K + k0 + 8 * c) = o; }
    LDS_WAIT(); asm volatile("" ::: "memory");
}

struct Args { const float* in[19]; float* out; unsigned char* ws; int ph_lo, ph_hi; };
typedef const __attribute__((address_space(4))) Args CArgs;
__device__ __forceinline__ CArgs* fresh_args(CArgs* p) { asm volatile("" : "+s"(p)); return p; }
__device__ __forceinline__ Frame fresh_frame(Frame F) { asm volatile("" : "+v"(F.tid)); F.lane = F.tid & 63; return F; }
__constant__ float INVF[32] = {1.000000000e+00f, 7.498942614e-01f, 5.623413324e-01f, 4.216965139e-01f, 3.162277639e-01f, 2.371373773e-01f, 1.778279394e-01f, 1.333521307e-01f, 1.000000015e-01f, 7.498941571e-02f, 5.623413250e-02f, 4.216965288e-02f, 3.162277490e-02f, 2.371373773e-02f, 1.778279431e-02f, 1.333521493e-02f, 9.999999776e-03f, 7.498941850e-03f, 5.623413250e-03f, 4.216964822e-03f, 3.162277630e-03f, 2.371373586e-03f, 1.778279431e-03f, 1.333521446e-03f, 1.000000047e-03f, 7.498942432e-04f, 5.623413017e-04f, 4.216965172e-04f, 3.162277571e-04f, 2.371373703e-04f, 1.778279402e-04f, 1.333521504e-04f};

constexpr int I_WI = (D / 64) * (2 * FF / 64), I_WO = (FF / 64) * (D / 64), I_WIN = (D / 64) * (IN_COLS / 64), I_WUQ = (QLR / 64) * (NH * QKD / 64), I_WUKV = (KVLR / 64) * (NH * 256 / 64), I_WOUT = (D / 64) * (D / 64);
constexpr int I_LAYER = 2 * I_WI + 2 * I_WO + I_WIN + I_WUQ + I_WUKV + I_WOUT;
__device__ __forceinline__ void pack_item(const CArgs& a, int it, LAS float* scr, int lane) {
    const int l = it / I_LAYER; int r = it - l * I_LAYER;
    unsigned char* wl = a.ws + WS_W + (size_t)l * W_LAYER;
    const float* src; const float* gk = nullptr; int K_, N_, kind = 0; size_t dsto;
    if (r < I_WI) { src = a.in[7] + (size_t)l * D * 2 * FF; K_ = D; N_ = 2 * FF; dsto = WO_WI1; kind = 1; }
    else if ((r -= I_WI) < I_WO) { src = a.in[8] + (size_t)l * FF * D; K_ = FF; N_ = D; dsto = WO_WO1; }
    else if ((r -= I_WO) < I_WI) { src = a.in[17] + (size_t)l * D * 2 * FF; K_ = D; N_ = 2 * FF; dsto = WO_WI2; kind = 1; }
    else if ((r -= I_WI) < I_WO) { src = a.in[18] + (size_t)l * FF * D; K_ = FF; N_ = D; dsto = WO_WO2; }
    else if ((r -= I_WO) < I_WIN) { src = a.in[9] + (size_t)l * D * IN_COLS; K_ = D; N_ = IN_COLS; dsto = WO_WIN; kind = 2; }
    else if ((r -= I_WIN) < I_WUQ) { src = a.in[12] + (size_t)l * QLR * NH * QKD; K_ = QLR; N_ = NH * QKD; dsto = WO_WUQ; kind = 3; gk = a.in[10] + l * QLR; }
    else if ((r -= I_WUQ) < I_WUKV) { src = a.in[13] + (size_t)l * KVLR * NH * 256; K_ = KVLR; N_ = NH * 256; dsto = WO_WUKV; gk = a.in[11] + l * KVLR; }
    else { r -= I_WUKV; src = a.in[16] + (size_t)l * D * D; K_ = D; N_ = D; dsto = WO_WOUT;
           gk = (r / (D / 64)) < 16 ? a.in[14] + l * 1024 : a.in[15] + l * 1024 - 1024; }
    tr_item(src, K_, N_, (bf16*)(wl + dsto), kind, gk, scr, r, lane);
}

constexpr int CW_BGQ = 8192;
constexpr unsigned BG_TOTAL = (unsigned)(DEPTH - 1) * I_LAYER;
__device__ __forceinline__ unsigned rfl(unsigned v) { return (unsigned)__builtin_amdgcn_readfirstlane((int)v); }
__device__ __forceinline__ void bg_items(const Frame& F, const CArgs& a, unsigned base) {
    const unsigned q = base + (unsigned)F.wave;
    if (q < BG_TOTAL) pack_item(a, (int)(I_LAYER + q), (LAS float*)(F.lds + F.wave * 16640), F.lane);
}
__device__ __forceinline__ void bg_drain(const XcdBarrier& b, const Frame& F, const CArgs& a, unsigned limit) {
    unsigned* q = (unsigned*)(a.ws + WS_CTL) + CW_BGQ;
    if (F.tid == 0) b.st[5] = xb_ld(q);
    __syncthreads();
    const unsigned q0 = rfl(b.st[5]);
    __syncthreads();
    const unsigned gw = (unsigned)(F.vcu * NWAVES + F.wave), NGW = (unsigned)(F.G * NWAVES);
    LAS float* scr = (LAS float*)(F.lds + F.wave * 16640);
    for (unsigned it = q0 - q0 % NGW + gw; it < limit; it += NGW) if (it >= q0) pack_item(a, (int)(I_LAYER + it), scr, F.lane);
}
__device__ __forceinline__ void bg_bump(const CArgs& a, unsigned limit) {
    if (threadIdx.x == 0) (void)__hip_atomic_fetch_max((unsigned*)(a.ws + WS_CTL) + CW_BGQ, limit, __ATOMIC_RELAXED, __HIP_MEMORY_SCOPE_AGENT);
}
__device__ __forceinline__ void xcd_barrier_bg(const XcdBarrier& b, const Frame& F, const CArgs& a) {
    asm volatile("s_waitcnt vmcnt(0)" ::: "memory");
    __syncthreads();
    if (threadIdx.x == 0) {
        unsigned* bar = b.bar;
        __builtin_amdgcn_s_waitcnt(0);
        unsigned nloc = b.st[0], nx = b.st[1];
        if (nloc == 0u) { xcd_barrier_complete(bar, b.x, nloc, nx); b.st[0] = nloc; b.st[1] = nx; }
        const unsigned old = xb_add(&bar[XB_XSUB(b.x)], 1u);
        const unsigned gen = old / nloc;
        if (old + 1u == (gen + 1u) * nloc) {
            __builtin_amdgcn_fence(__ATOMIC_RELEASE, "agent");
            asm volatile("s_waitcnt vmcnt(0)" ::: "memory");
            const unsigned og = xb_add(&bar[XB_TOP], 1u);
            const unsigned tg = og / nx;
            if (og + 1u == (tg + 1u) * nx) xb_add(&bar[XB_TOPGEN], 1u);
            else XB_SPIN(xb_ld(&bar[XB_TOPGEN]) == tg, bar);
            __builtin_amdgcn_fence(__ATOMIC_ACQUIRE, "agent");
            xb_add(&bar[XB_XGEN(b.x)], 1u);
            asm volatile("s_waitcnt vmcnt(0)" ::: "memory");
            b.st[2] = 1u;
        } else { b.st[2] = 0u; b.st[3] = gen; }
    }
    __syncthreads();
    if (rfl(b.st[2]) == 0u) {
        const unsigned gen = rfl(b.st[3]);
        unsigned* q = (unsigned*)(a.ws + WS_CTL) + CW_BGQ;
        for (;;) {
            if (threadIdx.x == 0) { const unsigned rel = xb_ld(&b.bar[XB_XGEN(b.x)]) != gen ? 1u : 0u; unsigned base = 0xFFFFFFFFu;
                if (!rel) { const bool xdone = !BG_XDONE || xb_ld(&b.bar[XB_XSUB(b.x)]) >= (gen + 1u) * b.st[0];
                    if (xdone && xb_ld(q) < BG_TOTAL) base = xb_add(q, 8u); }
                b.st[4] = rel; b.st[5] = base; }
            __syncthreads();
            const unsigned rel = rfl(b.st[4]), base = rfl(b.st[5]);
            __syncthreads();
            if (rel) break;
            if (base < BG_TOTAL) bg_items(F, a, base);
            else __builtin_amdgcn_s_sleep(8);
        }
        if (threadIdx.x == 0) { __builtin_amdgcn_fence(__ATOMIC_ACQUIRE, "agent"); asm volatile("s_waitcnt vmcnt(0)" ::: "memory"); }
        __syncthreads();
    }
}

__device__ __forceinline__ void p0_prologue(const Frame& F, const CArgs& a) {
    unsigned char* ws = a.ws;
    const int gw = F.vcu * NWAVES + F.wave, NGW = F.G * NWAVES;
    const int gt = F.vcu * (NWAVES * 64) + F.tid, NGT = F.G * NWAVES * 64;
#if P0_PARTS & 1
    {
        LAS float* scr = (LAS float*)(F.lds + F.wave * 16640);
        for (int it = gw; it < (BG_ON ? I_LAYER : DEPTH * I_LAYER); it += NGW) pack_item(a, it, scr, F.lane);
        constexpr int PADV = (WIN_ROWS - IN_COLS) * D * 2 / 16;
        for (int i = gt; i < DEPTH * PADV; i += NGT) { const int l = i / PADV, r = i - l * PADV;
            *(v4u*)(ws + WS_W + (size_t)l * W_LAYER + WO_WIN + (size_t)IN_COLS * D * 2 + (size_t)r * 16) = (v4u){0u, 0u, 0u, 0u}; }
    }
#endif
#if P0_PARTS & 2
    {
        const int* pos = (const int*)a.in[2]; float* rope = (float*)(ws + WS_ROPE);
        for (int i = gt; i < M * 32; i += NGT) { const int row = i >> 5, j = i & 31;
            const float ang = (float)pos[row] * INVF[j];
            double rev = (double)ang * 0.15915494309189535; rev -= __builtin_floor(rev);
            const float fr = (float)rev;
            *(float2*)(rope + (size_t)i * 2) = make_float2(__builtin_amdgcn_cosf(fr), __builtin_amdgcn_sinf(fr)); }
    }
#endif
    __syncthreads();
#if P0_PARTS & 4
    {
        LAS f32x4* cact = (LAS f32x4*)F.lds;
        for (int k = F.tid; k < D; k += NWAVES * 64) { f32x4 v;
#pragma unroll
            for (int b = 0; b < 4; ++b) { const float cv = a.in[1][b * D + k]; v[b] = cv / (1.0f + __expf(-cv)); }
            cact[k] = v; }
        __syncthreads();
        constexpr int NCH = NADA * D / 256, KSL = D / ADA_KS;
        float* adap = (float*)(ws + WS_ADAP);
        for (int it = gw; it < DEPTH * NCH * ADA_KS; it += NGW) {
            const int ks = it % ADA_KS, r = it / ADA_KS, ch = r % NCH, l = r / NCH;
            const int n = ch * 256 + 4 * F.lane;
            const float* w = a.in[3] + ((size_t)l * D + (size_t)ks * KSL) * (NADA * D) + n;
            f32x4 acc[4];
#pragma unroll
            for (int b = 0; b < 4; ++b) acc[b] = (f32x4){0.f, 0.f, 0.f, 0.f};
            if (ks == 0) { const f32x4 bv = *(const f32x4*)(a.in[4] + (size_t)l * NADA * D + n);
#pragma unroll
                for (int b = 0; b < 4; ++b) acc[b] = bv; }
#pragma unroll 16
            for (int kk = 0; kk < KSL; ++kk) { const f32x4 wv = *(const f32x4*)(w + (size_t)kk * (NADA * D)); const f32x4 cv = cact[ks * KSL + kk];
#pragma unroll
                for (int b = 0; b < 4; ++b) acc[b] += wv * cv[b]; }
#pragma unroll
            for (int b = 0; b < 4; ++b) *(f32x4*)(adap + (((size_t)ks * DEPTH + l) * BATCH + b) * (NADA * D) + n) = acc[b];
        }
    }
#endif
}
__device__ __forceinline__ void p1_ada_reduce(const Frame& F, const CArgs& a) {
    const int gt = F.vcu * (NWAVES * 64) + F.tid, NGT = F.G * NWAVES * 64;
    const f32x4* adap = (const f32x4*)(a.ws + WS_ADAP); f32x4* ada = (f32x4*)(a.ws + WS_ADA);
    constexpr int NV = DEPTH * BATCH * NADA * D / 4;
    for (int i = gt; i < NV; i += NGT) { f32x4 s = adap[i];
#pragma unroll
        for (int ks = 1; ks < ADA_KS; ++ks) s += adap[(size_t)ks * NV + i];
        ada[i] = s; }
}
__device__ __forceinline__ void p2_modulate0(const Frame& F, const CArgs& a) {
    const int gw = F.vcu * NWAVES + F.wave, NGW = F.G * NWAVES;
    const float* ada = (const float*)(a.ws + WS_ADA); bf16* H = (bf16*)(a.ws + WS_H);
    for (int row = gw; row < M; row += NGW) { const int b = row >> 12;
        const float* sh = ada + (size_t)b * NADA * D, * sc = sh + D;
#pragma unroll
        for (int j = 0; j < 8; ++j) { const int idx = 4 * (F.lane + 64 * j);
            const f32x4 xv = *(const f32x4*)(a.in[0] + (size_t)row * D + idx), s1 = *(const f32x4*)(sc + idx), s0 = *(const f32x4*)(sh + idx);
            const f32x4 h = xv * (s1 + 1.0f) + s0;
            *(v2u*)(H + (size_t)row * D + idx) = (v2u){pk2(h[0], h[1]), pk2(h[2], h[3])}; } }
}
__device__ __forceinline__ void vec_prep(const Frame& F, const CArgs& a) {
    const int gt = F.vcu * (NWAVES * 64) + F.tid, NGT = F.G * NWAVES * 64;
    const float* ada = (const float*)(a.ws + WS_ADA); float* vec = (float*)(a.ws + WS_VEC);
    for (int i = gt; i < 3 * DEPTH * BATCH * D; i += NGT) { const int d = i % D, sb = i / D, b = sb % BATCH, s = sb / BATCH, l = s / 3, j = s - 3 * l;
        const float* ad = ada + ((size_t)l * BATCH + b) * NADA * D + d;
        const float sh = ad[(3 * j) * D], sc = ad[(3 * j + 1) * D], gt_ = ad[(3 * j + 2) * D];
        const float lg = a.in[5][(size_t)(l * 3 + j) * D + d], lb = a.in[6][(size_t)(l * 3 + j) * D + d];
        float P = DN_ALPHA, Q = 0.f; if (s != 0) { P = DN_ALPHA / (1.0f + sc); Q = -P * sh; }
        float U = lg, W = lb;
        if (s != 3 * DEPTH - 1) { const int s1 = s + 1, l1 = s1 / 3, j1 = s1 - 3 * l1; const float* an = ada + ((size_t)l1 * BATCH + b) * NADA * D + d;
            const float nsh = an[(3 * j1) * D], nsc = an[(3 * j1 + 1) * D]; U = lg * (1.0f + nsc); W = lb * (1.0f + nsc) + nsh; }
        float* o = vec + (size_t)sb * 5 * D + d;
        o[0] = P; o[D] = Q; o[2 * D] = (j == 1 ? 1.0f : 0.5f) * (1.0f + gt_); o[3 * D] = U; o[4 * D] = W; }
}
__device__ __forceinline__ unsigned hl_enc(float h, unsigned hb) { const int d = (int)(__float_as_uint(h) - hb); int q = (d + 0x80) >> 8; q = q > 127 ? 127 : q; return (unsigned)q & 0xffu; }
__device__ __forceinline__ float hl_dec(unsigned hb, unsigned byte) { const int q = (int)(signed char)(byte & 0xffu); return __uint_as_float(hb + (unsigned)(q * 256)); }
template <bool FIRST>
__device__ __forceinline__ void ln_phase(const Frame& F, const bf16* H, const unsigned char* L, bf16* HO, unsigned char* LO, const bf16* f, const float* vecs  , const float* X32, float* OUT32) {
    const int gw = F.vcu * NWAVES + F.wave, NGW = F.G * NWAVES;
    constexpr int RPW = 8;
    int tid0_ = threadIdx.x; asm volatile("" : "+v"(tid0_)); const int Flane = tid0_ & 63, Ftid = tid0_;
    LAS f32x4* lv = (LAS f32x4*)F.lds;
    int staged_b = -1;
    for (int r0 = gw * RPW; r0 < M; r0 += NGW * RPW) { const int b = r0 >> 12;
        if (b != staged_b) {
            if (staged_b >= 0) __syncthreads();
            const f32x4* src = (const f32x4*)(vecs + (size_t)b * 5 * D);
            int t_ = Ftid; asm volatile("" : "+v"(t_));
#pragma unroll
            for (int i = 0; i < 5; ++i) { const int q = t_ + 512 * i, vec = q >> 9, e = (q & 511) * 4, j = e >> 9, ln = (e & 511) >> 3, half = (e >> 2) & 1;
                lv[((vec * 4 + j) * 2 + half) * 64 + ln] = src[q]; }
            __syncthreads(); staged_b = b; }
        constexpr int NS = FIRST ? 1 : LN_NS;
        v4u hq2[NS][4], fq2[NS][4]; v2u lq2[NS][4]; f32x4 xq2[NS][8];
#define LN_LOAD(row_, S_) do { _Pragma("unroll") for (int j = 0; j < 4; ++j) { const int idx = 8 * (Flane + 64 * j);                                     \
            fq2[S_][j] = *(const v4u*)(f + (size_t)(row_) * D + idx);                                                                                          \
            if (FIRST) { xq2[S_][2 * j] = *(const f32x4*)(X32 + (size_t)(row_) * D + idx); xq2[S_][2 * j + 1] = *(const f32x4*)(X32 + (size_t)(row_) * D + idx + 4); } \
            else { hq2[S_][j] = *(const v4u*)(H + (size_t)(row_) * D + idx); lq2[S_][j] = *(const v2u*)(L + (size_t)(row_) * D + idx); } } } while (0)
        LN_LOAD(r0, 0); if (NS == 2) LN_LOAD(r0 + 1, NS - 1);
#pragma unroll
        for (int i = 0; i < RPW; ++i) { const int row = r0 + i;
            v4u (&hq)[4] = hq2[i % NS]; v4u (&fq)[4] = fq2[i % NS]; v2u (&lq)[4] = lq2[i % NS]; f32x4 (&xq)[8] = xq2[i % NS];
            int ln_ = Flane; asm volatile("" : "+v"(ln_));
            float v[32]; float s = 0.f;
#pragma unroll
            for (int j = 0; j < 4; ++j) {
                const f32x4 p0 = lv[((0 * 4 + j) * 2 + 0) * 64 + ln_], p1 = lv[((0 * 4 + j) * 2 + 1) * 64 + ln_], q0 = lv[((1 * 4 + j) * 2 + 0) * 64 + ln_], q1 = lv[((1 * 4 + j) * 2 + 1) * 64 + ln_], c0 = lv[((2 * 4 + j) * 2 + 0) * 64 + ln_], c1 = lv[((2 * 4 + j) * 2 + 1) * 64 + ln_];
#pragma unroll
                for (int e = 0; e < 4; ++e) { const float fl = bf_lo(fq[j][e]), fh = bf_hi(fq[j][e]);
                    const float xl = FIRST ? xq[2 * j + (e >> 1)][(e & 1) * 2] : hl_dec(hq[j][e] << 16, lq[j][e >> 1] >> (16 * (e & 1))), xh = FIRST ? xq[2 * j + (e >> 1)][(e & 1) * 2 + 1] : hl_dec(hq[j][e] & 0xffff0000u, lq[j][e >> 1] >> (16 * (e & 1) + 8));
                    const float pl = e < 2 ? p0[2 * e] : p1[2 * e - 4], ph_ = e < 2 ? p0[2 * e + 1] : p1[2 * e - 3], ql = e < 2 ? q0[2 * e] : q1[2 * e - 4], qh = e < 2 ? q0[2 * e + 1] : q1[2 * e - 3], cl = e < 2 ? c0[2 * e] : c1[2 * e - 4], ch = e < 2 ? c0[2 * e + 1] : c1[2 * e - 3];
                    const float vl = pl * xl + ql + cl * fl, vh = ph_ * xh + qh + ch * fh; v[8 * j + 2 * e] = vl; v[8 * j + 2 * e + 1] = vh; s += vl + vh; } }
            if (i + NS < RPW) LN_LOAD(row + NS, i % NS);
            const float mean = wave_sum(s) * (1.0f / D); float s2 = 0.f;
#pragma unroll
            for (int k = 0; k < 32; ++k) { v[k] -= mean; s2 += v[k] * v[k]; }
            const float rstd = 1.0f / sqrtf(wave_sum(s2) * (1.0f / D) + LN_EPS);
#pragma unroll
            for (int j = 0; j < 4; ++j) { const int idx = 8 * (ln_ + 64 * j);
                const f32x4 u0 = lv[((3 * 4 + j) * 2 + 0) * 64 + ln_], u1 = lv[((3 * 4 + j) * 2 + 1) * 64 + ln_], w0 = lv[((4 * 4 + j) * 2 + 0) * 64 + ln_], w1 = lv[((4 * 4 + j) * 2 + 1) * 64 + ln_];
                float o[8];
#pragma unroll
                for (int e = 0; e < 8; ++e) o[e] = v[8 * j + e] * rstd * (e < 4 ? u0[e] : u1[e - 4]) + (e < 4 ? w0[e] : w1[e - 4]);
                if (OUT32) { *(f32x4*)(OUT32 + (size_t)row * D + idx) = (f32x4){o[0], o[1], o[2], o[3]}; *(f32x4*)(OUT32 + (size_t)row * D + idx + 4) = (f32x4){o[4], o[5], o[6], o[7]}; }
                else { v4u hw; v2u lw = {0u, 0u};
#pragma unroll
                    for (int e = 0; e < 4; ++e) { hw[e] = pk2(o[2 * e], o[2 * e + 1]);
                        lw[e >> 1] |= (hl_enc(o[2 * e], hw[e] << 16) | (hl_enc(o[2 * e + 1], hw[e] & 0xffff0000u) << 8)) << (16 * (e & 1)); }
                    *(v4u*)(HO + (size_t)row * D + idx) = hw; *(v2u*)(LO + (size_t)row * D + idx) = lw; } } }
#undef LN_LOAD
    }
    __syncthreads();
}
__device__ __forceinline__ void attn_phase(const Frame& F, const CArgs& a, int which) {
    unsigned char* ws = a.ws;
    const bf16* QM = (const bf16*)(ws + WS_QM); const bf16* KV = (const bf16*)(ws + WS_KV); const bf16* KPE = (const bf16*)(ws + WS_KPE);
    const bf16* SBQ = (const bf16*)(ws + WS_SBQ); const bf16* SBK = (const bf16*)(ws + WS_SBK); const bf16* SBV = (const bf16*)(ws + WS_SBV);
    bf16* O = (bf16*)(ws + WS_O); float* OSSQ = (float*)(ws + WS_OSSQ);
    constexpr int NQB = SEQ / 256, NPAIR = NQB / 2, NITEM = BATCH * NH * NPAIR;
    for (int it = F.vcu; it < NITEM; it += F.G) {
        const int bh = it / NPAIR, x = it - bh * NPAIR, b = bh / NH, h = bh - b * NH;
        const size_t r0 = (size_t)b * SEQ;
#if SITE_ATT & 1
#pragma unroll 1
        for (int pass = 0; pass < ((which & 1) ? 2 : 0); ++pass) { const int qb = pass ? NQB - 1 - x : x; const size_t rq = r0 + (size_t)qb * 256;
            att::attn_block<false>(F.lds, QM + rq * (NH * QKD) + h * QKD, NH * QKD, KV + r0 * D + h * 256, D, KV + r0 * D + h * 256 + 128, D, KPE + r0 * 64, O + rq * D + h * HD, D, OSSQ + rq * 16 + h, qb * 256); }
#endif
#if SITE_ATT & 2
#pragma unroll 1
        for (int pass = 0; pass < ((which & 2) ? 2 : 0); ++pass) { const int qb = pass ? NQB - 1 - x : x; const size_t rq = r0 + (size_t)qb * 256;
            att::attn_block<true>(F.lds, SBQ + rq * 1024 + h * HD, 1024, SBK + r0 * 1024 + h * HD, 1024, SBV + r0 * 1024 + h * HD, 1024, nullptr, O + rq * D + 1024 + h * HD, D, OSSQ + rq * 16 + 8 + h, qb * 256); }
#endif
    }
}

__global__ void __launch_bounds__(NWAVES * 64, 2) mk_fwd(Args args_unused) {
    extern __shared__ __attribute__((aligned(16))) unsigned char lds[];
    (void)args_unused;
    CArgs* ap = (CArgs*)__builtin_amdgcn_kernarg_segment_ptr();
    Frame F;
    F.lds = (LAS unsigned char*)lds;
    F.tid = threadIdx.x; F.lane = F.tid & 63; F.wave = __builtin_amdgcn_readfirstlane(F.tid >> 6);
    F.G = gridDim.x; { const int bx = blockIdx.x; F.vcu = (F.G % 8 == 0) ? (bx % 8) * (F.G / 8) + bx / 8 : bx; }
    volatile LAS unsigned* MISC = (volatile LAS unsigned*)(F.lds + MISC_OFF);
    for (int u = F.tid; u < (LDS_BYTES - MISC_OFF) / 4; u += NWAVES * 64) ((LAS unsigned*)(F.lds + MISC_OFF))[u] = 0u;
    __syncthreads();
    XcdBarrier bar; bar.bar = (unsigned*)(ap->ws + WS_CTL) + CW_BAR; bar.x = 0; bar.st = nullptr;
    if (MK_ONE_LAUNCH) bar = xcd_barrier_post((unsigned*)(ap->ws + WS_CTL) + CW_BAR, MISC + 8);
    const int lo = ap->ph_lo, hi = ap->ph_hi; int ph = 0; bool fin_ = false;
#define RUN_PH (ph >= lo && ph < hi)
#if TPROBE
#define TP_BASE ((unsigned long long*)(fresh_args(ap)->ws + WS_CTL + 524288))
#define TP_BEGIN(k) do { if (blockIdx.x == TPROBE_WG && threadIdx.x == 0) { unsigned long long* tp = TP_BASE; tp[30] = __builtin_amdgcn_s_memrealtime(); int kk_ = (k); asm volatile("" : "+s"(kk_)); ((unsigned*)tp)[64] = (unsigned)kk_; } } while (0)
#define TP_MID do { if (blockIdx.x == TPROBE_WG && threadIdx.x == 0) { asm volatile("s_waitcnt vmcnt(0)" ::: "memory"); TP_BASE[31] = __builtin_amdgcn_s_memrealtime(); } } while (0)
#define TP_END do { if (blockIdx.x == TPROBE_WG && threadIdx.x == 0) { unsigned long long* tp = TP_BASE; const unsigned long long t2 = __builtin_amdgcn_s_memrealtime(), t0 = tp[30], t1 = tp[31]; const int k = (int)((unsigned*)tp)[64]; tp[2 * k] += t1 - t0; tp[2 * k + 1] += t2 - t1; } } while (0)
#else
#define TP_BEGIN(k) do { } while (0)
#define TP_MID do { } while (0)
#define TP_END do { } while (0)
#endif
#define END_PH do { TP_MID; if (MK_ONE_LAUNCH && RUN_PH && ph + 1 < hi && !fin_) { xcd_barrier(bar); for (int xb_ = 0; xb_ < DUP_BAR; ++xb_) xcd_barrier(bar); } TP_END; ++ph; } while (0)
#define BG_T0 do { } while (0)
#define END_PH_BG(bit) do { TP_MID; if (MK_ONE_LAUNCH && RUN_PH && ph + 1 < hi && !fin_) { if (BG_ON && (BG_SITES & (bit))) xcd_barrier_bg(bar, fresh_frame(F), *fresh_args(ap)); else xcd_barrier(bar); for (int xb_ = 0; xb_ < DUP_BAR; ++xb_) xcd_barrier(bar); } TP_END; ++ph; } while (0)
#define WSP(T, off) ((T*)(A->ws + (off)))

REP(DUP_P0) { TP_BEGIN(0);
#if SITE_P0
    if (RUN_PH) p0_prologue(fresh_frame(F), *fresh_args(ap));
#endif
    END_PH; }
REP(DUP_P1) { TP_BEGIN(1);
#if SITE_P1
    if (RUN_PH) p1_ada_reduce(fresh_frame(F), *fresh_args(ap));
#endif
    END_PH; }
REP(DUP_P2) { TP_BEGIN(2);
#if SITE_P2
    if (RUN_PH) { p2_modulate0(fresh_frame(F), *fresh_args(ap)); vec_prep(fresh_frame(F), *fresh_args(ap)); }
#endif
    END_PH; }

#pragma unroll 1
    for (int s = 0; s <= DBG_LAST_S; ++s) {
        const int l = s / 3, j = s - 3 * l;
        if (j != 1) {
REP(DUP_G1) { TP_BEGIN(3); BG_T0;
#if SITE_G1
            if (RUN_PH) { CArgs* A = fresh_args(ap); const unsigned char* wl = A->ws + WS_W + (size_t)l * W_LAYER;
                pg8::Gemm g{WSP(const bf16, WS_H), (const bf16*)(wl + (j == 0 ? WO_WI1 : WO_WI2)), M, 2 * FF, D}; pg8::StaticOrder S; S.init(M, 2 * FF, F.G, (int)blockIdx.x);
                pg8::EpiSwiGLU E{WSP(bf16, WS_ACT), FF};
                pg8::gemm_phase<pg8::EpiSwiGLU, pg8::StaticOrder, G1_ALIGN, G1_SP2>(F.lds + RING_OFF, g, S, E);
            }
#endif
            END_PH_BG(1); }
        } else {
REP(DUP_WIN) { TP_BEGIN(4); BG_T0;
#if SITE_WIN
            if (RUN_PH) { CArgs* A = fresh_args(ap); const unsigned char* wl = A->ws + WS_W + (size_t)l * W_LAYER;
                pg8::Gemm g{WSP(const bf16, WS_H), (const bf16*)(wl + WO_WIN), M, WIN_ROWS, D}; pg8::WinOrder S; S.init(M, 16 * 256, F.G, (int)blockIdx.x);
                pg8::EpiWin E{WSP(bf16, WS_CQ), WSP(bf16, WS_CKV), WSP(bf16, WS_SBQ), WSP(bf16, WS_SBK), WSP(bf16, WS_SBV), WSP(bf16, WS_KPE), WSP(float, WS_SSQ), WSP(const float, WS_ROPE), SB_QSCALE};
                pg8::gemm_phase<pg8::EpiWin, pg8::WinOrder, true, true>(F.lds + RING_OFF, g, S, E);
            }
#endif
            END_PH_BG(2); }
REP(DUP_UQKV) { TP_BEGIN(5); BG_T0;
#if SITE_UQKV
            if (RUN_PH) {
                const int c = (int)blockIdx.x, G = F.G; const bool bal = G == 256; const bool grpA = ((c >> 3) & 1) == 0; const int gi = ((c >> 4) << 3) | (c & 7);
                pg8::ListOrder Swt, Suq, Sukv;
                if (bal) { Swt = pg8::ListOrder{gi, grpA ? 1 : 0, 1, 15}; Suq = grpA ? pg8::ListOrder{gi, 1, 1, 0} : pg8::ListOrder{128 + 2 * gi, 2, 1, 0}; Sukv = grpA ? pg8::ListOrder{gi, 1, 1, 0} : pg8::ListOrder{128 + 3 * gi, 3, 1, 0}; }
                else { Swt = pg8::ListOrder{c, c < 128 ? (128 - c + G - 1) / G : 0, G, 15}; Suq = pg8::ListOrder{c, c < 384 ? (384 - c + G - 1) / G : 0, G, 0}; Sukv = pg8::ListOrder{c, c < 512 ? (512 - c + G - 1) / G : 0, G, 0}; }
                { CArgs* A = fresh_args(ap); const unsigned char* wl = A->ws + WS_W + (size_t)l * W_LAYER;
                  pg8::Gemm g{WSP(const bf16, WS_H), (const bf16*)(wl + WO_WIN), M, WIN_ROWS, D};
                  pg8::EpiWin E{WSP(bf16, WS_CQ), WSP(bf16, WS_CKV), WSP(bf16, WS_SBQ), WSP(bf16, WS_SBK), WSP(bf16, WS_SBV), WSP(bf16, WS_KPE), WSP(float, WS_SSQ), WSP(const float, WS_ROPE), SB_QSCALE};
                  pg8::gemm_phase<pg8::EpiWin, pg8::ListOrder, true, true>(F.lds + RING_OFF, g, Swt, E); }
                { CArgs* A = fresh_args(ap); const unsigned char* wl = A->ws + WS_W + (size_t)l * W_LAYER;
                  pg8::Gemm g{WSP(const bf16, WS_CQ), (const bf16*)(wl + WO_WUQ), M, NH * QKD, QLR};
                  pg8::EpiRS<true> E{WSP(bf16, WS_QM), NH * QKD, WSP(const float, WS_SSQ), 0, 3, 1.0f / QLR, RMS_EPS, MLA_QSCALE, WSP(const float, WS_ROPE)};
                  pg8::gemm_phase<pg8::EpiRS<true>, pg8::ListOrder, true, true>(F.lds + RING_OFF, g, Suq, E); }
                { CArgs* A = fresh_args(ap); const unsigned char* wl = A->ws + WS_W + (size_t)l * W_LAYER;
                  pg8::Gemm g{WSP(const bf16, WS_CKV), (const bf16*)(wl + WO_WUKV), M, NH * 256, KVLR};
                  pg8::EpiRS<false> E{WSP(bf16, WS_KV), NH * 256, WSP(const float, WS_SSQ), 3, 2, 1.0f / KVLR, RMS_EPS, 1.0f, nullptr};
                  pg8::gemm_phase<pg8::EpiRS<false>, pg8::ListOrder, true, true>(F.lds + RING_OFF, g, Sukv, E); }
            }
#endif
            END_PH_BG(4); }
REP(DUP_ATT) { TP_BEGIN(6); BG_T0;
#if SITE_ATT
            if (RUN_PH) attn_phase(fresh_frame(F), *fresh_args(ap), rep_ == 0 ? 3 : DUP_ATT_WHICH);
#endif
            END_PH_BG(8); }
        }
REP(DUP_GF) { TP_BEGIN(8); BG_T0;
#if SITE_GF
        if (RUN_PH) { CArgs* A = fresh_args(ap); const unsigned char* wl = A->ws + WS_W + (size_t)l * W_LAYER;
            if (j != 1) { pg8::Gemm g{WSP(const bf16, WS_ACT), (const bf16*)(wl + (j == 0 ? WO_WO1 : WO_WO2)), M, D, FF}; pg8::StaticOrder S; S.init(M, D, F.G, (int)blockIdx.x);
                pg8::EpiPlain E{WSP(bf16, WS_F), D};
                pg8::gemm_phase<pg8::EpiPlain, pg8::StaticOrder, GF_ALIGN, G1_SP2>(F.lds + RING_OFF, g, S, E); }
            else { pg8::Gemm g{WSP(const bf16, WS_O), (const bf16*)(wl + WO_WOUT), M, D, D}; pg8::StaticOrder S; S.init(M, D, F.G, (int)blockIdx.x);
                pg8::EpiMixOut E{WSP(bf16, WS_F), D, WSP(const float, WS_OSSQ), 16, 1.0f / 1024.0f, RMS_EPS, nullptr, 0};
                { pg8::Unit u0, u1; const bool h0 = S.next(0, u0), h1 = S.next(1, u1);
                  PG8_LAS float* scw = (PG8_LAS float*)(F.lds + 131072); int t_ = (int)threadIdx.x; asm volatile("" : "+v"(t_));
                  if (h0) { E.prep(u0, 0, scw, t_); E.pm0 = u0.pm; } if (h1) E.prep(u1, 1, scw, t_); E.sc = scw; }
                pg8::gemm_phase<pg8::EpiMixOut, pg8::StaticOrder, GF_ALIGN, G1_SP2>(F.lds + RING_OFF, g, S, E); }
        }
#endif
        END_PH_BG(16); }
REP(DUP_LN) { TP_BEGIN(9);
#if SITE_LN
        fin_ = (s == DBG_LAST_S) && (rep_ == DUP_LN);
        if (RUN_PH) { CArgs* A = fresh_args(ap); const bool last = s == DBG_LAST_S; const bool dummy = DUP_LN && rep_ == 0;
            bf16* HO = dummy ? WSP(bf16, WS_DUMMY) : WSP(bf16, WS_H); unsigned char* LO = dummy ? WSP(unsigned char, WS_DUMMY + 64 * MiB) : WSP(unsigned char, WS_HL);
            if (s == 0) ln_phase<true>(F, WSP(const bf16, WS_H), WSP(const unsigned char, WS_HL), HO, LO, WSP(const bf16, WS_F), WSP(const float, WS_VEC), A->in[0], last ? A->out : nullptr);
            else ln_phase<false>(F, WSP(const bf16, WS_H), WSP(const unsigned char, WS_HL), HO, LO, WSP(const bf16, WS_F), WSP(const float, WS_VEC) + (size_t)s * BATCH * 5 * D, nullptr, last ? A->out : nullptr);
        }
#endif
        if (BG_ON && MK_ONE_LAUNCH && RUN_PH && j == 2 && l + 1 < DEPTH) bg_drain(bar, fresh_frame(F), *fresh_args(ap), (unsigned)(l + 1) * I_LAYER);
        END_PH;
        if (BG_ON && MK_ONE_LAUNCH && j == 2 && l + 1 < DEPTH) bg_bump(*fresh_args(ap), (unsigned)(l + 1) * I_LAYER); }
    }
#if TPROBE
    xcd_barrier(bar);
    { CArgs* A = fresh_args(ap); const unsigned long long* tp = (const unsigned long long*)(A->ws + WS_CTL + 524288); const float dall = 0.f * (float)tp[TPROBE_B], done_ = (TPROBE_A == 99 ? (float)(tp[1] + tp[3] + tp[5] + tp[7] + tp[9] + tp[11] + tp[13] + tp[15] + tp[17] + tp[19]) : (float)(tp[TPROBE_A] + tp[TPROBE_B])) * 1e-5f * TPROBE_SCALE;
      float* o = A->out; const int gt = (int)blockIdx.x * 512 + (int)threadIdx.x;
      for (int i = gt; i < M * D / 4; i += (int)gridDim.x * 512) { f32x4 v = *(f32x4*)(o + (size_t)i * 4); v = v + dall; if (i == 0) v[0] += done_; *(f32x4*)(o + (size_t)i * 4) = v; } }
#endif
#undef RUN_PH
#undef END_PH
#undef WSP
}

extern "C" void kernel_launch(void* const* d_in, const int* in_sizes, int n_in, void* d_out, int out_size, void* d_ws, size_t ws_size, hipStream_t stream) {
    static int grid = 0;
    if (grid == 0) {
        if (n_in != 19 || in_sizes[0] != M * D || out_size != M * D || ws_size < WS_END) { fprintf(stderr, "kernel_launch: unexpected shapes (n_in %d, in0 %d, out %d, ws %zu < %zu); nothing launched\n", n_in, n_in > 0 ? in_sizes[0] : -1, out_size, ws_size, (size_t)WS_END); grid = -1; return; }
        int dev = 0, cus = 0, per_cu = 0;
        if (hipGetDevice(&dev) != hipSuccess || hipDeviceGetAttribute(&cus, hipDeviceAttributeMultiprocessorCount, dev) != hipSuccess) { grid = -1; return; }
        if (hipFuncSetAttribute((const void*)mk_fwd, hipFuncAttributeMaxDynamicSharedMemorySize, LDS_BYTES) != hipSuccess) { fprintf(stderr, "kernel_launch: hipFuncSetAttribute failed\n"); grid = -1; return; }
        if (hipOccupancyMaxActiveBlocksPerMultiprocessor(&per_cu, (const void*)mk_fwd, NWAVES * 64, LDS_BYTES) != hipSuccess || per_cu < 1)
            fprintf(stderr, "kernel_launch: note: occupancy query reports %d workgroups per CU\n", per_cu);
        (void)hipGetLastError();
        grid = cus;
        if (grid * 2 < (M / 256) * (D / 256)) { fprintf(stderr, "kernel_launch: %d CUs: the mixer output projection keeps two units' row scales per workgroup and needs at least %d workgroups; nothing launched\n", cus, (M / 256) * (D / 256) / 2); grid = -1; return; }
    }
    if (grid < 0) return;
    if (hipMemsetAsync((char*)d_ws + WS_CTL, 0, CTL_ZERO_BYTES, stream) != hipSuccess) { fprintf(stderr, "kernel_launch: hipMemsetAsync failed\n"); return; }
    Args a{};
    for (int i = 0; i < 19; ++i) a.in[i] = (const float*)d_in[i];
    a.out = (float*)d_out; a.ws = (unsigned char*)d_ws;
#if MK_ONE_LAUNCH
    a.ph_lo = 0; a.ph_hi = 1 << 20;
    hipLaunchKernelGGL(mk_fwd, dim3(grid), dim3(NWAVES * 64), LDS_BYTES, stream, a);
#else
    for (int p = 0; p < N_PHASES; ++p) { a.ph_lo = p; a.ph_hi = p + 1; hipLaunchKernelGGL(mk_fwd, dim3(grid), dim3(NWAVES * 64), LDS_BYTES, stream, a); }
#endif
}
```

```cpp
#include <hip/hip_runtime.h>
#include <cstdio>
#include <cstdint>
#include <cmath>
namespace pg8 {
#define PG8_LAS __attribute__((address_space(3)))
typedef unsigned short bf16_t;
typedef short bf16x8 __attribute__((ext_vector_type(8)));
typedef float f32x4 __attribute__((ext_vector_type(4)));
typedef unsigned u32x4 __attribute__((ext_vector_type(4)));
constexpr int BM = 256, BK = 64, HALF = 128, HTB = HALF * BK * 2  , STAGE_BYTES = 8 * HTB, NXCD = 8, WGM = 8;

__host__ __device__ __forceinline__ int lds_byte(int r, int c) { const int st = (r >> 4) * 2 + (c >> 5), rr = r & 15, cc = c & 31, ob = rr * 64 + cc * 2; return st * 1024 + (ob ^ (((ob >> 9) & 1) << 5)); }
__host__ __device__ __forceinline__ void stage_rc(int b, int& R, int& C) { const int st = b / 1024, sb = b % 1024, swz = sb ^ (((sb >> 9) & 1) << 5); R = (st >> 1) * 16 + swz / 64; C = (st & 1) * 32 + (swz % 64) / 2; }
__host__ __device__ __forceinline__ int perm32(int rho) { const int n = rho >> 4, i = rho & 15; return 8 * (i >> 2) + 4 * n + (i & 3); }

struct Unit { int pm, pn; };
struct Gemm { const bf16_t* A; const bf16_t* Bt; int M, N, K; };

struct StaticOrder {
    int nM, nN, nwg, G, c;
    __host__ __device__ void init(int M, int N, int G_, int c_) { nM = M / BM; nN = N / BM; nwg = nM * nN; G = G_; c = c_; }
    __host__ __device__ __forceinline__ bool next(int i, Unit& u) const {
        const long L = (long)i * G + c; if (L >= nwg) return false;
        int wgid = (int)L; { const int q = nwg / NXCD, r = nwg % NXCD, xcd = wgid % NXCD, off = wgid / NXCD; wgid = (xcd < r ? xcd * (q + 1) : r * (q + 1) + (xcd - r) * q) + off; }
        const int nig = WGM * nN, gid = wgid / nig, fm = gid * WGM, gsz = (nM - fm) < WGM ? (nM - fm) : WGM;
        u.pm = fm + ((wgid % nig) % gsz); u.pn = (wgid % nig) / gsz; return true;
    }
    __device__ __forceinline__ void a_ready(const Unit&) const {}
    __device__ __forceinline__ void done(const Unit&) const {}
};


#ifndef EPIRS_SKIP
#define EPIRS_SKIP 0
#endif
#ifndef EPI_NT
#define EPI_NT 0
#endif

__device__ __forceinline__ unsigned cvt_pk_bf16(float lo, float hi) { unsigned r; asm volatile("v_cvt_pk_bf16_f32 %0, %1, %2" : "=v"(r) : "v"(lo), "v"(hi)); return r; }
typedef float f32x2 __attribute__((ext_vector_type(2)));
__device__ __forceinline__ u32x4 pack8bf(const f32x4 v0, const f32x4 v1) { u32x4 w; w.x = cvt_pk_bf16(v0[0], v0[1]); w.y = cvt_pk_bf16(v0[2], v0[3]); w.z = cvt_pk_bf16(v1[0], v1[1]); w.w = cvt_pk_bf16(v1[2], v1[3]); return w; }

__device__ __forceinline__ float add_xor16(float x) { auto a = __builtin_amdgcn_permlane16_swap(__float_as_uint(x), __float_as_uint(x), false, false); return __uint_as_float(a[0]) + __uint_as_float(a[1]); }
__device__ __forceinline__ float add_xor32(float x) { auto a = __builtin_amdgcn_permlane32_swap(__float_as_uint(x), __float_as_uint(x), false, false); return __uint_as_float(a[0]) + __uint_as_float(a[1]); }
struct EpiPlain {
    static constexpr bool PERM = true, AFTER_DRAIN = false, MID = false;
    bf16_t* O; int ldc;
    __device__ __forceinline__ void operator()(const f32x4 (&acc)[2][2][4][2], const Unit& u, int wr, int wc, int fr, int fq) const {
        const int row0 = u.pm * BM + wr * 64 + fr; const int col0 = u.pn * BM + wc * 32 + 8 * fq;
#pragma unroll
        for (int ai = 0; ai < 2; ++ai)
#pragma unroll
            for (int m = 0; m < 4; ++m) { bf16_t* rowp = O + (size_t)(row0 + ai * HALF + m * 16) * ldc + col0;
#pragma unroll
                for (int bj = 0; bj < 2; ++bj) { const u32x4 w = pack8bf(acc[ai][bj][m][0], acc[ai][bj][m][1]); if (EPI_NT) __builtin_nontemporal_store(w, (u32x4*)(rowp + bj * HALF)); else *(u32x4*)(rowp + bj * HALF) = w; } }
    }
};

struct EpiMixOut {
    static constexpr bool PERM = true, AFTER_DRAIN = false, MID = true;
    bf16_t* O; int ldc; const float* OSSQ; int mid_t; float invn, eps;
    const PG8_LAS float* sc; int pm0;
    static constexpr int SC_SLOT = 512;
    __device__ __forceinline__ void prep(const Unit& u, int slot, PG8_LAS float* scw, int tid) const {
        const int r = tid >> 1, g = tid & 1;
        const float* p = OSSQ + (size_t)(u.pm * BM + r) * 16 + 8 * g;
        const f32x4 a = *(const f32x4*)p, b = *(const f32x4*)(p + 4);
        const float s = ((a[0] + a[1]) + (a[2] + a[3])) + ((b[0] + b[1]) + (b[2] + b[3]));
        const float o = __builtin_bit_cast(float, __builtin_amdgcn_update_dpp(0, __builtin_bit_cast(int, s), 0xB1, 0xF, 0xF, false));
        const float sm = g ? o : s, ss = g ? s : o;
        if (g == 0) { scw[slot * SC_SLOT + r] = sqrtf((ss * invn + eps) / (sm * invn + eps)); scw[slot * SC_SLOT + 256 + r] = 1.0f / sqrtf(ss * invn + eps); }
    }
    __device__ __forceinline__ void scales(const Unit& u, int wr, int fr, int fq, int which, float (&v)[2][4]) const {
        int fr_ = fr; asm volatile("" : "+v"(fr_));
        const PG8_LAS float* p = sc + (u.pm != pm0 ? SC_SLOT : 0) + which * 256 + wr * 64 + fr_;
#pragma unroll
        for (int ai = 0; ai < 2; ++ai)
#pragma unroll
            for (int m = 0; m < 4; ++m) v[ai][m] = p[ai * HALF + m * 16];
    }
    __device__ __forceinline__ void mid(f32x4 (&acc)[2][2][4][2], const Unit& u, int wr, int wc, int fr, int fq) const {
        float v[2][4]; scales(u, wr, fr, fq, 0, v);
#pragma unroll
        for (int ai = 0; ai < 2; ++ai)
#pragma unroll
            for (int m = 0; m < 4; ++m) { const float ratio = v[ai][m];
#pragma unroll
                for (int bj = 0; bj < 2; ++bj) { acc[ai][bj][m][0] = acc[ai][bj][m][0] * ratio; acc[ai][bj][m][1] = acc[ai][bj][m][1] * ratio; } }
    }
    __device__ __forceinline__ void operator()(const f32x4 (&acc)[2][2][4][2], const Unit& u, int wr, int wc, int fr, int fq) const {
        float v[2][4]; scales(u, wr, fr, fq, 1, v);
        const int row0 = u.pm * BM + wr * 64 + fr; const int col0 = u.pn * BM + wc * 32 + 8 * fq;
#pragma unroll
        for (int ai = 0; ai < 2; ++ai)
#pragma unroll
            for (int m = 0; m < 4; ++m) { bf16_t* rowp = O + (size_t)(row0 + ai * HALF + m * 16) * ldc + col0; const float rs = v[ai][m];
#pragma unroll
                for (int bj = 0; bj < 2; ++bj) *(u32x4*)(rowp + bj * HALF) = pack8bf(acc[ai][bj][m][0] * rs, acc[ai][bj][m][1] * rs); }
    }
};

struct EpiSwiGLU {
    static constexpr bool PERM = true, AFTER_DRAIN = false, MID = false;
    bf16_t* O; int ldc;
    __device__ __forceinline__ static f32x4 sg(const f32x4 g, const f32x4 up) {
        f32x4 r;
#pragma unroll
        for (int i = 0; i < 4; ++i) { const float e = __builtin_amdgcn_exp2f(g[i] * -1.4426950408889634f); r[i] = g[i] * __builtin_amdgcn_rcpf(1.0f + e) * up[i]; }
        return r;
    }
    __device__ __forceinline__ void operator()(const f32x4 (&acc)[2][2][4][2], const Unit& u, int wr, int wc, int fr, int fq) const {
        const int row0 = u.pm * BM + wr * 64 + fr; const int col0 = u.pn * HALF + wc * 32 + 8 * fq;
#pragma unroll
        for (int ai = 0; ai < 2; ++ai) { f32x4 t[4][2];
#pragma unroll
            for (int m = 0; m < 4; ++m)
#pragma unroll
                for (int n = 0; n < 2; ++n) t[m][n] = acc[ai][0][m][n] * -1.4426950408889634f;
#pragma unroll
            for (int m = 0; m < 4; ++m)
#pragma unroll
                for (int n = 0; n < 2; ++n)
#pragma unroll
                    for (int i = 0; i < 4; ++i) t[m][n][i] = __builtin_amdgcn_exp2f(t[m][n][i]);
#pragma unroll
            for (int m = 0; m < 4; ++m)
#pragma unroll
                for (int n = 0; n < 2; ++n) t[m][n] = t[m][n] + 1.0f;
#pragma unroll
            for (int m = 0; m < 4; ++m)
#pragma unroll
                for (int n = 0; n < 2; ++n)
#pragma unroll
                    for (int i = 0; i < 4; ++i) t[m][n][i] = __builtin_amdgcn_rcpf(t[m][n][i]);
#pragma unroll
            for (int m = 0; m < 4; ++m)
#pragma unroll
                for (int n = 0; n < 2; ++n) t[m][n] = acc[ai][0][m][n] * t[m][n] * acc[ai][1][m][n];
#pragma unroll
            for (int m = 0; m < 4; ++m) { bf16_t* rowp = O + (size_t)(row0 + ai * HALF + m * 16) * ldc + col0; *(u32x4*)rowp = pack8bf(t[m][0], t[m][1]); } }
    }
};

__device__ __forceinline__ void rope8(f32x4& v0, f32x4& v1, const f32x4 cs0, const f32x4 cs1) {
    const float a0 = v0[0], b0 = v0[1], a1 = v0[2], b1 = v0[3], a2 = v1[0], b2 = v1[1], a3 = v1[2], b3 = v1[3];
    v0[0] = a0 * cs0[0] - b0 * cs0[1]; v0[1] = a0 * cs0[1] + b0 * cs0[0];
    v0[2] = a1 * cs0[2] - b1 * cs0[3]; v0[3] = a1 * cs0[3] + b1 * cs0[2];
    v1[0] = a2 * cs1[0] - b2 * cs1[1]; v1[1] = a2 * cs1[1] + b2 * cs1[0];
    v1[2] = a3 * cs1[2] - b3 * cs1[3]; v1[3] = a3 * cs1[3] + b3 * cs1[2];
}

struct EpiWin {
    static constexpr bool PERM = true, AFTER_DRAIN = false, MID = false;
    bf16_t *CQ, *CKV, *SBQ, *SBK, *SBV, *KPE; float* SSQ; const float* ROPE; float sbq_scale;
    __device__ __forceinline__ void operator()(const f32x4 (&acc)[2][2][4][2], const Unit& u, int wr, int wc, int fr, int fq) const {
        const int pn = u.pn; const int row0 = u.pm * BM + wr * 64 + fr;
        if (pn < 17) {
            bf16_t* base; int ldc, colt; float sc = 1.0f; const bool ssq = pn < 5;
            if (pn < 3) { base = CQ; ldc = 768; colt = pn * BM; }
            else if (pn < 5) { base = CKV; ldc = 512; colt = (pn - 3) * BM; }
            else if (pn < 9) { base = SBQ; ldc = 1024; colt = (pn - 5) * BM; sc = sbq_scale; }
            else if (pn < 13) { base = SBK; ldc = 1024; colt = (pn - 9) * BM; }
            else { base = SBV; ldc = 1024; colt = (pn - 13) * BM; }
            const int col0 = colt + wc * 32 + 8 * fq;
#pragma unroll
            for (int ai = 0; ai < 2; ++ai)
#pragma unroll
                for (int m = 0; m < 4; ++m) { const int row = row0 + ai * HALF + m * 16; bf16_t* rowp = base + (size_t)row * ldc + col0; float s = 0.f;
#pragma unroll
                    for (int bj = 0; bj < 2; ++bj) { const f32x4 v0 = acc[ai][bj][m][0] * sc, v1 = acc[ai][bj][m][1] * sc;
                        s += (v0[0] * v0[0] + v0[1] * v0[1]) + (v0[2] * v0[2] + v0[3] * v0[3]) + (v1[0] * v1[0] + v1[1] * v1[1]) + (v1[2] * v1[2] + v1[3] * v1[3]);
                        *(u32x4*)(rowp + bj * HALF) = pack8bf(v0, v1); }
                    if (ssq) { s = add_xor32(add_xor16(s)); if (fq == 0) SSQ[((size_t)row * 5 + pn) * 4 + wc] = s; } }
        } else if (wc < 2) {
            const int c0 = wc * 32 + 8 * fq;
#pragma unroll
            for (int ai = 0; ai < 2; ++ai)
#pragma unroll
                for (int m = 0; m < 4; ++m) { const int row = row0 + ai * HALF + m * 16;
                    const f32x4 cs0 = *(const f32x4*)(ROPE + (size_t)row * 64 + c0), cs1 = *(const f32x4*)(ROPE + (size_t)row * 64 + c0 + 4);
                    f32x4 v0 = acc[ai][0][m][0], v1 = acc[ai][0][m][1]; rope8(v0, v1, cs0, cs1);
                    *(u32x4*)(KPE + (size_t)row * 64 + c0) = pack8bf(v0, v1); }
        }
    }
};

template <bool ROPE_Q> struct EpiRS {
    static constexpr bool PERM = true, AFTER_DRAIN = false, MID = false;
    bf16_t* O; int ldc; const float* SSQ; int t0, nt; float invn, eps, oscale; const float* ROPE;
    __device__ __forceinline__ void operator()(const f32x4 (&acc)[2][2][4][2], const Unit& u, int wr, int wc, int fr, int fq) const {
        const int row0 = u.pm * BM + wr * 64 + fr; const int col0 = u.pn * BM + wc * 32 + 8 * fq;
        float rsv[2][4];
#pragma unroll
        for (int ai = 0; ai < 2; ++ai)
#pragma unroll
            for (int m = 0; m < 4; ++m) { const int row = row0 + ai * HALF + m * 16; f32x4 q = {0.f, 0.f, 0.f, 0.f};
                if (fq < nt && !(EPIRS_SKIP & 2)) q = *(const f32x4*)(SSQ + ((size_t)row * 5 + t0 + fq) * 4);
                rsv[ai][m] = (q[0] + q[1]) + (q[2] + q[3]); }
#pragma unroll
        for (int ai = 0; ai < 2; ++ai)
#pragma unroll
            for (int m = 0; m < 4; ++m) { const float ss = add_xor32(add_xor16(rsv[ai][m])); rsv[ai][m] = oscale / sqrtf(ss * invn + eps); }
#pragma unroll
        for (int ai = 0; ai < 2; ++ai)
#pragma unroll
            for (int m = 0; m < 4; ++m) { const int row = row0 + ai * HALF + m * 16;
                const float rs = rsv[ai][m];
#pragma unroll
                for (int bj = 0; bj < 2; ++bj) { const int c = col0 + bj * HALF; f32x4 v0 = acc[ai][bj][m][0] * rs, v1 = acc[ai][bj][m][1] * rs;
                    if (ROPE_Q && !(EPIRS_SKIP & 1)) { const int w = c % 192; if (w >= 128) { const float* cs = ROPE + (size_t)row * 64 + (w - 128); rope8(v0, v1, *(const f32x4*)cs, *(const f32x4*)(cs + 4)); } }
                    *(u32x4*)(O + (size_t)row * ldc + c) = pack8bf(v0, v1); } }
    }
};

struct WinOrder : StaticOrder {
    __device__ __forceinline__ bool next(int i, Unit& u) const { if (!StaticOrder::next(i, u)) return false; u.pn = u.pn < 5 ? u.pn : (u.pn == 5 ? 17 : u.pn - 1); return true; }
};
struct ListOrder {
    int first, count, stride, pn0;
    __device__ __forceinline__ bool next(int i, Unit& u) const { if (i >= count) return false; const int L = first + i * stride; u.pm = L & 63; u.pn = pn0 + (L >> 6); return true; }
    __device__ __forceinline__ void a_ready(const Unit&) const {}
    __device__ __forceinline__ void done(const Unit&) const {}
};

#ifndef PG8_EPI_DUP
#define PG8_EPI_DUP 0
#endif
template <class Epi, class Sched, bool ALIGN_EPI = false, bool SP2 = false>
__device__ __forceinline__ void gemm_phase(PG8_LAS unsigned char* lds, const Gemm g, const Sched& S, const Epi& E) {
    int tid_ = threadIdx.x; asm volatile("" : "+v"(tid_));
    const int tid = tid_, wid = __builtin_amdgcn_readfirstlane(tid >> 6), lane = tid & 63, wr = wid >> 2, wc = wid & 3, fr = lane & 15, fq = lane >> 4;
    const int K = g.K, nt = K / BK;
    unsigned voffA[2], voffB[2];
#pragma unroll
    for (int i = 0; i < 2; ++i) { int R, C; stage_rc(tid * 16 + i * 8192, R, C); const int Rb = Epi::PERM ? ((R & ~31) + perm32(R & 31)) : R;
        voffA[i] = (unsigned)(R * K + C) * 2u; voffB[i] = (unsigned)(Rb * K + C) * 2u; }
    const size_t kstep = (size_t)(BK * 2);
    const size_t hstep = (size_t)HALF * K * 2;
    const size_t tstep = 2 * hstep;
    const unsigned ldsw = (unsigned)wid * 1024u;
    const int aoff = lds_byte(wr * 64 + fr, fq * 8), boff = lds_byte(wc * 32 + fr, fq * 8);
#define PG8_SA(b, h) (((b) * 2 + (h)) * HTB)
#define PG8_SB(b, h) ((4 + (b) * 2 + (h)) * HTB)
#define PG8_STAGE(bufoff, gbase, voff) do { _Pragma("unroll") for (int _i = 0; _i < 2; ++_i) \
        __builtin_amdgcn_global_load_lds((const unsigned*)((const char*)(gbase) + (voff)[_i]), (PG8_LAS unsigned*)(lds + (bufoff) + ldsw + _i * 8192), 16, 0, 0); } while (0)
#define PG8_LDA(dst, b, h) do { _Pragma("unroll") for (int m = 0; m < 4; ++m) _Pragma("unroll") for (int k = 0; k < 2; ++k) dst[m][k] = *(const PG8_LAS bf16x8*)(lds + PG8_SA(b, h) + aoff + m * 2048 + k * 1024); } while (0)
#define PG8_LDB(dst, b, h) do { _Pragma("unroll") for (int n = 0; n < 2; ++n) _Pragma("unroll") for (int k = 0; k < 2; ++k) dst[n][k] = *(const PG8_LAS bf16x8*)(lds + PG8_SB(b, h) + boff + n * 2048 + k * 1024); } while (0)
#define PG8_MMA(ai, bj, At, Bt) do { __builtin_amdgcn_s_setprio(1); _Pragma("unroll") for (int m = 0; m < 4; ++m) _Pragma("unroll") for (int n = 0; n < 2; ++n) _Pragma("unroll") for (int k = 0; k < 2; ++k) \
        acc[ai][bj][m][n] = __builtin_amdgcn_mfma_f32_16x16x32_bf16(Bt[n][k], At[m][k], acc[ai][bj][m][n], 0, 0, 0); __builtin_amdgcn_s_setprio(0); } while (0)
#define PG8_WAIT_V(n) asm volatile("s_waitcnt vmcnt(" #n ")" ::: "memory")
#define PG8_WAIT_L(n) asm volatile("s_waitcnt lgkmcnt(" #n ")" ::: "memory")
#define PG8_BAR __builtin_amdgcn_s_barrier()
#define PG8_SCHED __builtin_amdgcn_sched_barrier(0)
    Unit cur, nxt; int ui = 0;
    if (!S.next(0, cur)) return;
    f32x4 acc[2][2][4][2];
#pragma unroll
    for (int a = 0; a < 2; ++a)
#pragma unroll
        for (int b = 0; b < 2; ++b)
#pragma unroll
            for (int m = 0; m < 4; ++m)
#pragma unroll
                for (int n = 0; n < 2; ++n) acc[a][b][m][n] = (f32x4){0.f, 0.f, 0.f, 0.f};
    bf16x8 At[4][2], B0[2][2], B1[2][2];
    const char* cA = (const char*)g.A + (size_t)cur.pm * tstep; const char* cB = (const char*)g.Bt + (size_t)cur.pn * tstep;
    S.a_ready(cur);
    if constexpr (SP2) {
        PG8_STAGE(PG8_SB(0, 0), cB, voffB); PG8_STAGE(PG8_SB(0, 1), cB + hstep, voffB); PG8_STAGE(PG8_SA(0, 0), cA, voffA); PG8_STAGE(PG8_SA(0, 1), cA + hstep, voffA);
        if (wr == 1) PG8_BAR;
        PG8_WAIT_V(2); PG8_BAR;
        PG8_STAGE(PG8_SB(1, 0), cB + kstep, voffB); PG8_STAGE(PG8_SA(1, 0), cA + kstep, voffA); PG8_STAGE(PG8_SB(1, 1), cB + hstep + kstep, voffB);
        PG8_WAIT_V(6); PG8_BAR;
    } else {
        PG8_STAGE(PG8_SB(0, 0), cB, voffB); PG8_STAGE(PG8_SA(0, 0), cA, voffA); PG8_STAGE(PG8_SB(0, 1), cB + hstep, voffB); PG8_STAGE(PG8_SA(0, 1), cA + hstep, voffA);
        if (wr == 1) PG8_BAR;
        PG8_WAIT_V(4); PG8_BAR;
        PG8_STAGE(PG8_SB(1, 0), cB + kstep, voffB); PG8_STAGE(PG8_SA(1, 0), cA + kstep, voffA); PG8_STAGE(PG8_SB(1, 1), cB + hstep + kstep, voffB);
        PG8_WAIT_V(6); PG8_BAR;
    }
    for (;;) {
        const bool has_next = S.next(ui + 1, nxt);
        const char* nA = has_next ? (const char*)g.A + (size_t)nxt.pm * tstep : cA; const char* nB = has_next ? (const char*)g.Bt + (size_t)nxt.pn * tstep : cB;
        for (int t = 0; t < nt; t += 2) {
            if constexpr (Epi::MID) { if (t == E.mid_t) E.mid(acc, cur, wr, wc, fr, fq); }
            const bool last = (t == nt - 2);
            const char* a1 = cA + (size_t)(t + 1) * kstep;
            const char* a2 = last ? nA : cA + (size_t)(t + 2) * kstep; const char* b2 = last ? nB : cB + (size_t)(t + 2) * kstep;
            const char* a3 = a2 + kstep; const char* b3 = b2 + kstep;
            if (last && has_next) S.a_ready(nxt);
            if constexpr (SP2) {
            PG8_LDB(B0, 0, 0); PG8_LDB(B1, 0, 1); PG8_SCHED; PG8_LDA(At, 0, 0); PG8_STAGE(PG8_SA(1, 1), a1 + hstep, voffA);
            PG8_WAIT_V(8); PG8_WAIT_L(0); PG8_BAR; PG8_MMA(0, 0, At, B0); PG8_MMA(0, 1, At, B1); PG8_BAR; PG8_SCHED;
            PG8_LDA(At, 0, 1); PG8_STAGE(PG8_SB(0, 0), b2, voffB); PG8_STAGE(PG8_SB(0, 1), b2 + hstep, voffB); PG8_STAGE(PG8_SA(0, 0), a2, voffA);
            PG8_WAIT_V(8); PG8_WAIT_L(0); PG8_BAR; PG8_MMA(1, 0, At, B0); PG8_MMA(1, 1, At, B1); PG8_BAR; PG8_SCHED;
            PG8_LDB(B0, 1, 0); PG8_LDB(B1, 1, 1); PG8_SCHED; PG8_LDA(At, 1, 0); PG8_STAGE(PG8_SA(0, 1), a2 + hstep, voffA);
            PG8_WAIT_V(8); PG8_WAIT_L(0); PG8_BAR; PG8_MMA(0, 0, At, B0); PG8_MMA(0, 1, At, B1); PG8_BAR; PG8_SCHED;
            PG8_LDA(At, 1, 1); PG8_STAGE(PG8_SB(1, 0), b3, voffB); PG8_STAGE(PG8_SB(1, 1), b3 + hstep, voffB); PG8_STAGE(PG8_SA(1, 0), a3, voffA);
            PG8_WAIT_V(8); PG8_WAIT_L(0); PG8_BAR; PG8_MMA(1, 0, At, B0); PG8_MMA(1, 1, At, B1); PG8_BAR; PG8_SCHED;
            } else {
            PG8_LDB(B0, 0, 0); PG8_SCHED; PG8_LDA(At, 0, 0); PG8_STAGE(PG8_SA(1, 1), a1 + hstep, voffA);
            PG8_WAIT_L(8); PG8_BAR; PG8_WAIT_L(0); PG8_MMA(0, 0, At, B0); PG8_BAR; PG8_SCHED;
            PG8_LDB(B1, 0, 1); PG8_STAGE(PG8_SB(0, 0), b2, voffB);
            PG8_BAR; PG8_WAIT_L(0); PG8_MMA(0, 1, At, B1); PG8_BAR;
            PG8_LDA(At, 0, 1); PG8_STAGE(PG8_SA(0, 0), a2, voffA);
            PG8_BAR; PG8_WAIT_L(0); PG8_MMA(1, 0, At, B0); PG8_BAR; PG8_SCHED;
            PG8_STAGE(PG8_SB(0, 1), b2 + hstep, voffB);
            PG8_WAIT_V(6); PG8_BAR; PG8_MMA(1, 1, At, B1); PG8_BAR;
            PG8_LDB(B0, 1, 0); PG8_SCHED; PG8_LDA(At, 1, 0); PG8_STAGE(PG8_SA(0, 1), a2 + hstep, voffA);
            PG8_WAIT_L(8); PG8_BAR; PG8_WAIT_L(0); PG8_MMA(0, 0, At, B0); PG8_BAR; PG8_SCHED;
            PG8_LDB(B1, 1, 1); PG8_STAGE(PG8_SB(1, 0), b3, voffB);
            PG8_BAR; PG8_WAIT_L(0); PG8_MMA(0, 1, At, B1); PG8_BAR;
            PG8_LDA(At, 1, 1); PG8_STAGE(PG8_SA(1, 0), a3, voffA);
            PG8_BAR; PG8_WAIT_L(0); PG8_MMA(1, 0, At, B0); PG8_BAR; PG8_SCHED;
            PG8_STAGE(PG8_SB(1, 1), b3 + hstep, voffB);
            PG8_WAIT_V(6); PG8_BAR; PG8_MMA(1, 1, At, B1); PG8_BAR;
            }
        }
        if constexpr (ALIGN_EPI) { if (wr == 0) PG8_BAR; }
        if constexpr (!Epi::AFTER_DRAIN) { E(acc, cur, wr, wc, fr, fq); if (PG8_EPI_DUP) { asm volatile("" ::: "memory"); E(acc, cur, wr, wc, fr, fq); } S.done(cur); }
        if (!has_next) break;
#pragma unroll
        for (int a = 0; a < 2; ++a)
#pragma unroll
            for (int b = 0; b < 2; ++b)
#pragma unroll
                for (int m = 0; m < 4; ++m)
#pragma unroll
                    for (int n = 0; n < 2; ++n) acc[a][b][m][n] = (f32x4){0.f, 0.f, 0.f, 0.f};
        cur = nxt; cA = nA; cB = nB; ++ui;
        if constexpr (ALIGN_EPI) { if (wr == 1) PG8_BAR; }
    }
    PG8_WAIT_V(0);
    if constexpr (!ALIGN_EPI) { if (wr == 0) PG8_BAR; }
    PG8_BAR;
    if constexpr (Epi::AFTER_DRAIN) { E.fused(acc, cur, wr, wc, fr, fq, lds, wid, lane); S.done(cur); }
#undef PG8_SA
#undef PG8_SB
#undef PG8_STAGE
#undef PG8_LDA
#undef PG8_LDB
#undef PG8_MMA
#undef PG8_WAIT_V
#undef PG8_WAIT_L
#undef PG8_BAR
#undef PG8_SCHED
}
}


namespace att {
typedef unsigned short bf16_t;
typedef short bf16x8 __attribute__((ext_vector_type(8)));
typedef short s16x4 __attribute__((ext_vector_type(4)));
typedef float f32x16 __attribute__((ext_vector_type(16)));
typedef float f32x4 __attribute__((ext_vector_type(4)));
typedef unsigned u32x4 __attribute__((ext_vector_type(4)));
#define ATT_LAS __attribute__((address_space(3)))
#ifndef ATT_THR
#define ATT_THR 8.0f
#endif
#ifndef ATT_SKIP
#define ATT_SKIP 0
#endif
#ifndef ATT_NOCOMPUTE
#define ATT_NOCOMPUTE 0
#endif
#ifndef ATT_PRIO
#define ATT_PRIO 1
#endif
#ifndef SB_EARLY_EXIT
#define SB_EARLY_EXIT 1
#endif
constexpr int KVBLK = 64, QB = 256;
constexpr int SHM_V = 16384, SHM_K = 16384, SHM_R = 8192;
#ifndef ATT_SKEW
#define ATT_SKEW 0
#endif
constexpr int NVS = (ATT_SKEW != 0) ? 4 : 3, NKS = 3;
constexpr int OFF_V = 0, OFF_K = NVS * SHM_V, OFF_R = OFF_K + NKS * SHM_K, OFF_WS = OFF_R + NKS * SHM_R, OFF_FLAG = OFF_WS + 8 * 256, ATT_LDS_BYTES = OFF_FLAG + 64;
#define KSWZ(row, colB) ((row) * 256 + ((colB) ^ (((row) & 7) << 4)))
#define RSWZ(row, colB) ((row) * 128 + ((colB) ^ (((row) & 7) << 4)))
#define SBAR() __builtin_amdgcn_sched_barrier(0)
__device__ __forceinline__ int v_st(int k, int c) { const int kk = (k & ~0xC) | ((k & 4) << 1) | ((k & 8) >> 1); return ((kk >> 3) * 4 + (c >> 5)) * 512 + ((kk & 7) * 32 + (c & 31)) * 2; }
__device__ __forceinline__ int v_rd_base(int lane) { return ((lane & 3) << 3) | (((lane >> 2) & 3) << 6) | (((lane >> 4) & 1) << 5) | (((lane >> 5) & 1) << 8); }
__device__ __forceinline__ int crow(int r, int hi) { return (r & 3) + 8 * (r >> 2) + 4 * hi; }
__device__ __forceinline__ unsigned cvtpk(float lo, float hi) { unsigned r; asm volatile("v_cvt_pk_bf16_f32 %0, %1, %2" : "=v"(r) : "v"(lo), "v"(hi)); return r; }
__device__ __forceinline__ float other_half(float x, int hi) { auto rr = __builtin_amdgcn_permlane32_swap(__float_as_uint(x), __float_as_uint(x), false, false); return __uint_as_float(hi ? rr[0] : rr[1]); }

__device__ __forceinline__ void pack_p(const f32x16& p0, const f32x16& p1, bf16x8& pa0, bf16x8& pa1, bf16x8& pa2, bf16x8& pa3) {
#define PK4(P, B_, OUT) do { unsigned a0 = cvtpk(P[B_+0], P[B_+1]), a1 = cvtpk(P[B_+2], P[B_+3]);                          \
        unsigned b0 = cvtpk(P[B_+4], P[B_+5]), b1 = cvtpk(P[B_+6], P[B_+7]);                                             \
        auto r0 = __builtin_amdgcn_permlane32_swap(a0, b0, false, false); auto r1 = __builtin_amdgcn_permlane32_swap(a1, b1, false, false); \
        u32x4 w = {r0[0], r1[0], r0[1], r1[1]}; OUT = __builtin_bit_cast(bf16x8, w); } while (0)
    PK4(p0, 0, pa0); PK4(p0, 8, pa1); PK4(p1, 0, pa2); PK4(p1, 8, pa3);
#undef PK4
}
__device__ __forceinline__ void pv_tile(f32x16* o, int vb, bf16x8 pa0, bf16x8 pa1, bf16x8 pa2, bf16x8 pa3) {
#define TRRD(dst, off) asm volatile("ds_read_b64_tr_b16 %0, %1 offset:%2" : "=&v"(dst) : "v"(vb), "i"(off) : "memory")
#define PV_D0(d0) do { s16x4 l0, l1, l2, l3, h0, h1, h2, h3; constexpr int b_ = (d0) * 512;   \
        TRRD(l0, b_); TRRD(h0, b_ + 2048); TRRD(l1, b_ + 4096); TRRD(h1, b_ + 6144); TRRD(l2, b_ + 8192); TRRD(h2, b_ + 10240); TRRD(l3, b_ + 12288); TRRD(h3, b_ + 14336); \
        asm volatile("s_waitcnt lgkmcnt(0)" ::: "memory"); SBAR();   \
        o[d0] = __builtin_amdgcn_mfma_f32_32x32x16_bf16((bf16x8){l0[0], l0[1], l0[2], l0[3], h0[0], h0[1], h0[2], h0[3]}, pa0, o[d0], 0, 0, 0);   \
        o[d0] = __builtin_amdgcn_mfma_f32_32x32x16_bf16((bf16x8){l1[0], l1[1], l1[2], l1[3], h1[0], h1[1], h1[2], h1[3]}, pa1, o[d0], 0, 0, 0);   \
        o[d0] = __builtin_amdgcn_mfma_f32_32x32x16_bf16((bf16x8){l2[0], l2[1], l2[2], l2[3], h2[0], h2[1], h2[2], h2[3]}, pa2, o[d0], 0, 0, 0);   \
        o[d0] = __builtin_amdgcn_mfma_f32_32x32x16_bf16((bf16x8){l3[0], l3[1], l3[2], l3[3], h3[0], h3[1], h3[2], h3[3]}, pa3, o[d0], 0, 0, 0); } while (0)
    PV_D0(0); PV_D0(1); PV_D0(2); PV_D0(3);
#undef PV_D0
#undef TRRD
}

template <bool SB>
__device__ __forceinline__ void attn_block(ATT_LAS unsigned char* lds, const bf16_t* Qg, int ldq, const bf16_t* Kg, int ldk, const bf16_t* Vg, int ldv, const bf16_t* Rg, bf16_t* Og, int ldo, float* Sq  , int P0) {
    constexpr int NQ = SB ? 8 : 12;
    constexpr int NDMA = SB ? 4 : 5;
    int tid_ = threadIdx.x; asm volatile("" : "+v"(tid_));
    const int tid = tid_, wid = __builtin_amdgcn_readfirstlane(tid >> 6), lane = tid & 63, r32 = lane & 31, hi = lane >> 5;
    const int qlo = P0 + wid * 32;
    const int NT = (P0 + QB) / KVBLK;
    ATT_LAS unsigned char* V_lds = lds + OFF_V; ATT_LAS unsigned char* K_lds = lds + OFF_K; ATT_LAS unsigned char* R_lds = lds + OFF_R;
    ATT_LAS float* ws = (ATT_LAS float*)(lds + OFF_WS) + wid * 64;
    ATT_LAS unsigned* flags = (ATT_LAS unsigned*)(lds + OFF_FLAG);
    const int vb0 = (int)(unsigned)(uintptr_t)V_lds + v_rd_base(lane);
    int kofs, vofs, rofs;
    { const int row = 4 * wid + (lane >> 4); kofs = row * ldk + ((((lane & 15) * 16) ^ ((row & 7) << 4)) >> 1); }
    { const int sub = 2 * wid + (lane >> 5), kk = (sub >> 2) * 8 + ((lane & 31) >> 2), k = (kk & ~0xC) | ((kk & 4) << 1) | ((kk & 8) >> 1); vofs = k * ldv + (sub & 3) * 32 + (lane & 3) * 8; }
    { const int row = 8 * wid + (lane >> 3); rofs = row * 64 + ((((lane & 7) ^ (row & 7)) * 16) >> 1); }
#define STAGE_DMA(t_, ks_, vs_) do { const size_t k0_ = (size_t)(t_) * KVBLK;                                                                                   \
        __builtin_amdgcn_global_load_lds((const unsigned*)(Kg + k0_ * ldk + kofs), (ATT_LAS unsigned*)(K_lds + (ks_) * SHM_K + wid * 1024), 16, 0, 0);                 \
        __builtin_amdgcn_global_load_lds((const unsigned*)(Kg + (k0_ + 32) * ldk + kofs), (ATT_LAS unsigned*)(K_lds + (ks_) * SHM_K + 8192 + wid * 1024), 16, 0, 0);   \
        __builtin_amdgcn_global_load_lds((const unsigned*)(Vg + k0_ * ldv + vofs), (ATT_LAS unsigned*)(V_lds + (vs_) * SHM_V + wid * 1024), 16, 0, 0);                 \
        __builtin_amdgcn_global_load_lds((const unsigned*)(Vg + (k0_ + 32) * ldv + vofs), (ATT_LAS unsigned*)(V_lds + (vs_) * SHM_V + 8192 + wid * 1024), 16, 0, 0);   \
        if (!SB) __builtin_amdgcn_global_load_lds((const unsigned*)(Rg + k0_ * 64 + rofs), (ATT_LAS unsigned*)(R_lds + (ks_) * SHM_R + wid * 1024), 16, 0, 0); } while (0)
#define TILE_OF(it_) (SB ? NT - 1 - (it_) : (it_))
#define WAIT_BAR(n_) do { if ((n_) == 0) asm volatile("s_waitcnt vmcnt(0) lgkmcnt(0)\n\ts_barrier" ::: "memory"); else if (SB) asm volatile("s_waitcnt vmcnt(4) lgkmcnt(0)\n\ts_barrier" ::: "memory"); else asm volatile("s_waitcnt vmcnt(5) lgkmcnt(0)\n\ts_barrier" ::: "memory"); } while (0)
    bf16x8 qr[NQ];
#pragma unroll
    for (int d0 = 0; d0 < NQ; ++d0) qr[d0] = *(const bf16x8*)(Qg + (size_t)(wid * 32 + r32) * ldq + d0 * 16 + hi * 8);
    f32x16 o[4];
#pragma unroll
    for (int d = 0; d < 4; ++d)
#pragma unroll
        for (int r = 0; r < 16; ++r) o[d][r] = 0.f;
    float m_reg = 0.f, l_reg = 0.f, R = 1.f; bool first_tile = true;
    int kro[4];
#pragma unroll
    for (int dd = 0; dd < 4; ++dd) kro[dd] = KSWZ(r32, (dd * 16 + hi * 8) * 2);
    STAGE_DMA(TILE_OF(0), 0, 0);
    if (NT > 1) { STAGE_DMA(TILE_OF(1), 1, 1); WAIT_BAR(NDMA); } else WAIT_BAR(0);
    const bool skew = ATT_SKEW && (ATT_SKEW == 1 ? wid >= 4 : (ATT_SKEW == 2 ? (wid & 1) : ((wid >> 1) & 1)));
    f32x16 p0, p1;
    bool pend = false; int pend_kb = 0, pend_vs = 0;
    int vs = 0, ks = 0, nt_eff = NT;
    for (int it = 0; it < nt_eff + ((ATT_SKEW != 0) ? 1 : 0); ++it) {
        const bool tile = it < nt_eff;
        const int t = TILE_OF(it); const int buf = it & 1; const bool more2 = tile && it + 2 < NT;
        { const int ks2 = ks == 0 ? 2 : ks - 1, vs2 = vs + 2 >= NVS ? vs + 2 - NVS : vs + 2;
          if (more2) STAGE_DMA(TILE_OF(it + 2), ks2, vs2); }
        const int kb = t * KVBLK;
        const bool act = tile && kb <= qlo + 31 && !ATT_NOCOMPUTE;
        bool do_sm; int sm_kb, sm_vs;
        if (!skew) { do_sm = act; sm_kb = kb; sm_vs = vs;
            if (act) {
#pragma unroll
            for (int r = 0; r < 16; ++r) { p0[r] = SB ? 0.f : -m_reg; p1[r] = SB ? 0.f : -m_reg; }
            ATT_LAS const unsigned char* kt = K_lds + ks * SHM_K;
            __builtin_amdgcn_s_setprio(ATT_PRIO);
            if (ATT_SKIP & 1) { p0[0] = (float)r32; p1[3] = (float)hi; } else {
#pragma unroll
            for (int d0 = 0; d0 < 8; ++d0) { ATT_LAS const unsigned char* a = kt + kro[d0 & 3] + (d0 >> 2) * 128;
                const bf16x8 b0 = *(ATT_LAS const bf16x8*)a; const bf16x8 b1 = *(ATT_LAS const bf16x8*)(a + 32 * 256);
                p0 = __builtin_amdgcn_mfma_f32_32x32x16_bf16(b0, qr[d0], p0, 0, 0, 0);
                p1 = __builtin_amdgcn_mfma_f32_32x32x16_bf16(b1, qr[d0], p1, 0, 0, 0); }
            if (!SB) { ATT_LAS const unsigned char* rt = R_lds + ks * SHM_R;
#pragma unroll
                for (int d0 = 0; d0 < 4; ++d0) { ATT_LAS const unsigned char* a = rt + (kro[d0] - 128 * r32);
                    const bf16x8 b0 = *(ATT_LAS const bf16x8*)a; const bf16x8 b1 = *(ATT_LAS const bf16x8*)(a + 32 * 128);
                    const bf16x8 qf = qr[SB ? 0 : 8 + d0];
                    p0 = __builtin_amdgcn_mfma_f32_32x32x16_bf16(b0, qf, p0, 0, 0, 0);
                    p1 = __builtin_amdgcn_mfma_f32_32x32x16_bf16(b1, qf, p1, 0, 0, 0); } }
            }
            __builtin_amdgcn_s_setprio(0);
            }
        } else { do_sm = pend; sm_kb = pend_kb; sm_vs = pend_vs; }
        if (do_sm) {
            const int dql = qlo + r32 - sm_kb - 4 * hi - (SB ? 1 : 0);
            const bool need_mask = SB ? (sm_kb + KVBLK - 1 >= qlo) : (sm_kb + KVBLK - 1 > qlo);
            bf16x8 pa0, pa1, pa2, pa3;
            if (ATT_SKIP & 2) { pa0 = __builtin_bit_cast(bf16x8, (f32x4){p0[0], p0[5], p0[10], p0[15]}); pa1 = __builtin_bit_cast(bf16x8, (f32x4){p1[0], p1[5], p1[10], p1[15]}); pa2 = pa0; pa3 = pa1; }
            else if (!SB) {
                if (need_mask) { const float NEG = -__builtin_inff();
#pragma unroll
                    for (int r = 0; r < 16; ++r) { const int c = (r & 3) + 8 * (r >> 2); if (c > dql) p0[r] = NEG; if (c + 32 > dql) p1[r] = NEG; } }
                float pmax = p0[0];
#pragma unroll
                for (int r = 1; r < 16; ++r) pmax = fmaxf(pmax, p0[r]);
#pragma unroll
                for (int r = 0; r < 16; ++r) pmax = fmaxf(pmax, p1[r]);
                pmax = fmaxf(pmax, other_half(pmax, hi));
                if (first_tile || __any(pmax > ATT_THR)) { const float dl = first_tile ? pmax : fmaxf(pmax, 0.f);
                    m_reg += dl;
#pragma unroll
                    for (int r = 0; r < 16; ++r) { p0[r] -= dl; p1[r] -= dl; }
                    if (!first_tile) { const float alpha = __builtin_amdgcn_exp2f(-dl); l_reg *= alpha;
#pragma unroll
                        for (int d = 0; d < 4; ++d)
#pragma unroll
                            for (int r = 0; r < 16; ++r) o[d][r] *= alpha; }
                    first_tile = false; }
                float ps = 0.f;
#pragma unroll
                for (int r = 0; r < 16; ++r) { p0[r] = __builtin_amdgcn_exp2f(p0[r]); ps += p0[r]; }
#pragma unroll
                for (int r = 0; r < 16; ++r) { p1[r] = __builtin_amdgcn_exp2f(p1[r]); ps += p1[r]; }
                ps += other_half(ps, hi);
                l_reg += ps;
                pack_p(p0, p1, pa0, pa1, pa2, pa3);
            } else {
                f32x16 l0, l1;
#pragma unroll
                for (int r = 0; r < 16; ++r) { const float e = __builtin_amdgcn_exp2f(fminf(-p0[r], 126.f)); const float be = __builtin_amdgcn_rcpf(1.0f + e); p0[r] = be; l0[r] = e * be; }
#pragma unroll
                for (int r = 0; r < 16; ++r) { const float e = __builtin_amdgcn_exp2f(fminf(-p1[r], 126.f)); const float be = __builtin_amdgcn_rcpf(1.0f + e); p1[r] = be; l1[r] = e * be; }
                if (need_mask) {
#pragma unroll
                    for (int r = 0; r < 16; ++r) { const int c = (r & 3) + 8 * (r >> 2); if (c > dql) { p0[r] = 0.f; l0[r] = 1.f; } if (c + 32 > dql) { p1[r] = 0.f; l1[r] = 1.f; } } }
                float T[8];
#pragma unroll
                for (int g = 0; g < 4; ++g) {
                    { const float a0 = l0[4 * g], a1 = l0[4 * g + 1], a2 = l0[4 * g + 2], a3 = l0[4 * g + 3]; const float x2 = a3, x1 = a3 * a2, x0 = x1 * a1; T[g] = x0 * a0;
                      l0[4 * g] = x0; l0[4 * g + 1] = x1; l0[4 * g + 2] = x2; l0[4 * g + 3] = 1.f; }
                    { const float a0 = l1[4 * g], a1 = l1[4 * g + 1], a2 = l1[4 * g + 2], a3 = l1[4 * g + 3]; const float x2 = a3, x1 = a3 * a2, x0 = x1 * a1; T[4 + g] = x0 * a0;
                      l1[4 * g] = x0; l1[4 * g + 1] = x1; l1[4 * g + 2] = x2; l1[4 * g + 3] = 1.f; }
                }
                float gs[8]; float run = R;
#pragma unroll
                for (int g = 7; g >= 0; --g) { const float To = other_half(T[g], hi); gs[g] = hi == 0 ? run * To : run; run *= T[g] * To; }
                R = run;
#pragma unroll
                for (int g = 0; g < 4; ++g)
#pragma unroll
                    for (int i = 0; i < 4; ++i) { p0[4 * g + i] = p0[4 * g + i] * (l0[4 * g + i] * gs[g]); p1[4 * g + i] = p1[4 * g + i] * (l1[4 * g + i] * gs[4 + g]); }
                pack_p(p0, p1, pa0, pa1, pa2, pa3);
            }
            if (!(ATT_SKIP & 4)) { __builtin_amdgcn_s_setprio(ATT_PRIO); pv_tile(o, vb0 + sm_vs * SHM_V, pa0, pa1, pa2, pa3); __builtin_amdgcn_s_setprio(0); } else { o[0][0] += __builtin_bit_cast(f32x4, pa0)[0] + __builtin_bit_cast(f32x4, pa1)[0] + __builtin_bit_cast(f32x4, pa2)[0] + __builtin_bit_cast(f32x4, pa3)[0]; }
        }
        if (skew) { pend = act; pend_kb = kb; pend_vs = vs;
            if (act) {
#pragma unroll
            for (int r = 0; r < 16; ++r) { p0[r] = SB ? 0.f : -m_reg; p1[r] = SB ? 0.f : -m_reg; }
            ATT_LAS const unsigned char* kt = K_lds + ks * SHM_K;
            __builtin_amdgcn_s_setprio(ATT_PRIO);
            if (ATT_SKIP & 1) { p0[0] = (float)r32; p1[3] = (float)hi; } else {
#pragma unroll
            for (int d0 = 0; d0 < 8; ++d0) { ATT_LAS const unsigned char* a = kt + kro[d0 & 3] + (d0 >> 2) * 128;
                const bf16x8 b0 = *(ATT_LAS const bf16x8*)a; const bf16x8 b1 = *(ATT_LAS const bf16x8*)(a + 32 * 256);
                p0 = __builtin_amdgcn_mfma_f32_32x32x16_bf16(b0, qr[d0], p0, 0, 0, 0);
                p1 = __builtin_amdgcn_mfma_f32_32x32x16_bf16(b1, qr[d0], p1, 0, 0, 0); }
            if (!SB) { ATT_LAS const unsigned char* rt = R_lds + ks * SHM_R;
#pragma unroll
                for (int d0 = 0; d0 < 4; ++d0) { ATT_LAS const unsigned char* a = rt + (kro[d0] - 128 * r32);
                    const bf16x8 b0 = *(ATT_LAS const bf16x8*)a; const bf16x8 b1 = *(ATT_LAS const bf16x8*)(a + 32 * 128);
                    const bf16x8 qf = qr[SB ? 0 : 8 + d0];
                    p0 = __builtin_amdgcn_mfma_f32_32x32x16_bf16(b0, qf, p0, 0, 0, 0);
                    p1 = __builtin_amdgcn_mfma_f32_32x32x16_bf16(b1, qf, p1, 0, 0, 0); } }
            }
            __builtin_amdgcn_s_setprio(0);
            }
        }
        if (SB && SB_EARLY_EXIT && tile) { const bool dead = __all(R == 0.f); if (lane == 0) flags[buf * 8 + wid] = dead ? 1u : 0u; }
        asm volatile("" ::: "memory");
        if (more2) WAIT_BAR(NDMA); else WAIT_BAR(0);
        asm volatile("" ::: "memory");
        if (SB && SB_EARLY_EXIT && tile) { const u32x4 f0 = *(ATT_LAS const u32x4*)(flags + buf * 8), f1 = *(ATT_LAS const u32x4*)(flags + buf * 8 + 4);
            if ((f0[0] & f0[1] & f0[2] & f0[3] & f1[0] & f1[1] & f1[2] & f1[3]) != 0u) nt_eff = it + 1; }
        vs = vs + 1 == NVS ? 0 : vs + 1; ks = ks == 2 ? 0 : ks + 1;
    }
    { const float rl = SB ? 1.0f : ((ATT_NOCOMPUTE && !(l_reg > 0.f)) ? 0.f : 1.0f / l_reg);
      unsigned char* rowb = (unsigned char*)(Og + (size_t)(wid * 32 + r32) * ldo) + (hi ? 16 : 0);
      { float sq = 0.f;
#pragma unroll
        for (int d = 0; d < 4; ++d)
#pragma unroll
            for (int r = 0; r < 16; ++r) { const float v = o[d][r] * rl; sq += v * v; }
        sq += other_half(sq, hi);
        if (hi == 0) Sq[(size_t)(wid * 32 + r32) * 16] = sq; }
#pragma unroll
      for (int k = 0; k < 16; k += 2) { const int d0 = k >> 2, ra = (k & 3) * 4, rb = ra + 4;
          unsigned ax = cvtpk(o[d0][ra] * rl, o[d0][ra + 1] * rl), ay = cvtpk(o[d0][ra + 2] * rl, o[d0][ra + 3] * rl);
          unsigned bx = cvtpk(o[d0][rb] * rl, o[d0][rb + 1] * rl), by = cvtpk(o[d0][rb + 2] * rl, o[d0][rb + 3] * rl);
          auto sx = __builtin_amdgcn_permlane32_swap(ax, bx, false, false); auto sy = __builtin_amdgcn_permlane32_swap(ay, by, false, false);
          *(u32x4*)(rowb + 16 * k) = (u32x4){sx[0], sy[0], sx[1], sy[1]}; } }
    asm volatile("" ::: "memory");
    asm volatile("s_waitcnt vmcnt(0) lgkmcnt(0)\n\ts_barrier" ::: "memory");
    asm volatile("" ::: "memory");
#undef STAGE_DMA
#undef TILE_OF
#undef WAIT_BAR
}
#undef KSWZ
#undef RSWZ
}

#ifdef DUP_LN
#define DUP_LN_ANY DUP_LN
#else
#define DUP_LN_ANY 0
#endif

constexpr int NWAVES = 8;
constexpr int D = 2048, BATCH = 4, SEQ = 4096, DEPTH = 4, M = BATCH * SEQ, FF = 5632, NADA = 9;
constexpr int QLR = 768, KVLR = 512, ROPE_D = 64, NH = 8, HD = 128, QKD = 192;
constexpr int IN_COLS = QLR + KVLR + ROPE_D + 3 * NH * HD;
constexpr int WIN_ROWS = 4608;
constexpr float LN_EPS = 1e-5f, RMS_EPS = 1e-6f;
constexpr float DN_ALPHA = 1.6817928305074290f;
constexpr float LOG2E = 1.4426950408889634f;
constexpr float MLA_QSCALE = 0.07216878364870322f * LOG2E;
constexpr float SB_QSCALE = 0.08838834764831845f * LOG2E;
#ifndef MK_ONE_LAUNCH
#define MK_ONE_LAUNCH 1
#endif
constexpr int N_PHASES = 3 + 8 * 3 + 4 * 5;

constexpr size_t MiB = 1u << 20;
#ifndef TPROBE
#define TPROBE 0
#endif
constexpr size_t WS_CTL = 0, CTL_ZERO_BYTES = TPROBE ? 1 * MiB : 64 * 1024;
constexpr size_t WS_ADA = 1 * MiB;
constexpr size_t WS_ADAP = 3 * MiB;
constexpr size_t WS_VEC = 22 * MiB;
constexpr size_t WS_ROPE = 24 * MiB;
constexpr size_t WS_SSQ = 28 * MiB;
constexpr size_t WS_KPE = 30 * MiB;
constexpr size_t WS_HL = 32 * MiB;
constexpr size_t WS_OSSQ = 64 * MiB;
constexpr size_t WS_H = 160 * MiB;
constexpr size_t WS_F = 224 * MiB;
constexpr size_t WS_ACT = 288 * MiB;
constexpr size_t WS_CQ = 464 * MiB;
constexpr size_t WS_CKV = 488 * MiB;
constexpr size_t WS_SBQ = 504 * MiB, WS_SBK = 536 * MiB, WS_SBV = 568 * MiB;
constexpr size_t WS_QM = 600 * MiB;
constexpr size_t WS_KV = 648 * MiB;
constexpr size_t WS_O = 712 * MiB;
constexpr size_t WS_W = 776 * MiB;
constexpr size_t W_WI = (size_t)2 * FF * D * 2, W_WO = (size_t)D * FF * 2, W_WIN = (size_t)WIN_ROWS * D * 2, W_WUQ = (size_t)NH * QKD * QLR * 2, W_WUKV = (size_t)NH * 256 * KVLR * 2, W_WOUT = (size_t)D * D * 2;
constexpr size_t WO_WI1 = 0, WO_WO1 = WO_WI1 + W_WI, WO_WI2 = WO_WO1 + W_WO, WO_WO2 = WO_WI2 + W_WI, WO_WIN = WO_WO2 + W_WO, WO_WUQ = WO_WIN + W_WIN, WO_WUKV = WO_WUQ + W_WUQ, WO_WOUT = WO_WUKV + W_WUKV;
constexpr size_t W_LAYER = WO_WOUT + W_WOUT;
constexpr size_t WS_DUMMY = WS_W + DEPTH * W_LAYER;
constexpr size_t WS_END = WS_DUMMY + (size_t)(DUP_LN_ANY ? 128 : 0) * MiB;
static_assert(W_LAYER % 256 == 0 && WS_END < (size_t)1700 * MiB, "ws map");
constexpr int ADA_KS = 16;
constexpr int CW_BAR = 4096;

constexpr int RING_OFF = 0, SCR_BYTES = 147200;
constexpr int MISC_OFF = SCR_BYTES;
constexpr int LDS_BYTES = 147456;

#define GAS __attribute__((address_space(1)))
#define LAS __attribute__((address_space(3)))
typedef unsigned short bf16;
typedef unsigned v4u __attribute__((ext_vector_type(4)));
typedef unsigned v2u __attribute__((ext_vector_type(2)));
typedef float f32x4 __attribute__((ext_vector_type(4)));
#define LDS_WAIT() asm volatile("s_waitcnt lgkmcnt(0)" ::: "memory")
#define VM_WAIT() asm volatile("s_waitcnt vmcnt(0)" ::: "memory")
__device__ __forceinline__ unsigned pk2(float lo, float hi) { unsigned r; asm volatile("v_cvt_pk_bf16_f32 %0, %1, %2" : "=v"(r) : "v"(lo), "v"(hi)); return r; }
__device__ __forceinline__ float bf_lo(unsigned w) { return __uint_as_float(w << 16); }
__device__ __forceinline__ float bf_hi(unsigned w) { return __uint_as_float(w & 0xffff0000u); }
__device__ __forceinline__ float wave_sum(float v) {
    v += __builtin_bit_cast(float, __builtin_amdgcn_update_dpp(0, __builtin_bit_cast(int, v), 0xB1, 0xF, 0xF, false));
    v += __builtin_bit_cast(float, __builtin_amdgcn_update_dpp(0, __builtin_bit_cast(int, v), 0x4E, 0xF, 0xF, false));
    v += __builtin_bit_cast(float, __builtin_amdgcn_update_dpp(0, __builtin_bit_cast(int, v), 0x124, 0xF, 0xF, false));
    v += __builtin_bit_cast(float, __builtin_amdgcn_update_dpp(0, __builtin_bit_cast(int, v), 0x128, 0xF, 0xF, false));
    { auto a = __builtin_amdgcn_permlane16_swap(__float_as_uint(v), __float_as_uint(v), false, false); v = __uint_as_float(a[0]) + __uint_as_float(a[1]); }
    { auto b = __builtin_amdgcn_permlane32_swap(__float_as_uint(v), __float_as_uint(v), false, false); v = __uint_as_float(b[0]) + __uint_as_float(b[1]); }
    return v;
}

#define XB_TMO      128
#define XB_XCNT(j)  (256  + 64 * (j))
#define XB_XSUB(j)  (1280 + 64 * (j))
#define XB_XGEN(j)  (2304 + 64 * (j))
#define XB_TOP      3328
#define XB_TOPGEN   3392
#define XCD_BAR_WORDS 3456
#define XB_SPIN_CAP (1u << 18)

__device__ __forceinline__ unsigned xb_ld(unsigned* p)              { return __hip_atomic_load(p, __ATOMIC_RELAXED, __HIP_MEMORY_SCOPE_AGENT); }
__device__ __forceinline__ unsigned xb_add(unsigned* p, unsigned v) { return __hip_atomic_fetch_add(p, v, __ATOMIC_RELAXED, __HIP_MEMORY_SCOPE_AGENT); }
__device__ __forceinline__ unsigned xb_xcc_id() { return (unsigned)__builtin_amdgcn_s_getreg((3 << 11) | 20) & 0xFu; }
#define XB_SPIN(cond, bar) do { unsigned _sp = 0; while (cond) { __builtin_amdgcn_s_sleep(1); \
    if ((++_sp & 255u) == 0u) { if (xb_ld(&(bar)[XB_TMO])) break; if (_sp > XB_SPIN_CAP) { atomicAdd(&(bar)[XB_TMO], 1u); break; } } } } while (0)

struct XcdBarrier {
    unsigned* bar; unsigned x;
    volatile LAS unsigned* st;
};

__device__ __forceinline__ XcdBarrier xcd_barrier_post(unsigned* bar, volatile LAS unsigned* st) {
    XcdBarrier b; b.bar = bar; b.x = xb_xcc_id(); b.st = st;
    if (threadIdx.x == 0) (void)xb_add(&bar[XB_XCNT(b.x)], 1u);
    return b;
}
__device__ __forceinline__ void xcd_barrier_complete(unsigned* bar, unsigned x, unsigned& nloc, unsigned& nx) {
    const unsigned G = gridDim.x * gridDim.y * gridDim.z;
    unsigned sum, cnt, mine, sp = 0u;
    for (;;) {
        sum = 0u; cnt = 0u; mine = 0u;
#pragma unroll 1
        for (unsigned j = 0; j < 16; ++j) { const unsigned c = xb_ld(&bar[XB_XCNT(j)]); sum += c; cnt += (c > 0u) ? 1u : 0u; mine = (j == x) ? c : mine; }
        if (sum == G) break;
        __builtin_amdgcn_s_sleep(1);
        if ((++sp & 255u) == 0u) { if (xb_ld(&bar[XB_TMO])) break; if (sp > XB_SPIN_CAP) { atomicAdd(&bar[XB_TMO], 1u); break; } }
    }
    nloc = mine > 0u ? mine : 1u; nx = cnt > 0u ? cnt : 1u;
}

__device__ __forceinline__ void xcd_barrier(const XcdBarrier& b) {
    asm volatile("s_waitcnt vmcnt(0)" ::: "memory");
    __syncthreads();
    if (threadIdx.x == 0) {
        unsigned* bar = b.bar;
        __builtin_amdgcn_s_waitcnt(0);
        unsigned nloc = b.st[0], nx = b.st[1];
        if (nloc == 0u) { xcd_barrier_complete(bar, b.x, nloc, nx); b.st[0] = nloc; b.st[1] = nx; }
        const unsigned old = xb_add(&bar[XB_XSUB(b.x)], 1u);
        const unsigned gen = old / nloc;
        if (old + 1u == (gen + 1u) * nloc) {
            __builtin_amdgcn_fence(__ATOMIC_RELEASE, "agent");
            asm volatile("s_waitcnt vmcnt(0)" ::: "memory");
            const unsigned og = xb_add(&bar[XB_TOP], 1u);
            const unsigned tg = og / nx;
            if (og + 1u == (tg + 1u) * nx) xb_add(&bar[XB_TOPGEN], 1u);
            else XB_SPIN(xb_ld(&bar[XB_TOPGEN]) == tg, bar);
            __builtin_amdgcn_fence(__ATOMIC_ACQUIRE, "agent");
            xb_add(&bar[XB_XGEN(b.x)], 1u);
            asm volatile("s_waitcnt vmcnt(0)" ::: "memory");
        } else {
            XB_SPIN(xb_ld(&bar[XB_XGEN(b.x)]) == gen, bar);
            __builtin_amdgcn_fence(__ATOMIC_ACQUIRE, "agent");
            asm volatile("s_waitcnt vmcnt(0)" ::: "memory");
        }
    }
    __syncthreads();
}

#ifndef LN_NS
#define LN_NS 1
#endif
#ifndef W_MANT_DROP
#define W_MANT_DROP 0
#endif
#ifndef TPROBE_SCALE
#define TPROBE_SCALE 1.0f
#endif
#ifndef TPROBE
#define TPROBE 0
#endif
#ifndef TPROBE_WG
#define TPROBE_WG 0
#endif
#ifndef TPROBE_A
#define TPROBE_A 6
#endif
#ifndef TPROBE_B
#define TPROBE_B 7
#endif
#ifndef G1_SP2
#define G1_SP2 true
#endif
#ifndef DUP_BAR
#define DUP_BAR 0
#endif
#ifndef G1_ALIGN
#define G1_ALIGN true
#endif
#ifndef GF_ALIGN
#define GF_ALIGN true
#endif
#ifndef DUP_ATT_WHICH
#define DUP_ATT_WHICH 3
#endif
#ifndef DUP_P0
#define DUP_P0 0
#endif
#ifndef DUP_P1
#define DUP_P1 0
#endif
#ifndef DUP_P2
#define DUP_P2 0
#endif
#ifndef DUP_G1
#define DUP_G1 0
#endif
#ifndef DUP_WIN
#define DUP_WIN 0
#endif
#ifndef DUP_UQKV
#define DUP_UQKV 0
#endif
#ifndef DUP_ATT
#define DUP_ATT 0
#endif
#ifndef DUP_ONORM
#define DUP_ONORM 0
#endif
#ifndef DUP_GF
#define DUP_GF 0
#endif
#ifndef DUP_LN
#define DUP_LN 0
#endif
#define REP(n) for (int rep_ = 0; rep_ < 1 + (n); ++rep_)
#ifndef P0_PARTS
#define P0_PARTS 7
#endif
#ifndef BG_ON
#define BG_ON 1
#endif
#ifndef HL_BITS
#define HL_BITS 4
#endif
#ifndef BG_SITES
#define BG_SITES 31
#endif
#ifndef BG_DIV
#define BG_DIV 0u
#endif
#ifndef BG_XDONE
#define BG_XDONE 1
#endif
#ifndef BG_EST0
#define BG_EST0 400u
#endif
#ifndef SITE_P0
#define SITE_P0 1
#endif
#ifndef SITE_P1
#define SITE_P1 1
#endif
#ifndef SITE_P2
#define SITE_P2 1
#endif
#ifndef SITE_ATT
#define SITE_ATT 3
#endif
#ifndef SITE_ONORM
#define SITE_ONORM 1
#endif
#ifndef SITE_G1
#define SITE_G1 1
#endif
#ifndef SITE_WIN
#define SITE_WIN 1
#endif
#ifndef SITE_UQKV
#define SITE_UQKV 1
#endif
#ifndef SITE_GF
#define SITE_GF 1
#endif
#ifndef SITE_LN
#define SITE_LN 1
#endif
#ifndef DBG_LAST_S
#define DBG_LAST_S (3 * DEPTH - 1)
#endif
#ifndef P0_PARTS
#define P0_PARTS 7
#endif
#ifndef BG_ON
#define BG_ON 1
#endif
#ifndef HL_BITS
#define HL_BITS 4
#endif
#ifndef BG_SITES
#define BG_SITES 31
#endif
#ifndef BG_DIV
#define BG_DIV 0u
#endif
#ifndef BG_XDONE
#define BG_XDONE 1
#endif
#ifndef BG_EST0
#define BG_EST0 400u
#endif

struct Frame {
    LAS unsigned char* lds;
    int tid, lane, wave;
    int vcu, G;
};

__device__ __forceinline__ int dst_row(int kind, int n) {
    if (kind == 1) { const int u = n >= FF ? 1 : 0, j = n - u * FF; return (j >> 7) * 256 + u * 128 + (j & 127); }
    if (kind == 2) { if (n < QLR + KVLR) return n; if (n < QLR + KVLR + ROPE_D) { const int j = n - (QLR + KVLR); return 4352 + (j < 32 ? 2 * j : 2 * (j - 32) + 1); } return n - ROPE_D; }
    if (kind == 3) { const int h = n / QKD, w = n - h * QKD; if (w < 128) return n; const int j = w - 128; return h * QKD + 128 + (j < 32 ? 2 * j : 2 * (j - 32) + 1); }
    return n;
}
__device__ __forceinline__ void tr_item(const float* __restrict__ W, int K, int N, bf16* __restrict__ WT, int kind, const float* __restrict__ gk, LAS float* scr, int item, int lane) {
    const int nblk = N >> 6, kb = item / nblk, nb = item - kb * nblk, k0 = kb << 6, n0 = nb << 6;
    const int kk4 = lane >> 4, n4 = (lane & 15) * 4;
    const float* src = W + (size_t)(k0 + kk4) * N + n0 + n4;
    f32x4 wv[16];
#pragma unroll
    for (int i = 0; i < 16; ++i) wv[i] = *(const f32x4*)(src + (size_t)(4 * i) * N);
#pragma unroll
    for (int i = 0; i < 16; ++i) { const int kk = 4 * i + kk4; f32x4 w = wv[i]; if (gk) w = w * gk[k0 + kk];
        LAS float* d = scr + kk * 65 + n4; d[0] = w[0]; d[1] = w[1]; d[2] = w[2]; d[3] = w[3]; }
    LDS_WAIT(); asm volatile("" ::: "memory");
    const int c = lane & 7;
#pragma unroll
    for (int j = 0; j < 8; ++j) { const int n = (lane >> 3) + 8 * j; const LAS float* s = scr + (8 * c) * 65 + n;
        v4u o; o.x = pk2(s[0 * 65], s[1 * 65]); o.y = pk2(s[2 * 65], s[3 * 65]); o.z = pk2(s[4 * 65], s[5 * 65]); o.w = pk2(s[6 * 65], s[7 * 65]);
#if W_MANT_DROP
        { const unsigned hb = (1u << (W_MANT_DROP - 1)) * 0x00010001u, mk = ~(((1u << W_MANT_DROP) - 1u) * 0x00010001u);
#pragma unroll
          for (int e = 0; e < 4; ++e) o[e] = (o[e] + hb) & mk; }
#endif
        *(v4u*)(WT + (size_t)dst_row(kind, n0 + n) * K + k0 + 8 * c) = o; }
    LDS_WAIT(); asm volatile("" ::: "memory");
}

struct Args { const float* in[19]; float* out; unsigned char* ws; int ph_lo, ph_hi; };
typedef const __attribute__((address_space(4))) Args CArgs;
__device__ __forceinline__ CArgs* fresh_args(CArgs* p) { asm volatile("" : "+s"(p)); return p; }
__device__ __forceinline__ Frame fresh_frame(Frame F) { asm volatile("" : "+v"(F.tid)); F.lane = F.tid & 63; return F; }
__constant__ float INVF[32] = {1.000000000e+00f, 7.498942614e-01f, 5.623413324e-01f, 4.216965139e-01f, 3.162277639e-01f, 2.371373773e-01f, 1.778279394e-01f, 1.333521307e-01f, 1.000000015e-01f, 7.498941571e-02f, 5.623413250e-02f, 4.216965288e-02f, 3.162277490e-02f, 2.371373773e-02f, 1.778279431e-02f, 1.333521493e-02f, 9.999999776e-03f, 7.498941850e-03f, 5.623413250e-03f, 4.216964822e-03f, 3.162277630e-03f, 2.371373586e-03f, 1.778279431e-03f, 1.333521446e-03f, 1.000000047e-03f, 7.498942432e-04f, 5.623413017e-04f, 4.216965172e-04f, 3.162277571e-04f, 2.371373703e-04f, 1.778279402e-04f, 1.333521504e-04f};

constexpr int I_WI = (D / 64) * (2 * FF / 64), I_WO = (FF / 64) * (D / 64), I_WIN = (D / 64) * (IN_COLS / 64), I_WUQ = (QLR / 64) * (NH * QKD / 64), I_WUKV = (KVLR / 64) * (NH * 256 / 64), I_WOUT = (D / 64) * (D / 64);
constexpr int I_LAYER = 2 * I_WI + 2 * I_WO + I_WIN + I_WUQ + I_WUKV + I_WOUT;
__device__ __forceinline__ void pack_item(const CArgs& a, int it, LAS float* scr, int lane) {
    const int l = it / I_LAYER; int r = it - l * I_LAYER;
    unsigned char* wl = a.ws + WS_W + (size_t)l * W_LAYER;
    const float* src; const float* gk = nullptr; int K_, N_, kind = 0; size_t dsto;
    if (r < I_WI) { src = a.in[7] + (size_t)l * D * 2 * FF; K_ = D; N_ = 2 * FF; dsto = WO_WI1; kind = 1; }
    else if ((r -= I_WI) < I_WO) { src = a.in[8] + (size_t)l * FF * D; K_ = FF; N_ = D; dsto = WO_WO1; }
    else if ((r -= I_WO) < I_WI) { src = a.in[17] + (size_t)l * D * 2 * FF; K_ = D; N_ = 2 * FF; dsto = WO_WI2; kind = 1; }
    else if ((r -= I_WI) < I_WO) { src = a.in[18] + (size_t)l * FF * D; K_ = FF; N_ = D; dsto = WO_WO2; }
    else if ((r -= I_WO) < I_WIN) { src = a.in[9] + (size_t)l * D * IN_COLS; K_ = D; N_ = IN_COLS; dsto = WO_WIN; kind = 2; }
    else if ((r -= I_WIN) < I_WUQ) { src = a.in[12] + (size_t)l * QLR * NH * QKD; K_ = QLR; N_ = NH * QKD; dsto = WO_WUQ; kind = 3; gk = a.in[10] + l * QLR; }
    else if ((r -= I_WUQ) < I_WUKV) { src = a.in[13] + (size_t)l * KVLR * NH * 256; K_ = KVLR; N_ = NH * 256; dsto = WO_WUKV; gk = a.in[11] + l * KVLR; }
    else { r -= I_WUKV; src = a.in[16] + (size_t)l * D * D; K_ = D; N_ = D; dsto = WO_WOUT;
           gk = (r / (D / 64)) < 16 ? a.in[14] + l * 1024 : a.in[15] + l * 1024 - 1024; }
    tr_item(src, K_, N_, (bf16*)(wl + dsto), kind, gk, scr, r, lane);
}

constexpr int CW_BGQ = 8192;
constexpr unsigned BG_TOTAL = (unsigned)(DEPTH - 1) * I_LAYER;
__device__ __forceinline__ unsigned rfl(unsigned v) { return (unsigned)__builtin_amdgcn_readfirstlane((int)v); }
__device__ __forceinline__ void bg_items(const Frame& F, const CArgs& a, unsigned base) {
    const unsigned q = base + (unsigned)F.wave;
    if (q < BG_TOTAL) pack_item(a, (int)(I_LAYER + q), (LAS float*)(F.lds + F.wave * 16640), F.lane);
}
__device__ __forceinline__ void bg_drain(const XcdBarrier& b, const Frame& F, const CArgs& a, unsigned limit) {
    unsigned* q = (unsigned*)(a.ws + WS_CTL) + CW_BGQ;
    if (F.tid == 0) b.st[5] = xb_ld(q);
    __syncthreads();
    const unsigned q0 = rfl(b.st[5]);
    __syncthreads();
    const unsigned gw = (unsigned)(F.vcu * NWAVES + F.wave), NGW = (unsigned)(F.G * NWAVES);
    LAS float* scr = (LAS float*)(F.lds + F.wave * 16640);
    for (unsigned it = q0 - q0 % NGW + gw; it < limit; it += NGW) if (it >= q0) pack_item(a, (int)(I_LAYER + it), scr, F.lane);
}
__device__ __forceinline__ void bg_bump(const CArgs& a, unsigned limit) {
    if (threadIdx.x == 0) (void)__hip_atomic_fetch_max((unsigned*)(a.ws + WS_CTL) + CW_BGQ, limit, __ATOMIC_RELAXED, __HIP_MEMORY_SCOPE_AGENT);
}
__device__ __forceinline__ void xcd_barrier_bg(const XcdBarrier& b, const Frame& F, const CArgs& a) {
    asm volatile("s_waitcnt vmcnt(0)" ::: "memory");
    __syncthreads();
    if (threadIdx.x == 0) {
        unsigned* bar = b.bar;
        __builtin_amdgcn_s_waitcnt(0);
        unsigned nloc = b.st[0], nx = b.st[1];
        if (nloc == 0u) { xcd_barrier_complete(bar, b.x, nloc, nx); b.st[0] = nloc; b.st[1] = nx; }
        const unsigned old = xb_add(&bar[XB_XSUB(b.x)], 1u);
        const unsigned gen = old / nloc;
        if (old + 1u == (gen + 1u) * nloc) {
            __builtin_amdgcn_fence(__ATOMIC_RELEASE, "agent");
            asm volatile("s_waitcnt vmcnt(0)" ::: "memory");
            const unsigned og = xb_add(&bar[XB_TOP], 1u);
            const unsigned tg = og / nx;
            if (og + 1u == (tg + 1u) * nx) xb_add(&bar[XB_TOPGEN], 1u);
            else XB_SPIN(xb_ld(&bar[XB_TOPGEN]) == tg, bar);
            __builtin_amdgcn_fence(__ATOMIC_ACQUIRE, "agent");
            xb_add(&bar[XB_XGEN(b.x)], 1u);
            asm volatile("s_waitcnt vmcnt(0)" ::: "memory");
            b.st[2] = 1u;
        } else { b.st[2] = 0u; b.st[3] = gen; }
    }
    __syncthreads();
    if (rfl(b.st[2]) == 0u) {
        const unsigned gen = rfl(b.st[3]);
        unsigned* q = (unsigned*)(a.ws + WS_CTL) + CW_BGQ;
        for (;;) {
            if (threadIdx.x == 0) { const unsigned rel = xb_ld(&b.bar[XB_XGEN(b.x)]) != gen ? 1u : 0u; unsigned base = 0xFFFFFFFFu;
                if (!rel) { const bool xdone = !BG_XDONE || xb_ld(&b.bar[XB_XSUB(b.x)]) >= (gen + 1u) * b.st[0];
                    if (xdone && xb_ld(q) < BG_TOTAL) base = xb_add(q, 8u); }
                b.st[4] = rel; b.st[5] = base; }
            __syncthreads();
            const unsigned rel = rfl(b.st[4]), base = rfl(b.st[5]);
            __syncthreads();
            if (rel) break;
            if (base < BG_TOTAL) bg_items(F, a, base);
            else __builtin_amdgcn_s_sleep(8);
        }
        if (threadIdx.x == 0) { __builtin_amdgcn_fence(__ATOMIC_ACQUIRE, "agent"); asm volatile("s_waitcnt vmcnt(0)" ::: "memory"); }
        __syncthreads();
    }
}

__device__ __forceinline__ void p0_prologue(const Frame& F, const CArgs& a) {
    unsigned char* ws = a.ws;
    const int gw = F.vcu * NWAVES + F.wave, NGW = F.G * NWAVES;
    const int gt = F.vcu * (NWAVES * 64) + F.tid, NGT = F.G * NWAVES * 64;
#if P0_PARTS & 1
    {
        LAS float* scr = (LAS float*)(F.lds + F.wave * 16640);
        for (int it = gw; it < (BG_ON ? I_LAYER : DEPTH * I_LAYER); it += NGW) pack_item(a, it, scr, F.lane);
        constexpr int PADV = (WIN_ROWS - IN_COLS) * D * 2 / 16;
        for (int i = gt; i < DEPTH * PADV; i += NGT) { const int l = i / PADV, r = i - l * PADV;
            *(v4u*)(ws + WS_W + (size_t)l * W_LAYER + WO_WIN + (size_t)IN_COLS * D * 2 + (size_t)r * 16) = (v4u){0u, 0u, 0u, 0u}; }
    }
#endif
#if P0_PARTS & 2
    {
        const int* pos = (const int*)a.in[2]; float* rope = (float*)(ws + WS_ROPE);
        for (int i = gt; i < M * 32; i += NGT) { const int row = i >> 5, j = i & 31;
            const float ang = (float)pos[row] * INVF[j];
            double rev = (double)ang * 0.15915494309189535; rev -= __builtin_floor(rev);
            const float fr = (float)rev;
            *(float2*)(rope + (size_t)i * 2) = make_float2(__builtin_amdgcn_cosf(fr), __builtin_amdgcn_sinf(fr)); }
    }
#endif
    __syncthreads();
#if P0_PARTS & 4
    {
        LAS f32x4* cact = (LAS f32x4*)F.lds;
        for (int k = F.tid; k < D; k += NWAVES * 64) { f32x4 v;
#pragma unroll
            for (int b = 0; b < 4; ++b) { const float cv = a.in[1][b * D + k]; v[b] = cv / (1.0f + __expf(-cv)); }
            cact[k] = v; }
        __syncthreads();
        constexpr int NCH = NADA * D / 256, KSL = D / ADA_KS;
        float* adap = (float*)(ws + WS_ADAP);
        for (int it = gw; it < DEPTH * NCH * ADA_KS; it += NGW) {
            const int ks = it % ADA_KS, r = it / ADA_KS, ch = r % NCH, l = r / NCH;
            const int n = ch * 256 + 4 * F.lane;
            const float* w = a.in[3] + ((size_t)l * D + (size_t)ks * KSL) * (NADA * D) + n;
            f32x4 acc[4];
#pragma unroll
            for (int b = 0; b < 4; ++b) acc[b] = (f32x4){0.f, 0.f, 0.f, 0.f};
            if (ks == 0) { const f32x4 bv = *(const f32x4*)(a.in[4] + (size_t)l * NADA * D + n);
#pragma unroll
                for (int b = 0; b < 4; ++b) acc[b] = bv; }
#pragma unroll 16
            for (int kk = 0; kk < KSL; ++kk) { const f32x4 wv = *(const f32x4*)(w + (size_t)kk * (NADA * D)); const f32x4 cv = cact[ks * KSL + kk];
#pragma unroll
                for (int b = 0; b < 4; ++b) acc[b] += wv * cv[b]; }
#pragma unroll
            for (int b = 0; b < 4; ++b) *(f32x4*)(adap + (((size_t)ks * DEPTH + l) * BATCH + b) * (NADA * D) + n) = acc[b];
        }
    }
#endif
}
__device__ __forceinline__ void p1_ada_reduce(const Frame& F, const CArgs& a) {
    const int gt = F.vcu * (NWAVES * 64) + F.tid, NGT = F.G * NWAVES * 64;
    const f32x4* adap = (const f32x4*)(a.ws + WS_ADAP); f32x4* ada = (f32x4*)(a.ws + WS_ADA);
    constexpr int NV = DEPTH * BATCH * NADA * D / 4;
    for (int i = gt; i < NV; i += NGT) { f32x4 s = adap[i];
#pragma unroll
        for (int ks = 1; ks < ADA_KS; ++ks) s += adap[(size_t)ks * NV + i];
        ada[i] = s; }
}
__device__ __forceinline__ void p2_modulate0(const Frame& F, const CArgs& a) {
    const int gw = F.vcu * NWAVES + F.wave, NGW = F.G * NWAVES;
    const float* ada = (const float*)(a.ws + WS_ADA); bf16* H = (bf16*)(a.ws + WS_H);
    for (int row = gw; row < M; row += NGW) { const int b = row >> 12;
        const float* sh = ada + (size_t)b * NADA * D, * sc = sh + D;
#pragma unroll
        for (int j = 0; j < 8; ++j) { const int idx = 4 * (F.lane + 64 * j);
            const f32x4 xv = *(const f32x4*)(a.in[0] + (size_t)row * D + idx), s1 = *(const f32x4*)(sc + idx), s0 = *(const f32x4*)(sh + idx);
            const f32x4 h = xv * (s1 + 1.0f) + s0;
            *(v2u*)(H + (size_t)row * D + idx) = (v2u){pk2(h[0], h[1]), pk2(h[2], h[3])}; } }
}
__device__ __forceinline__ void vec_prep(const Frame& F, const CArgs& a) {
    const int gt = F.vcu * (NWAVES * 64) + F.tid, NGT = F.G * NWAVES * 64;
    const float* ada = (const float*)(a.ws + WS_ADA); float* vec = (float*)(a.ws + WS_VEC);
    for (int i = gt; i < 3 * DEPTH * BATCH * D; i += NGT) { const int d = i % D, sb = i / D, b = sb % BATCH, s = sb / BATCH, l = s / 3, j = s - 3 * l;
        const float* ad = ada + ((size_t)l * BATCH + b) * NADA * D + d;
        const float sh = ad[(3 * j) * D], sc = ad[(3 * j + 1) * D], gt_ = ad[(3 * j + 2) * D];
        const float lg = a.in[5][(size_t)(l * 3 + j) * D + d], lb = a.in[6][(size_t)(l * 3 + j) * D + d];
        float P = DN_ALPHA, Q = 0.f; if (s != 0) { P = DN_ALPHA / (1.0f + sc); Q = -P * sh; }
        float U = lg, W = lb;
        if (s != 3 * DEPTH - 1) { const int s1 = s + 1, l1 = s1 / 3, j1 = s1 - 3 * l1; const float* an = ada + ((size_t)l1 * BATCH + b) * NADA * D + d;
            const float nsh = an[(3 * j1) * D], nsc = an[(3 * j1 + 1) * D]; U = lg * (1.0f + nsc); W = lb * (1.0f + nsc) + nsh; }
        float* o = vec + (size_t)sb * 5 * D + d;
        o[0] = P; o[D] = Q; o[2 * D] = (j == 1 ? 1.0f : 0.5f) * (1.0f + gt_); o[3 * D] = U; o[4 * D] = W; }
}
__device__ __forceinline__ unsigned hl_enc(float h, unsigned hb) { const int d = (int)(__float_as_uint(h) - hb); int q = (d + 0x80) >> 8; q = q > 127 ? 127 : q; return (unsigned)q & 0xffu; }
__device__ __forceinline__ float hl_dec(unsigned hb, unsigned byte) { const int q = (int)(signed char)(byte & 0xffu); return __uint_as_float(hb + (unsigned)(q * 256)); }
__device__ __forceinline__ unsigned hl_enc4(float h, unsigned hb) { const int d = (int)(__float_as_uint(h) - hb); int q = (d + 0x800) >> 12; q = q > 7 ? 7 : q; return (unsigned)q & 0xfu; }
__device__ __forceinline__ float hl_dec4(unsigned hb, unsigned w, int k) { const int q = __builtin_amdgcn_sbfe((int)w, 4 * k, 4); return __uint_as_float(hb + (unsigned)(q * 4096)); }
template <bool FIRST>
__device__ __forceinline__ void ln_phase(const Frame& F, const bf16* H, const unsigned char* L, bf16* HO, unsigned char* LO, const bf16* f, const float* vecs  , const float* X32, float* OUT32) {
    const int gw = F.vcu * NWAVES + F.wave, NGW = F.G * NWAVES;
    constexpr int RPW = 8;
    int tid0_ = threadIdx.x; asm volatile("" : "+v"(tid0_)); const int Flane = tid0_ & 63, Ftid = tid0_;
    LAS f32x4* lv = (LAS f32x4*)F.lds;
    int staged_b = -1;
    for (int r0 = gw * RPW; r0 < M; r0 += NGW * RPW) { const int b = r0 >> 12;
        if (b != staged_b) {
            if (staged_b >= 0) __syncthreads();
            const f32x4* src = (const f32x4*)(vecs + (size_t)b * 5 * D);
            int t_ = Ftid; asm volatile("" : "+v"(t_));
#pragma unroll
            for (int i = 0; i < 5; ++i) { const int q = t_ + 512 * i, vec = q >> 9, e = (q & 511) * 4, j = e >> 9, ln = (e & 511) >> 3, half = (e >> 2) & 1;
                lv[((vec * 4 + j) * 2 + half) * 64 + ln] = src[q]; }
            __syncthreads(); staged_b = b; }
        constexpr int NS = FIRST ? 1 : LN_NS;
        v4u hq2[NS][4], fq2[NS][4]; v2u lq2[NS][4]; f32x4 xq2[NS][8];
#define LN_LOAD(row_, S_) do { _Pragma("unroll") for (int j = 0; j < 4; ++j) { const int idx = 8 * (Flane + 64 * j);                                     \
            fq2[S_][j] = *(const v4u*)(f + (size_t)(row_) * D + idx);                                                                                          \
            if (FIRST) { xq2[S_][2 * j] = *(const f32x4*)(X32 + (size_t)(row_) * D + idx); xq2[S_][2 * j + 1] = *(const f32x4*)(X32 + (size_t)(row_) * D + idx + 4); } \
            else { hq2[S_][j] = *(const v4u*)(H + (size_t)(row_) * D + idx); if (HL_BITS == 4) lq2[S_][j][0] = *(const unsigned*)(L + (size_t)(row_) * (D / 2) + idx / 2); else lq2[S_][j] = *(const v2u*)(L + (size_t)(row_) * D + idx); } } } while (0)
        LN_LOAD(r0, 0); if (NS == 2) LN_LOAD(r0 + 1, NS - 1);
#pragma unroll
        for (int i = 0; i < RPW; ++i) { const int row = r0 + i;
            v4u (&hq)[4] = hq2[i % NS]; v4u (&fq)[4] = fq2[i % NS]; v2u (&lq)[4] = lq2[i % NS]; f32x4 (&xq)[8] = xq2[i % NS];
            int ln_ = Flane; asm volatile("" : "+v"(ln_));
            float v[32]; float s = 0.f;
#pragma unroll
            for (int j = 0; j < 4; ++j) {
                const f32x4 p0 = lv[((0 * 4 + j) * 2 + 0) * 64 + ln_], p1 = lv[((0 * 4 + j) * 2 + 1) * 64 + ln_], q0 = lv[((1 * 4 + j) * 2 + 0) * 64 + ln_], q1 = lv[((1 * 4 + j) * 2 + 1) * 64 + ln_], c0 = lv[((2 * 4 + j) * 2 + 0) * 64 + ln_], c1 = lv[((2 * 4 + j) * 2 + 1) * 64 + ln_];
#pragma unroll
                for (int e = 0; e < 4; ++e) { const float fl = bf_lo(fq[j][e]), fh = bf_hi(fq[j][e]);
                    const float xl = FIRST ? xq[2 * j + (e >> 1)][(e & 1) * 2] : HL_BITS == 4 ? hl_dec4(hq[j][e] << 16, lq[j][0], 2 * e) : hl_dec(hq[j][e] << 16, lq[j][e >> 1] >> (16 * (e & 1))), xh = FIRST ? xq[2 * j + (e >> 1)][(e & 1) * 2 + 1] : HL_BITS == 4 ? hl_dec4(hq[j][e] & 0xffff0000u, lq[j][0], 2 * e + 1) : hl_dec(hq[j][e] & 0xffff0000u, lq[j][e >> 1] >> (16 * (e & 1) + 8));
                    const float pl = e < 2 ? p0[2 * e] : p1[2 * e - 4], ph_ = e < 2 ? p0[2 * e + 1] : p1[2 * e - 3], ql = e < 2 ? q0[2 * e] : q1[2 * e - 4], qh = e < 2 ? q0[2 * e + 1] : q1[2 * e - 3], cl = e < 2 ? c0[2 * e] : c1[2 * e - 4], ch = e < 2 ? c0[2 * e + 1] : c1[2 * e - 3];
                    const float vl = pl * xl + ql + cl * fl, vh = ph_ * xh + qh + ch * fh; v[8 * j + 2 * e] = vl; v[8 * j + 2 * e + 1] = vh; s += vl + vh; } }
            if (i + NS < RPW) LN_LOAD(row + NS, i % NS);
            const float mean = wave_sum(s) * (1.0f / D); float s2 = 0.f;
#pragma unroll
            for (int k = 0; k < 32; ++k) { v[k] -= mean; s2 += v[k] * v[k]; }
            const float rstd = 1.0f / sqrtf(wave_sum(s2) * (1.0f / D) + LN_EPS);
#pragma unroll
            for (int j = 0; j < 4; ++j) { const int idx = 8 * (ln_ + 64 * j);
                const f32x4 u0 = lv[((3 * 4 + j) * 2 + 0) * 64 + ln_], u1 = lv[((3 * 4 + j) * 2 + 1) * 64 + ln_], w0 = lv[((4 * 4 + j) * 2 + 0) * 64 + ln_], w1 = lv[((4 * 4 + j) * 2 + 1) * 64 + ln_];
                float o[8];
#pragma unroll
                for (int e = 0; e < 8; ++e) o[e] = v[8 * j + e] * rstd * (e < 4 ? u0[e] : u1[e - 4]) + (e < 4 ? w0[e] : w1[e - 4]);
                if (OUT32) { *(f32x4*)(OUT32 + (size_t)row * D + idx) = (f32x4){o[0], o[1], o[2], o[3]}; *(f32x4*)(OUT32 + (size_t)row * D + idx + 4) = (f32x4){o[4], o[5], o[6], o[7]}; }
                else { v4u hw; v2u lw = {0u, 0u};
#pragma unroll
                    for (int e = 0; e < 4; ++e) { hw[e] = pk2(o[2 * e], o[2 * e + 1]);
                        if (HL_BITS == 4) lw[0] |= (hl_enc4(o[2 * e], hw[e] << 16) | (hl_enc4(o[2 * e + 1], hw[e] & 0xffff0000u) << 4)) << (8 * e);
                        else lw[e >> 1] |= (hl_enc(o[2 * e], hw[e] << 16) | (hl_enc(o[2 * e + 1], hw[e] & 0xffff0000u) << 8)) << (16 * (e & 1)); }
                    *(v4u*)(HO + (size_t)row * D + idx) = hw; if (HL_BITS == 4) *(unsigned*)(LO + (size_t)row * (D / 2) + idx / 2) = lw[0]; else *(v2u*)(LO + (size_t)row * D + idx) = lw; } } }
#undef LN_LOAD
    }
    __syncthreads();
}
__device__ __forceinline__ void attn_phase(const Frame& F, const CArgs& a, int which) {
    unsigned char* ws = a.ws;
    const bf16* QM = (const bf16*)(ws + WS_QM); const bf16* KV = (const bf16*)(ws + WS_KV); const bf16* KPE = (const bf16*)(ws + WS_KPE);
    const bf16* SBQ = (const bf16*)(ws + WS_SBQ); const bf16* SBK = (const bf16*)(ws + WS_SBK); const bf16* SBV = (const bf16*)(ws + WS_SBV);
    bf16* O = (bf16*)(ws + WS_O); float* OSSQ = (float*)(ws + WS_OSSQ);
    constexpr int NQB = SEQ / 256, NPAIR = NQB / 2, NITEM = BATCH * NH * NPAIR;
    for (int it = F.vcu; it < NITEM; it += F.G) {
        const int bh = it / NPAIR, x = it - bh * NPAIR, b = bh / NH, h = bh - b * NH;
        const size_t r0 = (size_t)b * SEQ;
#if SITE_ATT & 1
#pragma unroll 1
        for (int pass = 0; pass < ((which & 1) ? 2 : 0); ++pass) { const int qb = pass ? NQB - 1 - x : x; const size_t rq = r0 + (size_t)qb * 256;
            att::attn_block<false>(F.lds, QM + rq * (NH * QKD) + h * QKD, NH * QKD, KV + r0 * D + h * 256, D, KV + r0 * D + h * 256 + 128, D, KPE + r0 * 64, O + rq * D + h * HD, D, OSSQ + rq * 16 + h, qb * 256); }
#endif
#if SITE_ATT & 2
#pragma unroll 1
        for (int pass = 0; pass < ((which & 2) ? 2 : 0); ++pass) { const int qb = pass ? NQB - 1 - x : x; const size_t rq = r0 + (size_t)qb * 256;
            att::attn_block<true>(F.lds, SBQ + rq * 1024 + h * HD, 1024, SBK + r0 * 1024 + h * HD, 1024, SBV + r0 * 1024 + h * HD, 1024, nullptr, O + rq * D + 1024 + h * HD, D, OSSQ + rq * 16 + 8 + h, qb * 256); }
#endif
    }
}

__global__ void __launch_bounds__(NWAVES * 64, 2) mk_fwd(Args args_unused) {
    extern __shared__ __attribute__((aligned(16))) unsigned char lds[];
    (void)args_unused;
    CArgs* ap = (CArgs*)__builtin_amdgcn_kernarg_segment_ptr();
    Frame F;
    F.lds = (LAS unsigned char*)lds;
    F.tid = threadIdx.x; F.lane = F.tid & 63; F.wave = __builtin_amdgcn_readfirstlane(F.tid >> 6);
    F.G = gridDim.x; { const int bx = blockIdx.x; F.vcu = (F.G % 8 == 0) ? (bx % 8) * (F.G / 8) + bx / 8 : bx; }
    volatile LAS unsigned* MISC = (volatile LAS unsigned*)(F.lds + MISC_OFF);
    for (int u = F.tid; u < (LDS_BYTES - MISC_OFF) / 4; u += NWAVES * 64) ((LAS unsigned*)(F.lds + MISC_OFF))[u] = 0u;
    __syncthreads();
    XcdBarrier bar; bar.bar = (unsigned*)(ap->ws + WS_CTL) + CW_BAR; bar.x = 0; bar.st = nullptr;
    if (MK_ONE_LAUNCH) bar = xcd_barrier_post((unsigned*)(ap->ws + WS_CTL) + CW_BAR, MISC + 8);
    const int lo = ap->ph_lo, hi = ap->ph_hi; int ph = 0; bool fin_ = false;
#define RUN_PH (ph >= lo && ph < hi)
#if TPROBE
#define TP_BASE ((unsigned long long*)(fresh_args(ap)->ws + WS_CTL + 524288))
#define TP_BEGIN(k) do { if (blockIdx.x == TPROBE_WG && threadIdx.x == 0) { unsigned long long* tp = TP_BASE; tp[30] = __builtin_amdgcn_s_memrealtime(); int kk_ = (k); asm volatile("" : "+s"(kk_)); ((unsigned*)tp)[64] = (unsigned)kk_; } } while (0)
#define TP_MID do { if (blockIdx.x == TPROBE_WG && threadIdx.x == 0) { asm volatile("s_waitcnt vmcnt(0)" ::: "memory"); TP_BASE[31] = __builtin_amdgcn_s_memrealtime(); } } while (0)
#define TP_END do { if (blockIdx.x == TPROBE_WG && threadIdx.x == 0) { unsigned long long* tp = TP_BASE; const unsigned long long t2 = __builtin_amdgcn_s_memrealtime(), t0 = tp[30], t1 = tp[31]; const int k = (int)((unsigned*)tp)[64]; tp[2 * k] += t1 - t0; tp[2 * k + 1] += t2 - t1; } } while (0)
#else
#define TP_BEGIN(k) do { } while (0)
#define TP_MID do { } while (0)
#define TP_END do { } while (0)
#endif
#define END_PH do { TP_MID; if (MK_ONE_LAUNCH && RUN_PH && ph + 1 < hi && !fin_) { xcd_barrier(bar); for (int xb_ = 0; xb_ < DUP_BAR; ++xb_) xcd_barrier(bar); } TP_END; ++ph; } while (0)
#define BG_T0 do { } while (0)
#define END_PH_BG(bit) do { TP_MID; if (MK_ONE_LAUNCH && RUN_PH && ph + 1 < hi && !fin_) { if (BG_ON && (BG_SITES & (bit))) xcd_barrier_bg(bar, fresh_frame(F), *fresh_args(ap)); else xcd_barrier(bar); for (int xb_ = 0; xb_ < DUP_BAR; ++xb_) xcd_barrier(bar); } TP_END; ++ph; } while (0)
#define WSP(T, off) ((T*)(A->ws + (off)))

REP(DUP_P0) { TP_BEGIN(0);
#if SITE_P0
    if (RUN_PH) p0_prologue(fresh_frame(F), *fresh_args(ap));
#endif
    END_PH; }
REP(DUP_P1) { TP_BEGIN(1);
#if SITE_P1
    if (RUN_PH) p1_ada_reduce(fresh_frame(F), *fresh_args(ap));
#endif
    END_PH; }
REP(DUP_P2) { TP_BEGIN(2);
#if SITE_P2
    if (RUN_PH) { p2_modulate0(fresh_frame(F), *fresh_args(ap)); vec_prep(fresh_frame(F), *fresh_args(ap)); }
#endif
    END_PH; }

#pragma unroll 1
    for (int s = 0; s <= DBG_LAST_S; ++s) {
        const int l = s / 3, j = s - 3 * l;
        if (j != 1) {
REP(DUP_G1) { TP_BEGIN(3); BG_T0;
#if SITE_G1
            if (RUN_PH) { CArgs* A = fresh_args(ap); const unsigned char* wl = A->ws + WS_W + (size_t)l * W_LAYER;
                pg8::Gemm g{WSP(const bf16, WS_H), (const bf16*)(wl + (j == 0 ? WO_WI1 : WO_WI2)), M, 2 * FF, D}; pg8::StaticOrder S; S.init(M, 2 * FF, F.G, (int)blockIdx.x);
                pg8::EpiSwiGLU E{WSP(bf16, WS_ACT), FF};
                pg8::gemm_phase<pg8::EpiSwiGLU, pg8::StaticOrder, G1_ALIGN, G1_SP2>(F.lds + RING_OFF, g, S, E);
            }
#endif
            END_PH_BG(1); }
        } else {
REP(DUP_WIN) { TP_BEGIN(4); BG_T0;
#if SITE_WIN
            if (RUN_PH) { CArgs* A = fresh_args(ap); const unsigned char* wl = A->ws + WS_W + (size_t)l * W_LAYER;
                pg8::Gemm g{WSP(const bf16, WS_H), (const bf16*)(wl + WO_WIN), M, WIN_ROWS, D}; pg8::WinOrder S; S.init(M, 16 * 256, F.G, (int)blockIdx.x);
                pg8::EpiWin E{WSP(bf16, WS_CQ), WSP(bf16, WS_CKV), WSP(bf16, WS_SBQ), WSP(bf16, WS_SBK), WSP(bf16, WS_SBV), WSP(bf16, WS_KPE), WSP(float, WS_SSQ), WSP(const float, WS_ROPE), SB_QSCALE};
                pg8::gemm_phase<pg8::EpiWin, pg8::WinOrder, true, true>(F.lds + RING_OFF, g, S, E);
            }
#endif
            END_PH_BG(2); }
REP(DUP_UQKV) { TP_BEGIN(5); BG_T0;
#if SITE_UQKV
            if (RUN_PH) {
                const int c = (int)blockIdx.x, G = F.G; const bool bal = G == 256; const bool grpA = ((c >> 3) & 1) == 0; const int gi = ((c >> 4) << 3) | (c & 7);
                pg8::ListOrder Swt, Suq, Sukv;
                if (bal) { Swt = pg8::ListOrder{gi, grpA ? 1 : 0, 1, 15}; Suq = grpA ? pg8::ListOrder{gi, 1, 1, 0} : pg8::ListOrder{128 + 2 * gi, 2, 1, 0}; Sukv = grpA ? pg8::ListOrder{gi, 1, 1, 0} : pg8::ListOrder{128 + 3 * gi, 3, 1, 0}; }
                else { Swt = pg8::ListOrder{c, c < 128 ? (128 - c + G - 1) / G : 0, G, 15}; Suq = pg8::ListOrder{c, c < 384 ? (384 - c + G - 1) / G : 0, G, 0}; Sukv = pg8::ListOrder{c, c < 512 ? (512 - c + G - 1) / G : 0, G, 0}; }
                { CArgs* A = fresh_args(ap); const unsigned char* wl = A->ws + WS_W + (size_t)l * W_LAYER;
                  pg8::Gemm g{WSP(const bf16, WS_H), (const bf16*)(wl + WO_WIN), M, WIN_ROWS, D};
                  pg8::EpiWin E{WSP(bf16, WS_CQ), WSP(bf16, WS_CKV), WSP(bf16, WS_SBQ), WSP(bf16, WS_SBK), WSP(bf16, WS_SBV), WSP(bf16, WS_KPE), WSP(float, WS_SSQ), WSP(const float, WS_ROPE), SB_QSCALE};
                  pg8::gemm_phase<pg8::EpiWin, pg8::ListOrder, true, true>(F.lds + RING_OFF, g, Swt, E); }
                { CArgs* A = fresh_args(ap); const unsigned char* wl = A->ws + WS_W + (size_t)l * W_LAYER;
                  pg8::Gemm g{WSP(const bf16, WS_CQ), (const bf16*)(wl + WO_WUQ), M, NH * QKD, QLR};
                  pg8::EpiRS<true> E{WSP(bf16, WS_QM), NH * QKD, WSP(const float, WS_SSQ), 0, 3, 1.0f / QLR, RMS_EPS, MLA_QSCALE, WSP(const float, WS_ROPE)};
                  pg8::gemm_phase<pg8::EpiRS<true>, pg8::ListOrder, true, true>(F.lds + RING_OFF, g, Suq, E); }
                { CArgs* A = fresh_args(ap); const unsigned char* wl = A->ws + WS_W + (size_t)l * W_LAYER;
                  pg8::Gemm g{WSP(const bf16, WS_CKV), (const bf16*)(wl + WO_WUKV), M, NH * 256, KVLR};
                  pg8::EpiRS<false> E{WSP(bf16, WS_KV), NH * 256, WSP(const float, WS_SSQ), 3, 2, 1.0f / KVLR, RMS_EPS, 1.0f, nullptr};
                  pg8::gemm_phase<pg8::EpiRS<false>, pg8::ListOrder, true, true>(F.lds + RING_OFF, g, Sukv, E); }
            }
#endif
            END_PH_BG(4); }
REP(DUP_ATT) { TP_BEGIN(6); BG_T0;
#if SITE_ATT
            if (RUN_PH) attn_phase(fresh_frame(F), *fresh_args(ap), rep_ == 0 ? 3 : DUP_ATT_WHICH);
#endif
            END_PH_BG(8); }
        }
REP(DUP_GF) { TP_BEGIN(8); BG_T0;
#if SITE_GF
        if (RUN_PH) { CArgs* A = fresh_args(ap); const unsigned char* wl = A->ws + WS_W + (size_t)l * W_LAYER;
            if (j != 1) { pg8::Gemm g{WSP(const bf16, WS_ACT), (const bf16*)(wl + (j == 0 ? WO_WO1 : WO_WO2)), M, D, FF}; pg8::StaticOrder S; S.init(M, D, F.G, (int)blockIdx.x);
                pg8::EpiPlain E{WSP(bf16, WS_F), D};
                pg8::gemm_phase<pg8::EpiPlain, pg8::StaticOrder, GF_ALIGN, G1_SP2>(F.lds + RING_OFF, g, S, E); }
            else { pg8::Gemm g{WSP(const bf16, WS_O), (const bf16*)(wl + WO_WOUT), M, D, D}; pg8::StaticOrder S; S.init(M, D, F.G, (int)blockIdx.x);
                pg8::EpiMixOut E{WSP(bf16, WS_F), D, WSP(const float, WS_OSSQ), 16, 1.0f / 1024.0f, RMS_EPS, nullptr, 0};
                { pg8::Unit u0, u1; const bool h0 = S.next(0, u0), h1 = S.next(1, u1);
                  PG8_LAS float* scw = (PG8_LAS float*)(F.lds + 131072); int t_ = (int)threadIdx.x; asm volatile("" : "+v"(t_));
                  if (h0) { E.prep(u0, 0, scw, t_); E.pm0 = u0.pm; } if (h1) E.prep(u1, 1, scw, t_); E.sc = scw; }
                pg8::gemm_phase<pg8::EpiMixOut, pg8::StaticOrder, GF_ALIGN, G1_SP2>(F.lds + RING_OFF, g, S, E); }
        }
#endif
        END_PH_BG(16); }
REP(DUP_LN) { TP_BEGIN(9);
#if SITE_LN
        fin_ = (s == DBG_LAST_S) && (rep_ == DUP_LN);
        if (RUN_PH) { CArgs* A = fresh_args(ap); const bool last = s == DBG_LAST_S; const bool dummy = DUP_LN && rep_ == 0;
            bf16* HO = dummy ? WSP(bf16, WS_DUMMY) : WSP(bf16, WS_H); unsigned char* LO = dummy ? WSP(unsigned char, WS_DUMMY + 64 * MiB) : WSP(unsigned char, WS_HL);
            if (s == 0) ln_phase<true>(F, WSP(const bf16, WS_H), WSP(const unsigned char, WS_HL), HO, LO, WSP(const bf16, WS_F), WSP(const float, WS_VEC), A->in[0], last ? A->out : nullptr);
            else ln_phase<false>(F, WSP(const bf16, WS_H), WSP(const unsigned char, WS_HL), HO, LO, WSP(const bf16, WS_F), WSP(const float, WS_VEC) + (size_t)s * BATCH * 5 * D, nullptr, last ? A->out : nullptr);
        }
#endif
        if (BG_ON && MK_ONE_LAUNCH && RUN_PH && j == 2 && l + 1 < DEPTH) bg_drain(bar, fresh_frame(F), *fresh_args(ap), (unsigned)(l + 1) * I_LAYER);
        END_PH;
        if (BG_ON && MK_ONE_LAUNCH && j == 2 && l + 1 < DEPTH) bg_bump(*fresh_args(ap), (unsigned)(l + 1) * I_LAYER); }
    }
#if TPROBE
    xcd_barrier(bar);
    { CArgs* A = fresh_args(ap); const unsigned long long* tp = (const unsigned long long*)(A->ws + WS_CTL + 524288); const float dall = 0.f * (float)tp[TPROBE_B], done_ = (TPROBE_A == 99 ? (float)(tp[1] + tp[3] + tp[5] + tp[7] + tp[9] + tp[11] + tp[13] + tp[15] + tp[17] + tp[19]) : (float)(tp[TPROBE_A] + tp[TPROBE_B])) * 1e-5f * TPROBE_SCALE;
      float* o = A->out; const int gt = (int)blockIdx.x * 512 + (int)threadIdx.x;
      for (int i = gt; i < M * D / 4; i += (int)gridDim.x * 512) { f32x4 v = *(f32x4*)(o + (size_t)i * 4); v = v + dall; if (i == 0) v[0] += done_; *(f32x4*)(o + (size_t)i * 4) = v; } }
#endif
#undef RUN_PH
#undef END_PH
#undef WSP
}

extern "C" void kernel_launch(void* const* d_in, const int* in_sizes, int n_in, void* d_out, int out_size, void* d_ws, size_t ws_size, hipStream_t stream) {
    static int grid = 0;
    if (grid == 0) {
        if (n_in != 19 || in_sizes[0] != M * D || out_size != M * D || ws_size < WS_END) { fprintf(stderr, "kernel_launch: unexpected shapes (n_in %d, in0 %d, out %d, ws %zu < %zu); nothing launched\n", n_in, n_in > 0 ? in_sizes[0] : -1, out_size, ws_size, (size_t)WS_END); grid = -1; return; }
        int dev = 0, cus = 0, per_cu = 0;
        if (hipGetDevice(&dev) != hipSuccess || hipDeviceGetAttribute(&cus, hipDeviceAttributeMultiprocessorCount, dev) != hipSuccess) { grid = -1; return; }
        if (hipFuncSetAttribute((const void*)mk_fwd, hipFuncAttributeMaxDynamicSharedMemorySize, LDS_BYTES) != hipSuccess) { fprintf(stderr, "kernel_launch: hipFuncSetAttribute failed\n"); grid = -1; return; }
        if (hipOccupancyMaxActiveBlocksPerMultiprocessor(&per_cu, (const void*)mk_fwd, NWAVES * 64, LDS_BYTES) != hipSuccess || per_cu < 1)
            fprintf(stderr, "kernel_launch: note: occupancy query reports %d workgroups per CU\n", per_cu);
        (void)hipGetLastError();
        grid = cus;
        if (grid * 2 < (M / 256) * (D / 256)) { fprintf(stderr, "kernel_launch: %d CUs: the mixer output projection keeps two units' row scales per workgroup and needs at least %d workgroups; nothing launched\n", cus, (M / 256) * (D / 256) / 2); grid = -1; return; }
    }
    if (grid < 0) return;
    if (hipMemsetAsync((char*)d_ws + WS_CTL, 0, CTL_ZERO_BYTES, stream) != hipSuccess) { fprintf(stderr, "kernel_launch: hipMemsetAsync failed\n"); return; }
    Args a{};
    for (int i = 0; i < 19; ++i) a.in[i] = (const float*)d_in[i];
    a.out = (float*)d_out; a.ws = (unsigned char*)d_ws;
#if MK_ONE_LAUNCH
    a.ph_lo = 0; a.ph_hi = 1 << 20;
    hipLaunchKernelGGL(mk_fwd, dim3(grid), dim3(NWAVES * 64), LDS_BYTES, stream, a);
#else
    for (int p = 0; p < N_PHASES; ++p) { a.ph_lo = p; a.ph_hi = p + 1; hipLaunchKernelGGL(mk_fwd, dim3(grid), dim3(NWAVES * 64), LDS_BYTES, stream, a); }
#endif
}
```

```cpp
#include <hip/hip_runtime.h>
#include <cstdio>
#include <cstdint>
#include <cmath>
#ifndef SWIGLU_FOLD
#define SWIGLU_FOLD 1
#endif
namespace pg8 {
#define PG8_LAS __attribute__((address_space(3)))
typedef unsigned short bf16_t;
typedef short bf16x8 __attribute__((ext_vector_type(8)));
typedef float f32x4 __attribute__((ext_vector_type(4)));
typedef unsigned u32x4 __attribute__((ext_vector_type(4)));
constexpr int BM = 256, BK = 64, HALF = 128, HTB = HALF * BK * 2  , STAGE_BYTES = 8 * HTB, NXCD = 8, WGM = 8;

__host__ __device__ __forceinline__ int lds_byte(int r, int c) { const int st = (r >> 4) * 2 + (c >> 5), rr = r & 15, cc = c & 31, ob = rr * 64 + cc * 2; return st * 1024 + (ob ^ (((ob >> 9) & 1) << 5)); }
__host__ __device__ __forceinline__ void stage_rc(int b, int& R, int& C) { const int st = b / 1024, sb = b % 1024, swz = sb ^ (((sb >> 9) & 1) << 5); R = (st >> 1) * 16 + swz / 64; C = (st & 1) * 32 + (swz % 64) / 2; }
__host__ __device__ __forceinline__ int perm32(int rho) { const int n = rho >> 4, i = rho & 15; return 8 * (i >> 2) + 4 * n + (i & 3); }

struct Unit { int pm, pn; };
struct Gemm { const bf16_t* A; const bf16_t* Bt; int M, N, K; };

struct StaticOrder {
    int nM, nN, nwg, G, c;
    __host__ __device__ void init(int M, int N, int G_, int c_) { nM = M / BM; nN = N / BM; nwg = nM * nN; G = G_; c = c_; }
    __host__ __device__ __forceinline__ bool next(int i, Unit& u) const {
        const long L = (long)i * G + c; if (L >= nwg) return false;
        int wgid = (int)L; { const int q = nwg / NXCD, r = nwg % NXCD, xcd = wgid % NXCD, off = wgid / NXCD; wgid = (xcd < r ? xcd * (q + 1) : r * (q + 1) + (xcd - r) * q) + off; }
        const int nig = WGM * nN, gid = wgid / nig, fm = gid * WGM, gsz = (nM - fm) < WGM ? (nM - fm) : WGM;
        u.pm = fm + ((wgid % nig) % gsz); u.pn = (wgid % nig) / gsz; return true;
    }
    __device__ __forceinline__ void a_ready(const Unit&) const {}
    __device__ __forceinline__ void done(const Unit&) const {}
};


#ifndef EPIRS_SKIP
#define EPIRS_SKIP 0
#endif
#ifndef EPI_NT
#define EPI_NT 0
#endif

__device__ __forceinline__ unsigned cvt_pk_bf16(float lo, float hi) { unsigned r; asm volatile("v_cvt_pk_bf16_f32 %0, %1, %2" : "=v"(r) : "v"(lo), "v"(hi)); return r; }
typedef float f32x2 __attribute__((ext_vector_type(2)));
__device__ __forceinline__ u32x4 pack8bf(const f32x4 v0, const f32x4 v1) { u32x4 w; w.x = cvt_pk_bf16(v0[0], v0[1]); w.y = cvt_pk_bf16(v0[2], v0[3]); w.z = cvt_pk_bf16(v1[0], v1[1]); w.w = cvt_pk_bf16(v1[2], v1[3]); return w; }

__device__ __forceinline__ float add_xor16(float x) { auto a = __builtin_amdgcn_permlane16_swap(__float_as_uint(x), __float_as_uint(x), false, false); return __uint_as_float(a[0]) + __uint_as_float(a[1]); }
__device__ __forceinline__ float add_xor32(float x) { auto a = __builtin_amdgcn_permlane32_swap(__float_as_uint(x), __float_as_uint(x), false, false); return __uint_as_float(a[0]) + __uint_as_float(a[1]); }
struct EpiPlain {
    static constexpr bool PERM = true, AFTER_DRAIN = false, MID = false;
    bf16_t* O; int ldc;
    __device__ __forceinline__ void operator()(const f32x4 (&acc)[2][2][4][2], const Unit& u, int wr, int wc, int fr, int fq) const {
        const int row0 = u.pm * BM + wr * 64 + fr; const int col0 = u.pn * BM + wc * 32 + 8 * fq;
#pragma unroll
        for (int ai = 0; ai < 2; ++ai)
#pragma unroll
            for (int m = 0; m < 4; ++m) { bf16_t* rowp = O + (size_t)(row0 + ai * HALF + m * 16) * ldc + col0;
#pragma unroll
                for (int bj = 0; bj < 2; ++bj) { const u32x4 w = pack8bf(acc[ai][bj][m][0], acc[ai][bj][m][1]); if (EPI_NT) __builtin_nontemporal_store(w, (u32x4*)(rowp + bj * HALF)); else *(u32x4*)(rowp + bj * HALF) = w; } }
    }
};

struct EpiMixOut {
    static constexpr bool PERM = true, AFTER_DRAIN = false, MID = true;
    bf16_t* O; int ldc; const float* OSSQ; int mid_t; float invn, eps;
    const PG8_LAS float* sc; int pm0;
    static constexpr int SC_SLOT = 512;
    __device__ __forceinline__ void prep(const Unit& u, int slot, PG8_LAS float* scw, int tid) const {
        const int r = tid >> 1, g = tid & 1;
        const float* p = OSSQ + (size_t)(u.pm * BM + r) * 16 + 8 * g;
        const f32x4 a = *(const f32x4*)p, b = *(const f32x4*)(p + 4);
        const float s = ((a[0] + a[1]) + (a[2] + a[3])) + ((b[0] + b[1]) + (b[2] + b[3]));
        const float o = __builtin_bit_cast(float, __builtin_amdgcn_update_dpp(0, __builtin_bit_cast(int, s), 0xB1, 0xF, 0xF, false));
        const float sm = g ? o : s, ss = g ? s : o;
        if (g == 0) { scw[slot * SC_SLOT + r] = sqrtf((ss * invn + eps) / (sm * invn + eps)); scw[slot * SC_SLOT + 256 + r] = 1.0f / sqrtf(ss * invn + eps); }
    }
    __device__ __forceinline__ void scales(const Unit& u, int wr, int fr, int fq, int which, float (&v)[2][4]) const {
        int fr_ = fr; asm volatile("" : "+v"(fr_));
        const PG8_LAS float* p = sc + (u.pm != pm0 ? SC_SLOT : 0) + which * 256 + wr * 64 + fr_;
#pragma unroll
        for (int ai = 0; ai < 2; ++ai)
#pragma unroll
            for (int m = 0; m < 4; ++m) v[ai][m] = p[ai * HALF + m * 16];
    }
    __device__ __forceinline__ void mid(f32x4 (&acc)[2][2][4][2], const Unit& u, int wr, int wc, int fr, int fq) const {
        float v[2][4]; scales(u, wr, fr, fq, 0, v);
#pragma unroll
        for (int ai = 0; ai < 2; ++ai)
#pragma unroll
            for (int m = 0; m < 4; ++m) { const float ratio = v[ai][m];
#pragma unroll
                for (int bj = 0; bj < 2; ++bj) { acc[ai][bj][m][0] = acc[ai][bj][m][0] * ratio; acc[ai][bj][m][1] = acc[ai][bj][m][1] * ratio; } }
    }
    __device__ __forceinline__ void operator()(const f32x4 (&acc)[2][2][4][2], const Unit& u, int wr, int wc, int fr, int fq) const {
        float v[2][4]; scales(u, wr, fr, fq, 1, v);
        const int row0 = u.pm * BM + wr * 64 + fr; const int col0 = u.pn * BM + wc * 32 + 8 * fq;
#pragma unroll
        for (int ai = 0; ai < 2; ++ai)
#pragma unroll
            for (int m = 0; m < 4; ++m) { bf16_t* rowp = O + (size_t)(row0 + ai * HALF + m * 16) * ldc + col0; const float rs = v[ai][m];
#pragma unroll
                for (int bj = 0; bj < 2; ++bj) *(u32x4*)(rowp + bj * HALF) = pack8bf(acc[ai][bj][m][0] * rs, acc[ai][bj][m][1] * rs); }
    }
};

struct EpiSwiGLU {
    static constexpr bool PERM = true, AFTER_DRAIN = false, MID = false;
    bf16_t* O; int ldc;
    __device__ __forceinline__ static f32x4 sg(const f32x4 g, const f32x4 up) {
        f32x4 r;
#pragma unroll
        for (int i = 0; i < 4; ++i) { const float e = __builtin_amdgcn_exp2f(g[i] * -1.4426950408889634f); r[i] = g[i] * __builtin_amdgcn_rcpf(1.0f + e) * up[i]; }
        return r;
    }
    __device__ __forceinline__ void operator()(const f32x4 (&acc)[2][2][4][2], const Unit& u, int wr, int wc, int fr, int fq) const {
        const int row0 = u.pm * BM + wr * 64 + fr; const int col0 = u.pn * HALF + wc * 32 + 8 * fq;
#pragma unroll
        for (int ai = 0; ai < 2; ++ai) { f32x4 t[4][2];
#pragma unroll
            for (int m = 0; m < 4; ++m)
#pragma unroll
                for (int n = 0; n < 2; ++n) t[m][n] = SWIGLU_FOLD ? -acc[ai][0][m][n] : acc[ai][0][m][n] * -1.4426950408889634f;
#pragma unroll
            for (int m = 0; m < 4; ++m)
#pragma unroll
                for (int n = 0; n < 2; ++n)
#pragma unroll
                    for (int i = 0; i < 4; ++i) t[m][n][i] = __builtin_amdgcn_exp2f(t[m][n][i]);
#pragma unroll
            for (int m = 0; m < 4; ++m)
#pragma unroll
                for (int n = 0; n < 2; ++n) t[m][n] = t[m][n] + 1.0f;
#pragma unroll
            for (int m = 0; m < 4; ++m)
#pragma unroll
                for (int n = 0; n < 2; ++n)
#pragma unroll
                    for (int i = 0; i < 4; ++i) t[m][n][i] = __builtin_amdgcn_rcpf(t[m][n][i]);
#pragma unroll
            for (int m = 0; m < 4; ++m)
#pragma unroll
                for (int n = 0; n < 2; ++n) t[m][n] = acc[ai][0][m][n] * t[m][n] * acc[ai][1][m][n];
#pragma unroll
            for (int m = 0; m < 4; ++m) { bf16_t* rowp = O + (size_t)(row0 + ai * HALF + m * 16) * ldc + col0; *(u32x4*)rowp = pack8bf(t[m][0], t[m][1]); } }
    }
};

__device__ __forceinline__ void rope8(f32x4& v0, f32x4& v1, const f32x4 cs0, const f32x4 cs1) {
    const float a0 = v0[0], b0 = v0[1], a1 = v0[2], b1 = v0[3], a2 = v1[0], b2 = v1[1], a3 = v1[2], b3 = v1[3];
    v0[0] = a0 * cs0[0] - b0 * cs0[1]; v0[1] = a0 * cs0[1] + b0 * cs0[0];
    v0[2] = a1 * cs0[2] - b1 * cs0[3]; v0[3] = a1 * cs0[3] + b1 * cs0[2];
    v1[0] = a2 * cs1[0] - b2 * cs1[1]; v1[1] = a2 * cs1[1] + b2 * cs1[0];
    v1[2] = a3 * cs1[2] - b3 * cs1[3]; v1[3] = a3 * cs1[3] + b3 * cs1[2];
}

struct EpiWin {
    static constexpr bool PERM = true, AFTER_DRAIN = false, MID = false;
    bf16_t *CQ, *CKV, *SBQ, *SBK, *SBV, *KPE; float* SSQ; const float* ROPE; float sbq_scale;
    __device__ __forceinline__ void operator()(const f32x4 (&acc)[2][2][4][2], const Unit& u, int wr, int wc, int fr, int fq) const {
        const int pn = u.pn; const int row0 = u.pm * BM + wr * 64 + fr;
        if (pn < 17) {
            bf16_t* base; int ldc, colt; float sc = 1.0f; const bool ssq = pn < 5;
            if (pn < 3) { base = CQ; ldc = 768; colt = pn * BM; }
            else if (pn < 5) { base = CKV; ldc = 512; colt = (pn - 3) * BM; }
            else if (pn < 9) { base = SBQ; ldc = 1024; colt = (pn - 5) * BM; sc = sbq_scale; }
            else if (pn < 13) { base = SBK; ldc = 1024; colt = (pn - 9) * BM; }
            else { base = SBV; ldc = 1024; colt = (pn - 13) * BM; }
            const int col0 = colt + wc * 32 + 8 * fq;
#pragma unroll
            for (int ai = 0; ai < 2; ++ai)
#pragma unroll
                for (int m = 0; m < 4; ++m) { const int row = row0 + ai * HALF + m * 16; bf16_t* rowp = base + (size_t)row * ldc + col0; float s = 0.f;
#pragma unroll
                    for (int bj = 0; bj < 2; ++bj) { const f32x4 v0 = acc[ai][bj][m][0] * sc, v1 = acc[ai][bj][m][1] * sc;
                        s += (v0[0] * v0[0] + v0[1] * v0[1]) + (v0[2] * v0[2] + v0[3] * v0[3]) + (v1[0] * v1[0] + v1[1] * v1[1]) + (v1[2] * v1[2] + v1[3] * v1[3]);
                        *(u32x4*)(rowp + bj * HALF) = pack8bf(v0, v1); }
                    if (ssq) { s = add_xor32(add_xor16(s)); if (fq == 0) SSQ[((size_t)row * 5 + pn) * 4 + wc] = s; } }
        } else if (wc < 2) {
            const int c0 = wc * 32 + 8 * fq;
#pragma unroll
            for (int ai = 0; ai < 2; ++ai)
#pragma unroll
                for (int m = 0; m < 4; ++m) { const int row = row0 + ai * HALF + m * 16;
                    const f32x4 cs0 = *(const f32x4*)(ROPE + (size_t)row * 64 + c0), cs1 = *(const f32x4*)(ROPE + (size_t)row * 64 + c0 + 4);
                    f32x4 v0 = acc[ai][0][m][0], v1 = acc[ai][0][m][1]; rope8(v0, v1, cs0, cs1);
                    *(u32x4*)(KPE + (size_t)row * 64 + c0) = pack8bf(v0, v1); }
        }
    }
};

template <bool ROPE_Q> struct EpiRS {
    static constexpr bool PERM = true, AFTER_DRAIN = false, MID = false;
    bf16_t* O; int ldc; const float* SSQ; int t0, nt; float invn, eps, oscale; const float* ROPE;
    __device__ __forceinline__ void operator()(const f32x4 (&acc)[2][2][4][2], const Unit& u, int wr, int wc, int fr, int fq) const {
        const int row0 = u.pm * BM + wr * 64 + fr; const int col0 = u.pn * BM + wc * 32 + 8 * fq;
        float rsv[2][4];
#pragma unroll
        for (int ai = 0; ai < 2; ++ai)
#pragma unroll
            for (int m = 0; m < 4; ++m) { const int row = row0 + ai * HALF + m * 16; f32x4 q = {0.f, 0.f, 0.f, 0.f};
                if (fq < nt && !(EPIRS_SKIP & 2)) q = *(const f32x4*)(SSQ + ((size_t)row * 5 + t0 + fq) * 4);
                rsv[ai][m] = (q[0] + q[1]) + (q[2] + q[3]); }
#pragma unroll
        for (int ai = 0; ai < 2; ++ai)
#pragma unroll
            for (int m = 0; m < 4; ++m) { const float ss = add_xor32(add_xor16(rsv[ai][m])); rsv[ai][m] = oscale / sqrtf(ss * invn + eps); }
#pragma unroll
        for (int ai = 0; ai < 2; ++ai)
#pragma unroll
            for (int m = 0; m < 4; ++m) { const int row = row0 + ai * HALF + m * 16;
                const float rs = rsv[ai][m];
#pragma unroll
                for (int bj = 0; bj < 2; ++bj) { const int c = col0 + bj * HALF; f32x4 v0 = acc[ai][bj][m][0] * rs, v1 = acc[ai][bj][m][1] * rs;
                    if (ROPE_Q && !(EPIRS_SKIP & 1)) { const int w = c % 192; if (w >= 128) { const float* cs = ROPE + (size_t)row * 64 + (w - 128); rope8(v0, v1, *(const f32x4*)cs, *(const f32x4*)(cs + 4)); } }
                    *(u32x4*)(O + (size_t)row * ldc + c) = pack8bf(v0, v1); } }
    }
};

struct WinOrder : StaticOrder {
    __device__ __forceinline__ bool next(int i, Unit& u) const { if (!StaticOrder::next(i, u)) return false; u.pn = u.pn < 5 ? u.pn : (u.pn == 5 ? 17 : u.pn - 1); return true; }
};
struct ListOrder {
    int first, count, stride, pn0;
    __device__ __forceinline__ bool next(int i, Unit& u) const { if (i >= count) return false; const int L = first + i * stride; u.pm = L & 63; u.pn = pn0 + (L >> 6); return true; }
    __device__ __forceinline__ void a_ready(const Unit&) const {}
    __device__ __forceinline__ void done(const Unit&) const {}
};

#ifndef PG8_EPI_DUP
#define PG8_EPI_DUP 0
#endif
template <class Epi, class Sched, bool ALIGN_EPI = false, bool SP2 = false>
__device__ __forceinline__ void gemm_phase(PG8_LAS unsigned char* lds, const Gemm g, const Sched& S, const Epi& E) {
    int tid_ = threadIdx.x; asm volatile("" : "+v"(tid_));
    const int tid = tid_, wid = __builtin_amdgcn_readfirstlane(tid >> 6), lane = tid & 63, wr = wid >> 2, wc = wid & 3, fr = lane & 15, fq = lane >> 4;
    const int K = g.K, nt = K / BK;
    unsigned voffA[2], voffB[2];
#pragma unroll
    for (int i = 0; i < 2; ++i) { int R, C; stage_rc(tid * 16 + i * 8192, R, C); const int Rb = Epi::PERM ? ((R & ~31) + perm32(R & 31)) : R;
        voffA[i] = (unsigned)(R * K + C) * 2u; voffB[i] = (unsigned)(Rb * K + C) * 2u; }
    const size_t kstep = (size_t)(BK * 2);
    const size_t hstep = (size_t)HALF * K * 2;
    const size_t tstep = 2 * hstep;
    const unsigned ldsw = (unsigned)wid * 1024u;
    const int aoff = lds_byte(wr * 64 + fr, fq * 8), boff = lds_byte(wc * 32 + fr, fq * 8);
#define PG8_SA(b, h) (((b) * 2 + (h)) * HTB)
#define PG8_SB(b, h) ((4 + (b) * 2 + (h)) * HTB)
#define PG8_STAGE(bufoff, gbase, voff) do { _Pragma("unroll") for (int _i = 0; _i < 2; ++_i) \
        __builtin_amdgcn_global_load_lds((const unsigned*)((const char*)(gbase) + (voff)[_i]), (PG8_LAS unsigned*)(lds + (bufoff) + ldsw + _i * 8192), 16, 0, 0); } while (0)
#define PG8_LDA(dst, b, h) do { _Pragma("unroll") for (int m = 0; m < 4; ++m) _Pragma("unroll") for (int k = 0; k < 2; ++k) dst[m][k] = *(const PG8_LAS bf16x8*)(lds + PG8_SA(b, h) + aoff + m * 2048 + k * 1024); } while (0)
#define PG8_LDB(dst, b, h) do { _Pragma("unroll") for (int n = 0; n < 2; ++n) _Pragma("unroll") for (int k = 0; k < 2; ++k) dst[n][k] = *(const PG8_LAS bf16x8*)(lds + PG8_SB(b, h) + boff + n * 2048 + k * 1024); } while (0)
#define PG8_MMA(ai, bj, At, Bt) do { __builtin_amdgcn_s_setprio(1); _Pragma("unroll") for (int m = 0; m < 4; ++m) _Pragma("unroll") for (int n = 0; n < 2; ++n) _Pragma("unroll") for (int k = 0; k < 2; ++k) \
        acc[ai][bj][m][n] = __builtin_amdgcn_mfma_f32_16x16x32_bf16(Bt[n][k], At[m][k], acc[ai][bj][m][n], 0, 0, 0); __builtin_amdgcn_s_setprio(0); } while (0)
#define PG8_WAIT_V(n) asm volatile("s_waitcnt vmcnt(" #n ")" ::: "memory")
#define PG8_WAIT_L(n) asm volatile("s_waitcnt lgkmcnt(" #n ")" ::: "memory")
#define PG8_BAR __builtin_amdgcn_s_barrier()
#define PG8_SCHED __builtin_amdgcn_sched_barrier(0)
    Unit cur, nxt; int ui = 0;
    if (!S.next(0, cur)) return;
    f32x4 acc[2][2][4][2];
#pragma unroll
    for (int a = 0; a < 2; ++a)
#pragma unroll
        for (int b = 0; b < 2; ++b)
#pragma unroll
            for (int m = 0; m < 4; ++m)
#pragma unroll
                for (int n = 0; n < 2; ++n) acc[a][b][m][n] = (f32x4){0.f, 0.f, 0.f, 0.f};
    bf16x8 At[4][2], B0[2][2], B1[2][2];
    const char* cA = (const char*)g.A + (size_t)cur.pm * tstep; const char* cB = (const char*)g.Bt + (size_t)cur.pn * tstep;
    S.a_ready(cur);
    if constexpr (SP2) {
        PG8_STAGE(PG8_SB(0, 0), cB, voffB); PG8_STAGE(PG8_SB(0, 1), cB + hstep, voffB); PG8_STAGE(PG8_SA(0, 0), cA, voffA); PG8_STAGE(PG8_SA(0, 1), cA + hstep, voffA);
        if (wr == 1) PG8_BAR;
        PG8_WAIT_V(2); PG8_BAR;
        PG8_STAGE(PG8_SB(1, 0), cB + kstep, voffB); PG8_STAGE(PG8_SA(1, 0), cA + kstep, voffA); PG8_STAGE(PG8_SB(1, 1), cB + hstep + kstep, voffB);
        PG8_WAIT_V(6); PG8_BAR;
    } else {
        PG8_STAGE(PG8_SB(0, 0), cB, voffB); PG8_STAGE(PG8_SA(0, 0), cA, voffA); PG8_STAGE(PG8_SB(0, 1), cB + hstep, voffB); PG8_STAGE(PG8_SA(0, 1), cA + hstep, voffA);
        if (wr == 1) PG8_BAR;
        PG8_WAIT_V(4); PG8_BAR;
        PG8_STAGE(PG8_SB(1, 0), cB + kstep, voffB); PG8_STAGE(PG8_SA(1, 0), cA + kstep, voffA); PG8_STAGE(PG8_SB(1, 1), cB + hstep + kstep, voffB);
        PG8_WAIT_V(6); PG8_BAR;
    }
    for (;;) {
        const bool has_next = S.next(ui + 1, nxt);
        const char* nA = has_next ? (const char*)g.A + (size_t)nxt.pm * tstep : cA; const char* nB = has_next ? (const char*)g.Bt + (size_t)nxt.pn * tstep : cB;
        for (int t = 0; t < nt; t += 2) {
            if constexpr (Epi::MID) { if (t == E.mid_t) E.mid(acc, cur, wr, wc, fr, fq); }
            const bool last = (t == nt - 2);
            const char* a1 = cA + (size_t)(t + 1) * kstep;
            const char* a2 = last ? nA : cA + (size_t)(t + 2) * kstep; const char* b2 = last ? nB : cB + (size_t)(t + 2) * kstep;
            const char* a3 = a2 + kstep; const char* b3 = b2 + kstep;
            if (last && has_next) S.a_ready(nxt);
            if constexpr (SP2) {
            PG8_LDB(B0, 0, 0); PG8_LDB(B1, 0, 1); PG8_SCHED; PG8_LDA(At, 0, 0); PG8_STAGE(PG8_SA(1, 1), a1 + hstep, voffA);
            PG8_WAIT_V(8); PG8_WAIT_L(0); PG8_BAR; PG8_MMA(0, 0, At, B0); PG8_MMA(0, 1, At, B1); PG8_BAR; PG8_SCHED;
            PG8_LDA(At, 0, 1); PG8_STAGE(PG8_SB(0, 0), b2, voffB); PG8_STAGE(PG8_SB(0, 1), b2 + hstep, voffB); PG8_STAGE(PG8_SA(0, 0), a2, voffA);
            PG8_WAIT_V(8); PG8_WAIT_L(0); PG8_BAR; PG8_MMA(1, 0, At, B0); PG8_MMA(1, 1, At, B1); PG8_BAR; PG8_SCHED;
            PG8_LDB(B0, 1, 0); PG8_LDB(B1, 1, 1); PG8_SCHED; PG8_LDA(At, 1, 0); PG8_STAGE(PG8_SA(0, 1), a2 + hstep, voffA);
            PG8_WAIT_V(8); PG8_WAIT_L(0); PG8_BAR; PG8_MMA(0, 0, At, B0); PG8_MMA(0, 1, At, B1); PG8_BAR; PG8_SCHED;
            PG8_LDA(At, 1, 1); PG8_STAGE(PG8_SB(1, 0), b3, voffB); PG8_STAGE(PG8_SB(1, 1), b3 + hstep, voffB); PG8_STAGE(PG8_SA(1, 0), a3, voffA);
            PG8_WAIT_V(8); PG8_WAIT_L(0); PG8_BAR; PG8_MMA(1, 0, At, B0); PG8_MMA(1, 1, At, B1); PG8_BAR; PG8_SCHED;
            } else {
            PG8_LDB(B0, 0, 0); PG8_SCHED; PG8_LDA(At, 0, 0); PG8_STAGE(PG8_SA(1, 1), a1 + hstep, voffA);
            PG8_WAIT_L(8); PG8_BAR; PG8_WAIT_L(0); PG8_MMA(0, 0, At, B0); PG8_BAR; PG8_SCHED;
            PG8_LDB(B1, 0, 1); PG8_STAGE(PG8_SB(0, 0), b2, voffB);
            PG8_BAR; PG8_WAIT_L(0); PG8_MMA(0, 1, At, B1); PG8_BAR;
            PG8_LDA(At, 0, 1); PG8_STAGE(PG8_SA(0, 0), a2, voffA);
            PG8_BAR; PG8_WAIT_L(0); PG8_MMA(1, 0, At, B0); PG8_BAR; PG8_SCHED;
            PG8_STAGE(PG8_SB(0, 1), b2 + hstep, voffB);
            PG8_WAIT_V(6); PG8_BAR; PG8_MMA(1, 1, At, B1); PG8_BAR;
            PG8_LDB(B0, 1, 0); PG8_SCHED; PG8_LDA(At, 1, 0); PG8_STAGE(PG8_SA(0, 1), a2 + hstep, voffA);
            PG8_WAIT_L(8); PG8_BAR; PG8_WAIT_L(0); PG8_MMA(0, 0, At, B0); PG8_BAR; PG8_SCHED;
            PG8_LDB(B1, 1, 1); PG8_STAGE(PG8_SB(1, 0), b3, voffB);
            PG8_BAR; PG8_WAIT_L(0); PG8_MMA(0, 1, At, B1); PG8_BAR;
            PG8_LDA(At, 1, 1); PG8_STAGE(PG8_SA(1, 0), a3, voffA);
            PG8_BAR; PG8_WAIT_L(0); PG8_MMA(1, 0, At, B0); PG8_BAR; PG8_SCHED;
            PG8_STAGE(PG8_SB(1, 1), b3 + hstep, voffB);
            PG8_WAIT_V(6); PG8_BAR; PG8_MMA(1, 1, At, B1); PG8_BAR;
            }
        }
        if constexpr (ALIGN_EPI) { if (wr == 0) PG8_BAR; }
        if constexpr (!Epi::AFTER_DRAIN) { E(acc, cur, wr, wc, fr, fq); if (PG8_EPI_DUP) { asm volatile("" ::: "memory"); E(acc, cur, wr, wc, fr, fq); } S.done(cur); }
        if (!has_next) break;
#pragma unroll
        for (int a = 0; a < 2; ++a)
#pragma unroll
            for (int b = 0; b < 2; ++b)
#pragma unroll
                for (int m = 0; m < 4; ++m)
#pragma unroll
                    for (int n = 0; n < 2; ++n) acc[a][b][m][n] = (f32x4){0.f, 0.f, 0.f, 0.f};
        cur = nxt; cA = nA; cB = nB; ++ui;
        if constexpr (ALIGN_EPI) { if (wr == 1) PG8_BAR; }
    }
    PG8_WAIT_V(0);
    if constexpr (!ALIGN_EPI) { if (wr == 0) PG8_BAR; }
    PG8_BAR;
    if constexpr (Epi::AFTER_DRAIN) { E.fused(acc, cur, wr, wc, fr, fq, lds, wid, lane); S.done(cur); }
#undef PG8_SA
#undef PG8_SB
#undef PG8_STAGE
#undef PG8_LDA
#undef PG8_LDB
#undef PG8_MMA
#undef PG8_WAIT_V
#undef PG8_WAIT_L
#undef PG8_BAR
#undef PG8_SCHED
}
}


namespace att {
typedef unsigned short bf16_t;
typedef short bf16x8 __attribute__((ext_vector_type(8)));
typedef short s16x4 __attribute__((ext_vector_type(4)));
typedef float f32x16 __attribute__((ext_vector_type(16)));
typedef float f32x4 __attribute__((ext_vector_type(4)));
typedef unsigned u32x4 __attribute__((ext_vector_type(4)));
#define ATT_LAS __attribute__((address_space(3)))
#ifndef ATT_THR
#define ATT_THR 8.0f
#endif
#ifndef ATT_SKIP
#define ATT_SKIP 0
#endif
#ifndef ATT_NOCOMPUTE
#define ATT_NOCOMPUTE 0
#endif
#ifndef ATT_PRIO
#define ATT_PRIO 1
#endif
#ifndef SB_EARLY_EXIT
#define SB_EARLY_EXIT 1
#endif
constexpr int KVBLK = 64, QB = 256;
constexpr int SHM_V = 16384, SHM_K = 16384, SHM_R = 8192;
#ifndef ATT_SKEW
#define ATT_SKEW 0
#endif
constexpr int NVS = (ATT_SKEW != 0) ? 4 : 3, NKS = 3;
constexpr int OFF_V = 0, OFF_K = NVS * SHM_V, OFF_R = OFF_K + NKS * SHM_K, OFF_WS = OFF_R + NKS * SHM_R, OFF_FLAG = OFF_WS + 8 * 256, ATT_LDS_BYTES = OFF_FLAG + 64;
#define KSWZ(row, colB) ((row) * 256 + ((colB) ^ (((row) & 7) << 4)))
#define RSWZ(row, colB) ((row) * 128 + ((colB) ^ (((row) & 7) << 4)))
#define SBAR() __builtin_amdgcn_sched_barrier(0)
__device__ __forceinline__ int v_st(int k, int c) { const int kk = (k & ~0xC) | ((k & 4) << 1) | ((k & 8) >> 1); return ((kk >> 3) * 4 + (c >> 5)) * 512 + ((kk & 7) * 32 + (c & 31)) * 2; }
__device__ __forceinline__ int v_rd_base(int lane) { return ((lane & 3) << 3) | (((lane >> 2) & 3) << 6) | (((lane >> 4) & 1) << 5) | (((lane >> 5) & 1) << 8); }
__device__ __forceinline__ int crow(int r, int hi) { return (r & 3) + 8 * (r >> 2) + 4 * hi; }
__device__ __forceinline__ unsigned cvtpk(float lo, float hi) { unsigned r; asm volatile("v_cvt_pk_bf16_f32 %0, %1, %2" : "=v"(r) : "v"(lo), "v"(hi)); return r; }
__device__ __forceinline__ float other_half(float x, int hi) { auto rr = __builtin_amdgcn_permlane32_swap(__float_as_uint(x), __float_as_uint(x), false, false); return __uint_as_float(hi ? rr[0] : rr[1]); }

__device__ __forceinline__ void pack_p(const f32x16& p0, const f32x16& p1, bf16x8& pa0, bf16x8& pa1, bf16x8& pa2, bf16x8& pa3) {
#define PK4(P, B_, OUT) do { unsigned a0 = cvtpk(P[B_+0], P[B_+1]), a1 = cvtpk(P[B_+2], P[B_+3]);                          \
        unsigned b0 = cvtpk(P[B_+4], P[B_+5]), b1 = cvtpk(P[B_+6], P[B_+7]);                                             \
        auto r0 = __builtin_amdgcn_permlane32_swap(a0, b0, false, false); auto r1 = __builtin_amdgcn_permlane32_swap(a1, b1, false, false); \
        u32x4 w = {r0[0], r1[0], r0[1], r1[1]}; OUT = __builtin_bit_cast(bf16x8, w); } while (0)
    PK4(p0, 0, pa0); PK4(p0, 8, pa1); PK4(p1, 0, pa2); PK4(p1, 8, pa3);
#undef PK4
}
__device__ __forceinline__ void pv_tile(f32x16* o, int vb, bf16x8 pa0, bf16x8 pa1, bf16x8 pa2, bf16x8 pa3) {
#define TRRD(dst, off) asm volatile("ds_read_b64_tr_b16 %0, %1 offset:%2" : "=&v"(dst) : "v"(vb), "i"(off) : "memory")
#define PV_D0(d0) do { s16x4 l0, l1, l2, l3, h0, h1, h2, h3; constexpr int b_ = (d0) * 512;   \
        TRRD(l0, b_); TRRD(h0, b_ + 2048); TRRD(l1, b_ + 4096); TRRD(h1, b_ + 6144); TRRD(l2, b_ + 8192); TRRD(h2, b_ + 10240); TRRD(l3, b_ + 12288); TRRD(h3, b_ + 14336); \
        asm volatile("s_waitcnt lgkmcnt(0)" ::: "memory"); SBAR();   \
        o[d0] = __builtin_amdgcn_mfma_f32_32x32x16_bf16((bf16x8){l0[0], l0[1], l0[2], l0[3], h0[0], h0[1], h0[2], h0[3]}, pa0, o[d0], 0, 0, 0);   \
        o[d0] = __builtin_amdgcn_mfma_f32_32x32x16_bf16((bf16x8){l1[0], l1[1], l1[2], l1[3], h1[0], h1[1], h1[2], h1[3]}, pa1, o[d0], 0, 0, 0);   \
        o[d0] = __builtin_amdgcn_mfma_f32_32x32x16_bf16((bf16x8){l2[0], l2[1], l2[2], l2[3], h2[0], h2[1], h2[2], h2[3]}, pa2, o[d0], 0, 0, 0);   \
        o[d0] = __builtin_amdgcn_mfma_f32_32x32x16_bf16((bf16x8){l3[0], l3[1], l3[2], l3[3], h3[0], h3[1], h3[2], h3[3]}, pa3, o[d0], 0, 0, 0); } while (0)
    PV_D0(0); PV_D0(1); PV_D0(2); PV_D0(3);
#undef PV_D0
#undef TRRD
}

template <bool SB>
__device__ __forceinline__ void attn_block(ATT_LAS unsigned char* lds, const bf16_t* Qg, int ldq, const bf16_t* Kg, int ldk, const bf16_t* Vg, int ldv, const bf16_t* Rg, bf16_t* Og, int ldo, float* Sq  , int P0) {
    constexpr int NQ = SB ? 8 : 12;
    constexpr int NDMA = SB ? 4 : 5;
    int tid_ = threadIdx.x; asm volatile("" : "+v"(tid_));
    const int tid = tid_, wid = __builtin_amdgcn_readfirstlane(tid >> 6), lane = tid & 63, r32 = lane & 31, hi = lane >> 5;
    const int qlo = P0 + wid * 32;
    const int NT = (P0 + QB) / KVBLK;
    ATT_LAS unsigned char* V_lds = lds + OFF_V; ATT_LAS unsigned char* K_lds = lds + OFF_K; ATT_LAS unsigned char* R_lds = lds + OFF_R;
    ATT_LAS float* ws = (ATT_LAS float*)(lds + OFF_WS) + wid * 64;
    ATT_LAS unsigned* flags = (ATT_LAS unsigned*)(lds + OFF_FLAG);
    const int vb0 = (int)(unsigned)(uintptr_t)V_lds + v_rd_base(lane);
    int kofs, vofs, rofs;
    { const int row = 4 * wid + (lane >> 4); kofs = row * ldk + ((((lane & 15) * 16) ^ ((row & 7) << 4)) >> 1); }
    { const int sub = 2 * wid + (lane >> 5), kk = (sub >> 2) * 8 + ((lane & 31) >> 2), k = (kk & ~0xC) | ((kk & 4) << 1) | ((kk & 8) >> 1); vofs = k * ldv + (sub & 3) * 32 + (lane & 3) * 8; }
    { const int row = 8 * wid + (lane >> 3); rofs = row * 64 + ((((lane & 7) ^ (row & 7)) * 16) >> 1); }
#define STAGE_DMA(t_, ks_, vs_) do { const size_t k0_ = (size_t)(t_) * KVBLK;                                                                                   \
        __builtin_amdgcn_global_load_lds((const unsigned*)(Kg + k0_ * ldk + kofs), (ATT_LAS unsigned*)(K_lds + (ks_) * SHM_K + wid * 1024), 16, 0, 0);                 \
        __builtin_amdgcn_global_load_lds((const unsigned*)(Kg + (k0_ + 32) * ldk + kofs), (ATT_LAS unsigned*)(K_lds + (ks_) * SHM_K + 8192 + wid * 1024), 16, 0, 0);   \
        __builtin_amdgcn_global_load_lds((const unsigned*)(Vg + k0_ * ldv + vofs), (ATT_LAS unsigned*)(V_lds + (vs_) * SHM_V + wid * 1024), 16, 0, 0);                 \
        __builtin_amdgcn_global_load_lds((const unsigned*)(Vg + (k0_ + 32) * ldv + vofs), (ATT_LAS unsigned*)(V_lds + (vs_) * SHM_V + 8192 + wid * 1024), 16, 0, 0);   \
        if (!SB) __builtin_amdgcn_global_load_lds((const unsigned*)(Rg + k0_ * 64 + rofs), (ATT_LAS unsigned*)(R_lds + (ks_) * SHM_R + wid * 1024), 16, 0, 0); } while (0)
#define TILE_OF(it_) (SB ? NT - 1 - (it_) : (it_))
#define WAIT_BAR(n_) do { if ((n_) == 0) asm volatile("s_waitcnt vmcnt(0) lgkmcnt(0)\n\ts_barrier" ::: "memory"); else if (SB) asm volatile("s_waitcnt vmcnt(4) lgkmcnt(0)\n\ts_barrier" ::: "memory"); else asm volatile("s_waitcnt vmcnt(5) lgkmcnt(0)\n\ts_barrier" ::: "memory"); } while (0)
    bf16x8 qr[NQ];
#pragma unroll
    for (int d0 = 0; d0 < NQ; ++d0) qr[d0] = *(const bf16x8*)(Qg + (size_t)(wid * 32 + r32) * ldq + d0 * 16 + hi * 8);
    f32x16 o[4];
#pragma unroll
    for (int d = 0; d < 4; ++d)
#pragma unroll
        for (int r = 0; r < 16; ++r) o[d][r] = 0.f;
    float m_reg = 0.f, l_reg = 0.f, R = 1.f; bool first_tile = true;
    int kro[4];
#pragma unroll
    for (int dd = 0; dd < 4; ++dd) kro[dd] = KSWZ(r32, (dd * 16 + hi * 8) * 2);
    STAGE_DMA(TILE_OF(0), 0, 0);
    if (NT > 1) { STAGE_DMA(TILE_OF(1), 1, 1); WAIT_BAR(NDMA); } else WAIT_BAR(0);
    const bool skew = ATT_SKEW && (ATT_SKEW == 1 ? wid >= 4 : (ATT_SKEW == 2 ? (wid & 1) : ((wid >> 1) & 1)));
    f32x16 p0, p1;
    bool pend = false; int pend_kb = 0, pend_vs = 0;
    int vs = 0, ks = 0, nt_eff = NT;
    for (int it = 0; it < nt_eff + ((ATT_SKEW != 0) ? 1 : 0); ++it) {
        const bool tile = it < nt_eff;
        const int t = TILE_OF(it); const int buf = it & 1; const bool more2 = tile && it + 2 < NT;
        { const int ks2 = ks == 0 ? 2 : ks - 1, vs2 = vs + 2 >= NVS ? vs + 2 - NVS : vs + 2;
          if (more2) STAGE_DMA(TILE_OF(it + 2), ks2, vs2); }
        const int kb = t * KVBLK;
        const bool act = tile && kb <= qlo + 31 && !ATT_NOCOMPUTE;
        bool do_sm; int sm_kb, sm_vs;
        if (!skew) { do_sm = act; sm_kb = kb; sm_vs = vs;
            if (act) {
#pragma unroll
            for (int r = 0; r < 16; ++r) { p0[r] = SB ? 0.f : -m_reg; p1[r] = SB ? 0.f : -m_reg; }
            ATT_LAS const unsigned char* kt = K_lds + ks * SHM_K;
            __builtin_amdgcn_s_setprio(ATT_PRIO);
            if (ATT_SKIP & 1) { p0[0] = (float)r32; p1[3] = (float)hi; } else {
#pragma unroll
            for (int d0 = 0; d0 < 8; ++d0) { ATT_LAS const unsigned char* a = kt + kro[d0 & 3] + (d0 >> 2) * 128;
                const bf16x8 b0 = *(ATT_LAS const bf16x8*)a; const bf16x8 b1 = *(ATT_LAS const bf16x8*)(a + 32 * 256);
                p0 = __builtin_amdgcn_mfma_f32_32x32x16_bf16(b0, qr[d0], p0, 0, 0, 0);
                p1 = __builtin_amdgcn_mfma_f32_32x32x16_bf16(b1, qr[d0], p1, 0, 0, 0); }
            if (!SB) { ATT_LAS const unsigned char* rt = R_lds + ks * SHM_R;
#pragma unroll
                for (int d0 = 0; d0 < 4; ++d0) { ATT_LAS const unsigned char* a = rt + (kro[d0] - 128 * r32);
                    const bf16x8 b0 = *(ATT_LAS const bf16x8*)a; const bf16x8 b1 = *(ATT_LAS const bf16x8*)(a + 32 * 128);
                    const bf16x8 qf = qr[SB ? 0 : 8 + d0];
                    p0 = __builtin_amdgcn_mfma_f32_32x32x16_bf16(b0, qf, p0, 0, 0, 0);
                    p1 = __builtin_amdgcn_mfma_f32_32x32x16_bf16(b1, qf, p1, 0, 0, 0); } }
            }
            __builtin_amdgcn_s_setprio(0);
            }
        } else { do_sm = pend; sm_kb = pend_kb; sm_vs = pend_vs; }
        if (do_sm) {
            const int dql = qlo + r32 - sm_kb - 4 * hi - (SB ? 1 : 0);
            const bool need_mask = SB ? (sm_kb + KVBLK - 1 >= qlo) : (sm_kb + KVBLK - 1 > qlo);
            bf16x8 pa0, pa1, pa2, pa3;
            if (ATT_SKIP & 2) { pa0 = __builtin_bit_cast(bf16x8, (f32x4){p0[0], p0[5], p0[10], p0[15]}); pa1 = __builtin_bit_cast(bf16x8, (f32x4){p1[0], p1[5], p1[10], p1[15]}); pa2 = pa0; pa3 = pa1; }
            else if (!SB) {
                if (need_mask) { const float NEG = -__builtin_inff();
#pragma unroll
                    for (int r = 0; r < 16; ++r) { const int c = (r & 3) + 8 * (r >> 2); if (c > dql) p0[r] = NEG; if (c + 32 > dql) p1[r] = NEG; } }
                float pmax = p0[0];
#pragma unroll
                for (int r = 1; r < 16; ++r) pmax = fmaxf(pmax, p0[r]);
#pragma unroll
                for (int r = 0; r < 16; ++r) pmax = fmaxf(pmax, p1[r]);
                pmax = fmaxf(pmax, other_half(pmax, hi));
                if (first_tile || __any(pmax > ATT_THR)) { const float dl = first_tile ? pmax : fmaxf(pmax, 0.f);
                    m_reg += dl;
#pragma unroll
                    for (int r = 0; r < 16; ++r) { p0[r] -= dl; p1[r] -= dl; }
                    if (!first_tile) { const float alpha = __builtin_amdgcn_exp2f(-dl); l_reg *= alpha;
#pragma unroll
                        for (int d = 0; d < 4; ++d)
#pragma unroll
                            for (int r = 0; r < 16; ++r) o[d][r] *= alpha; }
                    first_tile = false; }
                float ps = 0.f;
#pragma unroll
                for (int r = 0; r < 16; ++r) { p0[r] = __builtin_amdgcn_exp2f(p0[r]); ps += p0[r]; }
#pragma unroll
                for (int r = 0; r < 16; ++r) { p1[r] = __builtin_amdgcn_exp2f(p1[r]); ps += p1[r]; }
                ps += other_half(ps, hi);
                l_reg += ps;
                pack_p(p0, p1, pa0, pa1, pa2, pa3);
            } else {
                f32x16 l0, l1;
#pragma unroll
                for (int r = 0; r < 16; ++r) { const float e = __builtin_amdgcn_exp2f(fminf(-p0[r], 126.f)); const float be = __builtin_amdgcn_rcpf(1.0f + e); p0[r] = be; l0[r] = e * be; }
#pragma unroll
                for (int r = 0; r < 16; ++r) { const float e = __builtin_amdgcn_exp2f(fminf(-p1[r], 126.f)); const float be = __builtin_amdgcn_rcpf(1.0f + e); p1[r] = be; l1[r] = e * be; }
                if (need_mask) {
#pragma unroll
                    for (int r = 0; r < 16; ++r) { const int c = (r & 3) + 8 * (r >> 2); if (c > dql) { p0[r] = 0.f; l0[r] = 1.f; } if (c + 32 > dql) { p1[r] = 0.f; l1[r] = 1.f; } } }
                float T[8];
#pragma unroll
                for (int g = 0; g < 4; ++g) {
                    { const float a0 = l0[4 * g], a1 = l0[4 * g + 1], a2 = l0[4 * g + 2], a3 = l0[4 * g + 3]; const float x2 = a3, x1 = a3 * a2, x0 = x1 * a1; T[g] = x0 * a0;
                      l0[4 * g] = x0; l0[4 * g + 1] = x1; l0[4 * g + 2] = x2; l0[4 * g + 3] = 1.f; }
                    { const float a0 = l1[4 * g], a1 = l1[4 * g + 1], a2 = l1[4 * g + 2], a3 = l1[4 * g + 3]; const float x2 = a3, x1 = a3 * a2, x0 = x1 * a1; T[4 + g] = x0 * a0;
                      l1[4 * g] = x0; l1[4 * g + 1] = x1; l1[4 * g + 2] = x2; l1[4 * g + 3] = 1.f; }
                }
                float gs[8]; float run = R;
#pragma unroll
                for (int g = 7; g >= 0; --g) { const float To = other_half(T[g], hi); gs[g] = hi == 0 ? run * To : run; run *= T[g] * To; }
                R = run;
#pragma unroll
                for (int g = 0; g < 4; ++g)
#pragma unroll
                    for (int i = 0; i < 4; ++i) { p0[4 * g + i] = p0[4 * g + i] * (l0[4 * g + i] * gs[g]); p1[4 * g + i] = p1[4 * g + i] * (l1[4 * g + i] * gs[4 + g]); }
                pack_p(p0, p1, pa0, pa1, pa2, pa3);
            }
            if (!(ATT_SKIP & 4)) { __builtin_amdgcn_s_setprio(ATT_PRIO); pv_tile(o, vb0 + sm_vs * SHM_V, pa0, pa1, pa2, pa3); __builtin_amdgcn_s_setprio(0); } else { o[0][0] += __builtin_bit_cast(f32x4, pa0)[0] + __builtin_bit_cast(f32x4, pa1)[0] + __builtin_bit_cast(f32x4, pa2)[0] + __builtin_bit_cast(f32x4, pa3)[0]; }
        }
        if (skew) { pend = act; pend_kb = kb; pend_vs = vs;
            if (act) {
#pragma unroll
            for (int r = 0; r < 16; ++r) { p0[r] = SB ? 0.f : -m_reg; p1[r] = SB ? 0.f : -m_reg; }
            ATT_LAS const unsigned char* kt = K_lds + ks * SHM_K;
            __builtin_amdgcn_s_setprio(ATT_PRIO);
            if (ATT_SKIP & 1) { p0[0] = (float)r32; p1[3] = (float)hi; } else {
#pragma unroll
            for (int d0 = 0; d0 < 8; ++d0) { ATT_LAS const unsigned char* a = kt + kro[d0 & 3] + (d0 >> 2) * 128;
                const bf16x8 b0 = *(ATT_LAS const bf16x8*)a; const bf16x8 b1 = *(ATT_LAS const bf16x8*)(a + 32 * 256);
                p0 = __builtin_amdgcn_mfma_f32_32x32x16_bf16(b0, qr[d0], p0, 0, 0, 0);
                p1 = __builtin_amdgcn_mfma_f32_32x32x16_bf16(b1, qr[d0], p1, 0, 0, 0); }
            if (!SB) { ATT_LAS const unsigned char* rt = R_lds + ks * SHM_R;
#pragma unroll
                for (int d0 = 0; d0 < 4; ++d0) { ATT_LAS const unsigned char* a = rt + (kro[d0] - 128 * r32);
                    const bf16x8 b0 = *(ATT_LAS const bf16x8*)a; const bf16x8 b1 = *(ATT_LAS const bf16x8*)(a + 32 * 128);
                    const bf16x8 qf = qr[SB ? 0 : 8 + d0];
                    p0 = __builtin_amdgcn_mfma_f32_32x32x16_bf16(b0, qf, p0, 0, 0, 0);
                    p1 = __builtin_amdgcn_mfma_f32_32x32x16_bf16(b1, qf, p1, 0, 0, 0); } }
            }
            __builtin_amdgcn_s_setprio(0);
            }
        }
        if (SB && SB_EARLY_EXIT && tile) { const bool dead = __all(R == 0.f); if (lane == 0) flags[buf * 8 + wid] = dead ? 1u : 0u; }
        asm volatile("" ::: "memory");
        if (more2) WAIT_BAR(NDMA); else WAIT_BAR(0);
        asm volatile("" ::: "memory");
        if (SB && SB_EARLY_EXIT && tile) { const u32x4 f0 = *(ATT_LAS const u32x4*)(flags + buf * 8), f1 = *(ATT_LAS const u32x4*)(flags + buf * 8 + 4);
            if ((f0[0] & f0[1] & f0[2] & f0[3] & f1[0] & f1[1] & f1[2] & f1[3]) != 0u) nt_eff = it + 1; }
        vs = vs + 1 == NVS ? 0 : vs + 1; ks = ks == 2 ? 0 : ks + 1;
    }
    { const float rl = SB ? 1.0f : ((ATT_NOCOMPUTE && !(l_reg > 0.f)) ? 0.f : 1.0f / l_reg);
      unsigned char* rowb = (unsigned char*)(Og + (size_t)(wid * 32 + r32) * ldo) + (hi ? 16 : 0);
      { float sq = 0.f;
#pragma unroll
        for (int d = 0; d < 4; ++d)
#pragma unroll
            for (int r = 0; r < 16; ++r) { const float v = o[d][r] * rl; sq += v * v; }
        sq += other_half(sq, hi);
        if (hi == 0) Sq[(size_t)(wid * 32 + r32) * 16] = sq; }
#pragma unroll
      for (int k = 0; k < 16; k += 2) { const int d0 = k >> 2, ra = (k & 3) * 4, rb = ra + 4;
          unsigned ax = cvtpk(o[d0][ra] * rl, o[d0][ra + 1] * rl), ay = cvtpk(o[d0][ra + 2] * rl, o[d0][ra + 3] * rl);
          unsigned bx = cvtpk(o[d0][rb] * rl, o[d0][rb + 1] * rl), by = cvtpk(o[d0][rb + 2] * rl, o[d0][rb + 3] * rl);
          auto sx = __builtin_amdgcn_permlane32_swap(ax, bx, false, false); auto sy = __builtin_amdgcn_permlane32_swap(ay, by, false, false);
          *(u32x4*)(rowb + 16 * k) = (u32x4){sx[0], sy[0], sx[1], sy[1]}; } }
    asm volatile("" ::: "memory");
    asm volatile("s_waitcnt vmcnt(0) lgkmcnt(0)\n\ts_barrier" ::: "memory");
    asm volatile("" ::: "memory");
#undef STAGE_DMA
#undef TILE_OF
#undef WAIT_BAR
}
#undef KSWZ
#undef RSWZ
}

#ifdef DUP_LN
#define DUP_LN_ANY DUP_LN
#else
#define DUP_LN_ANY 0
#endif

constexpr int NWAVES = 8;
constexpr int D = 2048, BATCH = 4, SEQ = 4096, DEPTH = 4, M = BATCH * SEQ, FF = 5632, NADA = 9;
constexpr int QLR = 768, KVLR = 512, ROPE_D = 64, NH = 8, HD = 128, QKD = 192;
constexpr int IN_COLS = QLR + KVLR + ROPE_D + 3 * NH * HD;
constexpr int WIN_ROWS = 4608;
constexpr float LN_EPS = 1e-5f, RMS_EPS = 1e-6f;
constexpr float DN_ALPHA = 1.6817928305074290f;
constexpr float LOG2E = 1.4426950408889634f;
constexpr float MLA_QSCALE = 0.07216878364870322f * LOG2E;
constexpr float SB_QSCALE = 0.08838834764831845f * LOG2E;
#ifndef MK_ONE_LAUNCH
#define MK_ONE_LAUNCH 1
#endif
constexpr int N_PHASES = 3 + 8 * 3 + 4 * 5;

constexpr size_t MiB = 1u << 20;
#ifndef TPROBE
#define TPROBE 0
#endif
constexpr size_t WS_CTL = 0, CTL_ZERO_BYTES = TPROBE ? 1 * MiB : 64 * 1024;
constexpr size_t WS_ADA = 1 * MiB;
constexpr size_t WS_ADAP = 3 * MiB;
constexpr size_t WS_VEC = 22 * MiB;
constexpr size_t WS_ROPE = 24 * MiB;
constexpr size_t WS_SSQ = 28 * MiB;
constexpr size_t WS_KPE = 30 * MiB;
constexpr size_t WS_HL = 32 * MiB;
constexpr size_t WS_OSSQ = 64 * MiB;
constexpr size_t WS_H = 160 * MiB;
constexpr size_t WS_F = 224 * MiB;
constexpr size_t WS_ACT = 288 * MiB;
constexpr size_t WS_CQ = 464 * MiB;
constexpr size_t WS_CKV = 488 * MiB;
constexpr size_t WS_SBQ = 504 * MiB, WS_SBK = 536 * MiB, WS_SBV = 568 * MiB;
constexpr size_t WS_QM = 600 * MiB;
constexpr size_t WS_KV = 648 * MiB;
constexpr size_t WS_O = 712 * MiB;
constexpr size_t WS_W = 776 * MiB;
constexpr size_t W_WI = (size_t)2 * FF * D * 2, W_WO = (size_t)D * FF * 2, W_WIN = (size_t)WIN_ROWS * D * 2, W_WUQ = (size_t)NH * QKD * QLR * 2, W_WUKV = (size_t)NH * 256 * KVLR * 2, W_WOUT = (size_t)D * D * 2;
constexpr size_t WO_WI1 = 0, WO_WO1 = WO_WI1 + W_WI, WO_WI2 = WO_WO1 + W_WO, WO_WO2 = WO_WI2 + W_WI, WO_WIN = WO_WO2 + W_WO, WO_WUQ = WO_WIN + W_WIN, WO_WUKV = WO_WUQ + W_WUQ, WO_WOUT = WO_WUKV + W_WUKV;
constexpr size_t W_LAYER = WO_WOUT + W_WOUT;
constexpr size_t WS_DUMMY = WS_W + DEPTH * W_LAYER;
constexpr size_t WS_END = WS_DUMMY + (size_t)(DUP_LN_ANY ? 128 : 0) * MiB;
static_assert(W_LAYER % 256 == 0 && WS_END < (size_t)1700 * MiB, "ws map");
constexpr int ADA_KS = 16;
constexpr int CW_BAR = 4096;

constexpr int RING_OFF = 0, SCR_BYTES = 147200;
constexpr int MISC_OFF = SCR_BYTES;
constexpr int LDS_BYTES = 147456;

#define GAS __attribute__((address_space(1)))
#define LAS __attribute__((address_space(3)))
typedef unsigned short bf16;
typedef unsigned v4u __attribute__((ext_vector_type(4)));
typedef unsigned v2u __attribute__((ext_vector_type(2)));
typedef float f32x4 __attribute__((ext_vector_type(4)));
#define LDS_WAIT() asm volatile("s_waitcnt lgkmcnt(0)" ::: "memory")
#define VM_WAIT() asm volatile("s_waitcnt vmcnt(0)" ::: "memory")
__device__ __forceinline__ unsigned pk2(float lo, float hi) { unsigned r; asm volatile("v_cvt_pk_bf16_f32 %0, %1, %2" : "=v"(r) : "v"(lo), "v"(hi)); return r; }
__device__ __forceinline__ float bf_lo(unsigned w) { return __uint_as_float(w << 16); }
__device__ __forceinline__ float bf_hi(unsigned w) { return __uint_as_float(w & 0xffff0000u); }
__device__ __forceinline__ float wave_sum(float v) {
    v += __builtin_bit_cast(float, __builtin_amdgcn_update_dpp(0, __builtin_bit_cast(int, v), 0xB1, 0xF, 0xF, false));
    v += __builtin_bit_cast(float, __builtin_amdgcn_update_dpp(0, __builtin_bit_cast(int, v), 0x4E, 0xF, 0xF, false));
    v += __builtin_bit_cast(float, __builtin_amdgcn_update_dpp(0, __builtin_bit_cast(int, v), 0x124, 0xF, 0xF, false));
    v += __builtin_bit_cast(float, __builtin_amdgcn_update_dpp(0, __builtin_bit_cast(int, v), 0x128, 0xF, 0xF, false));
    { auto a = __builtin_amdgcn_permlane16_swap(__float_as_uint(v), __float_as_uint(v), false, false); v = __uint_as_float(a[0]) + __uint_as_float(a[1]); }
    { auto b = __builtin_amdgcn_permlane32_swap(__float_as_uint(v), __float_as_uint(v), false, false); v = __uint_as_float(b[0]) + __uint_as_float(b[1]); }
    return v;
}

#define XB_TMO      128
#define XB_XCNT(j)  (256  + 64 * (j))
#define XB_XSUB(j)  (1280 + 64 * (j))
#define XB_XGEN(j)  (2304 + 64 * (j))
#define XB_TOP      3328
#define XB_TOPGEN   3392
#define XCD_BAR_WORDS 3456
#define XB_SPIN_CAP (1u << 18)

__device__ __forceinline__ unsigned xb_ld(unsigned* p)              { return __hip_atomic_load(p, __ATOMIC_RELAXED, __HIP_MEMORY_SCOPE_AGENT); }
__device__ __forceinline__ unsigned xb_add(unsigned* p, unsigned v) { return __hip_atomic_fetch_add(p, v, __ATOMIC_RELAXED, __HIP_MEMORY_SCOPE_AGENT); }
__device__ __forceinline__ unsigned xb_xcc_id() { return (unsigned)__builtin_amdgcn_s_getreg((3 << 11) | 20) & 0xFu; }
#define XB_SPIN(cond, bar) do { unsigned _sp = 0; while (cond) { __builtin_amdgcn_s_sleep(1); \
    if ((++_sp & 255u) == 0u) { if (xb_ld(&(bar)[XB_TMO])) break; if (_sp > XB_SPIN_CAP) { atomicAdd(&(bar)[XB_TMO], 1u); break; } } } } while (0)

struct XcdBarrier {
    unsigned* bar; unsigned x;
    volatile LAS unsigned* st;
};

__device__ __forceinline__ XcdBarrier xcd_barrier_post(unsigned* bar, volatile LAS unsigned* st) {
    XcdBarrier b; b.bar = bar; b.x = xb_xcc_id(); b.st = st;
    if (threadIdx.x == 0) (void)xb_add(&bar[XB_XCNT(b.x)], 1u);
    return b;
}
__device__ __forceinline__ void xcd_barrier_complete(unsigned* bar, unsigned x, unsigned& nloc, unsigned& nx) {
    const unsigned G = gridDim.x * gridDim.y * gridDim.z;
    unsigned sum, cnt, mine, sp = 0u;
    for (;;) {
        sum = 0u; cnt = 0u; mine = 0u;
#pragma unroll 1
        for (unsigned j = 0; j < 16; ++j) { const unsigned c = xb_ld(&bar[XB_XCNT(j)]); sum += c; cnt += (c > 0u) ? 1u : 0u; mine = (j == x) ? c : mine; }
        if (sum == G) break;
        __builtin_amdgcn_s_sleep(1);
        if ((++sp & 255u) == 0u) { if (xb_ld(&bar[XB_TMO])) break; if (sp > XB_SPIN_CAP) { atomicAdd(&bar[XB_TMO], 1u); break; } }
    }
    nloc = mine > 0u ? mine : 1u; nx = cnt > 0u ? cnt : 1u;
}

__device__ __forceinline__ void xcd_barrier(const XcdBarrier& b) {
    asm volatile("s_waitcnt vmcnt(0)" ::: "memory");
    __syncthreads();
    if (threadIdx.x == 0) {
        unsigned* bar = b.bar;
        __builtin_amdgcn_s_waitcnt(0);
        unsigned nloc = b.st[0], nx = b.st[1];
        if (nloc == 0u) { xcd_barrier_complete(bar, b.x, nloc, nx); b.st[0] = nloc; b.st[1] = nx; }
        const unsigned old = xb_add(&bar[XB_XSUB(b.x)], 1u);
        const unsigned gen = old / nloc;
        if (old + 1u == (gen + 1u) * nloc) {
            __builtin_amdgcn_fence(__ATOMIC_RELEASE, "agent");
            asm volatile("s_waitcnt vmcnt(0)" ::: "memory");
            const unsigned og = xb_add(&bar[XB_TOP], 1u);
            const unsigned tg = og / nx;
            if (og + 1u == (tg + 1u) * nx) xb_add(&bar[XB_TOPGEN], 1u);
            else XB_SPIN(xb_ld(&bar[XB_TOPGEN]) == tg, bar);
            __builtin_amdgcn_fence(__ATOMIC_ACQUIRE, "agent");
            xb_add(&bar[XB_XGEN(b.x)], 1u);
            asm volatile("s_waitcnt vmcnt(0)" ::: "memory");
        } else {
            XB_SPIN(xb_ld(&bar[XB_XGEN(b.x)]) == gen, bar);
            __builtin_amdgcn_fence(__ATOMIC_ACQUIRE, "agent");
            asm volatile("s_waitcnt vmcnt(0)" ::: "memory");
        }
    }
    __syncthreads();
}

#ifndef LN_NS
#define LN_NS 1
#endif
#ifndef W_MANT_DROP
#define W_MANT_DROP 0
#endif
#ifndef TPROBE_SCALE
#define TPROBE_SCALE 1.0f
#endif
#ifndef TPROBE
#define TPROBE 0
#endif
#ifndef TPROBE_WG
#define TPROBE_WG 0
#endif
#ifndef TPROBE_A
#define TPROBE_A 6
#endif
#ifndef TPROBE_B
#define TPROBE_B 7
#endif
#ifndef G1_SP2
#define G1_SP2 true
#endif
#ifndef DUP_BAR
#define DUP_BAR 0
#endif
#ifndef G1_ALIGN
#define G1_ALIGN true
#endif
#ifndef GF_ALIGN
#define GF_ALIGN true
#endif
#ifndef DUP_ATT_WHICH
#define DUP_ATT_WHICH 3
#endif
#ifndef DUP_P0
#define DUP_P0 0
#endif
#ifndef DUP_P1
#define DUP_P1 0
#endif
#ifndef DUP_P2
#define DUP_P2 0
#endif
#ifndef DUP_G1
#define DUP_G1 0
#endif
#ifndef DUP_WIN
#define DUP_WIN 0
#endif
#ifndef DUP_UQKV
#define DUP_UQKV 0
#endif
#ifndef DUP_ATT
#define DUP_ATT 0
#endif
#ifndef DUP_ONORM
#define DUP_ONORM 0
#endif
#ifndef DUP_GF
#define DUP_GF 0
#endif
#ifndef DUP_LN
#define DUP_LN 0
#endif
#define REP(n) for (int rep_ = 0; rep_ < 1 + (n); ++rep_)
#ifndef P0_PARTS
#define P0_PARTS 7
#endif
#ifndef BG_ON
#define BG_ON 1
#endif
#ifndef HL_BITS
#define HL_BITS 4
#endif
#ifndef BG_SITES
#define BG_SITES 31
#endif
#ifndef BG_XDONE
#define BG_XDONE 1
#endif
#ifndef SITE_P0
#define SITE_P0 1
#endif
#ifndef SITE_P1
#define SITE_P1 1
#endif
#ifndef SITE_P2
#define SITE_P2 1
#endif
#ifndef SITE_ATT
#define SITE_ATT 3
#endif
#ifndef SITE_ONORM
#define SITE_ONORM 1
#endif
#ifndef SITE_G1
#define SITE_G1 1
#endif
#ifndef SITE_WIN
#define SITE_WIN 1
#endif
#ifndef SITE_UQKV
#define SITE_UQKV 1
#endif
#ifndef SITE_GF
#define SITE_GF 1
#endif
#ifndef SITE_LN
#define SITE_LN 1
#endif
#ifndef DBG_LAST_S
#define DBG_LAST_S (3 * DEPTH - 1)
#endif

struct Frame {
    LAS unsigned char* lds;
    int tid, lane, wave;
    int vcu, G;
};

__device__ __forceinline__ int dst_row(int kind, int n) {
    if (kind == 1) { const int u = n >= FF ? 1 : 0, j = n - u * FF; return (j >> 7) * 256 + u * 128 + (j & 127); }
    if (kind == 2) { if (n < QLR + KVLR) return n; if (n < QLR + KVLR + ROPE_D) { const int j = n - (QLR + KVLR); return 4352 + (j < 32 ? 2 * j : 2 * (j - 32) + 1); } return n - ROPE_D; }
    if (kind == 3) { const int h = n / QKD, w = n - h * QKD; if (w < 128) return n; const int j = w - 128; return h * QKD + 128 + (j < 32 ? 2 * j : 2 * (j - 32) + 1); }
    return n;
}
__device__ __forceinline__ void tr_item(const float* __restrict__ W, int K, int N, bf16* __restrict__ WT, int kind, const float* __restrict__ gk, LAS float* scr, int item, int lane) {
    const int nblk = N >> 6, kb = item / nblk, nb = item - kb * nblk, k0 = kb << 6, n0 = nb << 6;
    const int kk4 = lane >> 4, n4 = (lane & 15) * 4;
    const float* src = W + (size_t)(k0 + kk4) * N + n0 + n4;
    f32x4 wv[16];
#pragma unroll
    for (int i = 0; i < 16; ++i) wv[i] = *(const f32x4*)(src + (size_t)(4 * i) * N);
    const float cs = (kind == 1 && SWIGLU_FOLD) ? (n0 < FF ? LOG2E : 1.0f / LOG2E) : 1.0f;
#pragma unroll
    for (int i = 0; i < 16; ++i) { const int kk = 4 * i + kk4; f32x4 w = wv[i]; if (gk) w = w * gk[k0 + kk]; if (kind == 1 && SWIGLU_FOLD) w = w * cs;
        LAS float* d = scr + kk * 65 + n4; d[0] = w[0]; d[1] = w[1]; d[2] = w[2]; d[3] = w[3]; }
    LDS_WAIT(); asm volatile("" ::: "memory");
    const int c = lane & 7;
#pragma unroll
    for (int j = 0; j < 8; ++j) { const int n = (lane >> 3) + 8 * j; const LAS float* s = scr + (8 * c) * 65 + n;
        v4u o; o.x = pk2(s[0 * 65], s[1 * 65]); o.y = pk2(s[2 * 65], s[3 * 65]); o.z = pk2(s[4 * 65], s[5 * 65]); o.w = pk2(s[6 * 65], s[7 * 65]);
#if W_MANT_DROP
        { const unsigned hb = (1u << (W_MANT_DROP - 1)) * 0x00010001u, mk = ~(((1u << W_MANT_DROP) - 1u) * 0x00010001u);
#pragma unroll
          for (int e = 0; e < 4; ++e) o[e] = (o[e] + hb) & mk; }
#endif
        *(v4u*)(WT + (size_t)dst_row(kind, n0 + n) * K + k0 + 8 * c) = o; }
    LDS_WAIT(); asm volatile("" ::: "memory");
}

struct Args { const float* in[19]; float* out; unsigned char* ws; int ph_lo, ph_hi; };
typedef const __attribute__((address_space(4))) Args CArgs;
__device__ __forceinline__ CArgs* fresh_args(CArgs* p) { asm volatile("" : "+s"(p)); return p; }
__device__ __forceinline__ Frame fresh_frame(Frame F) { asm volatile("" : "+v"(F.tid)); F.lane = F.tid & 63; return F; }
__constant__ float INVF[32] = {1.000000000e+00f, 7.498942614e-01f, 5.623413324e-01f, 4.216965139e-01f, 3.162277639e-01f, 2.371373773e-01f, 1.778279394e-01f, 1.333521307e-01f, 1.000000015e-01f, 7.498941571e-02f, 5.623413250e-02f, 4.216965288e-02f, 3.162277490e-02f, 2.371373773e-02f, 1.778279431e-02f, 1.333521493e-02f, 9.999999776e-03f, 7.498941850e-03f, 5.623413250e-03f, 4.216964822e-03f, 3.162277630e-03f, 2.371373586e-03f, 1.778279431e-03f, 1.333521446e-03f, 1.000000047e-03f, 7.498942432e-04f, 5.623413017e-04f, 4.216965172e-04f, 3.162277571e-04f, 2.371373703e-04f, 1.778279402e-04f, 1.333521504e-04f};

constexpr int I_WI = (D / 64) * (2 * FF / 64), I_WO = (FF / 64) * (D / 64), I_WIN = (D / 64) * (IN_COLS / 64), I_WUQ = (QLR / 64) * (NH * QKD / 64), I_WUKV = (KVLR / 64) * (NH * 256 / 64), I_WOUT = (D / 64) * (D / 64);
constexpr int I_LAYER = 2 * I_WI + 2 * I_WO + I_WIN + I_WUQ + I_WUKV + I_WOUT;
__device__ __forceinline__ void pack_item(const CArgs& a, int it, LAS float* scr, int lane) {
    const int l = it / I_LAYER; int r = it - l * I_LAYER;
    unsigned char* wl = a.ws + WS_W + (size_t)l * W_LAYER;
    const float* src; const float* gk = nullptr; int K_, N_, kind = 0; size_t dsto;
    if (r < I_WI) { src = a.in[7] + (size_t)l * D * 2 * FF; K_ = D; N_ = 2 * FF; dsto = WO_WI1; kind = 1; }
    else if ((r -= I_WI) < I_WO) { src = a.in[8] + (size_t)l * FF * D; K_ = FF; N_ = D; dsto = WO_WO1; }
    else if ((r -= I_WO) < I_WI) { src = a.in[17] + (size_t)l * D * 2 * FF; K_ = D; N_ = 2 * FF; dsto = WO_WI2; kind = 1; }
    else if ((r -= I_WI) < I_WO) { src = a.in[18] + (size_t)l * FF * D; K_ = FF; N_ = D; dsto = WO_WO2; }
    else if ((r -= I_WO) < I_WIN) { src = a.in[9] + (size_t)l * D * IN_COLS; K_ = D; N_ = IN_COLS; dsto = WO_WIN; kind = 2; }
    else if ((r -= I_WIN) < I_WUQ) { src = a.in[12] + (size_t)l * QLR * NH * QKD; K_ = QLR; N_ = NH * QKD; dsto = WO_WUQ; kind = 3; gk = a.in[10] + l * QLR; }
    else if ((r -= I_WUQ) < I_WUKV) { src = a.in[13] + (size_t)l * KVLR * NH * 256; K_ = KVLR; N_ = NH * 256; dsto = WO_WUKV; gk = a.in[11] + l * KVLR; }
    else { r -= I_WUKV; src = a.in[16] + (size_t)l * D * D; K_ = D; N_ = D; dsto = WO_WOUT;
           gk = (r / (D / 64)) < 16 ? a.in[14] + l * 1024 : a.in[15] + l * 1024 - 1024; }
    tr_item(src, K_, N_, (bf16*)(wl + dsto), kind, gk, scr, r, lane);
}

constexpr int CW_BGQ = 8192;
constexpr unsigned BG_TOTAL = (unsigned)(DEPTH - 1) * I_LAYER;
__device__ __forceinline__ unsigned rfl(unsigned v) { return (unsigned)__builtin_amdgcn_readfirstlane((int)v); }
__device__ __forceinline__ void bg_items(const Frame& F, const CArgs& a, unsigned base) {
    const unsigned q = base + (unsigned)F.wave;
    if (q < BG_TOTAL) pack_item(a, (int)(I_LAYER + q), (LAS float*)(F.lds + F.wave * 16640), F.lane);
}
__device__ __forceinline__ void bg_drain(const XcdBarrier& b, const Frame& F, const CArgs& a, unsigned limit) {
    unsigned* q = (unsigned*)(a.ws + WS_CTL) + CW_BGQ;
    if (F.tid == 0) b.st[5] = xb_ld(q);
    __syncthreads();
    const unsigned q0 = rfl(b.st[5]);
    __syncthreads();
    const unsigned gw = (unsigned)(F.vcu * NWAVES + F.wave), NGW = (unsigned)(F.G * NWAVES);
    LAS float* scr = (LAS float*)(F.lds + F.wave * 16640);
    for (unsigned it = q0 - q0 % NGW + gw; it < limit; it += NGW) if (it >= q0) pack_item(a, (int)(I_LAYER + it), scr, F.lane);
}
__device__ __forceinline__ void bg_bump(const CArgs& a, unsigned limit) {
    if (threadIdx.x == 0) (void)__hip_atomic_fetch_max((unsigned*)(a.ws + WS_CTL) + CW_BGQ, limit, __ATOMIC_RELAXED, __HIP_MEMORY_SCOPE_AGENT);
}
__device__ __forceinline__ void xcd_barrier_bg(const XcdBarrier& b, const Frame& F, const CArgs& a) {
    asm volatile("s_waitcnt vmcnt(0)" ::: "memory");
    __syncthreads();
    if (threadIdx.x == 0) {
        unsigned* bar = b.bar;
        __builtin_amdgcn_s_waitcnt(0);
        unsigned nloc = b.st[0], nx = b.st[1];
        if (nloc == 0u) { xcd_barrier_complete(bar, b.x, nloc, nx); b.st[0] = nloc; b.st[1] = nx; }
        const unsigned old = xb_add(&bar[XB_XSUB(b.x)], 1u);
        const unsigned gen = old / nloc;
        if (old + 1u == (gen + 1u) * nloc) {
            __builtin_amdgcn_fence(__ATOMIC_RELEASE, "agent");
            asm volatile("s_waitcnt vmcnt(0)" ::: "memory");
            const unsigned og = xb_add(&bar[XB_TOP], 1u);
            const unsigned tg = og / nx;
            if (og + 1u == (tg + 1u) * nx) xb_add(&bar[XB_TOPGEN], 1u);
            else XB_SPIN(xb_ld(&bar[XB_TOPGEN]) == tg, bar);
            __builtin_amdgcn_fence(__ATOMIC_ACQUIRE, "agent");
            xb_add(&bar[XB_XGEN(b.x)], 1u);
            asm volatile("s_waitcnt vmcnt(0)" ::: "memory");
            b.st[2] = 1u;
        } else { b.st[2] = 0u; b.st[3] = gen; }
    }
    __syncthreads();
    if (rfl(b.st[2]) == 0u) {
        const unsigned gen = rfl(b.st[3]);
        unsigned* q = (unsigned*)(a.ws + WS_CTL) + CW_BGQ;
        for (;;) {
            if (threadIdx.x == 0) { const unsigned rel = xb_ld(&b.bar[XB_XGEN(b.x)]) != gen ? 1u : 0u; unsigned base = 0xFFFFFFFFu;
                if (!rel) { const bool xdone = !BG_XDONE || xb_ld(&b.bar[XB_XSUB(b.x)]) >= (gen + 1u) * b.st[0];
                    if (xdone && xb_ld(q) < BG_TOTAL) base = xb_add(q, 8u); }
                b.st[4] = rel; b.st[5] = base; }
            __syncthreads();
            const unsigned rel = rfl(b.st[4]), base = rfl(b.st[5]);
            __syncthreads();
            if (rel) break;
            if (base < BG_TOTAL) bg_items(F, a, base);
            else __builtin_amdgcn_s_sleep(8);
        }
        if (threadIdx.x == 0) { __builtin_amdgcn_fence(__ATOMIC_ACQUIRE, "agent"); asm volatile("s_waitcnt vmcnt(0)" ::: "memory"); }
        __syncthreads();
    }
}

__device__ __forceinline__ void p0_prologue(const Frame& F, const CArgs& a) {
    unsigned char* ws = a.ws;
    const int gw = F.vcu * NWAVES + F.wave, NGW = F.G * NWAVES;
    const int gt = F.vcu * (NWAVES * 64) + F.tid, NGT = F.G * NWAVES * 64;
#if P0_PARTS & 1
    {
        LAS float* scr = (LAS float*)(F.lds + F.wave * 16640);
        for (int it = gw; it < (BG_ON ? I_LAYER : DEPTH * I_LAYER); it += NGW) pack_item(a, it, scr, F.lane);
        constexpr int PADV = (WIN_ROWS - IN_COLS) * D * 2 / 16;
        for (int i = gt; i < DEPTH * PADV; i += NGT) { const int l = i / PADV, r = i - l * PADV;
            *(v4u*)(ws + WS_W + (size_t)l * W_LAYER + WO_WIN + (size_t)IN_COLS * D * 2 + (size_t)r * 16) = (v4u){0u, 0u, 0u, 0u}; }
    }
#endif
#if P0_PARTS & 2
    {
        const int* pos = (const int*)a.in[2]; float* rope = (float*)(ws + WS_ROPE);
        for (int i = gt; i < M * 32; i += NGT) { const int row = i >> 5, j = i & 31;
            const float ang = (float)pos[row] * INVF[j];
            double rev = (double)ang * 0.15915494309189535; rev -= __builtin_floor(rev);
            const float fr = (float)rev;
            *(float2*)(rope + (size_t)i * 2) = make_float2(__builtin_amdgcn_cosf(fr), __builtin_amdgcn_sinf(fr)); }
    }
#endif
    __syncthreads();
#if P0_PARTS & 4
    {
        LAS f32x4* cact = (LAS f32x4*)F.lds;
        for (int k = F.tid; k < D; k += NWAVES * 64) { f32x4 v;
#pragma unroll
            for (int b = 0; b < 4; ++b) { const float cv = a.in[1][b * D + k]; v[b] = cv / (1.0f + __expf(-cv)); }
            cact[k] = v; }
        __syncthreads();
        constexpr int NCH = NADA * D / 256, KSL = D / ADA_KS;
        float* adap = (float*)(ws + WS_ADAP);
        for (int it = gw; it < DEPTH * NCH * ADA_KS; it += NGW) {
            const int ks = it % ADA_KS, r = it / ADA_KS, ch = r % NCH, l = r / NCH;
            const int n = ch * 256 + 4 * F.lane;
            const float* w = a.in[3] + ((size_t)l * D + (size_t)ks * KSL) * (NADA * D) + n;
            f32x4 acc[4];
#pragma unroll
            for (int b = 0; b < 4; ++b) acc[b] = (f32x4){0.f, 0.f, 0.f, 0.f};
            if (ks == 0) { const f32x4 bv = *(const f32x4*)(a.in[4] + (size_t)l * NADA * D + n);
#pragma unroll
                for (int b = 0; b < 4; ++b) acc[b] = bv; }
#pragma unroll 16
            for (int kk = 0; kk < KSL; ++kk) { const f32x4 wv = *(const f32x4*)(w + (size_t)kk * (NADA * D)); const f32x4 cv = cact[ks * KSL + kk];
#pragma unroll
                for (int b = 0; b < 4; ++b) acc[b] += wv * cv[b]; }
#pragma unroll
            for (int b = 0; b < 4; ++b) *(f32x4*)(adap + (((size_t)ks * DEPTH + l) * BATCH + b) * (NADA * D) + n) = acc[b];
        }
    }
#endif
}
__device__ __forceinline__ void p1_ada_reduce(const Frame& F, const CArgs& a) {
    const int gt = F.vcu * (NWAVES * 64) + F.tid, NGT = F.G * NWAVES * 64;
    const f32x4* adap = (const f32x4*)(a.ws + WS_ADAP); f32x4* ada = (f32x4*)(a.ws + WS_ADA);
    constexpr int NV = DEPTH * BATCH * NADA * D / 4;
    for (int i = gt; i < NV; i += NGT) { f32x4 s = adap[i];
#pragma unroll
        for (int ks = 1; ks < ADA_KS; ++ks) s += adap[(size_t)ks * NV + i];
        ada[i] = s; }
}
__device__ __forceinline__ void p2_modulate0(const Frame& F, const CArgs& a) {
    const int gw = F.vcu * NWAVES + F.wave, NGW = F.G * NWAVES;
    const float* ada = (const float*)(a.ws + WS_ADA); bf16* H = (bf16*)(a.ws + WS_H);
    for (int row = gw; row < M; row += NGW) { const int b = row >> 12;
        const float* sh = ada + (size_t)b * NADA * D, * sc = sh + D;
#pragma unroll
        for (int j = 0; j < 8; ++j) { const int idx = 4 * (F.lane + 64 * j);
            const f32x4 xv = *(const f32x4*)(a.in[0] + (size_t)row * D + idx), s1 = *(const f32x4*)(sc + idx), s0 = *(const f32x4*)(sh + idx);
            const f32x4 h = xv * (s1 + 1.0f) + s0;
            *(v2u*)(H + (size_t)row * D + idx) = (v2u){pk2(h[0], h[1]), pk2(h[2], h[3])}; } }
}
__device__ __forceinline__ void vec_prep(const Frame& F, const CArgs& a) {
    const int gt = F.vcu * (NWAVES * 64) + F.tid, NGT = F.G * NWAVES * 64;
    const float* ada = (const float*)(a.ws + WS_ADA); float* vec = (float*)(a.ws + WS_VEC);
    for (int i = gt; i < 3 * DEPTH * BATCH * D; i += NGT) { const int d = i % D, sb = i / D, b = sb % BATCH, s = sb / BATCH, l = s / 3, j = s - 3 * l;
        const float* ad = ada + ((size_t)l * BATCH + b) * NADA * D + d;
        const float sh = ad[(3 * j) * D], sc = ad[(3 * j + 1) * D], gt_ = ad[(3 * j + 2) * D];
        const float lg = a.in[5][(size_t)(l * 3 + j) * D + d], lb = a.in[6][(size_t)(l * 3 + j) * D + d];
        float P = DN_ALPHA, Q = 0.f; if (s != 0) { P = DN_ALPHA / (1.0f + sc); Q = -P * sh; }
        float U = lg, W = lb;
        if (s != 3 * DEPTH - 1) { const int s1 = s + 1, l1 = s1 / 3, j1 = s1 - 3 * l1; const float* an = ada + ((size_t)l1 * BATCH + b) * NADA * D + d;
            const float nsh = an[(3 * j1) * D], nsc = an[(3 * j1 + 1) * D]; U = lg * (1.0f + nsc); W = lb * (1.0f + nsc) + nsh; }
        float* o = vec + (size_t)sb * 5 * D + d;
        o[0] = P; o[D] = Q; o[2 * D] = (j == 1 ? 1.0f : 0.5f) * (1.0f + gt_); o[3 * D] = U; o[4 * D] = W; }
}
__device__ __forceinline__ unsigned hl_enc(float h, unsigned hb) { const int d = (int)(__float_as_uint(h) - hb); int q = (d + 0x80) >> 8; q = q > 127 ? 127 : q; return (unsigned)q & 0xffu; }
__device__ __forceinline__ float hl_dec(unsigned hb, unsigned byte) { const int q = (int)(signed char)(byte & 0xffu); return __uint_as_float(hb + (unsigned)(q * 256)); }
__device__ __forceinline__ unsigned hl_enc4(float h, unsigned hb) { const int d = (int)(__float_as_uint(h) - hb); int q = (d + 0x800) >> 12; q = q > 7 ? 7 : q; return (unsigned)q & 0xfu; }
__device__ __forceinline__ float hl_dec4(unsigned hb, unsigned w, int k) { const int q = __builtin_amdgcn_sbfe((int)w, 4 * k, 4); return __uint_as_float(hb + (unsigned)(q * 4096)); }
template <bool FIRST>
__device__ __forceinline__ void ln_phase(const Frame& F, const bf16* H, const unsigned char* L, bf16* HO, unsigned char* LO, const bf16* f, const float* vecs  , const float* X32, float* OUT32) {
    const int gw = F.vcu * NWAVES + F.wave, NGW = F.G * NWAVES;
    constexpr int RPW = 8;
    int tid0_ = threadIdx.x; asm volatile("" : "+v"(tid0_)); const int Flane = tid0_ & 63, Ftid = tid0_;
    LAS f32x4* lv = (LAS f32x4*)F.lds;
    int staged_b = -1;
    for (int r0 = gw * RPW; r0 < M; r0 += NGW * RPW) { const int b = r0 >> 12;
        if (b != staged_b) {
            if (staged_b >= 0) __syncthreads();
            const f32x4* src = (const f32x4*)(vecs + (size_t)b * 5 * D);
            int t_ = Ftid; asm volatile("" : "+v"(t_));
#pragma unroll
            for (int i = 0; i < 5; ++i) { const int q = t_ + 512 * i, vec = q >> 9, e = (q & 511) * 4, j = e >> 9, ln = (e & 511) >> 3, half = (e >> 2) & 1;
                lv[((vec * 4 + j) * 2 + half) * 64 + ln] = src[q]; }
            __syncthreads(); staged_b = b; }
        constexpr int NS = FIRST ? 1 : LN_NS;
        v4u hq2[NS][4], fq2[NS][4]; v2u lq2[NS][4]; f32x4 xq2[NS][8];
#define LN_LOAD(row_, S_) do { _Pragma("unroll") for (int j = 0; j < 4; ++j) { const int idx = 8 * (Flane + 64 * j);                                     \
            fq2[S_][j] = *(const v4u*)(f + (size_t)(row_) * D + idx);                                                                                          \
            if (FIRST) { xq2[S_][2 * j] = *(const f32x4*)(X32 + (size_t)(row_) * D + idx); xq2[S_][2 * j + 1] = *(const f32x4*)(X32 + (size_t)(row_) * D + idx + 4); } \
            else { hq2[S_][j] = *(const v4u*)(H + (size_t)(row_) * D + idx); if (HL_BITS == 4) lq2[S_][j][0] = *(const unsigned*)(L + (size_t)(row_) * (D / 2) + idx / 2); else lq2[S_][j] = *(const v2u*)(L + (size_t)(row_) * D + idx); } } } while (0)
        LN_LOAD(r0, 0); if (NS == 2) LN_LOAD(r0 + 1, NS - 1);
#pragma unroll
        for (int i = 0; i < RPW; ++i) { const int row = r0 + i;
            v4u (&hq)[4] = hq2[i % NS]; v4u (&fq)[4] = fq2[i % NS]; v2u (&lq)[4] = lq2[i % NS]; f32x4 (&xq)[8] = xq2[i % NS];
            int ln_ = Flane; asm volatile("" : "+v"(ln_));
            float v[32]; float s = 0.f;
#pragma unroll
            for (int j = 0; j < 4; ++j) {
                const f32x4 p0 = lv[((0 * 4 + j) * 2 + 0) * 64 + ln_], p1 = lv[((0 * 4 + j) * 2 + 1) * 64 + ln_], q0 = lv[((1 * 4 + j) * 2 + 0) * 64 + ln_], q1 = lv[((1 * 4 + j) * 2 + 1) * 64 + ln_], c0 = lv[((2 * 4 + j) * 2 + 0) * 64 + ln_], c1 = lv[((2 * 4 + j) * 2 + 1) * 64 + ln_];
#pragma unroll
                for (int e = 0; e < 4; ++e) { const float fl = bf_lo(fq[j][e]), fh = bf_hi(fq[j][e]);
                    const float xl = FIRST ? xq[2 * j + (e >> 1)][(e & 1) * 2] : HL_BITS == 4 ? hl_dec4(hq[j][e] << 16, lq[j][0], 2 * e) : hl_dec(hq[j][e] << 16, lq[j][e >> 1] >> (16 * (e & 1))), xh = FIRST ? xq[2 * j + (e >> 1)][(e & 1) * 2 + 1] : HL_BITS == 4 ? hl_dec4(hq[j][e] & 0xffff0000u, lq[j][0], 2 * e + 1) : hl_dec(hq[j][e] & 0xffff0000u, lq[j][e >> 1] >> (16 * (e & 1) + 8));
                    const float pl = e < 2 ? p0[2 * e] : p1[2 * e - 4], ph_ = e < 2 ? p0[2 * e + 1] : p1[2 * e - 3], ql = e < 2 ? q0[2 * e] : q1[2 * e - 4], qh = e < 2 ? q0[2 * e + 1] : q1[2 * e - 3], cl = e < 2 ? c0[2 * e] : c1[2 * e - 4], ch = e < 2 ? c0[2 * e + 1] : c1[2 * e - 3];
                    const float vl = pl * xl + ql + cl * fl, vh = ph_ * xh + qh + ch * fh; v[8 * j + 2 * e] = vl; v[8 * j + 2 * e + 1] = vh; s += vl + vh; } }
            if (i + NS < RPW) LN_LOAD(row + NS, i % NS);
            const float mean = wave_sum(s) * (1.0f / D); float s2 = 0.f;
#pragma unroll
            for (int k = 0; k < 32; ++k) { v[k] -= mean; s2 += v[k] * v[k]; }
            const float rstd = 1.0f / sqrtf(wave_sum(s2) * (1.0f / D) + LN_EPS);
#pragma unroll
            for (int j = 0; j < 4; ++j) { const int idx = 8 * (ln_ + 64 * j);
                const f32x4 u0 = lv[((3 * 4 + j) * 2 + 0) * 64 + ln_], u1 = lv[((3 * 4 + j) * 2 + 1) * 64 + ln_], w0 = lv[((4 * 4 + j) * 2 + 0) * 64 + ln_], w1 = lv[((4 * 4 + j) * 2 + 1) * 64 + ln_];
                float o[8];
#pragma unroll
                for (int e = 0; e < 8; ++e) o[e] = v[8 * j + e] * rstd * (e < 4 ? u0[e] : u1[e - 4]) + (e < 4 ? w0[e] : w1[e - 4]);
                if (OUT32) { *(f32x4*)(OUT32 + (size_t)row * D + idx) = (f32x4){o[0], o[1], o[2], o[3]}; *(f32x4*)(OUT32 + (size_t)row * D + idx + 4) = (f32x4){o[4], o[5], o[6], o[7]}; }
                else { v4u hw; v2u lw = {0u, 0u};
#pragma unroll
                    for (int e = 0; e < 4; ++e) { hw[e] = pk2(o[2 * e], o[2 * e + 1]);
                        if (HL_BITS == 4) lw[0] |= (hl_enc4(o[2 * e], hw[e] << 16) | (hl_enc4(o[2 * e + 1], hw[e] & 0xffff0000u) << 4)) << (8 * e);
                        else lw[e >> 1] |= (hl_enc(o[2 * e], hw[e] << 16) | (hl_enc(o[2 * e + 1], hw[e] & 0xffff0000u) << 8)) << (16 * (e & 1)); }
                    *(v4u*)(HO + (size_t)row * D + idx) = hw; if (HL_BITS == 4) *(unsigned*)(LO + (size_t)row * (D / 2) + idx / 2) = lw[0]; else *(v2u*)(LO + (size_t)row * D + idx) = lw; } } }
#undef LN_LOAD
    }
    __syncthreads();
}
__device__ __forceinline__ void attn_phase(const Frame& F, const CArgs& a, int which) {
    unsigned char* ws = a.ws;
    const bf16* QM = (const bf16*)(ws + WS_QM); const bf16* KV = (const bf16*)(ws + WS_KV); const bf16* KPE = (const bf16*)(ws + WS_KPE);
    const bf16* SBQ = (const bf16*)(ws + WS_SBQ); const bf16* SBK = (const bf16*)(ws + WS_SBK); const bf16* SBV = (const bf16*)(ws + WS_SBV);
    bf16* O = (bf16*)(ws + WS_O); float* OSSQ = (float*)(ws + WS_OSSQ);
    constexpr int NQB = SEQ / 256, NPAIR = NQB / 2, NITEM = BATCH * NH * NPAIR;
    for (int it = F.vcu; it < NITEM; it += F.G) {
        const int bh = it / NPAIR, x = it - bh * NPAIR, b = bh / NH, h = bh - b * NH;
        const size_t r0 = (size_t)b * SEQ;
#if SITE_ATT & 1
#pragma unroll 1
        for (int pass = 0; pass < ((which & 1) ? 2 : 0); ++pass) { const int qb = pass ? NQB - 1 - x : x; const size_t rq = r0 + (size_t)qb * 256;
            att::attn_block<false>(F.lds, QM + rq * (NH * QKD) + h * QKD, NH * QKD, KV + r0 * D + h * 256, D, KV + r0 * D + h * 256 + 128, D, KPE + r0 * 64, O + rq * D + h * HD, D, OSSQ + rq * 16 + h, qb * 256); }
#endif
#if SITE_ATT & 2
#pragma unroll 1
        for (int pass = 0; pass < ((which & 2) ? 2 : 0); ++pass) { const int qb = pass ? NQB - 1 - x : x; const size_t rq = r0 + (size_t)qb * 256;
            att::attn_block<true>(F.lds, SBQ + rq * 1024 + h * HD, 1024, SBK + r0 * 1024 + h * HD, 1024, SBV + r0 * 1024 + h * HD, 1024, nullptr, O + rq * D + 1024 + h * HD, D, OSSQ + rq * 16 + 8 + h, qb * 256); }
#endif
    }
}

__global__ void __launch_bounds__(NWAVES * 64, 2) mk_fwd(Args args_unused) {
    extern __shared__ __attribute__((aligned(16))) unsigned char lds[];
    (void)args_unused;
    CArgs* ap = (CArgs*)__builtin_amdgcn_kernarg_segment_ptr();
    Frame F;
    F.lds = (LAS unsigned char*)lds;
    F.tid = threadIdx.x; F.lane = F.tid & 63; F.wave = __builtin_amdgcn_readfirstlane(F.tid >> 6);
    F.G = gridDim.x; { const int bx = blockIdx.x; F.vcu = (F.G % 8 == 0) ? (bx % 8) * (F.G / 8) + bx / 8 : bx; }
    volatile LAS unsigned* MISC = (volatile LAS unsigned*)(F.lds + MISC_OFF);
    for (int u = F.tid; u < (LDS_BYTES - MISC_OFF) / 4; u += NWAVES * 64) ((LAS unsigned*)(F.lds + MISC_OFF))[u] = 0u;
    __syncthreads();
    XcdBarrier bar; bar.bar = (unsigned*)(ap->ws + WS_CTL) + CW_BAR; bar.x = 0; bar.st = nullptr;
    if (MK_ONE_LAUNCH) bar = xcd_barrier_post((unsigned*)(ap->ws + WS_CTL) + CW_BAR, MISC + 8);
    const int lo = ap->ph_lo, hi = ap->ph_hi; int ph = 0; bool fin_ = false;
#define RUN_PH (ph >= lo && ph < hi)
#if TPROBE
#define TP_BASE ((unsigned long long*)(fresh_args(ap)->ws + WS_CTL + 524288))
#define TP_BEGIN(k) do { if (blockIdx.x == TPROBE_WG && threadIdx.x == 0) { unsigned long long* tp = TP_BASE; tp[30] = __builtin_amdgcn_s_memrealtime(); int kk_ = (k); asm volatile("" : "+s"(kk_)); ((unsigned*)tp)[64] = (unsigned)kk_; } } while (0)
#define TP_MID do { if (blockIdx.x == TPROBE_WG && threadIdx.x == 0) { asm volatile("s_waitcnt vmcnt(0)" ::: "memory"); TP_BASE[31] = __builtin_amdgcn_s_memrealtime(); } } while (0)
#define TP_END do { if (blockIdx.x == TPROBE_WG && threadIdx.x == 0) { unsigned long long* tp = TP_BASE; const unsigned long long t2 = __builtin_amdgcn_s_memrealtime(), t0 = tp[30], t1 = tp[31]; const int k = (int)((unsigned*)tp)[64]; tp[2 * k] += t1 - t0; tp[2 * k + 1] += t2 - t1; } } while (0)
#else
#define TP_BEGIN(k) do { } while (0)
#define TP_MID do { } while (0)
#define TP_END do { } while (0)
#endif
#define END_PH do { TP_MID; if (MK_ONE_LAUNCH && RUN_PH && ph + 1 < hi && !fin_) { xcd_barrier(bar); for (int xb_ = 0; xb_ < DUP_BAR; ++xb_) xcd_barrier(bar); } TP_END; ++ph; } while (0)
#define END_PH_BG(bit) do { TP_MID; if (MK_ONE_LAUNCH && RUN_PH && ph + 1 < hi && !fin_) { if (BG_ON && (BG_SITES & (bit))) xcd_barrier_bg(bar, fresh_frame(F), *fresh_args(ap)); else xcd_barrier(bar); for (int xb_ = 0; xb_ < DUP_BAR; ++xb_) xcd_barrier(bar); } TP_END; ++ph; } while (0)
#define WSP(T, off) ((T*)(A->ws + (off)))

REP(DUP_P0) { TP_BEGIN(0);
#if SITE_P0
    if (RUN_PH) p0_prologue(fresh_frame(F), *fresh_args(ap));
#endif
    END_PH; }
REP(DUP_P1) { TP_BEGIN(1);
#if SITE_P1
    if (RUN_PH) p1_ada_reduce(fresh_frame(F), *fresh_args(ap));
#endif
    END_PH; }
REP(DUP_P2) { TP_BEGIN(2);
#if SITE_P2
    if (RUN_PH) { p2_modulate0(fresh_frame(F), *fresh_args(ap)); vec_prep(fresh_frame(F), *fresh_args(ap)); }
#endif
    END_PH; }

#pragma unroll 1
    for (int s = 0; s <= DBG_LAST_S; ++s) {
        const int l = s / 3, j = s - 3 * l;
        if (j != 1) {
REP(DUP_G1) { TP_BEGIN(3);
#if SITE_G1
            if (RUN_PH) { CArgs* A = fresh_args(ap); const unsigned char* wl = A->ws + WS_W + (size_t)l * W_LAYER;
                pg8::Gemm g{WSP(const bf16, WS_H), (const bf16*)(wl + (j == 0 ? WO_WI1 : WO_WI2)), M, 2 * FF, D}; pg8::StaticOrder S; S.init(M, 2 * FF, F.G, (int)blockIdx.x);
                pg8::EpiSwiGLU E{WSP(bf16, WS_ACT), FF};
                pg8::gemm_phase<pg8::EpiSwiGLU, pg8::StaticOrder, G1_ALIGN, G1_SP2>(F.lds + RING_OFF, g, S, E);
            }
#endif
            END_PH_BG(1); }
        } else {
REP(DUP_WIN) { TP_BEGIN(4);
#if SITE_WIN
            if (RUN_PH) { CArgs* A = fresh_args(ap); const unsigned char* wl = A->ws + WS_W + (size_t)l * W_LAYER;
                pg8::Gemm g{WSP(const bf16, WS_H), (const bf16*)(wl + WO_WIN), M, WIN_ROWS, D}; pg8::WinOrder S; S.init(M, 16 * 256, F.G, (int)blockIdx.x);
                pg8::EpiWin E{WSP(bf16, WS_CQ), WSP(bf16, WS_CKV), WSP(bf16, WS_SBQ), WSP(bf16, WS_SBK), WSP(bf16, WS_SBV), WSP(bf16, WS_KPE), WSP(float, WS_SSQ), WSP(const float, WS_ROPE), SB_QSCALE};
                pg8::gemm_phase<pg8::EpiWin, pg8::WinOrder, true, true>(F.lds + RING_OFF, g, S, E);
            }
#endif
            END_PH_BG(2); }
REP(DUP_UQKV) { TP_BEGIN(5);
#if SITE_UQKV
            if (RUN_PH) {
                const int c = (int)blockIdx.x, G = F.G; const bool bal = G == 256; const bool grpA = ((c >> 3) & 1) == 0; const int gi = ((c >> 4) << 3) | (c & 7);
                pg8::ListOrder Swt, Suq, Sukv;
                if (bal) { Swt = pg8::ListOrder{gi, grpA ? 1 : 0, 1, 15}; Suq = grpA ? pg8::ListOrder{gi, 1, 1, 0} : pg8::ListOrder{128 + 2 * gi, 2, 1, 0}; Sukv = grpA ? pg8::ListOrder{gi, 1, 1, 0} : pg8::ListOrder{128 + 3 * gi, 3, 1, 0}; }
                else { Swt = pg8::ListOrder{c, c < 128 ? (128 - c + G - 1) / G : 0, G, 15}; Suq = pg8::ListOrder{c, c < 384 ? (384 - c + G - 1) / G : 0, G, 0}; Sukv = pg8::ListOrder{c, c < 512 ? (512 - c + G - 1) / G : 0, G, 0}; }
                { CArgs* A = fresh_args(ap); const unsigned char* wl = A->ws + WS_W + (size_t)l * W_LAYER;
                  pg8::Gemm g{WSP(const bf16, WS_H), (const bf16*)(wl + WO_WIN), M, WIN_ROWS, D};
                  pg8::EpiWin E{WSP(bf16, WS_CQ), WSP(bf16, WS_CKV), WSP(bf16, WS_SBQ), WSP(bf16, WS_SBK), WSP(bf16, WS_SBV), WSP(bf16, WS_KPE), WSP(float, WS_SSQ), WSP(const float, WS_ROPE), SB_QSCALE};
                  pg8::gemm_phase<pg8::EpiWin, pg8::ListOrder, true, true>(F.lds + RING_OFF, g, Swt, E); }
                { CArgs* A = fresh_args(ap); const unsigned char* wl = A->ws + WS_W + (size_t)l * W_LAYER;
                  pg8::Gemm g{WSP(const bf16, WS_CQ), (const bf16*)(wl + WO_WUQ), M, NH * QKD, QLR};
                  pg8::EpiRS<true> E{WSP(bf16, WS_QM), NH * QKD, WSP(const float, WS_SSQ), 0, 3, 1.0f / QLR, RMS_EPS, MLA_QSCALE, WSP(const float, WS_ROPE)};
                  pg8::gemm_phase<pg8::EpiRS<true>, pg8::ListOrder, true, true>(F.lds + RING_OFF, g, Suq, E); }
                { CArgs* A = fresh_args(ap); const unsigned char* wl = A->ws + WS_W + (size_t)l * W_LAYER;
                  pg8::Gemm g{WSP(const bf16, WS_CKV), (const bf16*)(wl + WO_WUKV), M, NH * 256, KVLR};
                  pg8::EpiRS<false> E{WSP(bf16, WS_KV), NH * 256, WSP(const float, WS_SSQ), 3, 2, 1.0f / KVLR, RMS_EPS, 1.0f, nullptr};
                  pg8::gemm_phase<pg8::EpiRS<false>, pg8::ListOrder, true, true>(F.lds + RING_OFF, g, Sukv, E); }
            }
#endif
            END_PH_BG(4); }
REP(DUP_ATT) { TP_BEGIN(6);
#if SITE_ATT
            if (RUN_PH) attn_phase(fresh_frame(F), *fresh_args(ap), rep_ == 0 ? 3 : DUP_ATT_WHICH);
#endif
            END_PH_BG(8); }
        }
REP(DUP_GF) { TP_BEGIN(8);
#if SITE_GF
        if (RUN_PH) { CArgs* A = fresh_args(ap); const unsigned char* wl = A->ws + WS_W + (size_t)l * W_LAYER;
            if (j != 1) { pg8::Gemm g{WSP(const bf16, WS_ACT), (const bf16*)(wl + (j == 0 ? WO_WO1 : WO_WO2)), M, D, FF}; pg8::StaticOrder S; S.init(M, D, F.G, (int)blockIdx.x);
                pg8::EpiPlain E{WSP(bf16, WS_F), D};
                pg8::gemm_phase<pg8::EpiPlain, pg8::StaticOrder, GF_ALIGN, G1_SP2>(F.lds + RING_OFF, g, S, E); }
            else { pg8::Gemm g{WSP(const bf16, WS_O), (const bf16*)(wl + WO_WOUT), M, D, D}; pg8::StaticOrder S; S.init(M, D, F.G, (int)blockIdx.x);
                pg8::EpiMixOut E{WSP(bf16, WS_F), D, WSP(const float, WS_OSSQ), 16, 1.0f / 1024.0f, RMS_EPS, nullptr, 0};
                { pg8::Unit u0, u1; const bool h0 = S.next(0, u0), h1 = S.next(1, u1);
                  PG8_LAS float* scw = (PG8_LAS float*)(F.lds + 131072); int t_ = (int)threadIdx.x; asm volatile("" : "+v"(t_));
                  if (h0) { E.prep(u0, 0, scw, t_); E.pm0 = u0.pm; } if (h1) E.prep(u1, 1, scw, t_); E.sc = scw; }
                pg8::gemm_phase<pg8::EpiMixOut, pg8::StaticOrder, GF_ALIGN, G1_SP2>(F.lds + RING_OFF, g, S, E); }
        }
#endif
        END_PH_BG(16); }
REP(DUP_LN) { TP_BEGIN(9);
#if SITE_LN
        fin_ = (s == DBG_LAST_S) && (rep_ == DUP_LN);
        if (RUN_PH) { CArgs* A = fresh_args(ap); const bool last = s == DBG_LAST_S; const bool dummy = DUP_LN && rep_ == 0;
            bf16* HO = dummy ? WSP(bf16, WS_DUMMY) : WSP(bf16, WS_H); unsigned char* LO = dummy ? WSP(unsigned char, WS_DUMMY + 64 * MiB) : WSP(unsigned char, WS_HL);
            if (s == 0) ln_phase<true>(F, WSP(const bf16, WS_H), WSP(const unsigned char, WS_HL), HO, LO, WSP(const bf16, WS_F), WSP(const float, WS_VEC), A->in[0], last ? A->out : nullptr);
            else ln_phase<false>(F, WSP(const bf16, WS_H), WSP(const unsigned char, WS_HL), HO, LO, WSP(const bf16, WS_F), WSP(const float, WS_VEC) + (size_t)s * BATCH * 5 * D, nullptr, last ? A->out : nullptr);
        }
#endif
        if (BG_ON && MK_ONE_LAUNCH && RUN_PH && j == 2 && l + 1 < DEPTH) bg_drain(bar, fresh_frame(F), *fresh_args(ap), (unsigned)(l + 1) * I_LAYER);
        END_PH;
        if (BG_ON && MK_ONE_LAUNCH && j == 2 && l + 1 < DEPTH) bg_bump(*fresh_args(ap), (unsigned)(l + 1) * I_LAYER); }
    }
#if TPROBE
    xcd_barrier(bar);
    { CArgs* A = fresh_args(ap); const unsigned long long* tp = (const unsigned long long*)(A->ws + WS_CTL + 524288); const float dall = 0.f * (float)tp[TPROBE_B], done_ = (TPROBE_A == 99 ? (float)(tp[1] + tp[3] + tp[5] + tp[7] + tp[9] + tp[11] + tp[13] + tp[15] + tp[17] + tp[19]) : (float)(tp[TPROBE_A] + tp[TPROBE_B])) * 1e-5f * TPROBE_SCALE;
      float* o = A->out; const int gt = (int)blockIdx.x * 512 + (int)threadIdx.x;
      for (int i = gt; i < M * D / 4; i += (int)gridDim.x * 512) { f32x4 v = *(f32x4*)(o + (size_t)i * 4); v = v + dall; if (i == 0) v[0] += done_; *(f32x4*)(o + (size_t)i * 4) = v; } }
#endif
#undef RUN_PH
#undef END_PH
#undef WSP
}

extern "C" void kernel_launch(void* const* d_in, const int* in_sizes, int n_in, void* d_out, int out_size, void* d_ws, size_t ws_size, hipStream_t stream) {
    static int grid = 0;
    if (grid == 0) {
        if (n_in != 19 || in_sizes[0] != M * D || out_size != M * D || ws_size < WS_END) { fprintf(stderr, "kernel_launch: unexpected shapes (n_in %d, in0 %d, out %d, ws %zu < %zu); nothing launched\n", n_in, n_in > 0 ? in_sizes[0] : -1, out_size, ws_size, (size_t)WS_END); grid = -1; return; }
        int dev = 0, cus = 0, per_cu = 0;
        if (hipGetDevice(&dev) != hipSuccess || hipDeviceGetAttribute(&cus, hipDeviceAttributeMultiprocessorCount, dev) != hipSuccess) { grid = -1; return; }
        if (hipFuncSetAttribute((const void*)mk_fwd, hipFuncAttributeMaxDynamicSharedMemorySize, LDS_BYTES) != hipSuccess) { fprintf(stderr, "kernel_launch: hipFuncSetAttribute failed\n"); grid = -1; return; }
        if (hipOccupancyMaxActiveBlocksPerMultiprocessor(&per_cu, (const void*)mk_fwd, NWAVES * 64, LDS_BYTES) != hipSuccess || per_cu < 1)
            fprintf(stderr, "kernel_launch: note: occupancy query reports %d workgroups per CU\n", per_cu);
        (void)hipGetLastError();
        grid = cus;
        if (grid * 2 < (M / 256) * (D / 256)) { fprintf(stderr, "kernel_launch: %d CUs: the mixer output projection keeps two units' row scales per workgroup and needs at least %d workgroups; nothing launched\n", cus, (M / 256) * (D / 256) / 2); grid = -1; return; }
    }
    if (grid < 0) return;
    if (hipMemsetAsync((char*)d_ws + WS_CTL, 0, CTL_ZERO_BYTES, stream) != hipSuccess) { fprintf(stderr, "kernel_launch: hipMemsetAsync failed\n"); return; }
    Args a{};
    for (int i = 0; i < 19; ++i) a.in[i] = (const float*)d_in[i];
    a.out = (float*)d_out; a.ws = (unsigned char*)d_ws;
#if MK_ONE_LAUNCH
    a.ph_lo = 0; a.ph_hi = 1 << 20;
    hipLaunchKernelGGL(mk_fwd, dim3(grid), dim3(NWAVES * 64), LDS_BYTES, stream, a);
#else
    for (int p = 0; p < N_PHASES; ++p) { a.ph_lo = p; a.ph_hi = p + 1; hipLaunchKernelGGL(mk_fwd, dim3(grid), dim3(NWAVES * 64), LDS_BYTES, stream, a); }
#endif
}
```
